# Optimizing an MI355X kernel written in HIP

```python
import math
import jax, jax.numpy as jnp
from jax import lax
import numpy as np

D_MODEL = 1024
BATCH = 32
SEQ = 256
DEPTH = 2
DEC_BATCH = 2
DEC_SEQ = 2048
PAST_LEN = 512

GRID_W = 64
D_MIX = D_MODEL
D_POOL = D_MIX // 4
D_SSM = D_MIX // 4
D_ATTN = D_MIX // 4
D_CHUNK = D_MIX // 4
POOL_WINDOWS = (2, 4, 8, 16)
POOL_GROUP = D_POOL // len(POOL_WINDOWS)
SSM_GROUP = 16
N_SSM_GROUPS = D_SSM // SSM_GROUP
SSM_STATE = 64
HEAD_DIM = 64
N_HEADS = D_ATTN // HEAD_DIM
N_KV_HEADS = 2
D_KV = N_KV_HEADS * HEAD_DIM
Q_BLOCK = 128
CHUNK = 128
N_CHUNK_HEADS = 4
CHUNK_GROUP = D_CHUNK // N_CHUNK_HEADS
D_FF = 2816
N_MOD = 9
D_IN = D_POOL + D_SSM + D_ATTN + 2 * D_KV + 2 * D_CHUNK
IN_SPLITS = (D_POOL, D_POOL + D_SSM, D_POOL + D_SSM + D_ATTN,
             D_POOL + D_SSM + D_ATTN + D_KV, D_POOL + D_SSM + D_ATTN + 2 * D_KV)
ALPHA = (2 * DEPTH) ** 0.25
BETA = (8 * DEPTH) ** -0.25
LN_EPS = 1e-5
RMS_EPS = 1e-6
ROPE_THETA = 10000.0

kernel_name = 'hybrid_diffusion_prefix_step'


def layer_norm(x, g, b):
    xf = x.astype(jnp.float32)
    mu = jnp.mean(xf, axis=-1, keepdims=True)
    var = jnp.mean(jnp.square(xf - mu), axis=-1, keepdims=True)
    return ((xf - mu) * lax.rsqrt(var + LN_EPS)).astype(x.dtype) * g + b


def rms_norm(x, g):
    xf = x.astype(jnp.float32)
    return (xf * lax.rsqrt(jnp.mean(jnp.square(xf), axis=-1, keepdims=True) + RMS_EPS)).astype(x.dtype) * g


def swiglu(h, w1, w2):
    g, u = jnp.split(h @ w1, 2, axis=-1)
    return (jax.nn.silu(g) * u) @ w2


def axial_rope_tables(n_tok):
    rows = n_tok // GRID_W
    row_idx = jnp.repeat(jnp.arange(rows), GRID_W).astype(jnp.float32)
    col_idx = jnp.tile(jnp.arange(GRID_W), rows).astype(jnp.float32)
    n_freq = HEAD_DIM // 4
    inv = ROPE_THETA ** (-jnp.arange(n_freq, dtype=jnp.float32) / n_freq)
    ang = jnp.concatenate([row_idx[:, None] * inv, col_idx[:, None] * inv], axis=-1)
    return jnp.cos(ang), jnp.sin(ang)


def apply_rope(x, cos, sin):
    x1, x2 = jnp.split(x.astype(jnp.float32), 2, axis=-1)
    c = cos[None, :, None, :]
    s = sin[None, :, None, :]
    return jnp.concatenate([x1 * c - x2 * s, x1 * s + x2 * c], axis=-1).astype(x.dtype)


def block_attention(q, k, v):
    B, Lq, H, HD = q.shape
    rep = H // N_KV_HEADS
    kf = k.astype(jnp.float32)
    vf = v.astype(jnp.float32)
    qb = jnp.moveaxis(q.astype(jnp.float32).reshape(B, Lq // Q_BLOCK, Q_BLOCK, N_KV_HEADS, rep, HD), 1, 0)
    scale = HD ** -0.5

    def one_block(q_blk):
        s = jnp.einsum('bqgrd,bkgd->bgrqk', q_blk, kf) * scale
        p = jax.nn.softmax(s, axis=-1)
        return jnp.einsum('bgrqk,bkgd->bqgrd', p, vf)

    o = lax.map(one_block, qb)
    return jnp.moveaxis(o, 0, 1).reshape(B, Lq, H * HD).astype(q.dtype)


def pool_mix(p, pool_w, pool_scale):
    B, L, _ = p.shape
    pf = p.astype(jnp.float32)
    t = jnp.arange(L)
    outs = []
    for gi, w in enumerate(POOL_WINDOWS):
        pg = pf[..., gi * POOL_GROUP:(gi + 1) * POOL_GROUP]
        cs = jnp.pad(jnp.cumsum(pg, axis=1), ((0, 0), (1, 0), (0, 0)))
        lo = jnp.clip(t - w // 2, 0, L)
        hi = jnp.clip(t + w // 2, 0, L)
        mean = (jnp.take(cs, hi, axis=1) - jnp.take(cs, lo, axis=1)) / (hi - lo).astype(jnp.float32)[None, :, None]
        outs.append(jnp.einsum('blc,cd->bld', mean - pg, pool_w[gi].astype(jnp.float32)))
    return (jnp.concatenate(outs, axis=-1) * pool_scale).astype(p.dtype)


def _ssm_combine(e1, e2):
    a1, b1 = e1
    a2, b2 = e2
    return a2 * a1, a2 * b1 + b2


def s5_mix(u, h0_re, h0_im, lp):
    B, L, _ = u.shape
    f32 = jnp.float32
    uf = u.astype(f32)
    ug = uf.reshape(B, L, N_SSM_GROUPS, SSM_GROUP).astype(jnp.complex64)
    ys, fins = [], []
    for dirn in range(2):
        lam = lax.complex(lp['ssm_lam_re'][dirn].astype(f32), lp['ssm_lam_im'][dirn].astype(f32))
        dt = jnp.exp(lp['ssm_log_step'][dirn].astype(f32))[:, None]
        lam_bar = jnp.exp(lam * dt)
        b_mat = lax.complex(lp['ssm_b_re'][dirn].astype(f32), lp['ssm_b_im'][dirn].astype(f32))
        b_bar = ((lam_bar - 1.0) / lam)[..., None] * b_mat
        c_mat = lax.complex(lp['ssm_c_re'][dirn].astype(f32), lp['ssm_c_im'][dirn].astype(f32))
        h0 = lax.complex(h0_re[:, dirn].astype(f32), h0_im[:, dirn].astype(f32))
        seq = ug if dirn == 0 else ug[:, ::-1]
        bu = jnp.einsum('blgc,gnc->blgn', seq, b_bar)
        bu = bu.at[:, 0].add(lam_bar * h0)
        a = jnp.broadcast_to(lam_bar, bu.shape)
        _, hs = lax.associative_scan(_ssm_combine, (a, bu), axis=1)
        yd = jnp.einsum('blgn,gcn->blgc', hs, c_mat).real
        ys.append(yd if dirn == 0 else yd[:, ::-1])
        fins.append(hs[:, -1])
    y = (ys[0] + ys[1]).reshape(B, L, D_SSM) + lp['ssm_d'] * uf
    g = jax.nn.gelu(y)
    out = g * jax.nn.sigmoid(g @ lp['ssm_w_glu'] + lp['ssm_b_glu'])
    fin = jnp.stack(fins, axis=1)
    return out.astype(u.dtype), fin.real, fin.imag


def chunk_mix(uv, ln_g, ln_b, w_s, b_s):
    z = jax.nn.gelu(uv)
    u, v = jnp.split(z, 2, axis=-1)
    v = layer_norm(v, ln_g, ln_b)
    B, L, _ = v.shape
    vc = v.reshape(B, L // CHUNK, CHUNK, N_CHUNK_HEADS, CHUNK_GROUP)
    mixed = jnp.einsum('hpq,bnqhc->bnphc', w_s, vc) + b_s.T[None, None, :, :, None]
    return u * mixed.reshape(B, L, D_CHUNK)


def token_mixer(h, lp, rope, ctx):
    B, L, _ = h.shape
    proj = h @ lp['w_in']
    p_pool, u_ssm, q, k, v, uv = jnp.split(proj, IN_SPLITS, axis=-1)
    y_pool = pool_mix(p_pool, lp['pool_w'], lp['pool_scale'])
    if ctx is None:
        h0_re = jnp.zeros((B, 2, N_SSM_GROUPS, SSM_STATE), jnp.float32)
        h0_im = jnp.zeros((B, 2, N_SSM_GROUPS, SSM_STATE), jnp.float32)
    else:
        h0_re, h0_im = ctx[2], ctx[3]
    y_ssm, fin_re, fin_im = s5_mix(u_ssm, h0_re, h0_im, lp)
    q = rms_norm(q.reshape(B, L, N_HEADS, HEAD_DIM), lp['q_norm'])
    k = rms_norm(k.reshape(B, L, N_KV_HEADS, HEAD_DIM), lp['k_norm'])
    v = v.reshape(B, L, N_KV_HEADS, HEAD_DIM)
    if ctx is None:
        k_all, v_all = k, v
    else:
        cos, sin = rope
        q = apply_rope(q, cos, sin)
        k_lat = apply_rope(k, cos, sin)
        k_all = jnp.concatenate([ctx[0].astype(k.dtype), k_lat], axis=1)
        v_all = jnp.concatenate([ctx[1].astype(v.dtype), v], axis=1)
    y_attn = block_attention(q, k_all, v_all)
    y_chunk = chunk_mix(uv, lp['chunk_ln_g'], lp['chunk_ln_b'], lp['chunk_w_s'], lp['chunk_b_s'])
    y = jnp.concatenate([y_pool, y_ssm, y_attn, y_chunk], axis=-1) @ lp['w_out']
    return y, (k, v, fin_re, fin_im)


def trunk_layer(x, cond, lp, rope, ctx):
    m = jax.nn.silu(cond) @ lp['w_mod'] + lp['b_mod']
    sh1, sc1, g1, sh2, sc2, g2, sh3, sc3, g3 = [t[:, None, :] for t in jnp.split(m, N_MOD, axis=-1)]
    ffn = swiglu(x * (1.0 + sc1) + sh1, lp['ffn_w1'][0], lp['ffn_w2'][0])
    x = layer_norm(ALPHA * x + 0.5 * g1 * ffn, lp['ln_g'][0], lp['ln_b'][0])
    y, ctx_out = token_mixer(x * (1.0 + sc2) + sh2, lp, rope, ctx)
    x = layer_norm(ALPHA * x + g2 * y, lp['ln_g'][1], lp['ln_b'][1])
    ffn = swiglu(x * (1.0 + sc3) + sh3, lp['ffn_w1'][1], lp['ffn_w2'][1])
    x = layer_norm(ALPHA * x + 0.5 * g3 * ffn, lp['ln_g'][2], lp['ln_b'][2])
    return x, ctx_out


def setup_inputs(seed: int = 0) -> dict:
    key = jax.random.key(seed)
    keys = jax.random.split(key, 34)
    f32 = jnp.float32

    def nrm(i, shape, scale):
        return scale * jax.random.normal(keys[i], shape, f32)

    G, N, C = N_SSM_GROUPS, SSM_STATE, SSM_GROUP
    lam_im_init = np.pi * jnp.arange(N, dtype=f32)
    return {
        'x_prompt': nrm(0, (BATCH, SEQ, D_MODEL), 1.0),
        'x_sample': nrm(1, (DEC_BATCH, DEC_SEQ, D_MODEL), 1.0),
        'cache_k': nrm(2, (DEC_BATCH, DEPTH, PAST_LEN, N_KV_HEADS, HEAD_DIM), 1.0),
        'cache_v': nrm(3, (DEC_BATCH, DEPTH, PAST_LEN, N_KV_HEADS, HEAD_DIM), 1.0),
        'state_ssm_re': nrm(4, (DEC_BATCH, DEPTH, 2, G, N), 0.3),
        'state_ssm_im': nrm(5, (DEC_BATCH, DEPTH, 2, G, N), 0.3),
        'c': nrm(6, (DEC_BATCH, D_MODEL), 1.0),
        'c_ctx': nrm(7, (D_MODEL,), 1.0),
        'w_mod': nrm(8, (DEPTH, D_MODEL, N_MOD * D_MODEL), 0.5 * D_MODEL ** -0.5),
        'b_mod': nrm(9, (DEPTH, N_MOD * D_MODEL), 0.02),
        'ln_g': 1.0 + nrm(10, (DEPTH, 3, D_MODEL), 0.02),
        'ln_b': nrm(11, (DEPTH, 3, D_MODEL), 0.02),
        'ffn_w1': nrm(12, (DEPTH, 2, D_MODEL, 2 * D_FF), D_MODEL ** -0.5),
        'ffn_w2': nrm(13, (DEPTH, 2, D_FF, D_MODEL), BETA * D_FF ** -0.5),
        'w_in': nrm(14, (DEPTH, D_MODEL, D_IN), D_MODEL ** -0.5),
        'w_out': nrm(15, (DEPTH, D_MIX, D_MODEL), BETA * D_MIX ** -0.5),
        'pool_w': nrm(16, (DEPTH, len(POOL_WINDOWS), POOL_GROUP, POOL_GROUP), POOL_GROUP ** -0.5),
        'pool_scale': 1.0 + nrm(17, (DEPTH, D_POOL), 0.02),
        'ssm_lam_re': -0.5 + nrm(18, (DEPTH, 2, G, N), 0.01),
        'ssm_lam_im': lam_im_init + nrm(19, (DEPTH, 2, G, N), 0.01),
        'ssm_log_step': jax.random.uniform(keys[20], (DEPTH, 2, G), f32, math.log(1e-3), math.log(1e-1)),
        'ssm_b_re': nrm(21, (DEPTH, 2, G, N, C), (2 * C) ** -0.5),
        'ssm_b_im': nrm(22, (DEPTH, 2, G, N, C), (2 * C) ** -0.5),
        'ssm_c_re': nrm(23, (DEPTH, 2, G, C, N), N ** -0.5),
        'ssm_c_im': nrm(24, (DEPTH, 2, G, C, N), N ** -0.5),
        'ssm_d': nrm(25, (DEPTH, D_SSM), 0.5),
        'ssm_w_glu': nrm(26, (DEPTH, D_SSM, D_SSM), D_SSM ** -0.5),
        'ssm_b_glu': nrm(27, (DEPTH, D_SSM), 0.02),
        'q_norm': 1.0 + nrm(28, (DEPTH, HEAD_DIM), 0.02),
        'k_norm': 1.0 + nrm(29, (DEPTH, HEAD_DIM), 0.02),
        'chunk_ln_g': 1.0 + nrm(30, (DEPTH, D_CHUNK), 0.02),
        'chunk_ln_b': nrm(31, (DEPTH, D_CHUNK), 0.02),
        'chunk_w_s': nrm(32, (DEPTH, N_CHUNK_HEADS, CHUNK, CHUNK), CHUNK ** -0.5),
        'chunk_b_s': 1.0 + nrm(33, (DEPTH, N_CHUNK_HEADS, CHUNK), 0.02),
    }


def reference(x_prompt, x_sample, cache_k, cache_v, state_ssm_re, state_ssm_im, c, c_ctx,
              w_mod, b_mod, ln_g, ln_b, ffn_w1, ffn_w2, w_in, w_out, pool_w, pool_scale,
              ssm_lam_re, ssm_lam_im, ssm_log_step, ssm_b_re, ssm_b_im, ssm_c_re, ssm_c_im,
              ssm_d, ssm_w_glu, ssm_b_glu, q_norm, k_norm, chunk_ln_g, chunk_ln_b, chunk_w_s, chunk_b_s):
    rope = axial_rope_tables(x_sample.shape[1])
    y_p = x_prompt
    y_s = x_sample
    ks, vs, s_re, s_im = [], [], [], []
    for l in range(DEPTH):
        lp = {
            'w_mod': w_mod[l], 'b_mod': b_mod[l], 'ln_g': ln_g[l], 'ln_b': ln_b[l],
            'ffn_w1': ffn_w1[l], 'ffn_w2': ffn_w2[l], 'w_in': w_in[l], 'w_out': w_out[l],
            'pool_w': pool_w[l], 'pool_scale': pool_scale[l],
            'ssm_lam_re': ssm_lam_re[l], 'ssm_lam_im': ssm_lam_im[l], 'ssm_log_step': ssm_log_step[l],
            'ssm_b_re': ssm_b_re[l], 'ssm_b_im': ssm_b_im[l], 'ssm_c_re': ssm_c_re[l], 'ssm_c_im': ssm_c_im[l],
            'ssm_d': ssm_d[l], 'ssm_w_glu': ssm_w_glu[l], 'ssm_b_glu': ssm_b_glu[l],
            'q_norm': q_norm[l], 'k_norm': k_norm[l],
            'chunk_ln_g': chunk_ln_g[l], 'chunk_ln_b': chunk_ln_b[l],
            'chunk_w_s': chunk_w_s[l], 'chunk_b_s': chunk_b_s[l],
        }
        y_p, (k_l, v_l, fr_l, fi_l) = trunk_layer(y_p, c_ctx[None, :], lp, None, None)
        ks.append(k_l)
        vs.append(v_l)
        s_re.append(fr_l)
        s_im.append(fi_l)
        y_s, _ = trunk_layer(y_s, c, lp, rope,
                             (cache_k[:, l], cache_v[:, l], state_ssm_re[:, l], state_ssm_im[:, l]))
    new_cache_k = jnp.stack(ks, axis=1)
    new_cache_v = jnp.stack(vs, axis=1)
    new_state_ssm_re = jnp.stack(s_re, axis=1)
    new_state_ssm_im = jnp.stack(s_im, axis=1)
    return (y_p, y_s, new_cache_k, new_cache_v, new_state_ssm_re, new_state_ssm_im)
```

```cpp
#include <hip/hip_runtime.h>
#include <hip/hip_cooperative_groups.h>
#include <cstdio>
namespace cg = cooperative_groups;

#define DI __device__ __forceinline__
typedef unsigned short bf16_t;
typedef __attribute__((ext_vector_type(8))) short bf16x8;
typedef __attribute__((ext_vector_type(4))) short s16x4;
typedef __attribute__((ext_vector_type(4))) float f32x4;
typedef __attribute__((ext_vector_type(16))) float f32x16;
typedef __attribute__((ext_vector_type(2))) float f32x2;
typedef __attribute__((ext_vector_type(2))) __bf16 bf16x2v;
typedef __attribute__((ext_vector_type(4))) unsigned u32x4;
typedef __attribute__((ext_vector_type(2))) unsigned u32x2;

#ifndef ONE_LAUNCH
#define ONE_LAUNCH 1
#endif

constexpr int D = 1024, NTOK = 12288, NPROMPT = 8192, DFF = 2816, DIN = 1536;
constexpr float ALPHA = 1.4142135623730951f;
constexpr float LN_EPS = 1e-5f, RMS_EPS = 1e-6f;
enum { I_XP = 0, I_XS, I_CK, I_CV, I_SRE, I_SIM, I_C, I_CCTX, I_WMOD, I_BMOD, I_LNG, I_LNB, I_W1, I_W2, I_WIN, I_WOUT,
       I_POOLW, I_POOLS, I_LRE, I_LIM, I_LSTEP, I_BRE, I_BIM, I_CRE, I_CIM, I_SSMD, I_WGLU, I_BGLU, I_QN, I_KN,
       I_CLG, I_CLB, I_CWS, I_CBS, N_IN };
constexpr size_t OUT_K = 12582912, OUT_V = 14680064, OUT_SRE = 16777216, OUT_SIM = 16908288;

constexpr size_t OFF_W1T = 0;
constexpr size_t OFF_W2T = OFF_W1T + 46137344;
constexpr size_t OFF_WINT = OFF_W2T + 23068672;
constexpr size_t OFF_WOUTT = OFF_WINT + 6291456;
constexpr size_t OFF_WGLUT = OFF_WOUTT + 4194304;
constexpr size_t OFF_WPOOLT = OFF_WGLUT + 262144;
constexpr size_t OFF_MOD = OFF_WPOOLT + 262144;
constexpr size_t OFF_XY = OFF_MOD + 221184;
constexpr size_t OFF_H = OFF_XY + 50331648;
constexpr size_t OFF_YMIX = OFF_H + 25165824;
constexpr size_t OFF_R = OFF_YMIX + 25165824;
constexpr size_t OFF_QB = OFF_R + 75497472;
constexpr size_t OFF_KP = OFF_QB + 6291456;
constexpr size_t OFF_KS = OFF_KP + 2097152;
constexpr size_t OFF_VPT = OFF_KS + 2621440;
constexpr size_t OFF_VST = OFF_VPT + 2097152;
constexpr size_t OFF_VCT = OFF_VST + 2621440;
constexpr size_t OFF_DIFF = OFF_VCT + 6291456;
constexpr size_t OFF_SG = OFF_DIFF + 6291456;
constexpr size_t OFF_E = OFF_SG + 6291456;
constexpr size_t OFF_LAMB = OFF_E + 3145728;
constexpr size_t OFF_LAMT = OFF_LAMB + 32768;
constexpr size_t OFF_BBAR = OFF_LAMT + 32768;
constexpr size_t WS_TOTAL = OFF_BBAR + 524288;

struct Params { const float* in[N_IN]; float* out; char* ws; };

DI int otid() {
  int z = 0; asm volatile("" : "+s"(z));
  int lane = __builtin_amdgcn_mbcnt_hi(-1, __builtin_amdgcn_mbcnt_lo(-1, z));
  int w = __builtin_amdgcn_readfirstlane(threadIdx.x >> 6);
  return w * 64 + lane;
}
DI int osgpr(int i) { asm volatile("" : "+s"(i)); return i; }
#define INP(i) (p.in[osgpr(i)])
DI char* ows(char* w) { asm volatile("" : "+s"(w)); return w; }
#define PWS ows(p.ws)
DI unsigned pk2(float a, float b) { f32x2 v = {a, b}; bf16x2v r = __builtin_convertvector(v, bf16x2v); return __builtin_bit_cast(unsigned, r); }
DI bf16_t f2bf(float a) { return (bf16_t)(pk2(a, 0.f) & 0xffffu); }
DI float bf2f(bf16_t v) { return __uint_as_float(((unsigned)v) << 16); }
DI bf16x8 pack8(float a0, float a1, float a2, float a3, float a4, float a5, float a6, float a7) {
  u32x4 u = {pk2(a0, a1), pk2(a2, a3), pk2(a4, a5), pk2(a6, a7)};
  return __builtin_bit_cast(bf16x8, u);
}
DI float gelu_t(float x) {
  float z = 0.7978845608028654f * (x + 0.044715f * x * x * x);
  float e = __expf(2.f * z);
  float th = 1.f - 2.f / (e + 1.f);
  return 0.5f * x * (1.f + th);
}
DI float sigmoid_f(float x) { return 1.f / (1.f + __expf(-x)); }
DI float shfl_x(float v, int mask, int lane) {
  return __int_as_float(__builtin_amdgcn_ds_bpermute((lane ^ mask) << 2, __float_as_int(v)));
}
DI float wave_sum(float v, int lane) {
#pragma unroll
  for (int o = 32; o > 0; o >>= 1) v += shfl_x(v, o, lane);
  return v;
}
#define MFMA16(a, b, c) __builtin_amdgcn_mfma_f32_16x16x32_bf16((a), (b), (c), 0, 0, 0)
#define MFMA32(a, b, c) __builtin_amdgcn_mfma_f32_32x32x16_bf16((a), (b), (c), 0, 0, 0)

constexpr int BM = 256, BK = 64, HALF = 128, NXCD = 8, WGM = 8, HT = HALF * BK;
constexpr int GEMM_LDS = 8 * HT * 2;

DI int lds_byte(int r, int c) {
  int st = (r >> 4) * 2 + (c >> 5), rr = r & 15, cc = c & 31, ob = rr * 64 + cc * 2;
  return st * 1024 + (ob ^ (((ob >> 9) & 1) << 5));
}
DI void stage_rc(int b, int& R, int& C) {
  int st = b / 1024, sb = b % 1024, swz = sb ^ (((sb >> 9) & 1) << 5);
  R = (st >> 1) * 16 + swz / 64; C = (st & 1) * 32 + (swz % 64) / 2;
}

enum { EPI_SWIGLU = 0, EPI_RESID, EPI_F32, EPI_GLU, EPI_POOL };
struct EpiArgs {
  float* f0;
  bf16_t* b0;
  const float* c0;
  const bf16_t* cb;
  float w;
};

template <int K, int MODE>
DI void gemm_phase(const bf16_t* __restrict__ A, const bf16_t* __restrict__ Bt, int nM, int nN, EpiArgs ea,
                   char* shmc, int bid, int nblk) {
  bf16_t* shm = (bf16_t*)shmc;
#define SA(b, h) (shm + ((b) * 2 + (h)) * HT)
#define SB(b, h) (shm + (4 + (b) * 2 + (h)) * HT)
#define STAGE(P, RS, SOFF, kt) do { const int _so = (SOFF) + (kt) * (BK * 2); \
    __builtin_amdgcn_raw_ptr_buffer_load_lds(RS, (__attribute__((address_space(3))) void*)((char*)(P) + wid * 1024), 16, so0, _so, 0, 0); \
    __builtin_amdgcn_raw_ptr_buffer_load_lds(RS, (__attribute__((address_space(3))) void*)((char*)(P) + wid * 1024 + 8192), 16, so1, _so, 0, 0); } while (0)
#define LDA(dst, b, h) for (int m = 0; m < 4; ++m) for (int k = 0; k < 2; ++k) \
    dst[m][k] = *reinterpret_cast<const bf16x8*>((char*)SA(b, h) + lds_byte(wr * 64 + m * 16 + fr, k * 32 + fq * 8))
#define LDB(dst, b, h) for (int n = 0; n < 2; ++n) for (int k = 0; k < 2; ++k) \
    dst[n][k] = *reinterpret_cast<const bf16x8*>((char*)SB(b, h) + lds_byte(wc * 32 + n * 16 + fr, k * 32 + fq * 8))
#define MMA(ai, bj, At, Bt_) do { __builtin_amdgcn_s_setprio(1); \
    for (int m = 0; m < 4; ++m) for (int n = 0; n < 2; ++n) for (int k = 0; k < 2; ++k) \
      acc[ai][bj][m][n] = MFMA16(At[m][k], Bt_[n][k], acc[ai][bj][m][n]); \
    __builtin_amdgcn_s_setprio(0); } while (0)
#define WAIT_V(n) asm volatile("s_waitcnt vmcnt(" #n ")" ::: "memory")
#define WAIT_L(n) asm volatile("s_waitcnt lgkmcnt(" #n ")" ::: "memory")
#define BAR __builtin_amdgcn_s_barrier()
#define SCHED __builtin_amdgcn_sched_barrier(0)
  const int tid = otid();
  const int wid = __builtin_amdgcn_readfirstlane(tid >> 6), lane = tid & 63, wr = wid >> 2, wc = wid & 3, fr = lane & 15, fq = lane >> 4;
  const __amdgpu_buffer_rsrc_t rsA = __builtin_amdgcn_make_buffer_rsrc((void*)A, 0, 0x7fffffff, 0x00020000);
  const __amdgpu_buffer_rsrc_t rsB = __builtin_amdgcn_make_buffer_rsrc((void*)Bt, 0, 0x7fffffff, 0x00020000);
  unsigned so0, so1;
  { int R, C; stage_rc(tid * 16, R, C); so0 = (unsigned)(R * K + C) * 2u; stage_rc(tid * 16 + 8192, R, C); so1 = (unsigned)(R * K + C) * 2u; }
  constexpr int nt = K / BK;
  const int nwg = nM * nN;
  for (int tile = bid; tile < nwg; tile += nblk) {
    int wgid = tile;
    { int q = nwg / NXCD, r = nwg % NXCD, xcd = wgid % NXCD, off = wgid / NXCD;
      wgid = (xcd < r ? xcd * (q + 1) : r * (q + 1) + (xcd - r) * q) + off; }
    int nig = WGM * nN, gid = wgid / nig, fm = gid * WGM, gsz = min(nM - fm, WGM);
    int pm = fm + ((wgid % nig) % gsz), pn = (wgid % nig) / gsz, brow = pm * BM, bcol = pn * BM;
    const int A0 = brow * K * 2, A1 = A0 + HALF * K * 2, B0p = bcol * K * 2, B1p = B0p + HALF * K * 2;
    f32x4 acc[2][2][4][2] = {};
    bf16x8 At[4][2], B0[2][2], B1[2][2];
    STAGE(SB(0, 0), rsB, B0p, 0); STAGE(SA(0, 0), rsA, A0, 0);
    STAGE(SB(0, 1), rsB, B1p, 0); STAGE(SA(0, 1), rsA, A1, 0);
    if (wr == 1) BAR;
    WAIT_V(4); BAR;
    STAGE(SB(1, 0), rsB, B0p, 1); STAGE(SA(1, 0), rsA, A0, 1); STAGE(SB(1, 1), rsB, B1p, 1);
    WAIT_V(6); BAR;
    for (int t = 0; t < nt - 2; t += 2) {
      LDB(B0, 0, 0); SCHED; LDA(At, 0, 0); STAGE(SA(1, 1), rsA, A1, t + 1);
      WAIT_L(8); BAR; WAIT_L(0); MMA(0, 0, At, B0); BAR; SCHED;
      LDB(B1, 0, 1); STAGE(SB(0, 0), rsB, B0p, t + 2);
      BAR; WAIT_L(0); MMA(0, 1, At, B1); BAR;
      LDA(At, 0, 1); STAGE(SA(0, 0), rsA, A0, t + 2);
      BAR; WAIT_L(0); MMA(1, 0, At, B0); BAR; SCHED;
      STAGE(SB(0, 1), rsB, B1p, t + 2);
      WAIT_V(6); BAR; MMA(1, 1, At, B1); BAR;
      LDB(B0, 1, 0); SCHED; LDA(At, 1, 0); STAGE(SA(0, 1), rsA, A1, t + 2);
      WAIT_L(8); BAR; WAIT_L(0); MMA(0, 0, At, B0); BAR; SCHED;
      LDB(B1, 1, 1); STAGE(SB(1, 0), rsB, B0p, t + 3);
      BAR; WAIT_L(0); MMA(0, 1, At, B1); BAR;
      LDA(At, 1, 1); STAGE(SA(1, 0), rsA, A0, t + 3);
      BAR; WAIT_L(0); MMA(1, 0, At, B0); BAR; SCHED;
      STAGE(SB(1, 1), rsB, B1p, t + 3);
      WAIT_V(6); BAR; MMA(1, 1, At, B1); BAR;
    }
    { LDB(B0, 0, 0); LDA(At, 0, 0); STAGE(SA(1, 1), rsA, A1, nt - 1);
      BAR; WAIT_L(0); MMA(0, 0, At, B0); BAR;
      LDB(B1, 0, 1); BAR; WAIT_L(0); MMA(0, 1, At, B1); BAR;
      LDA(At, 0, 1); WAIT_V(4); BAR; WAIT_L(0); MMA(1, 0, At, B0); MMA(1, 1, At, B1); BAR; }
    { LDB(B0, 1, 0); LDA(At, 1, 0); WAIT_V(2); BAR; WAIT_L(0); MMA(0, 0, At, B0); BAR;
      LDB(B1, 1, 1); WAIT_V(0); BAR; WAIT_L(0); MMA(0, 1, At, B1); BAR;
      LDA(At, 1, 1); BAR; WAIT_L(0); MMA(1, 0, At, B0); MMA(1, 1, At, B1); BAR; }
    if (wr == 0) BAR;
    const int ci = brow < NPROMPT ? 0 : 1 + (brow - NPROMPT) / 2048;
    const int te = otid(), le = te & 63, wide = te >> 6;
    const int wr = wide >> 2, wc = wide & 3, fr = le & 15, fq = le >> 4;
#pragma unroll
    for (int ai = 0; ai < 2; ++ai)
#pragma unroll
      for (int m = 0; m < 4; ++m)
#pragma unroll
        for (int j = 0; j < 4; ++j) {
          const int row = brow + ai * HALF + wr * 64 + m * 16 + fq * 4 + j;
          if (MODE == EPI_SWIGLU) {
#pragma unroll
            for (int n = 0; n < 2; ++n) {
              float g = acc[ai][0][m][n][j], u = acc[ai][1][m][n][j];
              float v = g * sigmoid_f(g) * u;
              ea.b0[(size_t)row * DFF + pn * 128 + wc * 32 + n * 16 + fr] = f2bf(v);
            }
          } else {
#pragma unroll
            for (int bj = 0; bj < 2; ++bj)
#pragma unroll
              for (int n = 0; n < 2; ++n) {
                const int col = bcol + bj * HALF + wc * 32 + n * 16 + fr;
                float a = acc[ai][bj][m][n][j];
                if (MODE == EPI_RESID) {
                  float gate = ea.w * ea.c0[ci * 9216 + col];
                  size_t o = (size_t)row * D + col;
                  ea.f0[o] = ALPHA * ea.f0[o] + gate * a;
                } else if (MODE == EPI_F32) {
                  ea.f0[(size_t)row * DIN + col] = a;
                } else if (MODE == EPI_GLU) {
                  float g = bf2f(ea.cb[(size_t)row * 256 + col]);
                  ea.b0[(size_t)row * D + 256 + col] = f2bf(g * sigmoid_f(a + ea.c0[col]));
                } else if (MODE == EPI_POOL) {
                  ea.b0[(size_t)row * D + col] = f2bf(a * ea.c0[col]);
                }
              }
          }
        }
  }
#undef SA
#undef SB
}

DI void prep_phase(const Params& p, char* shmc, int bid, int nblk) {
  const int tid = otid(), wid = tid >> 6, lane = tid & 63;
  char* ws = PWS;
  {
    float* tile = (float*)shmc;
    constexpr int T_W1 = 16 * 88, T_W2 = 44 * 16, T_IN = 16 * 24, T_OUT = 256, T_GLU = 16;
    constexpr int PER_L = 2 * T_W1 + 2 * T_W2 + T_IN + T_OUT + T_GLU;
    for (int it = bid; it < 2 * PER_L; it += nblk) {
      int l = it / PER_L, r = it % PER_L;
      const float* src; bf16_t* dst; int K, N, mode = 0;
      if (r < 2 * T_W1) {
        int s = r / T_W1; r %= T_W1;
        src = INP(I_W1) + (size_t)(l * 2 + s) * 1024 * 5632; dst = (bf16_t*)(ws + OFF_W1T) + (size_t)(l * 2 + s) * 5632 * 1024;
        K = 1024; N = 5632; mode = 1;
      } else if (r < 2 * T_W1 + 2 * T_W2) {
        r -= 2 * T_W1; int s = r / T_W2; r %= T_W2;
        src = INP(I_W2) + (size_t)(l * 2 + s) * 2816 * 1024; dst = (bf16_t*)(ws + OFF_W2T) + (size_t)(l * 2 + s) * 1024 * 2816;
        K = 2816; N = 1024;
      } else if (r < 2 * T_W1 + 2 * T_W2 + T_IN) {
        r -= 2 * T_W1 + 2 * T_W2;
        src = INP(I_WIN) + (size_t)l * 1024 * 1536; dst = (bf16_t*)(ws + OFF_WINT) + (size_t)l * 1536 * 1024;
        K = 1024; N = 1536;
      } else if (r < 2 * T_W1 + 2 * T_W2 + T_IN + T_OUT) {
        r -= 2 * T_W1 + 2 * T_W2 + T_IN;
        src = INP(I_WOUT) + (size_t)l * 1024 * 1024; dst = (bf16_t*)(ws + OFF_WOUTT) + (size_t)l * 1024 * 1024;
        K = 1024; N = 1024;
      } else {
        r -= 2 * T_W1 + 2 * T_W2 + T_IN + T_OUT;
        src = INP(I_WGLU) + (size_t)l * 256 * 256; dst = (bf16_t*)(ws + OFF_WGLUT) + (size_t)l * 256 * 256;
        K = 256; N = 256;
      }
      int nkt = K / 64, kt = r % nkt, ntile = r / nkt;
#pragma unroll
      for (int i = 0; i < 2; ++i) {
        int k = (tid >> 4) + 32 * i, n = (tid & 15) * 4;
        float4 v = *(const float4*)(src + (size_t)(kt * 64 + k) * N + ntile * 64 + n);
        tile[k * 65 + n] = v.x; tile[k * 65 + n + 1] = v.y; tile[k * 65 + n + 2] = v.z; tile[k * 65 + n + 3] = v.w;
      }
      __syncthreads();
      {
        int n = tid >> 3, kk = (tid & 7) * 8;
        int nsrc = ntile * 64 + n, nrow = nsrc;
        if (mode == 1) {
          if (nsrc < 2816) nrow = (nsrc >> 7) * 256 + (nsrc & 127);
          else { int mm = nsrc - 2816; nrow = (mm >> 7) * 256 + 128 + (mm & 127); }
        }
        bf16x8 o = pack8(tile[(kk + 0) * 65 + n], tile[(kk + 1) * 65 + n], tile[(kk + 2) * 65 + n], tile[(kk + 3) * 65 + n],
                         tile[(kk + 4) * 65 + n], tile[(kk + 5) * 65 + n], tile[(kk + 6) * 65 + n], tile[(kk + 7) * 65 + n]);
        *(bf16x8*)(dst + (size_t)nrow * K + kt * 64 + kk) = o;
      }
      __syncthreads();
    }
  }
  const int gtid = bid * 512 + tid, gn = nblk * 512;
  for (int i = gtid; i < 2 * 65536; i += gn) {
    int l = i >> 16, n = (i >> 8) & 255, k = i & 255;
    int gi = n >> 6, d = n & 63, gj = k >> 6, c = k & 63;
    float v = (gi == gj) ? INP(I_POOLW)[((size_t)(l * 4 + gi) * 64 + c) * 64 + d] : 0.f;
    ((bf16_t*)(ws + OFF_WPOOLT))[i] = f2bf(v);
  }
  {
    float* sc = (float*)shmc + 64 * 65;
    float* red = sc + 3 * 1024;
    for (int i = tid; i < 3 * 1024; i += 512) {
      int ci = i >> 10, k = i & 1023;
      float v = ci == 0 ? INP(I_CCTX)[k] : INP(I_C)[(ci - 1) * 1024 + k];
      sc[i] = v * sigmoid_f(v);
    }
    __syncthreads();
    for (int it = bid; it < 288; it += nblk) {
      int l = it / 144, cb = it % 144, col = cb * 64 + lane;
      const float* wp = INP(I_WMOD) + (size_t)l * 1024 * 9216 + col;
      float a0 = 0.f, a1 = 0.f, a2 = 0.f;
#pragma unroll 8
      for (int k = wid * 128; k < wid * 128 + 128; ++k) {
        float w = wp[(size_t)k * 9216];
        a0 += sc[k] * w; a1 += sc[1024 + k] * w; a2 += sc[2048 + k] * w;
      }
      red[(wid * 3 + 0) * 64 + lane] = a0; red[(wid * 3 + 1) * 64 + lane] = a1; red[(wid * 3 + 2) * 64 + lane] = a2;
      __syncthreads();
      if (tid < 192) {
        int ci = tid >> 6;
        float s = 0.f;
        for (int w = 0; w < 8; ++w) s += red[(w * 3 + ci) * 64 + lane];
        ((float*)(ws + OFF_MOD))[(size_t)(l * 3 + ci) * 9216 + col] = s + INP(I_BMOD)[l * 9216 + col];
      }
      __syncthreads();
    }
  }
  for (int i = gtid; i < 2 * 2 * 512 * 128; i += gn) {
    int c = i & 127, t = (i >> 7) & 511, b = (i >> 16) & 1, l = i >> 17;
    size_t si = ((size_t)(b * 2 + l) * 512 + t) * 128 + c;
    ((bf16_t*)(ws + OFF_KS))[((size_t)(l * 2 + b) * 2560 + t) * 128 + c] = f2bf(INP(I_CK)[si]);
    ((bf16_t*)(ws + OFF_VST))[((size_t)(l * 2 + b) * 128 + c) * 2560 + t] = f2bf(INP(I_CV)[si]);
  }
  for (int i = gtid; i < 4096; i += gn) {
    float lre = INP(I_LRE)[i], lim = INP(I_LIM)[i];
    float dt = expf(INP(I_LSTEP)[i >> 6]);
    float e = expf(lre * dt), ang = lim * dt;
    float br = e * cosf(ang), bi = e * sinf(ang);
    float ar = br - 1.f, ai = bi, den = lre * lre + lim * lim;
    float cr = (ar * lre + ai * lim) / den, cim = (ai * lre - ar * lim) / den;
    ((float2*)(ws + OFF_LAMB))[i] = make_float2(br, bi);
    float pr = br, pi = bi;
    for (int s = 0; s < 6; ++s) { float nr = pr * pr - pi * pi, ni = 2.f * pr * pi; pr = nr; pi = ni; }
    ((float2*)(ws + OFF_LAMT))[i] = make_float2(pr, pi);
    for (int c = 0; c < 16; ++c) {
      float xr = INP(I_BRE)[(size_t)i * 16 + c], xi = INP(I_BIM)[(size_t)i * 16 + c];
      ((float2*)(ws + OFF_BBAR))[(size_t)i * 16 + c] = make_float2(cr * xr - cim * xi, cr * xi + cim * xr);
    }
  }
}

DI void lnmod_phase(const Params& p, int l_ln, int ln_idx, int l_mod, int mod_idx, int bid, int nblk) {
  const int tid = otid(), wid = tid >> 6, lane = tid & 63;
  float* xy = (float*)(PWS + OFF_XY);
  bf16_t* h = (bf16_t*)(PWS + OFF_H);
  const float* modv = (const float*)(PWS + OFF_MOD);
  for (int row = bid * 8 + wid; row < NTOK; row += nblk * 8) {
    const float* src = l_ln < 0 ? (row < NPROMPT ? INP(I_XP) + (size_t)row * D : INP(I_XS) + (size_t)(row - NPROMPT) * D)
                                : xy + (size_t)row * D;
    float4 v[4];
#pragma unroll
    for (int i = 0; i < 4; ++i) v[i] = *(const float4*)(src + lane * 4 + i * 256);
    if (l_ln >= 0) {
      float s = 0.f;
#pragma unroll
      for (int i = 0; i < 4; ++i) s += v[i].x + v[i].y + v[i].z + v[i].w;
      float mean = wave_sum(s, lane) * (1.f / 1024.f);
      float q = 0.f;
#pragma unroll
      for (int i = 0; i < 4; ++i) {
        v[i].x -= mean; v[i].y -= mean; v[i].z -= mean; v[i].w -= mean;
        q += v[i].x * v[i].x + v[i].y * v[i].y + v[i].z * v[i].z + v[i].w * v[i].w;
      }
      float rstd = rsqrtf(wave_sum(q, lane) * (1.f / 1024.f) + LN_EPS);
      const float* g = INP(I_LNG) + (l_ln * 3 + ln_idx) * 1024;
      const float* b = INP(I_LNB) + (l_ln * 3 + ln_idx) * 1024;
#pragma unroll
      for (int i = 0; i < 4; ++i) {
        float4 gg = *(const float4*)(g + lane * 4 + i * 256), bb = *(const float4*)(b + lane * 4 + i * 256);
        v[i].x = v[i].x * rstd * gg.x + bb.x; v[i].y = v[i].y * rstd * gg.y + bb.y;
        v[i].z = v[i].z * rstd * gg.z + bb.z; v[i].w = v[i].w * rstd * gg.w + bb.w;
      }
    }
    float* dx = l_mod < 0 ? p.out + (size_t)row * D : xy + (size_t)row * D;
#pragma unroll
    for (int i = 0; i < 4; ++i) *(float4*)(dx + lane * 4 + i * 256) = v[i];
    if (l_mod >= 0) {
      int ci = row < NPROMPT ? 0 : 1 + (row - NPROMPT) / 2048;
      const float* sh = modv + (size_t)(l_mod * 3 + ci) * 9216 + mod_idx * 1024;
      const float* sc = sh + 1024;
#pragma unroll
      for (int i = 0; i < 4; ++i) {
        float4 a = *(const float4*)(sh + lane * 4 + i * 256), c = *(const float4*)(sc + lane * 4 + i * 256);
        u32x2 o = {pk2(v[i].x * (1.f + c.x) + a.x, v[i].y * (1.f + c.y) + a.y),
                   pk2(v[i].z * (1.f + c.z) + a.z, v[i].w * (1.f + c.w) + a.w)};
        *(u32x2*)(h + (size_t)row * D + lane * 4 + i * 256) = o;
      }
    }
  }
}

DI void post_phase(const Params& p, int l, int bid, int nblk) {
  const int tid = otid(), wid = tid >> 6, lane = tid & 63;
  char* ws = PWS;
  const float* proj = (const float*)(ws + OFF_R);
  bf16_t* qb = (bf16_t*)(ws + OFF_QB);
  const float qn = INP(I_QN)[l * 64 + lane], kn = INP(I_KN)[l * 64 + lane];
  const int fi = lane & 15;
  const float inv = exp2f(-(float)fi * (13.287712379549449f / 16.f));
  for (int row = bid * 8 + wid; row < NTOK; row += nblk * 8) {
    const float* pr = proj + (size_t)row * DIN;
    const bool samp = row >= NPROMPT;
    int b, t, L;
    if (samp) { b = (row - NPROMPT) >> 11; t = (row - NPROMPT) & 2047; L = 2048; }
    else { b = row >> 8; t = row & 255; L = 256; }
    float cs = 1.f, sn = 0.f;
    if (samp) {
      float pos = (float)((lane & 31) < 16 ? (t >> 6) : (t & 63));
      float ang = pos * inv;
      cs = cosf(ang); sn = sinf(ang);
    }
#pragma unroll
    for (int hd = 0; hd < 4; ++hd) {
      float x = pr[512 + hd * 64 + lane];
      float ss = wave_sum(x * x, lane) * (1.f / 64.f);
      float xn = x * rsqrtf(ss + RMS_EPS) * qn;
      if (samp) {
        float o = shfl_x(xn, 32, lane);
        xn = lane < 32 ? xn * cs - o * sn : o * sn + xn * cs;
      }
      qb[(size_t)row * 256 + hd * 64 + lane] = f2bf(xn);
    }
#pragma unroll
    for (int hd = 0; hd < 2; ++hd) {
      float x = pr[768 + hd * 64 + lane];
      float ss = wave_sum(x * x, lane) * (1.f / 64.f);
      float xn = x * rsqrtf(ss + RMS_EPS) * kn;
      float vv = pr[896 + hd * 64 + lane];
      if (samp) {
        float o = shfl_x(xn, 32, lane);
        xn = lane < 32 ? xn * cs - o * sn : o * sn + xn * cs;
        ((bf16_t*)(ws + OFF_KS))[((size_t)(l * 2 + b) * 2560 + 512 + t) * 128 + hd * 64 + lane] = f2bf(xn);
        ((bf16_t*)(ws + OFF_VST))[((size_t)(l * 2 + b) * 128 + hd * 64 + lane) * 2560 + 512 + t] = f2bf(vv);
      } else {
        size_t oo = ((size_t)(b * 2 + l) * 256 + t) * 128 + hd * 64 + lane;
        p.out[OUT_K + oo] = xn;
        p.out[OUT_V + oo] = vv;
        ((bf16_t*)(ws + OFF_KP))[(size_t)row * 128 + hd * 64 + lane] = f2bf(xn);
        ((bf16_t*)(ws + OFF_VPT))[((size_t)b * 128 + hd * 64 + lane) * 256 + t] = f2bf(vv);
      }
    }
    {
      float z[4]; float s = 0.f;
#pragma unroll
      for (int i = 0; i < 4; ++i) { z[i] = gelu_t(pr[1280 + i * 64 + lane]); s += z[i]; }
      float mean = wave_sum(s, lane) * (1.f / 256.f);
      float q = 0.f;
#pragma unroll
      for (int i = 0; i < 4; ++i) { z[i] -= mean; q += z[i] * z[i]; }
      float rstd = rsqrtf(wave_sum(q, lane) * (1.f / 256.f) + LN_EPS);
      bf16_t* vct = (bf16_t*)(ws + OFF_VCT) + (size_t)(row >> 7) * 256 * 128 + (row & 127);
#pragma unroll
      for (int i = 0; i < 4; ++i) {
        int c = i * 64 + lane;
        float vn = z[i] * rstd * INP(I_CLG)[l * 256 + c] + INP(I_CLB)[l * 256 + c];
        vct[(size_t)c * 128] = f2bf(vn);
      }
    }
    {
      bf16_t* df = (bf16_t*)(ws + OFF_DIFF) + (size_t)row * 256;
#pragma unroll
      for (int gi = 0; gi < 4; ++gi) {
        const int hw = 1 << gi;
        int lo = max(t - hw, 0), hi = min(t + hw, L);
        float s = 0.f;
        for (int tt = lo; tt < hi; ++tt) s += pr[(ptrdiff_t)(tt - t) * DIN + gi * 64 + lane];
        float mean = s / (float)(hi - lo);
        df[gi * 64 + lane] = f2bf(mean - pr[gi * 64 + lane]);
      }
    }
  }
}

DI void attn_item(const bf16_t* __restrict__ Q, int qrow0, int head, const bf16_t* __restrict__ Kb,
                  const bf16_t* __restrict__ Vt, int nkeys, bf16_t* __restrict__ Y, int lane) {
  const int r = lane & 31, hh = lane >> 5, kvh = head >> 1;
  bf16x8 qf[4];
  const bf16_t* qp = Q + (size_t)(qrow0 + r) * 256 + head * 64 + 8 * hh;
#pragma unroll
  for (int s = 0; s < 4; ++s) qf[s] = *(const bf16x8*)(qp + 16 * s);
  f32x16 o0, o1;
#pragma unroll
  for (int i = 0; i < 16; ++i) { o0[i] = 0.f; o1[i] = 0.f; }
  float m = -INFINITY, lsum = 0.f;
  const float c = 0.125f * 1.4426950408889634f;
  const bf16_t* kp = Kb + (size_t)r * 128 + kvh * 64 + 8 * hh;
  const bf16_t* vp0 = Vt + (size_t)(kvh * 64 + r) * nkeys + 4 * hh;
  const bf16_t* vp1 = vp0 + (size_t)32 * nkeys;
  for (int k0 = 0; k0 < nkeys; k0 += 32) {
    f32x16 sa;
#pragma unroll
    for (int i = 0; i < 16; ++i) sa[i] = 0.f;
    const bf16_t* kq = kp + (size_t)k0 * 128;
#pragma unroll
    for (int s = 0; s < 4; ++s) { bf16x8 kf = *(const bf16x8*)(kq + 16 * s); sa = MFMA32(kf, qf[s], sa); }
    bf16x8 vf[2][2];
#pragma unroll
    for (int s = 0; s < 2; ++s) {
      s16x4 lo0 = *(const s16x4*)(vp0 + k0 + 16 * s), hi0 = *(const s16x4*)(vp0 + k0 + 16 * s + 8);
      s16x4 lo1 = *(const s16x4*)(vp1 + k0 + 16 * s), hi1 = *(const s16x4*)(vp1 + k0 + 16 * s + 8);
      vf[s][0] = __builtin_shufflevector(lo0, hi0, 0, 1, 2, 3, 4, 5, 6, 7);
      vf[s][1] = __builtin_shufflevector(lo1, hi1, 0, 1, 2, 3, 4, 5, 6, 7);
    }
    float mx = sa[0];
#pragma unroll
    for (int i = 1; i < 16; ++i) mx = fmaxf(mx, sa[i]);
    mx = fmaxf(mx, shfl_x(mx, 32, lane));
    float mn = fmaxf(m, mx);
    float alpha = __builtin_amdgcn_exp2f((m - mn) * c);
    m = mn;
    float pv[16]; float ps = 0.f;
#pragma unroll
    for (int i = 0; i < 16; ++i) { pv[i] = __builtin_amdgcn_exp2f((sa[i] - mn) * c); ps += pv[i]; }
    lsum = lsum * alpha + ps;
#pragma unroll
    for (int i = 0; i < 16; ++i) { o0[i] *= alpha; o1[i] *= alpha; }
#pragma unroll
    for (int s = 0; s < 2; ++s) {
      bf16x8 pf = pack8(pv[8 * s], pv[8 * s + 1], pv[8 * s + 2], pv[8 * s + 3], pv[8 * s + 4], pv[8 * s + 5], pv[8 * s + 6], pv[8 * s + 7]);
      o0 = MFMA32(vf[s][0], pf, o0);
      o1 = MFMA32(vf[s][1], pf, o1);
    }
  }
  lsum += shfl_x(lsum, 32, lane);
  const float il = 1.f / lsum;
  bf16_t* yp = Y + (size_t)(qrow0 + r) * D + 512 + head * 64 + 4 * hh;
#pragma unroll
  for (int g4 = 0; g4 < 4; ++g4) {
    u32x2 a = {pk2(o0[4 * g4] * il, o0[4 * g4 + 1] * il), pk2(o0[4 * g4 + 2] * il, o0[4 * g4 + 3] * il)};
    u32x2 b = {pk2(o1[4 * g4] * il, o1[4 * g4 + 1] * il), pk2(o1[4 * g4 + 2] * il, o1[4 * g4 + 3] * il)};
    *(u32x2*)(yp + 8 * g4) = a;
    *(u32x2*)(yp + 32 + 8 * g4) = b;
  }
}

DI void chunk_item(const Params& p, int l, int ch, int hd, int sp, int lane) {
  const int fr = lane & 15, fq = lane >> 4;
  const float* wsrc = INP(I_CWS) + ((size_t)(l * 4 + hd) * 128 + sp * 16 + fr) * 128 + fq * 8;
  const bf16_t* vb = (const bf16_t*)(PWS + OFF_VCT) + ((size_t)ch * 256 + hd * 64 + fr) * 128 + fq * 8;
  f32x4 acc[4];
#pragma unroll
  for (int i = 0; i < 4; ++i) acc[i] = (f32x4){0.f, 0.f, 0.f, 0.f};
#pragma unroll
  for (int ks = 0; ks < 4; ++ks) {
    float4 a0 = *(const float4*)(wsrc + ks * 32), a1 = *(const float4*)(wsrc + ks * 32 + 4);
    bf16x8 af = pack8(a0.x, a0.y, a0.z, a0.w, a1.x, a1.y, a1.z, a1.w);
#pragma unroll
    for (int nt = 0; nt < 4; ++nt) {
      bf16x8 bfr = *(const bf16x8*)(vb + (size_t)nt * 16 * 128 + ks * 32);
      acc[nt] = MFMA16(af, bfr, acc[nt]);
    }
  }
  const float* proj = (const float*)(PWS + OFF_R);
  bf16_t* ymix = (bf16_t*)(PWS + OFF_YMIX);
#pragma unroll
  for (int j = 0; j < 4; ++j) {
    int pp = sp * 16 + fq * 4 + j, tok = ch * 128 + pp;
    float bs = INP(I_CBS)[(l * 4 + hd) * 128 + pp];
#pragma unroll
    for (int nt = 0; nt < 4; ++nt) {
      int c = hd * 64 + nt * 16 + fr;
      float u = gelu_t(proj[(size_t)tok * DIN + 1024 + c]);
      ymix[(size_t)tok * D + 768 + c] = f2bf(u * (acc[nt][j] + bs));
    }
  }
}

#define SSM_STEP(UP) do { \
    float4 u0 = *(const float4*)(UP), u1 = *(const float4*)((UP) + 4), u2 = *(const float4*)((UP) + 8), u3 = *(const float4*)((UP) + 12); \
    float uu[16] = {u0.x, u0.y, u0.z, u0.w, u1.x, u1.y, u1.z, u1.w, u2.x, u2.y, u2.z, u2.w, u3.x, u3.y, u3.z, u3.w}; \
    float br_ = 0.f, bi_ = 0.f; \
    _Pragma("unroll") for (int c_ = 0; c_ < 16; ++c_) { br_ += Bb[c_].x * uu[c_]; bi_ += Bb[c_].y * uu[c_]; } \
    float nr_ = lam.x * hr - lam.y * hi + br_, ni_ = lam.x * hi + lam.y * hr + bi_; hr = nr_; hi = ni_; } while (0)

DI void ssm1_item(const Params& p, int l, int ck, int g, int dir, int lane) {
  const int idx = ((l * 2 + dir) * 16 + g) * 64 + lane;
  const float2* bbp = (const float2*)(PWS + OFF_BBAR) + (size_t)idx * 16;
  float2 Bb[16];
#pragma unroll
  for (int c = 0; c < 16; ++c) Bb[c] = bbp[c];
  const float2 lam = ((const float2*)(PWS + OFF_LAMB))[idx];
  float hr = 0.f, hi = 0.f;
  const float* ub = (const float*)(PWS + OFF_R) + (size_t)ck * 64 * DIN + 256 + g * 16;
#pragma unroll 2
  for (int tt = 0; tt < 64; ++tt) {
    int t = dir ? 63 - tt : tt;
    const float* up = ub + (size_t)t * DIN;
    SSM_STEP(up);
  }
  ((float2*)(PWS + OFF_E))[((size_t)(ck * 16 + g) * 2 + dir) * 64 + lane] = make_float2(hr, hi);
}

DI void ssm2_item(const Params& p, int l, int ck, int g, int lane, bf16_t* Hs) {
  const int fr = lane & 15, fq = lane >> 4;
  const bool samp = ck >= 128;
  const int CPS = samp ? 32 : 4;
  const int cs = samp ? ((ck - 128) & 31) : (ck & 3);
  const int cbase = ck - cs;
  const int b = samp ? ((ck - 128) >> 5) : (ck >> 2);
  const float* ub = (const float*)(PWS + OFF_R) + (size_t)ck * 64 * DIN + 256 + g * 16;
  const float2* Eb = (const float2*)(PWS + OFF_E);
  f32x4 yacc[4];
#pragma unroll
  for (int i = 0; i < 4; ++i) yacc[i] = (f32x4){0.f, 0.f, 0.f, 0.f};
#pragma unroll
  for (int dir = 0; dir < 2; ++dir) {
    const int gidx = (l * 2 + dir) * 16 + g, idx = gidx * 64 + lane;
    const float2* bbp = (const float2*)(PWS + OFF_BBAR) + (size_t)idx * 16;
    float2 Bb[16];
#pragma unroll
    for (int c = 0; c < 16; ++c) Bb[c] = bbp[c];
    const float2 lam = ((const float2*)(PWS + OFF_LAMB))[idx];
    const float2 lamT = ((const float2*)(PWS + OFF_LAMT))[idx];
    bf16x8 cf[4];
#pragma unroll
    for (int ks = 0; ks < 4; ++ks) {
      const float* cp = (ks < 2 ? INP(I_CRE) : INP(I_CIM)) + ((size_t)gidx * 16 + fr) * 64 + (ks & 1) * 32 + fq * 8;
      float4 a0 = *(const float4*)cp, a1 = *(const float4*)(cp + 4);
      const float sg = ks < 2 ? 1.f : -1.f;
      cf[ks] = pack8(sg * a0.x, sg * a0.y, sg * a0.z, sg * a0.w, sg * a1.x, sg * a1.y, sg * a1.z, sg * a1.w);
    }
    float hr = 0.f, hi = 0.f;
    if (samp) {
      size_t si = ((size_t)((b * 2 + l) * 2 + dir) * 16 + g) * 64 + lane;
      hr = INP(I_SRE)[si]; hi = INP(I_SIM)[si];
    }
    if (dir == 0) {
      for (int c2 = 0; c2 < cs; ++c2) {
        float2 e = Eb[((size_t)((cbase + c2) * 16 + g) * 2 + 0) * 64 + lane];
        float nr = lamT.x * hr - lamT.y * hi + e.x, ni = lamT.x * hi + lamT.y * hr + e.y; hr = nr; hi = ni;
      }
    } else {
      for (int c2 = CPS - 1; c2 > cs; --c2) {
        float2 e = Eb[((size_t)((cbase + c2) * 16 + g) * 2 + 1) * 64 + lane];
        float nr = lamT.x * hr - lamT.y * hi + e.x, ni = lamT.x * hi + lamT.y * hr + e.y; hr = nr; hi = ni;
      }
    }
#pragma unroll
    for (int sb = 0; sb < 4; ++sb) {
#pragma unroll 1
      for (int tt = 0; tt < 16; ++tt) {
        int tl = sb * 16 + tt, t = dir ? 63 - tl : tl;
        const float* up = ub + (size_t)t * DIN;
        SSM_STEP(up);
        int hrow = dir ? 15 - tt : tt;
        Hs[hrow * 136 + lane] = f2bf(hr);
        Hs[hrow * 136 + 64 + lane] = f2bf(hi);
      }
      asm volatile("s_waitcnt lgkmcnt(0)" ::: "memory");
      __builtin_amdgcn_wave_barrier();
      const int ysb = dir ? 3 - sb : sb;
#pragma unroll
      for (int ks = 0; ks < 4; ++ks) {
        bf16x8 af = *(const bf16x8*)(Hs + fr * 136 + ks * 32 + fq * 8);
        yacc[ysb] = MFMA16(af, cf[ks], yacc[ysb]);
      }
      asm volatile("s_waitcnt lgkmcnt(0)" ::: "memory");
      __builtin_amdgcn_wave_barrier();
    }
    if (!samp && ((dir == 0 && cs == 3) || (dir == 1 && cs == 0))) {
      size_t so = ((size_t)((b * 2 + l) * 2 + dir) * 16 + g) * 64 + lane;
      p.out[OUT_SRE + so] = hr; p.out[OUT_SIM + so] = hi;
    }
  }
  bf16_t* sg = (bf16_t*)(PWS + OFF_SG);
  const int c = g * 16 + fr;
  const float dd = INP(I_SSMD)[l * 256 + c];
#pragma unroll
  for (int ysb = 0; ysb < 4; ++ysb)
#pragma unroll
    for (int j = 0; j < 4; ++j) {
      int tl = ysb * 16 + fq * 4 + j;
      size_t row = (size_t)ck * 64 + tl;
      float u = ub[(size_t)tl * DIN + fr];
      float y = yacc[ysb][j] + dd * u;
      sg[row * 256 + c] = f2bf(gelu_t(y));
    }
}

DI void mix_phase(const Params& p, int l, int bid, int nblk) {
  const int tid = otid(), wid = tid >> 6, lane = tid & 63;
  const int slot = wid * nblk + bid, nslot = nblk * 8;
  char* ws = PWS;
  const bf16_t* qb = (const bf16_t*)(ws + OFF_QB);
  bf16_t* ymix = (bf16_t*)(ws + OFF_YMIX);
  for (int it = slot; it < 1536; it += nslot) {
    if (it < 512) {
      int b = it >> 8, head = (it >> 6) & 3, qt = it & 63;
      attn_item(qb, NPROMPT + b * 2048 + qt * 32, head,
                (const bf16_t*)(ws + OFF_KS) + (size_t)(l * 2 + b) * 2560 * 128,
                (const bf16_t*)(ws + OFF_VST) + (size_t)(l * 2 + b) * 128 * 2560, 2560, ymix, lane);
    } else {
      int j = it - 512;
      int b = j >> 5, head = (j >> 3) & 3, qt = j & 7;
      attn_item(qb, b * 256 + qt * 32, head,
                (const bf16_t*)(ws + OFF_KP) + (size_t)b * 256 * 128,
                (const bf16_t*)(ws + OFF_VPT) + (size_t)b * 128 * 256, 256, ymix, lane);
    }
  }
  const int NL = 3072 + 6144;
  int j0, jst;
  if (nslot > 1024) { j0 = slot - 512; jst = nslot - 512; } else { j0 = slot; jst = nslot; }
  if (j0 >= 0)
    for (int it = j0; it < NL; it += jst) {
      if (it < 3072) {
        chunk_item(p, l, it >> 5, (it >> 3) & 3, it & 7, lane);
      } else {
        int j = it - 3072;
        ssm1_item(p, l, j >> 5, (j >> 1) & 15, j & 1, lane);
      }
    }
}

DI void ssm2_phase(const Params& p, int l, char* shmc, int bid, int nblk) {
  const int tid = otid(), wid = tid >> 6, lane = tid & 63;
  bf16_t* Hs = (bf16_t*)shmc + wid * (16 * 136);
  for (int it = wid * nblk + bid; it < 3072; it += nblk * 8) ssm2_item(p, l, it >> 4, it & 15, lane, Hs);
}

constexpr int N_PHASE = 28;
DI void run_phase(const Params& p, int ph, char* shm, int bid, int nblk) {
  char* ws = PWS;
  if (ph == 0) { prep_phase(p, shm, bid, nblk); return; }
  if (ph == 27) { lnmod_phase(p, 1, 2, -1, 0, bid, nblk); return; }
  const int l = (ph - 1) / 13, s = (ph - 1) % 13;
  const bf16_t* hA = (const bf16_t*)(ws + OFF_H);
  bf16_t* hid = (bf16_t*)(ws + OFF_R);
  float* xy = (float*)(ws + OFF_XY);
  const float* modl = (const float*)(ws + OFF_MOD) + (size_t)l * 3 * 9216;
  EpiArgs ea; ea.f0 = nullptr; ea.b0 = nullptr; ea.c0 = nullptr; ea.cb = nullptr; ea.w = 0.f;
  switch (s) {
    case 0: if (l == 0) lnmod_phase(p, -1, 0, 0, 0, bid, nblk); else lnmod_phase(p, l - 1, 2, l, 0, bid, nblk); break;
    case 1: case 11: {
      int sI = s == 1 ? 0 : 1;
      ea.b0 = hid;
      gemm_phase<1024, EPI_SWIGLU>(hA, (const bf16_t*)(ws + OFF_W1T) + (size_t)(l * 2 + sI) * 5632 * 1024, 48, 22, ea, shm, bid, nblk);
    } break;
    case 2: case 12: {
      int sI = s == 2 ? 0 : 1;
      ea.f0 = xy; ea.c0 = modl + (s == 2 ? 2 : 8) * 1024; ea.w = 0.5f;
      gemm_phase<2816, EPI_RESID>(hid, (const bf16_t*)(ws + OFF_W2T) + (size_t)(l * 2 + sI) * 1024 * 2816, 48, 4, ea, shm, bid, nblk);
    } break;
    case 3: lnmod_phase(p, l, 0, l, 3, bid, nblk); break;
    case 4: {
      ea.f0 = (float*)(ws + OFF_R);
      gemm_phase<1024, EPI_F32>(hA, (const bf16_t*)(ws + OFF_WINT) + (size_t)l * 1536 * 1024, 48, 6, ea, shm, bid, nblk);
    } break;
    case 5: post_phase(p, l, bid, nblk); break;
    case 6: mix_phase(p, l, bid, nblk); break;
    case 7: ssm2_phase(p, l, shm, bid, nblk); break;
    case 8: {
      ea.b0 = (bf16_t*)(ws + OFF_YMIX); ea.cb = (const bf16_t*)(ws + OFF_SG); ea.c0 = INP(I_BGLU) + l * 256;
      gemm_phase<256, EPI_GLU>((const bf16_t*)(ws + OFF_SG), (const bf16_t*)(ws + OFF_WGLUT) + (size_t)l * 65536, 48, 1, ea, shm, bid, nblk);
      ea.c0 = INP(I_POOLS) + l * 256;
      int bid2 = (bid + nblk - (nblk >> 1)) % nblk;
      gemm_phase<256, EPI_POOL>((const bf16_t*)(ws + OFF_DIFF), (const bf16_t*)(ws + OFF_WPOOLT) + (size_t)l * 65536, 48, 1, ea, shm, bid2, nblk);
    } break;
    case 9: {
      ea.f0 = xy; ea.c0 = modl + 5 * 1024; ea.w = 1.0f;
      gemm_phase<1024, EPI_RESID>((const bf16_t*)(ws + OFF_YMIX), (const bf16_t*)(ws + OFF_WOUTT) + (size_t)l * 1024 * 1024, 48, 4, ea, shm, bid, nblk);
    } break;
    case 10: lnmod_phase(p, l, 1, l, 6, bid, nblk); break;
  }
}

__global__ __launch_bounds__(512, 2) void mega(Params p, int ph_lo, int ph_hi) {
  extern __shared__ __attribute__((aligned(16))) char shm[];
  const int bid = blockIdx.x, nblk = gridDim.x;
  for (int ph = ph_lo; ph < ph_hi; ++ph) {
    if (ph > ph_lo) cg::this_grid().sync();
    run_phase(p, ph, shm, bid, nblk);
  }
}

extern "C" void kernel_launch(void* const* d_in, const int* in_sizes, int n_in, void* d_out, int out_size, void* d_ws,
                              size_t ws_size, hipStream_t stream) {
  static int grid_blocks = 0;
  if (!grid_blocks) {
    hipFuncSetAttribute((const void*)mega, hipFuncAttributeMaxDynamicSharedMemorySize, GEMM_LDS);
    int dev = 0, cus = 0, per_cu = 0;
    hipGetDevice(&dev);
    hipDeviceGetAttribute(&cus, hipDeviceAttributeMultiprocessorCount, dev);
    hipOccupancyMaxActiveBlocksPerMultiprocessor(&per_cu, mega, 512, GEMM_LDS);
    if (per_cu < 1) per_cu = 1;
    if (per_cu > 1) per_cu = 1;
    grid_blocks = cus * per_cu;
  }
  Params p{};
  for (int i = 0; i < N_IN; ++i) p.in[i] = (const float*)d_in[i];
  p.out = (float*)d_out;
  p.ws = (char*)d_ws;
#if ONE_LAUNCH
  int lo = 0, hi = N_PHASE;
  void* args[] = {&p, &lo, &hi};
  hipError_t e = hipLaunchCooperativeKernel((const void*)mega, dim3(grid_blocks), dim3(512), args, GEMM_LDS, stream);
  if (e != hipSuccess) fprintf(stderr, "cooperative launch failed: %s (grid %d)\n", hipGetErrorString(e), grid_blocks);
#else
  for (int ph = 0; ph < N_PHASE; ++ph) mega<<<grid_blocks, 512, GEMM_LDS, stream>>>(p, ph, ph + 1);
#endif
}
```

```cpp
#include <hip/hip_runtime.h>
#include <hip/hip_cooperative_groups.h>
#include <cstdio>
namespace cg = cooperative_groups;

#define DI __device__ __forceinline__
typedef unsigned short bf16_t;
typedef __attribute__((ext_vector_type(8))) short bf16x8;
typedef __attribute__((ext_vector_type(4))) short s16x4;
typedef __attribute__((ext_vector_type(4))) float f32x4;
typedef __attribute__((ext_vector_type(16))) float f32x16;
typedef __attribute__((ext_vector_type(2))) float f32x2;
typedef __attribute__((ext_vector_type(2))) __bf16 bf16x2v;
typedef __attribute__((ext_vector_type(4))) unsigned u32x4;
typedef __attribute__((ext_vector_type(2))) unsigned u32x2;

#ifndef ONE_LAUNCH
#define ONE_LAUNCH 1
#endif

constexpr int D = 1024, NTOK = 12288, NPROMPT = 8192, DFF = 2816, DIN = 1536;
constexpr float ALPHA = 1.4142135623730951f;
constexpr float LN_EPS = 1e-5f, RMS_EPS = 1e-6f;
enum { I_XP = 0, I_XS, I_CK, I_CV, I_SRE, I_SIM, I_C, I_CCTX, I_WMOD, I_BMOD, I_LNG, I_LNB, I_W1, I_W2, I_WIN, I_WOUT,
       I_POOLW, I_POOLS, I_LRE, I_LIM, I_LSTEP, I_BRE, I_BIM, I_CRE, I_CIM, I_SSMD, I_WGLU, I_BGLU, I_QN, I_KN,
       I_CLG, I_CLB, I_CWS, I_CBS, N_IN };
constexpr size_t OUT_K = 12582912, OUT_V = 14680064, OUT_SRE = 16777216, OUT_SIM = 16908288;

constexpr size_t OFF_W1T = 0;
constexpr size_t OFF_W2T = OFF_W1T + 46137344;
constexpr size_t OFF_WINT = OFF_W2T + 23068672;
constexpr size_t OFF_WOUTT = OFF_WINT + 6291456;
constexpr size_t OFF_WGLUT = OFF_WOUTT + 4194304;
constexpr size_t OFF_WPOOLT = OFF_WGLUT + 262144;
constexpr size_t OFF_MOD = OFF_WPOOLT + 262144;
constexpr size_t OFF_XY = OFF_MOD + 221184;
constexpr size_t OFF_H = OFF_XY + 50331648;
constexpr size_t OFF_YMIX = OFF_H + 25165824;
constexpr size_t OFF_R = OFF_YMIX + 25165824;
constexpr size_t OFF_QB = OFF_R + 75497472;
constexpr size_t OFF_KP = OFF_QB + 6291456;
constexpr size_t OFF_KS = OFF_KP + 2097152;
constexpr size_t OFF_VPT = OFF_KS + 2621440;
constexpr size_t OFF_VST = OFF_VPT + 2097152;
constexpr size_t OFF_VCT = OFF_VST + 2621440;
constexpr size_t OFF_DIFF = OFF_VCT + 6291456;
constexpr size_t OFF_SG = OFF_DIFF + 6291456;
constexpr size_t OFF_E = OFF_SG + 6291456;
constexpr size_t OFF_LAMB = OFF_E + 3145728;
constexpr size_t OFF_LAMT = OFF_LAMB + 32768;
constexpr size_t OFF_BBAR = OFF_LAMT + 32768;
constexpr size_t OFF_BAR = OFF_BBAR + 524288;
constexpr size_t WS_TOTAL = OFF_BAR + 16384;

struct Params { const float* in[N_IN]; float* out; char* ws; };

DI int otid() {
  int z = 0; asm volatile("" : "+s"(z));
  int lane = __builtin_amdgcn_mbcnt_hi(-1, __builtin_amdgcn_mbcnt_lo(-1, z));
  int w = __builtin_amdgcn_readfirstlane(threadIdx.x >> 6);
  return w * 64 + lane;
}
DI int osgpr(int i) { asm volatile("" : "+s"(i)); return i; }
#define INP(i) (p.in[osgpr(i)])
DI char* ows(char* w) { asm volatile("" : "+s"(w)); return w; }
#define PWS ows(p.ws)
DI unsigned pk2(float a, float b) { f32x2 v = {a, b}; bf16x2v r = __builtin_convertvector(v, bf16x2v); return __builtin_bit_cast(unsigned, r); }
DI bf16_t f2bf(float a) { return (bf16_t)(pk2(a, 0.f) & 0xffffu); }
DI float bf2f(bf16_t v) { return __uint_as_float(((unsigned)v) << 16); }
DI bf16x8 pack8(float a0, float a1, float a2, float a3, float a4, float a5, float a6, float a7) {
  u32x4 u = {pk2(a0, a1), pk2(a2, a3), pk2(a4, a5), pk2(a6, a7)};
  return __builtin_bit_cast(bf16x8, u);
}
DI float gelu_t(float x) {
  float z = 0.7978845608028654f * (x + 0.044715f * x * x * x);
  float e = __expf(2.f * z);
  float th = 1.f - 2.f / (e + 1.f);
  return 0.5f * x * (1.f + th);
}
DI float sigmoid_f(float x) { return 1.f / (1.f + __expf(-x)); }
DI float shfl_x(float v, int mask, int lane) {
  return __int_as_float(__builtin_amdgcn_ds_bpermute((lane ^ mask) << 2, __float_as_int(v)));
}
DI float wave_sum(float v, int lane) {
#pragma unroll
  for (int o = 32; o > 0; o >>= 1) v += shfl_x(v, o, lane);
  return v;
}
#define MFMA16(a, b, c) __builtin_amdgcn_mfma_f32_16x16x32_bf16((a), (b), (c), 0, 0, 0)
#define MFMA32(a, b, c) __builtin_amdgcn_mfma_f32_32x32x16_bf16((a), (b), (c), 0, 0, 0)


#define XB_TMO      128
#define XB_XCNT(j)  (256  + 64 * (j))
#define XB_XSUB(j)  (1280 + 64 * (j))
#define XB_XGEN(j)  (2304 + 64 * (j))
#define XB_TOP      3328
#define XB_TOPGEN   3392
#define XCD_BAR_WORDS 3456
#define XB_SPIN_CAP (1u << 18)
#define LAS __attribute__((address_space(3)))
DI unsigned xb_ld(unsigned* p) { return __hip_atomic_load(p, __ATOMIC_RELAXED, __HIP_MEMORY_SCOPE_AGENT); }
DI unsigned xb_add(unsigned* p, unsigned v) { return __hip_atomic_fetch_add(p, v, __ATOMIC_RELAXED, __HIP_MEMORY_SCOPE_AGENT); }
DI unsigned xb_xcc_id() { return (unsigned)__builtin_amdgcn_s_getreg((3 << 11) | 20) & 0xFu; }
#define XB_SPIN(cond, bar) do { unsigned _sp = 0; while (cond) { __builtin_amdgcn_s_sleep(1); \
    if ((++_sp & 255u) == 0u) { if (xb_ld(&(bar)[XB_TMO])) break; if (_sp > XB_SPIN_CAP) { atomicAdd(&(bar)[XB_TMO], 1u); break; } } } } while (0)
struct XcdBarrier { unsigned* bar; unsigned x; volatile LAS unsigned* st; };
DI XcdBarrier xcd_barrier_post(unsigned* bar, volatile LAS unsigned* st) {
  XcdBarrier b; b.bar = bar; b.x = xb_xcc_id(); b.st = st;
  if (threadIdx.x == 0) (void)xb_add(&bar[XB_XCNT(b.x)], 1u);
  return b;
}
DI void xcd_barrier_complete(unsigned* bar, unsigned x, unsigned& nloc, unsigned& nx) {
  const unsigned G = gridDim.x * gridDim.y * gridDim.z;
  unsigned sum, cnt, mine, sp = 0u;
  for (;;) {
    sum = 0u; cnt = 0u; mine = 0u;
#pragma unroll
    for (unsigned j = 0; j < 16; ++j) { const unsigned c = xb_ld(&bar[XB_XCNT(j)]); sum += c; cnt += (c > 0u) ? 1u : 0u; mine = (j == x) ? c : mine; }
    if (sum == G) break;
    __builtin_amdgcn_s_sleep(1);
    if ((++sp & 255u) == 0u) { if (xb_ld(&bar[XB_TMO])) break; if (sp > XB_SPIN_CAP) { atomicAdd(&bar[XB_TMO], 1u); break; } }
  }
  nloc = mine > 0u ? mine : 1u; nx = cnt > 0u ? cnt : 1u;
}
DI void xcd_barrier(const XcdBarrier& b) {
  asm volatile("s_waitcnt vmcnt(0)" ::: "memory");
  __syncthreads();
  if (threadIdx.x == 0) {
    unsigned* bar = b.bar;
    __builtin_amdgcn_s_waitcnt(0);
    unsigned nloc = b.st[0], nx = b.st[1];
    if (nloc == 0u) { xcd_barrier_complete(bar, b.x, nloc, nx); b.st[0] = nloc; b.st[1] = nx; }
    const unsigned old = xb_add(&bar[XB_XSUB(b.x)], 1u);
    const unsigned gen = old / nloc;
    if (old + 1u == (gen + 1u) * nloc) {
      __builtin_amdgcn_fence(__ATOMIC_RELEASE, "agent");
      asm volatile("s_waitcnt vmcnt(0)" ::: "memory");
      const unsigned og = xb_add(&bar[XB_TOP], 1u);
      const unsigned tg = og / nx;
      if (og + 1u == (tg + 1u) * nx) xb_add(&bar[XB_TOPGEN], 1u);
      else XB_SPIN(xb_ld(&bar[XB_TOPGEN]) == tg, bar);
      __builtin_amdgcn_fence(__ATOMIC_ACQUIRE, "agent");
      xb_add(&bar[XB_XGEN(b.x)], 1u);
      asm volatile("s_waitcnt vmcnt(0)" ::: "memory");
    } else {
      XB_SPIN(xb_ld(&bar[XB_XGEN(b.x)]) == gen, bar);
      __builtin_amdgcn_fence(__ATOMIC_ACQUIRE, "agent");
      asm volatile("s_waitcnt vmcnt(0)" ::: "memory");
    }
  }
  __syncthreads();
}

constexpr int BM = 256, BK = 64, HALF = 128, NXCD = 8, WGM = 8, HT = HALF * BK;
constexpr int GEMM_LDS = 8 * HT * 2;

DI int lds_byte(int r, int c) {
  int st = (r >> 4) * 2 + (c >> 5), rr = r & 15, cc = c & 31, ob = rr * 64 + cc * 2;
  return st * 1024 + (ob ^ (((ob >> 9) & 1) << 5));
}
DI void stage_rc(int b, int& R, int& C) {
  int st = b / 1024, sb = b % 1024, swz = sb ^ (((sb >> 9) & 1) << 5);
  R = (st >> 1) * 16 + swz / 64; C = (st & 1) * 32 + (swz % 64) / 2;
}

enum { EPI_SWIGLU = 0, EPI_RESID, EPI_F32, EPI_GLU, EPI_POOL };
struct EpiArgs {
  float* f0;
  bf16_t* b0;
  const float* c0;
  const bf16_t* cb;
  float w;
};

template <int K, int MODE>
DI void gemm_phase(const bf16_t* __restrict__ A, const bf16_t* __restrict__ Bt, int nM, int nN, EpiArgs ea,
                   char* shmc, int bid, int nblk) {
  bf16_t* shm = (bf16_t*)shmc;
#define SA(b, h) (shm + ((b) * 2 + (h)) * HT)
#define SB(b, h) (shm + (4 + (b) * 2 + (h)) * HT)
#define STAGE(P, RS, SOFF, kt) do { const int _so = (SOFF) + (kt) * (BK * 2); \
    __builtin_amdgcn_raw_ptr_buffer_load_lds(RS, (__attribute__((address_space(3))) void*)((char*)(P) + wid * 1024), 16, so0, _so, 0, 0); \
    __builtin_amdgcn_raw_ptr_buffer_load_lds(RS, (__attribute__((address_space(3))) void*)((char*)(P) + wid * 1024 + 8192), 16, so1, _so, 0, 0); } while (0)
#define LDA(dst, b, h) for (int m = 0; m < 4; ++m) for (int k = 0; k < 2; ++k) \
    dst[m][k] = *reinterpret_cast<const bf16x8*>((char*)SA(b, h) + lds_byte(wr * 64 + m * 16 + fr, k * 32 + fq * 8))
#define LDB(dst, b, h) for (int n = 0; n < 2; ++n) for (int k = 0; k < 2; ++k) \
    dst[n][k] = *reinterpret_cast<const bf16x8*>((char*)SB(b, h) + lds_byte(wc * 32 + n * 16 + fr, k * 32 + fq * 8))
#define MMA(ai, bj, At, Bt_) do { __builtin_amdgcn_s_setprio(1); \
    for (int m = 0; m < 4; ++m) for (int n = 0; n < 2; ++n) for (int k = 0; k < 2; ++k) \
      acc[ai][bj][m][n] = MFMA16(At[m][k], Bt_[n][k], acc[ai][bj][m][n]); \
    __builtin_amdgcn_s_setprio(0); } while (0)
#define WAIT_V(n) asm volatile("s_waitcnt vmcnt(" #n ")" ::: "memory")
#define WAIT_L(n) asm volatile("s_waitcnt lgkmcnt(" #n ")" ::: "memory")
#define BAR __builtin_amdgcn_s_barrier()
#define SCHED __builtin_amdgcn_sched_barrier(0)
  const int tid = otid();
  const int wid = __builtin_amdgcn_readfirstlane(tid >> 6), lane = tid & 63, wr = wid >> 2, wc = wid & 3, fr = lane & 15, fq = lane >> 4;
  const __amdgpu_buffer_rsrc_t rsA = __builtin_amdgcn_make_buffer_rsrc((void*)A, 0, 0x7fffffff, 0x00020000);
  const __amdgpu_buffer_rsrc_t rsB = __builtin_amdgcn_make_buffer_rsrc((void*)Bt, 0, 0x7fffffff, 0x00020000);
  unsigned so0, so1;
  { int R, C; stage_rc(tid * 16, R, C); so0 = (unsigned)(R * K + C) * 2u; stage_rc(tid * 16 + 8192, R, C); so1 = (unsigned)(R * K + C) * 2u; }
  constexpr int nt = K / BK;
  const int nwg = nM * nN;
  for (int tile = bid; tile < nwg; tile += nblk) {
    int wgid = tile;
    { int q = nwg / NXCD, r = nwg % NXCD, xcd = wgid % NXCD, off = wgid / NXCD;
      wgid = (xcd < r ? xcd * (q + 1) : r * (q + 1) + (xcd - r) * q) + off; }
    int nig = WGM * nN, gid = wgid / nig, fm = gid * WGM, gsz = min(nM - fm, WGM);
    int pm = fm + ((wgid % nig) % gsz), pn = (wgid % nig) / gsz, brow = pm * BM, bcol = pn * BM;
    const int A0 = brow * K * 2, A1 = A0 + HALF * K * 2, B0p = bcol * K * 2, B1p = B0p + HALF * K * 2;
    f32x4 acc[2][2][4][2] = {};
    bf16x8 At[4][2], B0[2][2], B1[2][2];
    STAGE(SB(0, 0), rsB, B0p, 0); STAGE(SA(0, 0), rsA, A0, 0);
    STAGE(SB(0, 1), rsB, B1p, 0); STAGE(SA(0, 1), rsA, A1, 0);
    if (wr == 1) BAR;
    WAIT_V(4); BAR;
    STAGE(SB(1, 0), rsB, B0p, 1); STAGE(SA(1, 0), rsA, A0, 1); STAGE(SB(1, 1), rsB, B1p, 1);
    WAIT_V(6); BAR;
    for (int t = 0; t < nt - 2; t += 2) {
      LDB(B0, 0, 0); SCHED; LDA(At, 0, 0); STAGE(SA(1, 1), rsA, A1, t + 1);
      WAIT_L(8); BAR; WAIT_L(0); MMA(0, 0, At, B0); BAR; SCHED;
      LDB(B1, 0, 1); STAGE(SB(0, 0), rsB, B0p, t + 2);
      BAR; WAIT_L(0); MMA(0, 1, At, B1); BAR;
      LDA(At, 0, 1); STAGE(SA(0, 0), rsA, A0, t + 2);
      BAR; WAIT_L(0); MMA(1, 0, At, B0); BAR; SCHED;
      STAGE(SB(0, 1), rsB, B1p, t + 2);
      WAIT_V(6); BAR; MMA(1, 1, At, B1); BAR;
      LDB(B0, 1, 0); SCHED; LDA(At, 1, 0); STAGE(SA(0, 1), rsA, A1, t + 2);
      WAIT_L(8); BAR; WAIT_L(0); MMA(0, 0, At, B0); BAR; SCHED;
      LDB(B1, 1, 1); STAGE(SB(1, 0), rsB, B0p, t + 3);
      BAR; WAIT_L(0); MMA(0, 1, At, B1); BAR;
      LDA(At, 1, 1); STAGE(SA(1, 0), rsA, A0, t + 3);
      BAR; WAIT_L(0); MMA(1, 0, At, B0); BAR; SCHED;
      STAGE(SB(1, 1), rsB, B1p, t + 3);
      WAIT_V(6); BAR; MMA(1, 1, At, B1); BAR;
    }
    { LDB(B0, 0, 0); LDA(At, 0, 0); STAGE(SA(1, 1), rsA, A1, nt - 1);
      BAR; WAIT_L(0); MMA(0, 0, At, B0); BAR;
      LDB(B1, 0, 1); BAR; WAIT_L(0); MMA(0, 1, At, B1); BAR;
      LDA(At, 0, 1); WAIT_V(4); BAR; WAIT_L(0); MMA(1, 0, At, B0); MMA(1, 1, At, B1); BAR; }
    { LDB(B0, 1, 0); LDA(At, 1, 0); WAIT_V(2); BAR; WAIT_L(0); MMA(0, 0, At, B0); BAR;
      LDB(B1, 1, 1); WAIT_V(0); BAR; WAIT_L(0); MMA(0, 1, At, B1); BAR;
      LDA(At, 1, 1); BAR; WAIT_L(0); MMA(1, 0, At, B0); MMA(1, 1, At, B1); BAR; }
    if (wr == 0) BAR;
    const int ci = brow < NPROMPT ? 0 : 1 + (brow - NPROMPT) / 2048;
    const int te = otid(), le = te & 63, wide = te >> 6;
    const int wr = wide >> 2, wc = wide & 3, fr = le & 15, fq = le >> 4;
#pragma unroll
    for (int ai = 0; ai < 2; ++ai)
#pragma unroll
      for (int m = 0; m < 4; ++m)
#pragma unroll
        for (int j = 0; j < 4; ++j) {
          const int row = brow + ai * HALF + wr * 64 + m * 16 + fq * 4 + j;
          if (MODE == EPI_SWIGLU) {
#pragma unroll
            for (int n = 0; n < 2; ++n) {
              float g = acc[ai][0][m][n][j], u = acc[ai][1][m][n][j];
              float v = g * sigmoid_f(g) * u;
              ea.b0[(size_t)row * DFF + pn * 128 + wc * 32 + n * 16 + fr] = f2bf(v);
            }
          } else {
#pragma unroll
            for (int bj = 0; bj < 2; ++bj)
#pragma unroll
              for (int n = 0; n < 2; ++n) {
                const int col = bcol + bj * HALF + wc * 32 + n * 16 + fr;
                float a = acc[ai][bj][m][n][j];
                if (MODE == EPI_RESID) {
                  float gate = ea.w * ea.c0[ci * 9216 + col];
                  size_t o = (size_t)row * D + col;
                  ea.f0[o] = ALPHA * ea.f0[o] + gate * a;
                } else if (MODE == EPI_F32) {
                  ea.f0[(size_t)row * DIN + col] = a;
                } else if (MODE == EPI_GLU) {
                  float g = bf2f(ea.cb[(size_t)row * 256 + col]);
                  ea.b0[(size_t)row * D + 256 + col] = f2bf(g * sigmoid_f(a + ea.c0[col]));
                } else if (MODE == EPI_POOL) {
                  ea.b0[(size_t)row * D + col] = f2bf(a * ea.c0[col]);
                }
              }
          }
        }
  }
#undef SA
#undef SB
}

DI void prep_phase(const Params& p, char* shmc, int bid, int nblk) {
  const int tid = otid(), wid = tid >> 6, lane = tid & 63;
  char* ws = PWS;
  {
    float* tile = (float*)shmc;
    constexpr int T_W1 = 16 * 88, T_W2 = 44 * 16, T_IN = 16 * 24, T_OUT = 256, T_GLU = 16;
    constexpr int PER_L = 2 * T_W1 + 2 * T_W2 + T_IN + T_OUT + T_GLU;
    for (int it = bid; it < 2 * PER_L; it += nblk) {
      int l = it / PER_L, r = it % PER_L;
      const float* src; bf16_t* dst; int K, N, mode = 0;
      if (r < 2 * T_W1) {
        int s = r / T_W1; r %= T_W1;
        src = INP(I_W1) + (size_t)(l * 2 + s) * 1024 * 5632; dst = (bf16_t*)(ws + OFF_W1T) + (size_t)(l * 2 + s) * 5632 * 1024;
        K = 1024; N = 5632; mode = 1;
      } else if (r < 2 * T_W1 + 2 * T_W2) {
        r -= 2 * T_W1; int s = r / T_W2; r %= T_W2;
        src = INP(I_W2) + (size_t)(l * 2 + s) * 2816 * 1024; dst = (bf16_t*)(ws + OFF_W2T) + (size_t)(l * 2 + s) * 1024 * 2816;
        K = 2816; N = 1024;
      } else if (r < 2 * T_W1 + 2 * T_W2 + T_IN) {
        r -= 2 * T_W1 + 2 * T_W2;
        src = INP(I_WIN) + (size_t)l * 1024 * 1536; dst = (bf16_t*)(ws + OFF_WINT) + (size_t)l * 1536 * 1024;
        K = 1024; N = 1536;
      } else if (r < 2 * T_W1 + 2 * T_W2 + T_IN + T_OUT) {
        r -= 2 * T_W1 + 2 * T_W2 + T_IN;
        src = INP(I_WOUT) + (size_t)l * 1024 * 1024; dst = (bf16_t*)(ws + OFF_WOUTT) + (size_t)l * 1024 * 1024;
        K = 1024; N = 1024;
      } else {
        r -= 2 * T_W1 + 2 * T_W2 + T_IN + T_OUT;
        src = INP(I_WGLU) + (size_t)l * 256 * 256; dst = (bf16_t*)(ws + OFF_WGLUT) + (size_t)l * 256 * 256;
        K = 256; N = 256;
      }
      int nkt = K / 64, kt = r % nkt, ntile = r / nkt;
#pragma unroll
      for (int i = 0; i < 2; ++i) {
        int k = (tid >> 4) + 32 * i, n = (tid & 15) * 4;
        float4 v = *(const float4*)(src + (size_t)(kt * 64 + k) * N + ntile * 64 + n);
        tile[k * 65 + n] = v.x; tile[k * 65 + n + 1] = v.y; tile[k * 65 + n + 2] = v.z; tile[k * 65 + n + 3] = v.w;
      }
      __syncthreads();
      {
        int n = tid >> 3, kk = (tid & 7) * 8;
        int nsrc = ntile * 64 + n, nrow = nsrc;
        if (mode == 1) {
          if (nsrc < 2816) nrow = (nsrc >> 7) * 256 + (nsrc & 127);
          else { int mm = nsrc - 2816; nrow = (mm >> 7) * 256 + 128 + (mm & 127); }
        }
        bf16x8 o = pack8(tile[(kk + 0) * 65 + n], tile[(kk + 1) * 65 + n], tile[(kk + 2) * 65 + n], tile[(kk + 3) * 65 + n],
                         tile[(kk + 4) * 65 + n], tile[(kk + 5) * 65 + n], tile[(kk + 6) * 65 + n], tile[(kk + 7) * 65 + n]);
        *(bf16x8*)(dst + (size_t)nrow * K + kt * 64 + kk) = o;
      }
      __syncthreads();
    }
  }
  const int gtid = bid * 512 + tid, gn = nblk * 512;
  for (int i = gtid; i < 2 * 65536; i += gn) {
    int l = i >> 16, n = (i >> 8) & 255, k = i & 255;
    int gi = n >> 6, d = n & 63, gj = k >> 6, c = k & 63;
    float v = (gi == gj) ? INP(I_POOLW)[((size_t)(l * 4 + gi) * 64 + c) * 64 + d] : 0.f;
    ((bf16_t*)(ws + OFF_WPOOLT))[i] = f2bf(v);
  }
  {
    float* sc = (float*)shmc + 64 * 65;
    float* red = sc + 3 * 1024;
    for (int i = tid; i < 3 * 1024; i += 512) {
      int ci = i >> 10, k = i & 1023;
      float v = ci == 0 ? INP(I_CCTX)[k] : INP(I_C)[(ci - 1) * 1024 + k];
      sc[i] = v * sigmoid_f(v);
    }
    __syncthreads();
    for (int it = bid; it < 288; it += nblk) {
      int l = it / 144, cb = it % 144, col = cb * 64 + lane;
      const float* wp = INP(I_WMOD) + (size_t)l * 1024 * 9216 + col;
      float a0 = 0.f, a1 = 0.f, a2 = 0.f;
#pragma unroll 8
      for (int k = wid * 128; k < wid * 128 + 128; ++k) {
        float w = wp[(size_t)k * 9216];
        a0 += sc[k] * w; a1 += sc[1024 + k] * w; a2 += sc[2048 + k] * w;
      }
      red[(wid * 3 + 0) * 64 + lane] = a0; red[(wid * 3 + 1) * 64 + lane] = a1; red[(wid * 3 + 2) * 64 + lane] = a2;
      __syncthreads();
      if (tid < 192) {
        int ci = tid >> 6;
        float s = 0.f;
        for (int w = 0; w < 8; ++w) s += red[(w * 3 + ci) * 64 + lane];
        ((float*)(ws + OFF_MOD))[(size_t)(l * 3 + ci) * 9216 + col] = s + INP(I_BMOD)[l * 9216 + col];
      }
      __syncthreads();
    }
  }
  for (int i = gtid; i < 2 * 2 * 512 * 128; i += gn) {
    int c = i & 127, t = (i >> 7) & 511, b = (i >> 16) & 1, l = i >> 17;
    size_t si = ((size_t)(b * 2 + l) * 512 + t) * 128 + c;
    ((bf16_t*)(ws + OFF_KS))[((size_t)(l * 2 + b) * 2560 + t) * 128 + c] = f2bf(INP(I_CK)[si]);
    ((bf16_t*)(ws + OFF_VST))[((size_t)(l * 2 + b) * 128 + c) * 2560 + t] = f2bf(INP(I_CV)[si]);
  }
  for (int i = gtid; i < 4096; i += gn) {
    float lre = INP(I_LRE)[i], lim = INP(I_LIM)[i];
    float dt = expf(INP(I_LSTEP)[i >> 6]);
    float e = expf(lre * dt), ang = lim * dt;
    float br = e * cosf(ang), bi = e * sinf(ang);
    float ar = br - 1.f, ai = bi, den = lre * lre + lim * lim;
    float cr = (ar * lre + ai * lim) / den, cim = (ai * lre - ar * lim) / den;
    ((float2*)(ws + OFF_LAMB))[i] = make_float2(br, bi);
    float pr = br, pi = bi;
    for (int s = 0; s < 6; ++s) { float nr = pr * pr - pi * pi, ni = 2.f * pr * pi; pr = nr; pi = ni; }
    ((float2*)(ws + OFF_LAMT))[i] = make_float2(pr, pi);
    for (int c = 0; c < 16; ++c) {
      float xr = INP(I_BRE)[(size_t)i * 16 + c], xi = INP(I_BIM)[(size_t)i * 16 + c];
      ((float2*)(ws + OFF_BBAR))[(size_t)i * 16 + c] = make_float2(cr * xr - cim * xi, cr * xi + cim * xr);
    }
  }
}

DI void lnmod_phase(const Params& p, int l_ln, int ln_idx, int l_mod, int mod_idx, int bid, int nblk) {
  const int tid = otid(), wid = tid >> 6, lane = tid & 63;
  float* xy = (float*)(PWS + OFF_XY);
  bf16_t* h = (bf16_t*)(PWS + OFF_H);
  const float* modv = (const float*)(PWS + OFF_MOD);
  for (int row = bid * 8 + wid; row < NTOK; row += nblk * 8) {
    const float* src = l_ln < 0 ? (row < NPROMPT ? INP(I_XP) + (size_t)row * D : INP(I_XS) + (size_t)(row - NPROMPT) * D)
                                : xy + (size_t)row * D;
    float4 v[4];
#pragma unroll
    for (int i = 0; i < 4; ++i) v[i] = *(const float4*)(src + lane * 4 + i * 256);
    if (l_ln >= 0) {
      float s = 0.f;
#pragma unroll
      for (int i = 0; i < 4; ++i) s += v[i].x + v[i].y + v[i].z + v[i].w;
      float mean = wave_sum(s, lane) * (1.f / 1024.f);
      float q = 0.f;
#pragma unroll
      for (int i = 0; i < 4; ++i) {
        v[i].x -= mean; v[i].y -= mean; v[i].z -= mean; v[i].w -= mean;
        q += v[i].x * v[i].x + v[i].y * v[i].y + v[i].z * v[i].z + v[i].w * v[i].w;
      }
      float rstd = rsqrtf(wave_sum(q, lane) * (1.f / 1024.f) + LN_EPS);
      const float* g = INP(I_LNG) + (l_ln * 3 + ln_idx) * 1024;
      const float* b = INP(I_LNB) + (l_ln * 3 + ln_idx) * 1024;
#pragma unroll
      for (int i = 0; i < 4; ++i) {
        float4 gg = *(const float4*)(g + lane * 4 + i * 256), bb = *(const float4*)(b + lane * 4 + i * 256);
        v[i].x = v[i].x * rstd * gg.x + bb.x; v[i].y = v[i].y * rstd * gg.y + bb.y;
        v[i].z = v[i].z * rstd * gg.z + bb.z; v[i].w = v[i].w * rstd * gg.w + bb.w;
      }
    }
    float* dx = l_mod < 0 ? p.out + (size_t)row * D : xy + (size_t)row * D;
#pragma unroll
    for (int i = 0; i < 4; ++i) *(float4*)(dx + lane * 4 + i * 256) = v[i];
    if (l_mod >= 0) {
      int ci = row < NPROMPT ? 0 : 1 + (row - NPROMPT) / 2048;
      const float* sh = modv + (size_t)(l_mod * 3 + ci) * 9216 + mod_idx * 1024;
      const float* sc = sh + 1024;
#pragma unroll
      for (int i = 0; i < 4; ++i) {
        float4 a = *(const float4*)(sh + lane * 4 + i * 256), c = *(const float4*)(sc + lane * 4 + i * 256);
        u32x2 o = {pk2(v[i].x * (1.f + c.x) + a.x, v[i].y * (1.f + c.y) + a.y),
                   pk2(v[i].z * (1.f + c.z) + a.z, v[i].w * (1.f + c.w) + a.w)};
        *(u32x2*)(h + (size_t)row * D + lane * 4 + i * 256) = o;
      }
    }
  }
}

DI void post_phase(const Params& p, int l, int bid, int nblk) {
  const int tid = otid(), wid = tid >> 6, lane = tid & 63;
  char* ws = PWS;
  const float* proj = (const float*)(ws + OFF_R);
  bf16_t* qb = (bf16_t*)(ws + OFF_QB);
  const float qn = INP(I_QN)[l * 64 + lane], kn = INP(I_KN)[l * 64 + lane];
  const int fi = lane & 15;
  const float inv = exp2f(-(float)fi * (13.287712379549449f / 16.f));
  for (int row = bid * 8 + wid; row < NTOK; row += nblk * 8) {
    const float* pr = proj + (size_t)row * DIN;
    const bool samp = row >= NPROMPT;
    int b, t, L;
    if (samp) { b = (row - NPROMPT) >> 11; t = (row - NPROMPT) & 2047; L = 2048; }
    else { b = row >> 8; t = row & 255; L = 256; }
    float cs = 1.f, sn = 0.f;
    if (samp) {
      float pos = (float)((lane & 31) < 16 ? (t >> 6) : (t & 63));
      float ang = pos * inv;
      cs = cosf(ang); sn = sinf(ang);
    }
#pragma unroll
    for (int hd = 0; hd < 4; ++hd) {
      float x = pr[512 + hd * 64 + lane];
      float ss = wave_sum(x * x, lane) * (1.f / 64.f);
      float xn = x * rsqrtf(ss + RMS_EPS) * qn;
      if (samp) {
        float o = shfl_x(xn, 32, lane);
        xn = lane < 32 ? xn * cs - o * sn : o * sn + xn * cs;
      }
      qb[(size_t)row * 256 + hd * 64 + lane] = f2bf(xn);
    }
#pragma unroll
    for (int hd = 0; hd < 2; ++hd) {
      float x = pr[768 + hd * 64 + lane];
      float ss = wave_sum(x * x, lane) * (1.f / 64.f);
      float xn = x * rsqrtf(ss + RMS_EPS) * kn;
      float vv = pr[896 + hd * 64 + lane];
      if (samp) {
        float o = shfl_x(xn, 32, lane);
        xn = lane < 32 ? xn * cs - o * sn : o * sn + xn * cs;
        ((bf16_t*)(ws + OFF_KS))[((size_t)(l * 2 + b) * 2560 + 512 + t) * 128 + hd * 64 + lane] = f2bf(xn);
        ((bf16_t*)(ws + OFF_VST))[((size_t)(l * 2 + b) * 128 + hd * 64 + lane) * 2560 + 512 + t] = f2bf(vv);
      } else {
        size_t oo = ((size_t)(b * 2 + l) * 256 + t) * 128 + hd * 64 + lane;
        p.out[OUT_K + oo] = xn;
        p.out[OUT_V + oo] = vv;
        ((bf16_t*)(ws + OFF_KP))[(size_t)row * 128 + hd * 64 + lane] = f2bf(xn);
        ((bf16_t*)(ws + OFF_VPT))[((size_t)b * 128 + hd * 64 + lane) * 256 + t] = f2bf(vv);
      }
    }
    {
      float z[4]; float s = 0.f;
#pragma unroll
      for (int i = 0; i < 4; ++i) { z[i] = gelu_t(pr[1280 + i * 64 + lane]); s += z[i]; }
      float mean = wave_sum(s, lane) * (1.f / 256.f);
      float q = 0.f;
#pragma unroll
      for (int i = 0; i < 4; ++i) { z[i] -= mean; q += z[i] * z[i]; }
      float rstd = rsqrtf(wave_sum(q, lane) * (1.f / 256.f) + LN_EPS);
      bf16_t* vct = (bf16_t*)(ws + OFF_VCT) + (size_t)(row >> 7) * 256 * 128 + (row & 127);
#pragma unroll
      for (int i = 0; i < 4; ++i) {
        int c = i * 64 + lane;
        float vn = z[i] * rstd * INP(I_CLG)[l * 256 + c] + INP(I_CLB)[l * 256 + c];
        vct[(size_t)c * 128] = f2bf(vn);
      }
    }
    {
      bf16_t* df = (bf16_t*)(ws + OFF_DIFF) + (size_t)row * 256;
#pragma unroll
      for (int gi = 0; gi < 4; ++gi) {
        const int hw = 1 << gi;
        int lo = max(t - hw, 0), hi = min(t + hw, L);
        float s = 0.f;
        for (int tt = lo; tt < hi; ++tt) s += pr[(ptrdiff_t)(tt - t) * DIN + gi * 64 + lane];
        float mean = s / (float)(hi - lo);
        df[gi * 64 + lane] = f2bf(mean - pr[gi * 64 + lane]);
      }
    }
  }
}

DI void attn_item(const bf16_t* __restrict__ Q, int qrow0, int head, const bf16_t* __restrict__ Kb,
                  const bf16_t* __restrict__ Vt, int nkeys, bf16_t* __restrict__ Y, int lane) {
  const int r = lane & 31, hh = lane >> 5, kvh = head >> 1;
  bf16x8 qf[4];
  const bf16_t* qp = Q + (size_t)(qrow0 + r) * 256 + head * 64 + 8 * hh;
#pragma unroll
  for (int s = 0; s < 4; ++s) qf[s] = *(const bf16x8*)(qp + 16 * s);
  f32x16 o0, o1;
#pragma unroll
  for (int i = 0; i < 16; ++i) { o0[i] = 0.f; o1[i] = 0.f; }
  float m = -INFINITY, lsum = 0.f;
  const float c = 0.125f * 1.4426950408889634f;
  const bf16_t* kp = Kb + (size_t)r * 128 + kvh * 64 + 8 * hh;
  const bf16_t* vp0 = Vt + (size_t)(kvh * 64 + r) * nkeys + 4 * hh;
  const bf16_t* vp1 = vp0 + (size_t)32 * nkeys;
  for (int k0 = 0; k0 < nkeys; k0 += 32) {
    f32x16 sa;
#pragma unroll
    for (int i = 0; i < 16; ++i) sa[i] = 0.f;
    const bf16_t* kq = kp + (size_t)k0 * 128;
#pragma unroll
    for (int s = 0; s < 4; ++s) { bf16x8 kf = *(const bf16x8*)(kq + 16 * s); sa = MFMA32(kf, qf[s], sa); }
    bf16x8 vf[2][2];
#pragma unroll
    for (int s = 0; s < 2; ++s) {
      s16x4 lo0 = *(const s16x4*)(vp0 + k0 + 16 * s), hi0 = *(const s16x4*)(vp0 + k0 + 16 * s + 8);
      s16x4 lo1 = *(const s16x4*)(vp1 + k0 + 16 * s), hi1 = *(const s16x4*)(vp1 + k0 + 16 * s + 8);
      vf[s][0] = __builtin_shufflevector(lo0, hi0, 0, 1, 2, 3, 4, 5, 6, 7);
      vf[s][1] = __builtin_shufflevector(lo1, hi1, 0, 1, 2, 3, 4, 5, 6, 7);
    }
    float mx = sa[0];
#pragma unroll
    for (int i = 1; i < 16; ++i) mx = fmaxf(mx, sa[i]);
    mx = fmaxf(mx, shfl_x(mx, 32, lane));
    float mn = fmaxf(m, mx);
    float alpha = __builtin_amdgcn_exp2f((m - mn) * c);
    m = mn;
    float pv[16]; float ps = 0.f;
#pragma unroll
    for (int i = 0; i < 16; ++i) { pv[i] = __builtin_amdgcn_exp2f((sa[i] - mn) * c); ps += pv[i]; }
    lsum = lsum * alpha + ps;
#pragma unroll
    for (int i = 0; i < 16; ++i) { o0[i] *= alpha; o1[i] *= alpha; }
#pragma unroll
    for (int s = 0; s < 2; ++s) {
      bf16x8 pf = pack8(pv[8 * s], pv[8 * s + 1], pv[8 * s + 2], pv[8 * s + 3], pv[8 * s + 4], pv[8 * s + 5], pv[8 * s + 6], pv[8 * s + 7]);
      o0 = MFMA32(vf[s][0], pf, o0);
      o1 = MFMA32(vf[s][1], pf, o1);
    }
  }
  lsum += shfl_x(lsum, 32, lane);
  const float il = 1.f / lsum;
  bf16_t* yp = Y + (size_t)(qrow0 + r) * D + 512 + head * 64 + 4 * hh;
#pragma unroll
  for (int g4 = 0; g4 < 4; ++g4) {
    u32x2 a = {pk2(o0[4 * g4] * il, o0[4 * g4 + 1] * il), pk2(o0[4 * g4 + 2] * il, o0[4 * g4 + 3] * il)};
    u32x2 b = {pk2(o1[4 * g4] * il, o1[4 * g4 + 1] * il), pk2(o1[4 * g4 + 2] * il, o1[4 * g4 + 3] * il)};
    *(u32x2*)(yp + 8 * g4) = a;
    *(u32x2*)(yp + 32 + 8 * g4) = b;
  }
}

DI void chunk_item(const Params& p, int l, int ch, int hd, int sp, int lane) {
  const int fr = lane & 15, fq = lane >> 4;
  const float* wsrc = INP(I_CWS) + ((size_t)(l * 4 + hd) * 128 + sp * 16 + fr) * 128 + fq * 8;
  const bf16_t* vb = (const bf16_t*)(PWS + OFF_VCT) + ((size_t)ch * 256 + hd * 64 + fr) * 128 + fq * 8;
  f32x4 acc[4];
#pragma unroll
  for (int i = 0; i < 4; ++i) acc[i] = (f32x4){0.f, 0.f, 0.f, 0.f};
#pragma unroll
  for (int ks = 0; ks < 4; ++ks) {
    float4 a0 = *(const float4*)(wsrc + ks * 32), a1 = *(const float4*)(wsrc + ks * 32 + 4);
    bf16x8 af = pack8(a0.x, a0.y, a0.z, a0.w, a1.x, a1.y, a1.z, a1.w);
#pragma unroll
    for (int nt = 0; nt < 4; ++nt) {
      bf16x8 bfr = *(const bf16x8*)(vb + (size_t)nt * 16 * 128 + ks * 32);
      acc[nt] = MFMA16(af, bfr, acc[nt]);
    }
  }
  const float* proj = (const float*)(PWS + OFF_R);
  bf16_t* ymix = (bf16_t*)(PWS + OFF_YMIX);
#pragma unroll
  for (int j = 0; j < 4; ++j) {
    int pp = sp * 16 + fq * 4 + j, tok = ch * 128 + pp;
    float bs = INP(I_CBS)[(l * 4 + hd) * 128 + pp];
#pragma unroll
    for (int nt = 0; nt < 4; ++nt) {
      int c = hd * 64 + nt * 16 + fr;
      float u = gelu_t(proj[(size_t)tok * DIN + 1024 + c]);
      ymix[(size_t)tok * D + 768 + c] = f2bf(u * (acc[nt][j] + bs));
    }
  }
}

#define SSM_STEP(UP) do { \
    float4 u0 = *(const float4*)(UP), u1 = *(const float4*)((UP) + 4), u2 = *(const float4*)((UP) + 8), u3 = *(const float4*)((UP) + 12); \
    float uu[16] = {u0.x, u0.y, u0.z, u0.w, u1.x, u1.y, u1.z, u1.w, u2.x, u2.y, u2.z, u2.w, u3.x, u3.y, u3.z, u3.w}; \
    float br_ = 0.f, bi_ = 0.f; \
    _Pragma("unroll") for (int c_ = 0; c_ < 16; ++c_) { br_ += Bb[c_].x * uu[c_]; bi_ += Bb[c_].y * uu[c_]; } \
    float nr_ = lam.x * hr - lam.y * hi + br_, ni_ = lam.x * hi + lam.y * hr + bi_; hr = nr_; hi = ni_; } while (0)

DI void ssm1_item(const Params& p, int l, int ck, int g, int dir, int lane) {
  const int idx = ((l * 2 + dir) * 16 + g) * 64 + lane;
  const float2* bbp = (const float2*)(PWS + OFF_BBAR) + (size_t)idx * 16;
  float2 Bb[16];
#pragma unroll
  for (int c = 0; c < 16; ++c) Bb[c] = bbp[c];
  const float2 lam = ((const float2*)(PWS + OFF_LAMB))[idx];
  float hr = 0.f, hi = 0.f;
  const float* ub = (const float*)(PWS + OFF_R) + (size_t)ck * 64 * DIN + 256 + g * 16;
#pragma unroll 2
  for (int tt = 0; tt < 64; ++tt) {
    int t = dir ? 63 - tt : tt;
    const float* up = ub + (size_t)t * DIN;
    SSM_STEP(up);
  }
  ((float2*)(PWS + OFF_E))[((size_t)(ck * 16 + g) * 2 + dir) * 64 + lane] = make_float2(hr, hi);
}

DI void ssm2_item(const Params& p, int l, int ck, int g, int lane, bf16_t* Hs) {
  const int fr = lane & 15, fq = lane >> 4;
  const bool samp = ck >= 128;
  const int CPS = samp ? 32 : 4;
  const int cs = samp ? ((ck - 128) & 31) : (ck & 3);
  const int cbase = ck - cs;
  const int b = samp ? ((ck - 128) >> 5) : (ck >> 2);
  const float* ub = (const float*)(PWS + OFF_R) + (size_t)ck * 64 * DIN + 256 + g * 16;
  const float2* Eb = (const float2*)(PWS + OFF_E);
  f32x4 yacc[4];
#pragma unroll
  for (int i = 0; i < 4; ++i) yacc[i] = (f32x4){0.f, 0.f, 0.f, 0.f};
#pragma unroll
  for (int dir = 0; dir < 2; ++dir) {
    const int gidx = (l * 2 + dir) * 16 + g, idx = gidx * 64 + lane;
    const float2* bbp = (const float2*)(PWS + OFF_BBAR) + (size_t)idx * 16;
    float2 Bb[16];
#pragma unroll
    for (int c = 0; c < 16; ++c) Bb[c] = bbp[c];
    const float2 lam = ((const float2*)(PWS + OFF_LAMB))[idx];
    const float2 lamT = ((const float2*)(PWS + OFF_LAMT))[idx];
    bf16x8 cf[4];
#pragma unroll
    for (int ks = 0; ks < 4; ++ks) {
      const float* cp = (ks < 2 ? INP(I_CRE) : INP(I_CIM)) + ((size_t)gidx * 16 + fr) * 64 + (ks & 1) * 32 + fq * 8;
      float4 a0 = *(const float4*)cp, a1 = *(const float4*)(cp + 4);
      const float sg = ks < 2 ? 1.f : -1.f;
      cf[ks] = pack8(sg * a0.x, sg * a0.y, sg * a0.z, sg * a0.w, sg * a1.x, sg * a1.y, sg * a1.z, sg * a1.w);
    }
    float hr = 0.f, hi = 0.f;
    if (samp) {
      size_t si = ((size_t)((b * 2 + l) * 2 + dir) * 16 + g) * 64 + lane;
      hr = INP(I_SRE)[si]; hi = INP(I_SIM)[si];
    }
    if (dir == 0) {
      for (int c2 = 0; c2 < cs; ++c2) {
        float2 e = Eb[((size_t)((cbase + c2) * 16 + g) * 2 + 0) * 64 + lane];
        float nr = lamT.x * hr - lamT.y * hi + e.x, ni = lamT.x * hi + lamT.y * hr + e.y; hr = nr; hi = ni;
      }
    } else {
      for (int c2 = CPS - 1; c2 > cs; --c2) {
        float2 e = Eb[((size_t)((cbase + c2) * 16 + g) * 2 + 1) * 64 + lane];
        float nr = lamT.x * hr - lamT.y * hi + e.x, ni = lamT.x * hi + lamT.y * hr + e.y; hr = nr; hi = ni;
      }
    }
#pragma unroll
    for (int sb = 0; sb < 4; ++sb) {
#pragma unroll 1
      for (int tt = 0; tt < 16; ++tt) {
        int tl = sb * 16 + tt, t = dir ? 63 - tl : tl;
        const float* up = ub + (size_t)t * DIN;
        SSM_STEP(up);
        int hrow = dir ? 15 - tt : tt;
        Hs[hrow * 136 + lane] = f2bf(hr);
        Hs[hrow * 136 + 64 + lane] = f2bf(hi);
      }
      asm volatile("s_waitcnt lgkmcnt(0)" ::: "memory");
      __builtin_amdgcn_wave_barrier();
      const int ysb = dir ? 3 - sb : sb;
#pragma unroll
      for (int ks = 0; ks < 4; ++ks) {
        bf16x8 af = *(const bf16x8*)(Hs + fr * 136 + ks * 32 + fq * 8);
        yacc[ysb] = MFMA16(af, cf[ks], yacc[ysb]);
      }
      asm volatile("s_waitcnt lgkmcnt(0)" ::: "memory");
      __builtin_amdgcn_wave_barrier();
    }
    if (!samp && ((dir == 0 && cs == 3) || (dir == 1 && cs == 0))) {
      size_t so = ((size_t)((b * 2 + l) * 2 + dir) * 16 + g) * 64 + lane;
      p.out[OUT_SRE + so] = hr; p.out[OUT_SIM + so] = hi;
    }
  }
  bf16_t* sg = (bf16_t*)(PWS + OFF_SG);
  const int c = g * 16 + fr;
  const float dd = INP(I_SSMD)[l * 256 + c];
#pragma unroll
  for (int ysb = 0; ysb < 4; ++ysb)
#pragma unroll
    for (int j = 0; j < 4; ++j) {
      int tl = ysb * 16 + fq * 4 + j;
      size_t row = (size_t)ck * 64 + tl;
      float u = ub[(size_t)tl * DIN + fr];
      float y = yacc[ysb][j] + dd * u;
      sg[row * 256 + c] = f2bf(gelu_t(y));
    }
}

DI void mix_phase(const Params& p, int l, int bid, int nblk) {
  const int tid = otid(), wid = tid >> 6, lane = tid & 63;
  const int slot = wid * nblk + bid, nslot = nblk * 8;
  char* ws = PWS;
  const bf16_t* qb = (const bf16_t*)(ws + OFF_QB);
  bf16_t* ymix = (bf16_t*)(ws + OFF_YMIX);
  for (int it = slot; it < 1536; it += nslot) {
    if (it < 512) {
      int b = it >> 8, head = (it >> 6) & 3, qt = it & 63;
      attn_item(qb, NPROMPT + b * 2048 + qt * 32, head,
                (const bf16_t*)(ws + OFF_KS) + (size_t)(l * 2 + b) * 2560 * 128,
                (const bf16_t*)(ws + OFF_VST) + (size_t)(l * 2 + b) * 128 * 2560, 2560, ymix, lane);
    } else {
      int j = it - 512;
      int b = j >> 5, head = (j >> 3) & 3, qt = j & 7;
      attn_item(qb, b * 256 + qt * 32, head,
                (const bf16_t*)(ws + OFF_KP) + (size_t)b * 256 * 128,
                (const bf16_t*)(ws + OFF_VPT) + (size_t)b * 128 * 256, 256, ymix, lane);
    }
  }
  const int NL = 3072 + 6144;
  int j0, jst;
  if (nslot > 1024) { j0 = slot - 512; jst = nslot - 512; } else { j0 = slot; jst = nslot; }
  if (j0 >= 0)
    for (int it = j0; it < NL; it += jst) {
      if (it < 3072) {
        chunk_item(p, l, it >> 5, (it >> 3) & 3, it & 7, lane);
      } else {
        int j = it - 3072;
        ssm1_item(p, l, j >> 5, (j >> 1) & 15, j & 1, lane);
      }
    }
}

DI void ssm2_phase(const Params& p, int l, char* shmc, int bid, int nblk) {
  const int tid = otid(), wid = tid >> 6, lane = tid & 63;
  bf16_t* Hs = (bf16_t*)shmc + wid * (16 * 136);
  for (int it = wid * nblk + bid; it < 3072; it += nblk * 8) ssm2_item(p, l, it >> 4, it & 15, lane, Hs);
}

constexpr int N_PHASE = 28;
DI void run_phase(const Params& p, int ph, char* shm, int bid, int nblk) {
  char* ws = PWS;
  if (ph == 0) { prep_phase(p, shm, bid, nblk); return; }
  if (ph == 27) { lnmod_phase(p, 1, 2, -1, 0, bid, nblk); return; }
  const int l = (ph - 1) / 13, s = (ph - 1) % 13;
  const bf16_t* hA = (const bf16_t*)(ws + OFF_H);
  bf16_t* hid = (bf16_t*)(ws + OFF_R);
  float* xy = (float*)(ws + OFF_XY);
  const float* modl = (const float*)(ws + OFF_MOD) + (size_t)l * 3 * 9216;
  EpiArgs ea; ea.f0 = nullptr; ea.b0 = nullptr; ea.c0 = nullptr; ea.cb = nullptr; ea.w = 0.f;
  switch (s) {
    case 0: if (l == 0) lnmod_phase(p, -1, 0, 0, 0, bid, nblk); else lnmod_phase(p, l - 1, 2, l, 0, bid, nblk); break;
    case 1: case 11: {
      int sI = s == 1 ? 0 : 1;
      ea.b0 = hid;
      gemm_phase<1024, EPI_SWIGLU>(hA, (const bf16_t*)(ws + OFF_W1T) + (size_t)(l * 2 + sI) * 5632 * 1024, 48, 22, ea, shm, bid, nblk);
    } break;
    case 2: case 12: {
      int sI = s == 2 ? 0 : 1;
      ea.f0 = xy; ea.c0 = modl + (s == 2 ? 2 : 8) * 1024; ea.w = 0.5f;
      gemm_phase<2816, EPI_RESID>(hid, (const bf16_t*)(ws + OFF_W2T) + (size_t)(l * 2 + sI) * 1024 * 2816, 48, 4, ea, shm, bid, nblk);
    } break;
    case 3: lnmod_phase(p, l, 0, l, 3, bid, nblk); break;
    case 4: {
      ea.f0 = (float*)(ws + OFF_R);
      gemm_phase<1024, EPI_F32>(hA, (const bf16_t*)(ws + OFF_WINT) + (size_t)l * 1536 * 1024, 48, 6, ea, shm, bid, nblk);
    } break;
    case 5: post_phase(p, l, bid, nblk); break;
    case 6: mix_phase(p, l, bid, nblk); break;
    case 7: ssm2_phase(p, l, shm, bid, nblk); break;
    case 8: {
      ea.b0 = (bf16_t*)(ws + OFF_YMIX); ea.cb = (const bf16_t*)(ws + OFF_SG); ea.c0 = INP(I_BGLU) + l * 256;
      gemm_phase<256, EPI_GLU>((const bf16_t*)(ws + OFF_SG), (const bf16_t*)(ws + OFF_WGLUT) + (size_t)l * 65536, 48, 1, ea, shm, bid, nblk);
      ea.c0 = INP(I_POOLS) + l * 256;
      int bid2 = (bid + nblk - (nblk >> 1)) % nblk;
      gemm_phase<256, EPI_POOL>((const bf16_t*)(ws + OFF_DIFF), (const bf16_t*)(ws + OFF_WPOOLT) + (size_t)l * 65536, 48, 1, ea, shm, bid2, nblk);
    } break;
    case 9: {
      ea.f0 = xy; ea.c0 = modl + 5 * 1024; ea.w = 1.0f;
      gemm_phase<1024, EPI_RESID>((const bf16_t*)(ws + OFF_YMIX), (const bf16_t*)(ws + OFF_WOUTT) + (size_t)l * 1024 * 1024, 48, 4, ea, shm, bid, nblk);
    } break;
    case 10: lnmod_phase(p, l, 1, l, 6, bid, nblk); break;
  }
}

__global__ __launch_bounds__(512, 2) void mega(Params p, int ph_lo, int ph_hi) {
  extern __shared__ __attribute__((aligned(16))) char shm[];
  __shared__ uint4 xb_words;
  const int bid = blockIdx.x, nblk = gridDim.x;
  if (threadIdx.x == 0) xb_words = make_uint4(0u, 0u, 0u, 0u);
  __syncthreads();
  const XcdBarrier xb = xcd_barrier_post((unsigned*)(p.ws + OFF_BAR), (volatile LAS unsigned*)&xb_words);
  for (int ph = ph_lo; ph < ph_hi; ++ph) {
    if (ph > ph_lo) {
      if (ph == ph_lo + 1) cg::this_grid().sync();
      else xcd_barrier(xb);
    }
    run_phase(p, ph, shm, bid, nblk);
  }
}

extern "C" void kernel_launch(void* const* d_in, const int* in_sizes, int n_in, void* d_out, int out_size, void* d_ws,
                              size_t ws_size, hipStream_t stream) {
  static int grid_blocks = 0;
  if (!grid_blocks) {
    hipFuncSetAttribute((const void*)mega, hipFuncAttributeMaxDynamicSharedMemorySize, GEMM_LDS);
    int dev = 0, cus = 0, per_cu = 0;
    hipGetDevice(&dev);
    hipDeviceGetAttribute(&cus, hipDeviceAttributeMultiprocessorCount, dev);
    hipOccupancyMaxActiveBlocksPerMultiprocessor(&per_cu, mega, 512, GEMM_LDS);
    if (per_cu < 1) per_cu = 1;
    if (per_cu > 1) per_cu = 1;
    grid_blocks = cus * per_cu;
  }
  Params p{};
  for (int i = 0; i < N_IN; ++i) p.in[i] = (const float*)d_in[i];
  p.out = (float*)d_out;
  p.ws = (char*)d_ws;
  hipMemsetAsync((char*)d_ws + OFF_BAR, 0, 16384, stream);
#if ONE_LAUNCH
  int lo = 0, hi = N_PHASE;
  void* args[] = {&p, &lo, &hi};
  hipError_t e = hipLaunchCooperativeKernel((const void*)mega, dim3(grid_blocks), dim3(512), args, GEMM_LDS, stream);
  if (e != hipSuccess) fprintf(stderr, "cooperative launch failed: %s (grid %d)\n", hipGetErrorString(e), grid_blocks);
#else
  for (int ph = 0; ph < N_PHASE; ++ph) mega<<<grid_blocks, 512, GEMM_LDS, stream>>>(p, ph, ph + 1);
#endif
}
```

```cpp
#include <hip/hip_runtime.h>
#include <hip/hip_cooperative_groups.h>
#include <cstdio>
namespace cg = cooperative_groups;

#define DI __device__ __forceinline__
typedef unsigned short bf16_t;
typedef __attribute__((ext_vector_type(8))) short bf16x8;
typedef __attribute__((ext_vector_type(4))) short s16x4;
typedef __attribute__((ext_vector_type(4))) float f32x4;
typedef __attribute__((ext_vector_type(16))) float f32x16;
typedef __attribute__((ext_vector_type(2))) float f32x2;
typedef __attribute__((ext_vector_type(2))) __bf16 bf16x2v;
typedef __attribute__((ext_vector_type(4))) unsigned u32x4;
typedef __attribute__((ext_vector_type(2))) unsigned u32x2;

#ifndef ONE_LAUNCH
#define ONE_LAUNCH 1
#endif

constexpr int D = 1024, NTOK = 12288, NPROMPT = 8192, DFF = 2816, DIN = 1536;
constexpr float ALPHA = 1.4142135623730951f;
constexpr float LN_EPS = 1e-5f, RMS_EPS = 1e-6f;
enum { I_XP = 0, I_XS, I_CK, I_CV, I_SRE, I_SIM, I_C, I_CCTX, I_WMOD, I_BMOD, I_LNG, I_LNB, I_W1, I_W2, I_WIN, I_WOUT,
       I_POOLW, I_POOLS, I_LRE, I_LIM, I_LSTEP, I_BRE, I_BIM, I_CRE, I_CIM, I_SSMD, I_WGLU, I_BGLU, I_QN, I_KN,
       I_CLG, I_CLB, I_CWS, I_CBS, N_IN };
constexpr size_t OUT_K = 12582912, OUT_V = 14680064, OUT_SRE = 16777216, OUT_SIM = 16908288;

constexpr size_t OFF_W1T = 0;
constexpr size_t OFF_W2T = OFF_W1T + 46137344;
constexpr size_t OFF_WINT = OFF_W2T + 23068672;
constexpr size_t OFF_WOUTT = OFF_WINT + 6291456;
constexpr size_t OFF_WGLUT = OFF_WOUTT + 4194304;
constexpr size_t OFF_WPOOLT = OFF_WGLUT + 262144;
constexpr size_t OFF_MOD = OFF_WPOOLT + 262144;
constexpr size_t OFF_XY = OFF_MOD + 221184;
constexpr size_t OFF_H = OFF_XY + 50331648;
constexpr size_t OFF_YMIX = OFF_H + 25165824;
constexpr size_t OFF_R = OFF_YMIX + 25165824;
constexpr size_t OFF_QB = OFF_R + 75497472;
constexpr size_t OFF_KP = OFF_QB + 6291456;
constexpr size_t OFF_KS = OFF_KP + 2097152;
constexpr size_t OFF_VPT = OFF_KS + 2621440;
constexpr size_t OFF_VST = OFF_VPT + 2097152;
constexpr size_t OFF_VCT = OFF_VST + 2621440;
constexpr size_t OFF_DIFF = OFF_VCT + 6291456;
constexpr size_t OFF_SG = OFF_DIFF + 6291456;
constexpr size_t OFF_E = OFF_SG + 6291456;
constexpr size_t OFF_LAMB = OFF_E + 3145728;
constexpr size_t OFF_LAMT = OFF_LAMB + 32768;
constexpr size_t OFF_BBAR = OFF_LAMT + 32768;
constexpr size_t OFF_BAR = OFF_BBAR + 524288;
constexpr size_t OFF_BF = OFF_BAR + 16384;
constexpr size_t OFF_CF = OFF_BF + 524288;
constexpr size_t WS_TOTAL = OFF_CF + 262144;

struct Params { const float* in[N_IN]; float* out; char* ws; };

DI int otid() {
  int z = 0; asm volatile("" : "+s"(z));
  int lane = __builtin_amdgcn_mbcnt_hi(-1, __builtin_amdgcn_mbcnt_lo(-1, z));
  int w = __builtin_amdgcn_readfirstlane(threadIdx.x >> 6);
  return w * 64 + lane;
}
DI int osgpr(int i) { asm volatile("" : "+s"(i)); return i; }
#define INP(i) (p.in[osgpr(i)])
DI char* ows(char* w) { asm volatile("" : "+s"(w)); return w; }
#define PWS ows(p.ws)
DI unsigned pk2(float a, float b) { f32x2 v = {a, b}; bf16x2v r = __builtin_convertvector(v, bf16x2v); return __builtin_bit_cast(unsigned, r); }
DI bf16_t f2bf(float a) { return (bf16_t)(pk2(a, 0.f) & 0xffffu); }
DI float bf2f(bf16_t v) { return __uint_as_float(((unsigned)v) << 16); }
DI bf16x8 pack8(float a0, float a1, float a2, float a3, float a4, float a5, float a6, float a7) {
  u32x4 u = {pk2(a0, a1), pk2(a2, a3), pk2(a4, a5), pk2(a6, a7)};
  return __builtin_bit_cast(bf16x8, u);
}
DI float gelu_t(float x) {
  float z = 0.7978845608028654f * (x + 0.044715f * x * x * x);
  float e = __expf(2.f * z);
  float th = 1.f - 2.f / (e + 1.f);
  return 0.5f * x * (1.f + th);
}
DI float sigmoid_f(float x) { return 1.f / (1.f + __expf(-x)); }
DI float shfl_x(float v, int mask, int lane) {
  return __int_as_float(__builtin_amdgcn_ds_bpermute((lane ^ mask) << 2, __float_as_int(v)));
}
template <int CTRL> DI float dpp_f(float v) {
  return __int_as_float(__builtin_amdgcn_update_dpp(0, __float_as_int(v), CTRL, 0xf, 0xf, true));
}
DI float wave_sum(float v, int lane) {
  (void)lane;
  v += dpp_f<0xB1>(v);
  v += dpp_f<0x4E>(v);
  v += dpp_f<0x141>(v);
  v += dpp_f<0x140>(v);
  const int iv = __float_as_int(v);
  float r0 = __int_as_float(__builtin_amdgcn_readlane(iv, 0)), r1 = __int_as_float(__builtin_amdgcn_readlane(iv, 16));
  float r2 = __int_as_float(__builtin_amdgcn_readlane(iv, 32)), r3 = __int_as_float(__builtin_amdgcn_readlane(iv, 48));
  return (r0 + r1) + (r2 + r3);
}
DI size_t kfrag_off(int key, int d) {
  return ((size_t)((key >> 5) * 4 + (d >> 4)) * 64 + ((d >> 3) & 1) * 32 + (key & 31)) * 8 + (d & 7);
}
DI size_t vfrag_off(int key, int d) {
  const int kk = key & 31, w = kk & 15;
  return ((size_t)(((key >> 5) * 2 + (kk >> 4)) * 2 + (d >> 5)) * 64 + ((w >> 2) & 1) * 32 + (d & 31)) * 8 + (((w >> 3) << 2) | (w & 3));
}

#define MFMA16(a, b, c) __builtin_amdgcn_mfma_f32_16x16x32_bf16((a), (b), (c), 0, 0, 0)
#define MFMA32(a, b, c) __builtin_amdgcn_mfma_f32_32x32x16_bf16((a), (b), (c), 0, 0, 0)


#define XB_TMO      128
#define XB_XCNT(j)  (256  + 64 * (j))
#define XB_XSUB(j)  (1280 + 64 * (j))
#define XB_XGEN(j)  (2304 + 64 * (j))
#define XB_TOP      3328
#define XB_TOPGEN   3392
#define XCD_BAR_WORDS 3456
#define XB_SPIN_CAP (1u << 18)
#define LAS __attribute__((address_space(3)))
DI unsigned xb_ld(unsigned* p) { return __hip_atomic_load(p, __ATOMIC_RELAXED, __HIP_MEMORY_SCOPE_AGENT); }
DI unsigned xb_add(unsigned* p, unsigned v) { return __hip_atomic_fetch_add(p, v, __ATOMIC_RELAXED, __HIP_MEMORY_SCOPE_AGENT); }
DI unsigned xb_xcc_id() { return (unsigned)__builtin_amdgcn_s_getreg((3 << 11) | 20) & 0xFu; }
#define XB_SPIN(cond, bar) do { unsigned _sp = 0; while (cond) { __builtin_amdgcn_s_sleep(1); \
    if ((++_sp & 255u) == 0u) { if (xb_ld(&(bar)[XB_TMO])) break; if (_sp > XB_SPIN_CAP) { atomicAdd(&(bar)[XB_TMO], 1u); break; } } } } while (0)
struct XcdBarrier { unsigned* bar; unsigned x; volatile LAS unsigned* st; };
DI XcdBarrier xcd_barrier_post(unsigned* bar, volatile LAS unsigned* st) {
  XcdBarrier b; b.bar = bar; b.x = xb_xcc_id(); b.st = st;
  if (threadIdx.x == 0) (void)xb_add(&bar[XB_XCNT(b.x)], 1u);
  return b;
}
DI void xcd_barrier_complete(unsigned* bar, unsigned x, unsigned& nloc, unsigned& nx) {
  const unsigned G = gridDim.x * gridDim.y * gridDim.z;
  unsigned sum, cnt, mine, sp = 0u;
  for (;;) {
    sum = 0u; cnt = 0u; mine = 0u;
#pragma unroll
    for (unsigned j = 0; j < 16; ++j) { const unsigned c = xb_ld(&bar[XB_XCNT(j)]); sum += c; cnt += (c > 0u) ? 1u : 0u; mine = (j == x) ? c : mine; }
    if (sum == G) break;
    __builtin_amdgcn_s_sleep(1);
    if ((++sp & 255u) == 0u) { if (xb_ld(&bar[XB_TMO])) break; if (sp > XB_SPIN_CAP) { atomicAdd(&bar[XB_TMO], 1u); break; } }
  }
  nloc = mine > 0u ? mine : 1u; nx = cnt > 0u ? cnt : 1u;
}
DI void xcd_barrier(const XcdBarrier& b) {
  asm volatile("s_waitcnt vmcnt(0)" ::: "memory");
  __syncthreads();
  if (threadIdx.x == 0) {
    unsigned* bar = b.bar;
    __builtin_amdgcn_s_waitcnt(0);
    unsigned nloc = b.st[0], nx = b.st[1];
    if (nloc == 0u) { xcd_barrier_complete(bar, b.x, nloc, nx); b.st[0] = nloc; b.st[1] = nx; }
    const unsigned old = xb_add(&bar[XB_XSUB(b.x)], 1u);
    const unsigned gen = old / nloc;
    if (old + 1u == (gen + 1u) * nloc) {
      __builtin_amdgcn_fence(__ATOMIC_RELEASE, "agent");
      asm volatile("s_waitcnt vmcnt(0)" ::: "memory");
      const unsigned og = xb_add(&bar[XB_TOP], 1u);
      const unsigned tg = og / nx;
      if (og + 1u == (tg + 1u) * nx) xb_add(&bar[XB_TOPGEN], 1u);
      else XB_SPIN(xb_ld(&bar[XB_TOPGEN]) == tg, bar);
      __builtin_amdgcn_fence(__ATOMIC_ACQUIRE, "agent");
      xb_add(&bar[XB_XGEN(b.x)], 1u);
      asm volatile("s_waitcnt vmcnt(0)" ::: "memory");
    } else {
      XB_SPIN(xb_ld(&bar[XB_XGEN(b.x)]) == gen, bar);
      __builtin_amdgcn_fence(__ATOMIC_ACQUIRE, "agent");
      asm volatile("s_waitcnt vmcnt(0)" ::: "memory");
    }
  }
  __syncthreads();
}

constexpr int BM = 256, BK = 64, HALF = 128, NXCD = 8, WGM = 8, HT = HALF * BK;
constexpr int GEMM_LDS = 8 * HT * 2;

DI int lds_byte(int r, int c) {
  int st = (r >> 4) * 2 + (c >> 5), rr = r & 15, cc = c & 31, ob = rr * 64 + cc * 2;
  return st * 1024 + (ob ^ (((ob >> 9) & 1) << 5));
}
DI void stage_rc(int b, int& R, int& C) {
  int st = b / 1024, sb = b % 1024, swz = sb ^ (((sb >> 9) & 1) << 5);
  R = (st >> 1) * 16 + swz / 64; C = (st & 1) * 32 + (swz % 64) / 2;
}

enum { EPI_SWIGLU = 0, EPI_RESID, EPI_F32, EPI_GLU, EPI_POOL };
struct EpiArgs {
  float* f0;
  bf16_t* b0;
  const float* c0;
  const bf16_t* cb;
  float w;
};

template <int K, int MODE>
DI void gemm_phase(const bf16_t* __restrict__ A, const bf16_t* __restrict__ Bt, int nM, int nN, EpiArgs ea,
                   char* shmc, int bid, int nblk) {
  bf16_t* shm = (bf16_t*)shmc;
#define SA(b, h) (shm + ((b) * 2 + (h)) * HT)
#define SB(b, h) (shm + (4 + (b) * 2 + (h)) * HT)
#define STAGE(P, RS, SOFF, kt) do { const int _so = (SOFF) + (kt) * (BK * 2); \
    __builtin_amdgcn_raw_ptr_buffer_load_lds(RS, (__attribute__((address_space(3))) void*)((char*)(P) + wid * 1024), 16, so0, _so, 0, 0); \
    __builtin_amdgcn_raw_ptr_buffer_load_lds(RS, (__attribute__((address_space(3))) void*)((char*)(P) + wid * 1024 + 8192), 16, so1, _so, 0, 0); } while (0)
#define LDA(dst, b, h) for (int m = 0; m < 4; ++m) for (int k = 0; k < 2; ++k) \
    dst[m][k] = *reinterpret_cast<const bf16x8*>((char*)SA(b, h) + lds_byte(wr * 64 + m * 16 + fr, k * 32 + fq * 8))
#define LDB(dst, b, h) for (int n = 0; n < 2; ++n) for (int k = 0; k < 2; ++k) \
    dst[n][k] = *reinterpret_cast<const bf16x8*>((char*)SB(b, h) + lds_byte(wc * 32 + n * 16 + fr, k * 32 + fq * 8))
#define MMA(ai, bj, At, Bt_) do { __builtin_amdgcn_s_setprio(1); \
    for (int m = 0; m < 4; ++m) for (int n = 0; n < 2; ++n) for (int k = 0; k < 2; ++k) \
      acc[ai][bj][m][n] = MFMA16(At[m][k], Bt_[n][k], acc[ai][bj][m][n]); \
    __builtin_amdgcn_s_setprio(0); } while (0)
#define WAIT_V(n) asm volatile("s_waitcnt vmcnt(" #n ")" ::: "memory")
#define WAIT_L(n) asm volatile("s_waitcnt lgkmcnt(" #n ")" ::: "memory")
#define BAR __builtin_amdgcn_s_barrier()
#define SCHED __builtin_amdgcn_sched_barrier(0)
  const int tid = otid();
  const int wid = __builtin_amdgcn_readfirstlane(tid >> 6), lane = tid & 63, wr = wid >> 2, wc = wid & 3, fr = lane & 15, fq = lane >> 4;
  const __amdgpu_buffer_rsrc_t rsA = __builtin_amdgcn_make_buffer_rsrc((void*)A, 0, 0x7fffffff, 0x00020000);
  const __amdgpu_buffer_rsrc_t rsB = __builtin_amdgcn_make_buffer_rsrc((void*)Bt, 0, 0x7fffffff, 0x00020000);
  unsigned so0, so1;
  { int R, C; stage_rc(tid * 16, R, C); so0 = (unsigned)(R * K + C) * 2u; stage_rc(tid * 16 + 8192, R, C); so1 = (unsigned)(R * K + C) * 2u; }
  constexpr int nt = K / BK;
  const int nwg = nM * nN;
  for (int tile = bid; tile < nwg; tile += nblk) {
    int wgid = tile;
    { int q = nwg / NXCD, r = nwg % NXCD, xcd = wgid % NXCD, off = wgid / NXCD;
      wgid = (xcd < r ? xcd * (q + 1) : r * (q + 1) + (xcd - r) * q) + off; }
    int nig = WGM * nN, gid = wgid / nig, fm = gid * WGM, gsz = min(nM - fm, WGM);
    int pm = fm + ((wgid % nig) % gsz), pn = (wgid % nig) / gsz, brow = pm * BM, bcol = pn * BM;
    const int A0 = brow * K * 2, A1 = A0 + HALF * K * 2, B0p = bcol * K * 2, B1p = B0p + HALF * K * 2;
    f32x4 acc[2][2][4][2] = {};
    bf16x8 At[4][2], B0[2][2], B1[2][2];
    STAGE(SB(0, 0), rsB, B0p, 0); STAGE(SA(0, 0), rsA, A0, 0);
    STAGE(SB(0, 1), rsB, B1p, 0); STAGE(SA(0, 1), rsA, A1, 0);
    if (wr == 1) BAR;
    WAIT_V(4); BAR;
    STAGE(SB(1, 0), rsB, B0p, 1); STAGE(SA(1, 0), rsA, A0, 1); STAGE(SB(1, 1), rsB, B1p, 1);
    WAIT_V(6); BAR;
    for (int t = 0; t < nt - 2; t += 2) {
      LDB(B0, 0, 0); SCHED; LDA(At, 0, 0); STAGE(SA(1, 1), rsA, A1, t + 1);
      WAIT_L(8); BAR; WAIT_L(0); MMA(0, 0, At, B0); BAR; SCHED;
      LDB(B1, 0, 1); STAGE(SB(0, 0), rsB, B0p, t + 2);
      BAR; WAIT_L(0); MMA(0, 1, At, B1); BAR;
      LDA(At, 0, 1); STAGE(SA(0, 0), rsA, A0, t + 2);
      BAR; WAIT_L(0); MMA(1, 0, At, B0); BAR; SCHED;
      STAGE(SB(0, 1), rsB, B1p, t + 2);
      WAIT_V(6); BAR; MMA(1, 1, At, B1); BAR;
      LDB(B0, 1, 0); SCHED; LDA(At, 1, 0); STAGE(SA(0, 1), rsA, A1, t + 2);
      WAIT_L(8); BAR; WAIT_L(0); MMA(0, 0, At, B0); BAR; SCHED;
      LDB(B1, 1, 1); STAGE(SB(1, 0), rsB, B0p, t + 3);
      BAR; WAIT_L(0); MMA(0, 1, At, B1); BAR;
      LDA(At, 1, 1); STAGE(SA(1, 0), rsA, A0, t + 3);
      BAR; WAIT_L(0); MMA(1, 0, At, B0); BAR; SCHED;
      STAGE(SB(1, 1), rsB, B1p, t + 3);
      WAIT_V(6); BAR; MMA(1, 1, At, B1); BAR;
    }
    { LDB(B0, 0, 0); LDA(At, 0, 0); STAGE(SA(1, 1), rsA, A1, nt - 1);
      BAR; WAIT_L(0); MMA(0, 0, At, B0); BAR;
      LDB(B1, 0, 1); BAR; WAIT_L(0); MMA(0, 1, At, B1); BAR;
      LDA(At, 0, 1); WAIT_V(4); BAR; WAIT_L(0); MMA(1, 0, At, B0); MMA(1, 1, At, B1); BAR; }
    { LDB(B0, 1, 0); LDA(At, 1, 0); WAIT_V(2); BAR; WAIT_L(0); MMA(0, 0, At, B0); BAR;
      LDB(B1, 1, 1); WAIT_V(0); BAR; WAIT_L(0); MMA(0, 1, At, B1); BAR;
      LDA(At, 1, 1); BAR; WAIT_L(0); MMA(1, 0, At, B0); MMA(1, 1, At, B1); BAR; }
    if (wr == 0) BAR;
    const int ci = brow < NPROMPT ? 0 : 1 + (brow - NPROMPT) / 2048;
    const int te = otid(), le = te & 63, wide = te >> 6;
    const int wr = wide >> 2, wc = wide & 3, fr = le & 15, fq = le >> 4;
#pragma unroll
    for (int ai = 0; ai < 2; ++ai)
#pragma unroll
      for (int m = 0; m < 4; ++m)
#pragma unroll
        for (int j = 0; j < 4; ++j) {
          const int row = brow + ai * HALF + wr * 64 + m * 16 + fq * 4 + j;
          if (MODE == EPI_SWIGLU) {
#pragma unroll
            for (int n = 0; n < 2; ++n) {
              float g = acc[ai][0][m][n][j], u = acc[ai][1][m][n][j];
              float v = g * sigmoid_f(g) * u;
              ea.b0[(size_t)row * DFF + pn * 128 + wc * 32 + n * 16 + fr] = f2bf(v);
            }
          } else {
#pragma unroll
            for (int bj = 0; bj < 2; ++bj)
#pragma unroll
              for (int n = 0; n < 2; ++n) {
                const int col = bcol + bj * HALF + wc * 32 + n * 16 + fr;
                float a = acc[ai][bj][m][n][j];
                if (MODE == EPI_RESID) {
                  float gate = ea.w * ea.c0[ci * 9216 + col];
                  size_t o = (size_t)row * D + col;
                  ea.f0[o] = ALPHA * ea.f0[o] + gate * a;
                } else if (MODE == EPI_F32) {
                  ea.f0[(size_t)row * DIN + col] = a;
                } else if (MODE == EPI_GLU) {
                  float g = bf2f(ea.cb[(size_t)row * 256 + col]);
                  ea.b0[(size_t)row * D + 256 + col] = f2bf(g * sigmoid_f(a + ea.c0[col]));
                } else if (MODE == EPI_POOL) {
                  ea.b0[(size_t)row * D + col] = f2bf(a * ea.c0[col]);
                }
              }
          }
        }
  }
#undef SA
#undef SB
}

DI void prep_phase(const Params& p, char* shmc, int bid, int nblk) {
  const int tid = otid(), wid = tid >> 6, lane = tid & 63;
  char* ws = PWS;
  {
    float* tile = (float*)shmc;
    constexpr int T_W1 = 16 * 88, T_W2 = 44 * 16, T_IN = 16 * 24, T_OUT = 256, T_GLU = 16;
    constexpr int PER_L = 2 * T_W1 + 2 * T_W2 + T_IN + T_OUT + T_GLU;
    for (int it = bid; it < 2 * PER_L; it += nblk) {
      int l = it / PER_L, r = it % PER_L;
      const float* src; bf16_t* dst; int K, N, mode = 0;
      if (r < 2 * T_W1) {
        int s = r / T_W1; r %= T_W1;
        src = INP(I_W1) + (size_t)(l * 2 + s) * 1024 * 5632; dst = (bf16_t*)(ws + OFF_W1T) + (size_t)(l * 2 + s) * 5632 * 1024;
        K = 1024; N = 5632; mode = 1;
      } else if (r < 2 * T_W1 + 2 * T_W2) {
        r -= 2 * T_W1; int s = r / T_W2; r %= T_W2;
        src = INP(I_W2) + (size_t)(l * 2 + s) * 2816 * 1024; dst = (bf16_t*)(ws + OFF_W2T) + (size_t)(l * 2 + s) * 1024 * 2816;
        K = 2816; N = 1024;
      } else if (r < 2 * T_W1 + 2 * T_W2 + T_IN) {
        r -= 2 * T_W1 + 2 * T_W2;
        src = INP(I_WIN) + (size_t)l * 1024 * 1536; dst = (bf16_t*)(ws + OFF_WINT) + (size_t)l * 1536 * 1024;
        K = 1024; N = 1536;
      } else if (r < 2 * T_W1 + 2 * T_W2 + T_IN + T_OUT) {
        r -= 2 * T_W1 + 2 * T_W2 + T_IN;
        src = INP(I_WOUT) + (size_t)l * 1024 * 1024; dst = (bf16_t*)(ws + OFF_WOUTT) + (size_t)l * 1024 * 1024;
        K = 1024; N = 1024;
      } else {
        r -= 2 * T_W1 + 2 * T_W2 + T_IN + T_OUT;
        src = INP(I_WGLU) + (size_t)l * 256 * 256; dst = (bf16_t*)(ws + OFF_WGLUT) + (size_t)l * 256 * 256;
        K = 256; N = 256;
      }
      int nkt = K / 64, kt = r % nkt, ntile = r / nkt;
#pragma unroll
      for (int i = 0; i < 2; ++i) {
        int k = (tid >> 4) + 32 * i, n = (tid & 15) * 4;
        float4 v = *(const float4*)(src + (size_t)(kt * 64 + k) * N + ntile * 64 + n);
        tile[k * 65 + n] = v.x; tile[k * 65 + n + 1] = v.y; tile[k * 65 + n + 2] = v.z; tile[k * 65 + n + 3] = v.w;
      }
      __syncthreads();
      {
        int n = tid >> 3, kk = (tid & 7) * 8;
        int nsrc = ntile * 64 + n, nrow = nsrc;
        if (mode == 1) {
          if (nsrc < 2816) nrow = (nsrc >> 7) * 256 + (nsrc & 127);
          else { int mm = nsrc - 2816; nrow = (mm >> 7) * 256 + 128 + (mm & 127); }
        }
        bf16x8 o = pack8(tile[(kk + 0) * 65 + n], tile[(kk + 1) * 65 + n], tile[(kk + 2) * 65 + n], tile[(kk + 3) * 65 + n],
                         tile[(kk + 4) * 65 + n], tile[(kk + 5) * 65 + n], tile[(kk + 6) * 65 + n], tile[(kk + 7) * 65 + n]);
        *(bf16x8*)(dst + (size_t)nrow * K + kt * 64 + kk) = o;
      }
      __syncthreads();
    }
  }
  const int gtid = bid * 512 + tid, gn = nblk * 512;
  for (int i = gtid; i < 2 * 65536; i += gn) {
    int l = i >> 16, n = (i >> 8) & 255, k = i & 255;
    int gi = n >> 6, d = n & 63, gj = k >> 6, c = k & 63;
    float v = (gi == gj) ? INP(I_POOLW)[((size_t)(l * 4 + gi) * 64 + c) * 64 + d] : 0.f;
    ((bf16_t*)(ws + OFF_WPOOLT))[i] = f2bf(v);
  }
  {
    float* sc = (float*)shmc + 64 * 65;
    float* red = sc + 3 * 1024;
    for (int i = tid; i < 3 * 1024; i += 512) {
      int ci = i >> 10, k = i & 1023;
      float v = ci == 0 ? INP(I_CCTX)[k] : INP(I_C)[(ci - 1) * 1024 + k];
      sc[i] = v * sigmoid_f(v);
    }
    __syncthreads();
    for (int it = bid; it < 288; it += nblk) {
      int l = it / 144, cb = it % 144, col = cb * 64 + lane;
      const float* wp = INP(I_WMOD) + (size_t)l * 1024 * 9216 + col;
      float a0 = 0.f, a1 = 0.f, a2 = 0.f;
#pragma unroll 8
      for (int k = wid * 128; k < wid * 128 + 128; ++k) {
        float w = wp[(size_t)k * 9216];
        a0 += sc[k] * w; a1 += sc[1024 + k] * w; a2 += sc[2048 + k] * w;
      }
      red[(wid * 3 + 0) * 64 + lane] = a0; red[(wid * 3 + 1) * 64 + lane] = a1; red[(wid * 3 + 2) * 64 + lane] = a2;
      __syncthreads();
      if (tid < 192) {
        int ci = tid >> 6;
        float s = 0.f;
        for (int w = 0; w < 8; ++w) s += red[(w * 3 + ci) * 64 + lane];
        ((float*)(ws + OFF_MOD))[(size_t)(l * 3 + ci) * 9216 + col] = s + INP(I_BMOD)[l * 9216 + col];
      }
      __syncthreads();
    }
  }
  for (int i = gtid; i < 2 * 2 * 512 * 128; i += gn) {
    int c = i & 127, t = (i >> 7) & 511, b = (i >> 16) & 1, l = i >> 17;
    size_t si = ((size_t)(b * 2 + l) * 512 + t) * 128 + c;
    const size_t sb_ = (size_t)((l * 2 + b) * 2 + (c >> 6)) * 163840;
    ((bf16_t*)(ws + OFF_KS))[sb_ + kfrag_off(t, c & 63)] = f2bf(INP(I_CK)[si]);
    ((bf16_t*)(ws + OFF_VST))[sb_ + vfrag_off(t, c & 63)] = f2bf(INP(I_CV)[si]);
  }
  for (int i = gtid; i < 4096; i += gn) {
    float lre = INP(I_LRE)[i], lim = INP(I_LIM)[i];
    float dt = expf(INP(I_LSTEP)[i >> 6]);
    float e = expf(lre * dt), ang = lim * dt;
    float br = e * cosf(ang), bi = e * sinf(ang);
    float ar = br - 1.f, ai = bi, den = lre * lre + lim * lim;
    float cr = (ar * lre + ai * lim) / den, cim = (ai * lre - ar * lim) / den;
    ((float2*)(ws + OFF_LAMB))[i] = make_float2(br, bi);
    float pr = br, pi = bi;
    for (int s = 0; s < 6; ++s) { float nr = pr * pr - pi * pi, ni = 2.f * pr * pi; pr = nr; pi = ni; }
    ((float2*)(ws + OFF_LAMT))[i] = make_float2(pr, pi);
  }
  for (int i = gtid; i < 64 * 8 * 64; i += gn) {
    const int gidx = i >> 9, nt = (i >> 6) & 7, ln = i & 63, fr = ln & 15, fq = ln >> 4;
    bf16x8 o = (bf16x8){0, 0, 0, 0, 0, 0, 0, 0};
    if (fq < 2) {
      const int n = nt * 8 + (fr >> 1), idx = gidx * 64 + n;
      float lre = INP(I_LRE)[idx], lim = INP(I_LIM)[idx];
      float dt = expf(INP(I_LSTEP)[gidx]);
      float e = expf(lre * dt), ang = lim * dt;
      float br = e * cosf(ang), bi = e * sinf(ang);
      float ar = br - 1.f, ai = bi, den = lre * lre + lim * lim;
      float cr = (ar * lre + ai * lim) / den, cim = (ai * lre - ar * lim) / den;
      float v[8];
#pragma unroll
      for (int j = 0; j < 8; ++j) {
        float xr = INP(I_BRE)[(size_t)idx * 16 + fq * 8 + j], xi = INP(I_BIM)[(size_t)idx * 16 + fq * 8 + j];
        v[j] = (fr & 1) ? cr * xi + cim * xr : cr * xr - cim * xi;
      }
      o = pack8(v[0], v[1], v[2], v[3], v[4], v[5], v[6], v[7]);
    }
    ((bf16x8*)(ws + OFF_BF))[i] = o;
  }
  for (int i = gtid; i < 64 * 4 * 64; i += gn) {
    const int gidx = i >> 8, ks = (i >> 6) & 3, ln = i & 63, fr = ln & 15, fq = ln >> 4;
    const size_t co = ((size_t)gidx * 16 + fr) * 64 + ks * 16 + fq * 4;
    float4 cr = *(const float4*)(INP(I_CRE) + co), cim = *(const float4*)(INP(I_CIM) + co);
    ((bf16x8*)(ws + OFF_CF))[i] = pack8(cr.x, -cim.x, cr.y, -cim.y, cr.z, -cim.z, cr.w, -cim.w);
  }
}

DI void lnmod_phase(const Params& p, int l_ln, int ln_idx, int l_mod, int mod_idx, int bid, int nblk) {
  const int tid = otid(), wid = tid >> 6, lane = tid & 63;
  float* xy = (float*)(PWS + OFF_XY);
  bf16_t* h = (bf16_t*)(PWS + OFF_H);
  const float* modv = (const float*)(PWS + OFF_MOD);
  for (int row = bid * 8 + wid; row < NTOK; row += nblk * 8) {
    const float* src = l_ln < 0 ? (row < NPROMPT ? INP(I_XP) + (size_t)row * D : INP(I_XS) + (size_t)(row - NPROMPT) * D)
                                : xy + (size_t)row * D;
    float4 v[4];
#pragma unroll
    for (int i = 0; i < 4; ++i) v[i] = *(const float4*)(src + lane * 4 + i * 256);
    if (l_ln >= 0) {
      float s = 0.f;
#pragma unroll
      for (int i = 0; i < 4; ++i) s += v[i].x + v[i].y + v[i].z + v[i].w;
      float mean = wave_sum(s, lane) * (1.f / 1024.f);
      float q = 0.f;
#pragma unroll
      for (int i = 0; i < 4; ++i) {
        v[i].x -= mean; v[i].y -= mean; v[i].z -= mean; v[i].w -= mean;
        q += v[i].x * v[i].x + v[i].y * v[i].y + v[i].z * v[i].z + v[i].w * v[i].w;
      }
      float rstd = rsqrtf(wave_sum(q, lane) * (1.f / 1024.f) + LN_EPS);
      const float* g = INP(I_LNG) + (l_ln * 3 + ln_idx) * 1024;
      const float* b = INP(I_LNB) + (l_ln * 3 + ln_idx) * 1024;
#pragma unroll
      for (int i = 0; i < 4; ++i) {
        float4 gg = *(const float4*)(g + lane * 4 + i * 256), bb = *(const float4*)(b + lane * 4 + i * 256);
        v[i].x = v[i].x * rstd * gg.x + bb.x; v[i].y = v[i].y * rstd * gg.y + bb.y;
        v[i].z = v[i].z * rstd * gg.z + bb.z; v[i].w = v[i].w * rstd * gg.w + bb.w;
      }
    }
    float* dx = l_mod < 0 ? p.out + (size_t)row * D : xy + (size_t)row * D;
#pragma unroll
    for (int i = 0; i < 4; ++i) *(float4*)(dx + lane * 4 + i * 256) = v[i];
    if (l_mod >= 0) {
      int ci = row < NPROMPT ? 0 : 1 + (row - NPROMPT) / 2048;
      const float* sh = modv + (size_t)(l_mod * 3 + ci) * 9216 + mod_idx * 1024;
      const float* sc = sh + 1024;
#pragma unroll
      for (int i = 0; i < 4; ++i) {
        float4 a = *(const float4*)(sh + lane * 4 + i * 256), c = *(const float4*)(sc + lane * 4 + i * 256);
        u32x2 o = {pk2(v[i].x * (1.f + c.x) + a.x, v[i].y * (1.f + c.y) + a.y),
                   pk2(v[i].z * (1.f + c.z) + a.z, v[i].w * (1.f + c.w) + a.w)};
        *(u32x2*)(h + (size_t)row * D + lane * 4 + i * 256) = o;
      }
    }
  }
}

DI void post_phase(const Params& p, int l, char* shmc, int bid, int nblk) {
  const int tid = otid(), wid = tid >> 6, lane = tid & 63;
  char* ws = PWS;
  const float* proj = (const float*)(ws + OFF_R);
  bf16_t* qb = (bf16_t*)(ws + OFF_QB);
  const float qn = INP(I_QN)[l * 64 + lane], kn = INP(I_KN)[l * 64 + lane];
  const int fi = lane & 15;
  const float inv = exp2f(-(float)fi * (13.287712379549449f / 16.f));
  for (int row = bid * 8 + wid; row < NTOK; row += nblk * 8) {
    const float* pr = proj + (size_t)row * DIN;
    const bool samp = row >= NPROMPT;
    int b, t, L;
    if (samp) { b = (row - NPROMPT) >> 11; t = (row - NPROMPT) & 2047; L = 2048; }
    else { b = row >> 8; t = row & 255; L = 256; }
    float cs = 1.f, sn = 0.f;
    if (samp) {
      float pos = (float)((lane & 31) < 16 ? (t >> 6) : (t & 63));
      float ang = pos * inv;
      cs = cosf(ang); sn = sinf(ang);
    }
#pragma unroll
    for (int hd = 0; hd < 4; ++hd) {
      float x = pr[512 + hd * 64 + lane];
      float ss = wave_sum(x * x, lane) * (1.f / 64.f);
      float xn = x * rsqrtf(ss + RMS_EPS) * qn;
      if (samp) {
        float o = shfl_x(xn, 32, lane);
        xn = lane < 32 ? xn * cs - o * sn : o * sn + xn * cs;
      }
      qb[(size_t)row * 256 + hd * 64 + lane] = f2bf(xn);
    }
#pragma unroll
    for (int hd = 0; hd < 2; ++hd) {
      float x = pr[768 + hd * 64 + lane];
      float ss = wave_sum(x * x, lane) * (1.f / 64.f);
      float xn = x * rsqrtf(ss + RMS_EPS) * kn;
      float vv = pr[896 + hd * 64 + lane];
      if (samp) {
        float o = shfl_x(xn, 32, lane);
        xn = lane < 32 ? xn * cs - o * sn : o * sn + xn * cs;
        const size_t sb_ = (size_t)((l * 2 + b) * 2 + hd) * 163840;
        ((bf16_t*)(ws + OFF_KS))[sb_ + kfrag_off(512 + t, lane)] = f2bf(xn);
        ((bf16_t*)(ws + OFF_VST))[sb_ + vfrag_off(512 + t, lane)] = f2bf(vv);
      } else {
        size_t oo = ((size_t)(b * 2 + l) * 256 + t) * 128 + hd * 64 + lane;
        p.out[OUT_K + oo] = xn;
        p.out[OUT_V + oo] = vv;
        const size_t sb_ = (size_t)(b * 2 + hd) * 16384;
        ((bf16_t*)(ws + OFF_KP))[sb_ + kfrag_off(t, lane)] = f2bf(xn);
        ((bf16_t*)(ws + OFF_VPT))[sb_ + vfrag_off(t, lane)] = f2bf(vv);
      }
    }
    {
      float z[4]; float s = 0.f;
#pragma unroll
      for (int i = 0; i < 4; ++i) { z[i] = gelu_t(pr[1280 + i * 64 + lane]); s += z[i]; }
      float mean = wave_sum(s, lane) * (1.f / 256.f);
      float q = 0.f;
#pragma unroll
      for (int i = 0; i < 4; ++i) { z[i] -= mean; q += z[i] * z[i]; }
      float rstd = rsqrtf(wave_sum(q, lane) * (1.f / 256.f) + LN_EPS);
      bf16_t* vct = (bf16_t*)(ws + OFF_VCT) + (size_t)(row >> 7) * 256 * 128 + (row & 127);
#pragma unroll
      for (int i = 0; i < 4; ++i) {
        int c = i * 64 + lane;
        float vn = z[i] * rstd * INP(I_CLG)[l * 256 + c] + INP(I_CLB)[l * 256 + c];
        vct[(size_t)c * 128] = f2bf(vn);
      }
    }
    {
      bf16_t* df = (bf16_t*)(ws + OFF_DIFF) + (size_t)row * 256;
#pragma unroll
      for (int gi = 0; gi < 4; ++gi) {
        const int hw = 1 << gi;
        int lo = max(t - hw, 0), hi = min(t + hw, L);
        float s = 0.f;
        for (int tt = lo; tt < hi; ++tt) s += pr[(ptrdiff_t)(tt - t) * DIN + gi * 64 + lane];
        float mean = s / (float)(hi - lo);
        df[gi * 64 + lane] = f2bf(mean - pr[gi * 64 + lane]);
      }
    }
  }
}

struct AttnState { f32x16 o0, o1; float m, l; };
#define ATT_LOADKV(KF, VF, K0) do { const int kt_ = (K0) >> 5; \
    _Pragma("unroll") for (int s_ = 0; s_ < 4; ++s_) KF[s_] = *(const bf16x8*)(Kb + ((size_t)(kt_ * 4 + s_) * 64 + lane) * 8); \
    _Pragma("unroll") for (int s_ = 0; s_ < 2; ++s_) { \
      VF[s_][0] = *(const bf16x8*)(Vt + ((size_t)((kt_ * 2 + s_) * 2 + 0) * 64 + lane) * 8); \
      VF[s_][1] = *(const bf16x8*)(Vt + ((size_t)((kt_ * 2 + s_) * 2 + 1) * 64 + lane) * 8); } } while (0)

DI void attn_core(const bf16_t* __restrict__ Q, int qrow0, int head, const bf16_t* __restrict__ Kb,
                  const bf16_t* __restrict__ Vt, int kbeg, int kend, int lane, AttnState& st) {
  const int r = lane & 31, hh = lane >> 5;
  bf16x8 qf[4];
  const bf16_t* qp = Q + (size_t)(qrow0 + r) * 256 + head * 64 + 8 * hh;
#pragma unroll
  for (int s = 0; s < 4; ++s) qf[s] = *(const bf16x8*)(qp + 16 * s);
  f32x16 o0, o1;
#pragma unroll
  for (int i = 0; i < 16; ++i) { o0[i] = 0.f; o1[i] = 0.f; }
  float m = -INFINITY, lsum = 0.f;
  const float c = 0.125f * 1.4426950408889634f;
  bf16x8 kf[4], vf[2][2];
  ATT_LOADKV(kf, vf, kbeg);
  for (int k0 = kbeg; k0 < kend; k0 += 32) {
    const int kn = min(k0 + 32, kend - 32);
    bf16x8 kfn[4], vfn[2][2];
    ATT_LOADKV(kfn, vfn, kn);
    f32x16 sa;
#pragma unroll
    for (int i = 0; i < 16; ++i) sa[i] = 0.f;
#pragma unroll
    for (int s = 0; s < 4; ++s) sa = MFMA32(kf[s], qf[s], sa);
    float mx = sa[0];
#pragma unroll
    for (int i = 1; i < 16; ++i) mx = fmaxf(mx, sa[i]);
    mx = fmaxf(mx, shfl_x(mx, 32, lane));
    float mn = fmaxf(m, mx);
    float alpha = __builtin_amdgcn_exp2f((m - mn) * c);
    m = mn;
    float pv[16]; float ps = 0.f;
#pragma unroll
    for (int i = 0; i < 16; ++i) { pv[i] = __builtin_amdgcn_exp2f((sa[i] - mn) * c); ps += pv[i]; }
    lsum = lsum * alpha + ps;
#pragma unroll
    for (int i = 0; i < 16; ++i) { o0[i] *= alpha; o1[i] *= alpha; }
#pragma unroll
    for (int s = 0; s < 2; ++s) {
      bf16x8 pf = pack8(pv[8 * s], pv[8 * s + 1], pv[8 * s + 2], pv[8 * s + 3], pv[8 * s + 4], pv[8 * s + 5], pv[8 * s + 6], pv[8 * s + 7]);
      o0 = MFMA32(vf[s][0], pf, o0);
      o1 = MFMA32(vf[s][1], pf, o1);
    }
#pragma unroll
    for (int s = 0; s < 4; ++s) kf[s] = kfn[s];
#pragma unroll
    for (int s = 0; s < 2; ++s) { vf[s][0] = vfn[s][0]; vf[s][1] = vfn[s][1]; }
  }
  lsum += shfl_x(lsum, 32, lane);
  st.o0 = o0; st.o1 = o1; st.m = m; st.l = lsum;
}

DI void attn_prompt_item(const bf16_t* Q, int qrow0, int head, const bf16_t* Kb, const bf16_t* Vt, bf16_t* Y, int lane) {
  AttnState st;
  attn_core(Q, qrow0, head, Kb, Vt, 0, 256, lane, st);
  const int r = lane & 31, hh = lane >> 5;
  const float il = 1.f / st.l;
  bf16_t* yp = Y + (size_t)(qrow0 + r) * D + 512 + head * 64 + 4 * hh;
#pragma unroll
  for (int g4 = 0; g4 < 4; ++g4) {
    u32x2 a = {pk2(st.o0[4 * g4] * il, st.o0[4 * g4 + 1] * il), pk2(st.o0[4 * g4 + 2] * il, st.o0[4 * g4 + 3] * il)};
    u32x2 b = {pk2(st.o1[4 * g4] * il, st.o1[4 * g4 + 1] * il), pk2(st.o1[4 * g4 + 2] * il, st.o1[4 * g4 + 3] * il)};
    *(u32x2*)(yp + 8 * g4) = a;
    *(u32x2*)(yp + 32 + 8 * g4) = b;
  }
}

DI void attn_sample_item(const Params& p, int l, int it, char* shmc, int wid, int lane) {
  char* ws = PWS;
  float* Osh = (float*)shmc;
  float* Msh = Osh + 8 * 32 * 64;
  float* Lsh = Msh + 8 * 64;
  const int b = it >> 7, head = (it >> 5) & 3, qpair = it & 31;
  const int qsub = wid & 1, ksplit = wid >> 1;
  const int qrow0 = NPROMPT + b * 2048 + (qpair * 2 + qsub) * 32;
  AttnState st;
  attn_core((const bf16_t*)(ws + OFF_QB), qrow0, head, (const bf16_t*)(ws + OFF_KS) + (size_t)((l * 2 + b) * 2 + (head >> 1)) * 163840,
            (const bf16_t*)(ws + OFF_VST) + (size_t)((l * 2 + b) * 2 + (head >> 1)) * 163840, ksplit * 640, ksplit * 640 + 640, lane, st);
  Msh[wid * 64 + lane] = st.m; Lsh[wid * 64 + lane] = st.l;
#pragma unroll
  for (int i = 0; i < 16; ++i) { Osh[(wid * 32 + i) * 64 + lane] = st.o0[i]; Osh[(wid * 32 + 16 + i) * 64 + lane] = st.o1[i]; }
  __syncthreads();
  {
    const float c = 0.125f * 1.4426950408889634f;
    float mm[4], M = -INFINITY;
#pragma unroll
    for (int k = 0; k < 4; ++k) { mm[k] = Msh[(2 * k + qsub) * 64 + lane]; M = fmaxf(M, mm[k]); }
    float sc[4], Lt = 0.f;
#pragma unroll
    for (int k = 0; k < 4; ++k) { sc[k] = __builtin_amdgcn_exp2f((mm[k] - M) * c); Lt += Lsh[(2 * k + qsub) * 64 + lane] * sc[k]; }
    const float il = 1.f / Lt;
    float ov[8];
#pragma unroll
    for (int e = 0; e < 8; ++e) {
      float a = 0.f;
#pragma unroll
      for (int k = 0; k < 4; ++k) a += Osh[((2 * k + qsub) * 32 + ksplit * 8 + e) * 64 + lane] * sc[k];
      ov[e] = a * il;
    }
    const int r = lane & 31, hh = lane >> 5;
    const int dblk = ksplit >> 1, g4 = (ksplit & 1) * 2;
    bf16_t* yp = (bf16_t*)(ws + OFF_YMIX) + (size_t)(qrow0 + r) * D + 512 + head * 64 + dblk * 32 + 8 * g4 + 4 * hh;
    u32x2 a = {pk2(ov[0], ov[1]), pk2(ov[2], ov[3])};
    u32x2 bq = {pk2(ov[4], ov[5]), pk2(ov[6], ov[7])};
    *(u32x2*)yp = a;
    *(u32x2*)(yp + 8) = bq;
  }
  __syncthreads();
}

DI void chunk_item(const Params& p, int l, int ch, int hd, int sp, int lane) {
  const int fr = lane & 15, fq = lane >> 4;
  char* ws = PWS;
  const float* wsrc = INP(I_CWS) + ((size_t)(l * 4 + hd) * 128 + sp * 16 + fr) * 128 + fq * 8;
  const bf16_t* vb = (const bf16_t*)(ws + OFF_VCT) + ((size_t)ch * 256 + hd * 64 + fr) * 128 + fq * 8;
  f32x4 acc[4];
#pragma unroll
  for (int i = 0; i < 4; ++i) acc[i] = (f32x4){0.f, 0.f, 0.f, 0.f};
#pragma unroll
  for (int ks = 0; ks < 4; ++ks) {
    float4 a0 = *(const float4*)(wsrc + ks * 32), a1 = *(const float4*)(wsrc + ks * 32 + 4);
    bf16x8 af = pack8(a0.x, a0.y, a0.z, a0.w, a1.x, a1.y, a1.z, a1.w);
#pragma unroll
    for (int nt = 0; nt < 4; ++nt) {
      bf16x8 bfr = *(const bf16x8*)(vb + (size_t)nt * 16 * 128 + ks * 32);
      acc[nt] = MFMA16(af, bfr, acc[nt]);
    }
  }
  const float* proj = (const float*)(ws + OFF_R);
  bf16_t* ymix = (bf16_t*)(ws + OFF_YMIX);
  float uu[4][4];
#pragma unroll
  for (int j = 0; j < 4; ++j)
#pragma unroll
    for (int nt = 0; nt < 4; ++nt)
      uu[j][nt] = proj[(size_t)(ch * 128 + sp * 16 + fq * 4 + j) * DIN + 1024 + hd * 64 + nt * 16 + fr];
#pragma unroll
  for (int j = 0; j < 4; ++j) {
    int pp = sp * 16 + fq * 4 + j, tok = ch * 128 + pp;
    float bs = INP(I_CBS)[(l * 4 + hd) * 128 + pp];
#pragma unroll
    for (int nt = 0; nt < 4; ++nt) {
      int c = hd * 64 + nt * 16 + fr;
      ymix[(size_t)tok * D + 768 + c] = f2bf(gelu_t(uu[j][nt]) * (acc[nt][j] + bs));
    }
  }
}

constexpr int SSM_BU_LD = 132, SSM_H_LD = 136;
constexpr int SSM_WAVE_LDS = 16 * SSM_BU_LD * 4 + 16 * SSM_H_LD * 2;
#define LDS_FENCE() do { asm volatile("s_waitcnt lgkmcnt(0)" ::: "memory"); __builtin_amdgcn_wave_barrier(); } while (0)

DI void ssm_load_u(const Params& p, int ck, int g, int lane, bf16x8 (&af)[4]) {
  const int fr = lane & 15, fq = lane >> 4;
  const float* ub = (const float*)(PWS + OFF_R) + (size_t)ck * 64 * DIN + 256 + g * 16;
#pragma unroll
  for (int tile = 0; tile < 4; ++tile) {
    if (fq < 2) {
      const float* up = ub + (size_t)(tile * 16 + fr) * DIN + fq * 8;
      float4 a0 = *(const float4*)up, a1 = *(const float4*)(up + 4);
      af[tile] = pack8(a0.x, a0.y, a0.z, a0.w, a1.x, a1.y, a1.z, a1.w);
    } else {
      af[tile] = (bf16x8){0, 0, 0, 0, 0, 0, 0, 0};
    }
  }
}

template <int MODE, int DIR>
DI void ssm_dir(const Params& p, int l, int ck, int g, int lane, const bf16x8 (&af)[4], f32x4 (&yacc)[4], char* wlds) {
  constexpr bool CHAIN = MODE == 1;
  const int fr = lane & 15, fq = lane >> 4;
  char* ws = PWS;
  float* BU = (float*)wlds;
  bf16_t* Hs = (bf16_t*)(wlds + 16 * SSM_BU_LD * 4);
  const int gidx = (l * 2 + DIR) * 16 + g, idx = gidx * 64 + lane;
  bf16x8 bfr[8], cf[4];
#pragma unroll
  for (int nt = 0; nt < 8; ++nt) bfr[nt] = ((const bf16x8*)(ws + OFF_BF))[(gidx * 8 + nt) * 64 + lane];
#pragma unroll
  for (int ks = 0; ks < 4; ++ks) cf[ks] = ((const bf16x8*)(ws + OFF_CF))[(gidx * 4 + ks) * 64 + lane];
  const float2 lam = ((const float2*)(ws + OFF_LAMB))[idx];
  float hr = 0.f, hi = 0.f;
  const bool samp = ck >= 128;
  const int CPS = samp ? 32 : 4;
  const int cs = samp ? ((ck - 128) & 31) : (ck & 3);
  const int b = samp ? ((ck - 128) >> 5) : (ck >> 2);
  if (CHAIN) {
    const float2 lamT = ((const float2*)(ws + OFF_LAMT))[idx];
    const float2* Eb = (const float2*)(ws + OFF_E);
    const int cbase = ck - cs;
    if (samp) {
      size_t si = ((size_t)((b * 2 + l) * 2 + DIR) * 16 + g) * 64 + lane;
      hr = INP(I_SRE)[si]; hi = INP(I_SIM)[si];
    }
    const int nstep = DIR == 0 ? cs : CPS - 1 - cs;
    for (int base = 0; base < nstep; base += 8) {
      float2 ev[8];
#pragma unroll
      for (int k = 0; k < 8; ++k) {
        const int st = min(base + k, nstep - 1);
        const int c2 = DIR == 0 ? st : CPS - 1 - st;
        ev[k] = Eb[((size_t)((cbase + c2) * 16 + g) * 2 + DIR) * 64 + lane];
      }
#pragma unroll
      for (int k = 0; k < 8; ++k)
        if (base + k < nstep) {
          float nr = lamT.x * hr - lamT.y * hi + ev[k].x, ni = lamT.x * hi + lamT.y * hr + ev[k].y; hr = nr; hi = ni;
        }
    }
  }
#pragma unroll
  for (int sb = 0; sb < 4; ++sb) {
    const int tile = DIR ? 3 - sb : sb;
#pragma unroll
    for (int nt = 0; nt < 8; ++nt) {
      f32x4 cz = MFMA16(af[tile], bfr[nt], ((f32x4){0.f, 0.f, 0.f, 0.f}));
#pragma unroll
      for (int j = 0; j < 4; ++j) BU[(fq * 4 + j) * SSM_BU_LD + nt * 16 + fr] = cz[j];
    }
    LDS_FENCE();
#pragma unroll
    for (int q = 0; q < 16; ++q) {
      const int tt = DIR ? 15 - q : q;
      const float2 bu = *(const float2*)(BU + tt * SSM_BU_LD + 2 * lane);
      float nr = lam.x * hr - lam.y * hi + bu.x, ni = lam.x * hi + lam.y * hr + bu.y; hr = nr; hi = ni;
      *(unsigned*)(Hs + tt * SSM_H_LD + 2 * lane) = pk2(hr, hi);
    }
    LDS_FENCE();
#pragma unroll
    for (int ks = 0; ks < 4; ++ks) {
      bf16x8 ah = *(const bf16x8*)(Hs + fr * SSM_H_LD + ks * 32 + fq * 8);
      yacc[tile] = MFMA16(ah, cf[ks], yacc[tile]);
    }
    LDS_FENCE();
  }
  if (!CHAIN) {
    ((float2*)(ws + OFF_E))[((size_t)(ck * 16 + g) * 2 + DIR) * 64 + lane] = make_float2(hr, hi);
  } else if (!samp && ((DIR == 0 && cs == 3) || (DIR == 1 && cs == 0))) {
    size_t so = ((size_t)((b * 2 + l) * 2 + DIR) * 16 + g) * 64 + lane;
    p.out[OUT_SRE + so] = hr; p.out[OUT_SIM + so] = hi;
  }
}

#define SSM1_MODE 2
DI void ssm1_item(const Params& p, int l, int ck, int g, int dir, int lane, char* wlds) {
  bf16x8 af[4]; f32x4 yacc[4];
#pragma unroll
  for (int i = 0; i < 4; ++i) yacc[i] = (f32x4){0.f, 0.f, 0.f, 0.f};
  ssm_load_u(p, ck, g, lane, af);
  if (dir) ssm_dir<SSM1_MODE, 1>(p, l, ck, g, lane, af, yacc, wlds);
  else ssm_dir<SSM1_MODE, 0>(p, l, ck, g, lane, af, yacc, wlds);
}

DI void ssm2_item(const Params& p, int l, int ck, int g, int lane, char* wlds) {
  const int fr = lane & 15, fq = lane >> 4;
  bf16x8 af[4]; f32x4 yacc[4];
#pragma unroll
  for (int i = 0; i < 4; ++i) yacc[i] = (f32x4){0.f, 0.f, 0.f, 0.f};
  ssm_load_u(p, ck, g, lane, af);
  ssm_dir<1, 0>(p, l, ck, g, lane, af, yacc, wlds);
  ssm_dir<1, 1>(p, l, ck, g, lane, af, yacc, wlds);
  char* ws = PWS;
  const float* ub = (const float*)(ws + OFF_R) + (size_t)ck * 64 * DIN + 256 + g * 16;
  bf16_t* sg = (bf16_t*)(ws + OFF_SG);
  const int c = g * 16 + fr;
  const float dd = INP(I_SSMD)[l * 256 + c];
  float uv[4][4];
#pragma unroll
  for (int t4 = 0; t4 < 4; ++t4)
#pragma unroll
    for (int j = 0; j < 4; ++j) uv[t4][j] = ub[(size_t)(t4 * 16 + fq * 4 + j) * DIN + fr];
#pragma unroll
  for (int t4 = 0; t4 < 4; ++t4)
#pragma unroll
    for (int j = 0; j < 4; ++j) {
      size_t row = (size_t)ck * 64 + t4 * 16 + fq * 4 + j;
      sg[row * 256 + c] = f2bf(gelu_t(yacc[t4][j] + dd * uv[t4][j]));
    }
}

DI void ssm1_phase(const Params& p, int l, char* shmc, int bid, int nblk) {
  const int tid = otid(), wid = __builtin_amdgcn_readfirstlane(tid >> 6), lane = tid & 63;
  char* wlds = shmc + wid * SSM_WAVE_LDS;
  for (int it = wid * nblk + bid; it < 6144; it += nblk * 8) ssm1_item(p, l, it >> 5, (it >> 1) & 15, it & 1, lane, wlds);
}

DI void mix_phase(const Params& p, int l, char* shmc, int bid, int nblk) {
  const int tid = otid(), wid = __builtin_amdgcn_readfirstlane(tid >> 6), lane = tid & 63;
  char* ws = PWS;
  for (int it = bid; it < 256; it += nblk) attn_sample_item(p, l, it, shmc, wid, lane);
  for (int it = bid * 8 + wid; it < 1024; it += nblk * 8) {
    int b = it >> 5, head = (it >> 3) & 3, qt = it & 7;
    attn_prompt_item((const bf16_t*)(ws + OFF_QB), b * 256 + qt * 32, head, (const bf16_t*)(ws + OFF_KP) + (size_t)(b * 2 + (head >> 1)) * 16384,
                     (const bf16_t*)(ws + OFF_VPT) + (size_t)(b * 2 + (head >> 1)) * 16384, (bf16_t*)(ws + OFF_YMIX), lane);
  }
  __syncthreads();
  char* wlds = shmc + wid * SSM_WAVE_LDS;
  const int slot = wid * nblk + bid, nslot = nblk * 8;
  for (int it = slot; it < 6144; it += nslot) {
    if (it < 3072) ssm2_item(p, l, it >> 4, it & 15, lane, wlds);
    else { int j = it - 3072; chunk_item(p, l, j >> 5, (j >> 3) & 3, j & 7, lane); }
  }
}

constexpr int N_PHASE = 26;
DI void run_phase(const Params& p, int ph, char* shm, int bid, int nblk) {
  char* ws = PWS;
  if (ph == 0) { prep_phase(p, shm, bid, nblk); return; }
  if (ph == 25) { lnmod_phase(p, 1, 2, -1, 0, bid, nblk); return; }
  const int l = (ph - 1) / 12, s = (ph - 1) % 12;
  const bf16_t* hA = (const bf16_t*)(ws + OFF_H);
  bf16_t* hid = (bf16_t*)(ws + OFF_R);
  float* xy = (float*)(ws + OFF_XY);
  const float* modl = (const float*)(ws + OFF_MOD) + (size_t)l * 3 * 9216;
  EpiArgs ea; ea.f0 = nullptr; ea.b0 = nullptr; ea.c0 = nullptr; ea.cb = nullptr; ea.w = 0.f;
  switch (s) {
    case 0: if (l == 0) lnmod_phase(p, -1, 0, 0, 0, bid, nblk); else lnmod_phase(p, l - 1, 2, l, 0, bid, nblk); break;
    case 1: case 10: {
      int sI = s == 1 ? 0 : 1;
      ea.b0 = hid;
      gemm_phase<1024, EPI_SWIGLU>(hA, (const bf16_t*)(ws + OFF_W1T) + (size_t)(l * 2 + sI) * 5632 * 1024, 48, 22, ea, shm, bid, nblk);
    } break;
    case 2: case 11: {
      int sI = s == 2 ? 0 : 1;
      ea.f0 = xy; ea.c0 = modl + (s == 2 ? 2 : 8) * 1024; ea.w = 0.5f;
      gemm_phase<2816, EPI_RESID>(hid, (const bf16_t*)(ws + OFF_W2T) + (size_t)(l * 2 + sI) * 1024 * 2816, 48, 4, ea, shm, bid, nblk);
    } break;
    case 3: lnmod_phase(p, l, 0, l, 3, bid, nblk); break;
    case 4: {
      ea.f0 = (float*)(ws + OFF_R);
      gemm_phase<1024, EPI_F32>(hA, (const bf16_t*)(ws + OFF_WINT) + (size_t)l * 1536 * 1024, 48, 6, ea, shm, bid, nblk);
    } break;
    case 5: post_phase(p, l, shm, bid, nblk); ssm1_phase(p, l, shm, bid, nblk); break;
    case 6: mix_phase(p, l, shm, bid, nblk); break;
    case 7: {
      ea.b0 = (bf16_t*)(ws + OFF_YMIX); ea.cb = (const bf16_t*)(ws + OFF_SG); ea.c0 = INP(I_BGLU) + l * 256;
      gemm_phase<256, EPI_GLU>((const bf16_t*)(ws + OFF_SG), (const bf16_t*)(ws + OFF_WGLUT) + (size_t)l * 65536, 48, 1, ea, shm, bid, nblk);
      ea.c0 = INP(I_POOLS) + l * 256;
      int bid2 = (bid + nblk - (nblk >> 1)) % nblk;
      gemm_phase<256, EPI_POOL>((const bf16_t*)(ws + OFF_DIFF), (const bf16_t*)(ws + OFF_WPOOLT) + (size_t)l * 65536, 48, 1, ea, shm, bid2, nblk);
    } break;
    case 8: {
      ea.f0 = xy; ea.c0 = modl + 5 * 1024; ea.w = 1.0f;
      gemm_phase<1024, EPI_RESID>((const bf16_t*)(ws + OFF_YMIX), (const bf16_t*)(ws + OFF_WOUTT) + (size_t)l * 1024 * 1024, 48, 4, ea, shm, bid, nblk);
    } break;
    case 9: lnmod_phase(p, l, 1, l, 6, bid, nblk); break;
  }
}

__global__ __launch_bounds__(512, 2) void mega(Params p, int ph_lo, int ph_hi) {
  extern __shared__ __attribute__((aligned(16))) char shm[];
  __shared__ uint4 xb_words;
  const int bid = blockIdx.x, nblk = gridDim.x;
  if (threadIdx.x == 0) xb_words = make_uint4(0u, 0u, 0u, 0u);
  __syncthreads();
  const XcdBarrier xb = xcd_barrier_post((unsigned*)(p.ws + OFF_BAR), (volatile LAS unsigned*)&xb_words);
  for (int ph = ph_lo; ph < ph_hi; ++ph) {
    if (ph > ph_lo) {
      if (ph == ph_lo + 1) cg::this_grid().sync();
      else xcd_barrier(xb);
    }
    run_phase(p, ph, shm, bid, nblk);
  }
}

extern "C" void kernel_launch(void* const* d_in, const int* in_sizes, int n_in, void* d_out, int out_size, void* d_ws,
                              size_t ws_size, hipStream_t stream) {
  static int grid_blocks = 0;
  if (!grid_blocks) {
    hipFuncSetAttribute((const void*)mega, hipFuncAttributeMaxDynamicSharedMemorySize, GEMM_LDS);
    int dev = 0, cus = 0, per_cu = 0;
    hipGetDevice(&dev);
    hipDeviceGetAttribute(&cus, hipDeviceAttributeMultiprocessorCount, dev);
    hipOccupancyMaxActiveBlocksPerMultiprocessor(&per_cu, mega, 512, GEMM_LDS);
    if (per_cu < 1) per_cu = 1;
    if (per_cu > 1) per_cu = 1;
    grid_blocks = cus * per_cu;
  }
  Params p{};
  for (int i = 0; i < N_IN; ++i) p.in[i] = (const float*)d_in[i];
  p.out = (float*)d_out;
  p.ws = (char*)d_ws;
  hipMemsetAsync((char*)d_ws + OFF_BAR, 0, 16384, stream);
#if ONE_LAUNCH
  int lo = 0, hi = N_PHASE;
  void* args[] = {&p, &lo, &hi};
  hipError_t e = hipLaunchCooperativeKernel((const void*)mega, dim3(grid_blocks), dim3(512), args, GEMM_LDS, stream);
  if (e != hipSuccess) fprintf(stderr, "cooperative launch failed: %s (grid %d)\n", hipGetErrorString(e), grid_blocks);
#else
  for (int ph = 0; ph < N_PHASE; ++ph) mega<<<grid_blocks, 512, GEMM_LDS, stream>>>(p, ph, ph + 1);
#endif
}
```

```cpp
#include <hip/hip_runtime.h>
#include <hip/hip_cooperative_groups.h>
#include <cstdio>
namespace cg = cooperative_groups;

#define DI __device__ __forceinline__
typedef unsigned short bf16_t;
typedef __attribute__((ext_vector_type(8))) short bf16x8;
typedef __attribute__((ext_vector_type(4))) short s16x4;
typedef __attribute__((ext_vector_type(4))) float f32x4;
typedef __attribute__((ext_vector_type(16))) float f32x16;
typedef __attribute__((ext_vector_type(2))) float f32x2;
typedef __attribute__((ext_vector_type(2))) __bf16 bf16x2v;
typedef __attribute__((ext_vector_type(4))) unsigned u32x4;
typedef __attribute__((ext_vector_type(2))) unsigned u32x2;

#ifndef ONE_LAUNCH
#define ONE_LAUNCH 1
#endif

constexpr int D = 1024, NTOK = 12288, NPROMPT = 8192, DFF = 2816, DIN = 1536;
constexpr float ALPHA = 1.4142135623730951f;
constexpr float LN_EPS = 1e-5f, RMS_EPS = 1e-6f;
enum { I_XP = 0, I_XS, I_CK, I_CV, I_SRE, I_SIM, I_C, I_CCTX, I_WMOD, I_BMOD, I_LNG, I_LNB, I_W1, I_W2, I_WIN, I_WOUT,
       I_POOLW, I_POOLS, I_LRE, I_LIM, I_LSTEP, I_BRE, I_BIM, I_CRE, I_CIM, I_SSMD, I_WGLU, I_BGLU, I_QN, I_KN,
       I_CLG, I_CLB, I_CWS, I_CBS, N_IN };
constexpr size_t OUT_K = 12582912, OUT_V = 14680064, OUT_SRE = 16777216, OUT_SIM = 16908288;

constexpr size_t OFF_W1T = 0;
constexpr size_t OFF_W2T = OFF_W1T + 46137344;
constexpr size_t OFF_WINT = OFF_W2T + 23068672;
constexpr size_t OFF_WOUTT = OFF_WINT + 6291456;
constexpr size_t OFF_WGLUT = OFF_WOUTT + 4194304;
constexpr size_t OFF_WPOOLT = OFF_WGLUT + 262144;
constexpr size_t OFF_MOD = OFF_WPOOLT + 262144;
constexpr size_t OFF_XY = OFF_MOD + 221184;
constexpr size_t OFF_H = OFF_XY + 50331648;
constexpr size_t OFF_YMIX = OFF_H + 25165824;
constexpr size_t OFF_R = OFF_YMIX + 25165824;
constexpr size_t OFF_QB = OFF_R + 75497472;
constexpr size_t OFF_KP = OFF_QB + 6291456;
constexpr size_t OFF_KS = OFF_KP + 2097152;
constexpr size_t OFF_VPT = OFF_KS + 2621440;
constexpr size_t OFF_VST = OFF_VPT + 2097152;
constexpr size_t OFF_VCT = OFF_VST + 2621440;
constexpr size_t OFF_DIFF = OFF_VCT + 6291456;
constexpr size_t OFF_SG = OFF_DIFF + 6291456;
constexpr size_t OFF_E = OFF_SG + 6291456;
constexpr size_t OFF_LAMB = OFF_E + 3145728;
constexpr size_t OFF_LAMT = OFF_LAMB + 32768;
constexpr size_t OFF_BBAR = OFF_LAMT + 32768;
constexpr size_t OFF_BAR = OFF_BBAR + 524288;
constexpr size_t OFF_BF = OFF_BAR + 16384;
constexpr size_t OFF_CF = OFF_BF + 524288;
constexpr size_t WS_TOTAL = OFF_CF + 262144;

struct Params { const float* in[N_IN]; float* out; char* ws; };

DI int otid() {
  int z = 0; asm volatile("" : "+s"(z));
  int lane = __builtin_amdgcn_mbcnt_hi(-1, __builtin_amdgcn_mbcnt_lo(-1, z));
  int w = __builtin_amdgcn_readfirstlane(threadIdx.x >> 6);
  return w * 64 + lane;
}
DI int osgpr(int i) { asm volatile("" : "+s"(i)); return i; }
#define INP(i) (p.in[osgpr(i)])
DI char* ows(char* w) { asm volatile("" : "+s"(w)); return w; }
#define PWS ows(p.ws)
DI unsigned pk2(float a, float b) { f32x2 v = {a, b}; bf16x2v r = __builtin_convertvector(v, bf16x2v); return __builtin_bit_cast(unsigned, r); }
DI bf16_t f2bf(float a) { return (bf16_t)(pk2(a, 0.f) & 0xffffu); }
DI float bf2f(bf16_t v) { return __uint_as_float(((unsigned)v) << 16); }
DI bf16x8 pack8(float a0, float a1, float a2, float a3, float a4, float a5, float a6, float a7) {
  u32x4 u = {pk2(a0, a1), pk2(a2, a3), pk2(a4, a5), pk2(a6, a7)};
  return __builtin_bit_cast(bf16x8, u);
}
DI float gelu_t(float x) {
  float z = 0.7978845608028654f * (x + 0.044715f * x * x * x);
  float e = __expf(2.f * z);
  float th = 1.f - 2.f / (e + 1.f);
  return 0.5f * x * (1.f + th);
}
DI float sigmoid_f(float x) { return 1.f / (1.f + __expf(-x)); }
DI float shfl_x(float v, int mask, int lane) {
  return __int_as_float(__builtin_amdgcn_ds_bpermute((lane ^ mask) << 2, __float_as_int(v)));
}
template <int CTRL> DI float dpp_f(float v) {
  return __int_as_float(__builtin_amdgcn_update_dpp(0, __float_as_int(v), CTRL, 0xf, 0xf, true));
}
DI float wave_sum(float v, int lane) {
  (void)lane;
  v += dpp_f<0xB1>(v);
  v += dpp_f<0x4E>(v);
  v += dpp_f<0x141>(v);
  v += dpp_f<0x140>(v);
  const int iv = __float_as_int(v);
  float r0 = __int_as_float(__builtin_amdgcn_readlane(iv, 0)), r1 = __int_as_float(__builtin_amdgcn_readlane(iv, 16));
  float r2 = __int_as_float(__builtin_amdgcn_readlane(iv, 32)), r3 = __int_as_float(__builtin_amdgcn_readlane(iv, 48));
  return (r0 + r1) + (r2 + r3);
}
DI size_t kfrag_off(int key, int d) {
  return ((size_t)((key >> 5) * 4 + (d >> 4)) * 64 + ((d >> 3) & 1) * 32 + (key & 31)) * 8 + (d & 7);
}
DI size_t vfrag_off(int key, int d) {
  const int kk = key & 31, w = kk & 15;
  return ((size_t)(((key >> 5) * 2 + (kk >> 4)) * 2 + (d >> 5)) * 64 + ((w >> 2) & 1) * 32 + (d & 31)) * 8 + (((w >> 3) << 2) | (w & 3));
}

#define MFMA16(a, b, c) __builtin_amdgcn_mfma_f32_16x16x32_bf16((a), (b), (c), 0, 0, 0)
#define MFMA32(a, b, c) __builtin_amdgcn_mfma_f32_32x32x16_bf16((a), (b), (c), 0, 0, 0)


#define XB_TMO      128
#define XB_XCNT(j)  (256  + 64 * (j))
#define XB_XSUB(j)  (1280 + 64 * (j))
#define XB_XGEN(j)  (2304 + 64 * (j))
#define XB_TOP      3328
#define XB_TOPGEN   3392
#define XCD_BAR_WORDS 3456
#define XB_SPIN_CAP (1u << 18)
#define LAS __attribute__((address_space(3)))
DI unsigned xb_ld(unsigned* p) { return __hip_atomic_load(p, __ATOMIC_RELAXED, __HIP_MEMORY_SCOPE_AGENT); }
DI unsigned xb_add(unsigned* p, unsigned v) { return __hip_atomic_fetch_add(p, v, __ATOMIC_RELAXED, __HIP_MEMORY_SCOPE_AGENT); }
DI unsigned xb_xcc_id() { return (unsigned)__builtin_amdgcn_s_getreg((3 << 11) | 20) & 0xFu; }
#define XB_SPIN(cond, bar) do { unsigned _sp = 0; while (cond) { __builtin_amdgcn_s_sleep(1); \
    if ((++_sp & 255u) == 0u) { if (xb_ld(&(bar)[XB_TMO])) break; if (_sp > XB_SPIN_CAP) { atomicAdd(&(bar)[XB_TMO], 1u); break; } } } } while (0)
struct XcdBarrier { unsigned* bar; unsigned x; volatile LAS unsigned* st; };
DI XcdBarrier xcd_barrier_post(unsigned* bar, volatile LAS unsigned* st) {
  XcdBarrier b; b.bar = bar; b.x = xb_xcc_id(); b.st = st;
  if (threadIdx.x == 0) (void)xb_add(&bar[XB_XCNT(b.x)], 1u);
  return b;
}
DI void xcd_barrier_complete(unsigned* bar, unsigned x, unsigned& nloc, unsigned& nx) {
  const unsigned G = gridDim.x * gridDim.y * gridDim.z;
  unsigned sum, cnt, mine, sp = 0u;
  for (;;) {
    sum = 0u; cnt = 0u; mine = 0u;
#pragma unroll
    for (unsigned j = 0; j < 16; ++j) { const unsigned c = xb_ld(&bar[XB_XCNT(j)]); sum += c; cnt += (c > 0u) ? 1u : 0u; mine = (j == x) ? c : mine; }
    if (sum == G) break;
    __builtin_amdgcn_s_sleep(1);
    if ((++sp & 255u) == 0u) { if (xb_ld(&bar[XB_TMO])) break; if (sp > XB_SPIN_CAP) { atomicAdd(&bar[XB_TMO], 1u); break; } }
  }
  nloc = mine > 0u ? mine : 1u; nx = cnt > 0u ? cnt : 1u;
}
DI void xcd_barrier(const XcdBarrier& b) {
  asm volatile("s_waitcnt vmcnt(0)" ::: "memory");
  __syncthreads();
  if (threadIdx.x == 0) {
    unsigned* bar = b.bar;
    __builtin_amdgcn_s_waitcnt(0);
    unsigned nloc = b.st[0], nx = b.st[1];
    if (nloc == 0u) { xcd_barrier_complete(bar, b.x, nloc, nx); b.st[0] = nloc; b.st[1] = nx; }
    const unsigned old = xb_add(&bar[XB_XSUB(b.x)], 1u);
    const unsigned gen = old / nloc;
    if (old + 1u == (gen + 1u) * nloc) {
      __builtin_amdgcn_fence(__ATOMIC_RELEASE, "agent");
      asm volatile("s_waitcnt vmcnt(0)" ::: "memory");
      const unsigned og = xb_add(&bar[XB_TOP], 1u);
      const unsigned tg = og / nx;
      if (og + 1u == (tg + 1u) * nx) xb_add(&bar[XB_TOPGEN], 1u);
      else XB_SPIN(xb_ld(&bar[XB_TOPGEN]) == tg, bar);
      __builtin_amdgcn_fence(__ATOMIC_ACQUIRE, "agent");
      xb_add(&bar[XB_XGEN(b.x)], 1u);
      asm volatile("s_waitcnt vmcnt(0)" ::: "memory");
    } else {
      XB_SPIN(xb_ld(&bar[XB_XGEN(b.x)]) == gen, bar);
      __builtin_amdgcn_fence(__ATOMIC_ACQUIRE, "agent");
      asm volatile("s_waitcnt vmcnt(0)" ::: "memory");
    }
  }
  __syncthreads();
}

constexpr int BM = 256, BK = 64, HALF = 128, NXCD = 8, WGM = 8, HT = HALF * BK;
constexpr int GEMM_LDS = 8 * HT * 2;

DI int lds_byte(int r, int c) {
  int st = (r >> 4) * 2 + (c >> 5), rr = r & 15, cc = c & 31, ob = rr * 64 + cc * 2;
  return st * 1024 + (ob ^ (((ob >> 9) & 1) << 5));
}
DI void stage_rc(int b, int& R, int& C) {
  int st = b / 1024, sb = b % 1024, swz = sb ^ (((sb >> 9) & 1) << 5);
  R = (st >> 1) * 16 + swz / 64; C = (st & 1) * 32 + (swz % 64) / 2;
}

enum { EPI_SWIGLU = 0, EPI_RESID, EPI_F32, EPI_GLU, EPI_POOL };
struct EpiArgs {
  float* f0;
  bf16_t* b0;
  const float* c0;
  const bf16_t* cb;
  float w;
};

template <int K, int MODE, int SPLITS = 1>
DI void gemm_phase(const bf16_t* __restrict__ A, const bf16_t* __restrict__ Bt, int nM, int nN, EpiArgs ea,
                   char* shmc, int bid, int nblk) {
  bf16_t* shm = (bf16_t*)shmc;
#define SA(b, h) (shm + ((b) * 2 + (h)) * HT)
#define SB(b, h) (shm + (4 + (b) * 2 + (h)) * HT)
#define STAGE(P, RS, SOFF, kt) do { const int _so = (SOFF) + (kt0 + (kt)) * (BK * 2); \
    __builtin_amdgcn_raw_ptr_buffer_load_lds(RS, (__attribute__((address_space(3))) void*)((char*)(P) + wid * 1024), 16, so0, _so, 0, 0); \
    __builtin_amdgcn_raw_ptr_buffer_load_lds(RS, (__attribute__((address_space(3))) void*)((char*)(P) + wid * 1024 + 8192), 16, so1, _so, 0, 0); } while (0)
#define LDA(dst, b, h) for (int m = 0; m < 4; ++m) for (int k = 0; k < 2; ++k) \
    dst[m][k] = *reinterpret_cast<const bf16x8*>((char*)SA(b, h) + lds_byte(wr * 64 + m * 16 + fr, k * 32 + fq * 8))
#define LDB(dst, b, h) for (int n = 0; n < 2; ++n) for (int k = 0; k < 2; ++k) \
    dst[n][k] = *reinterpret_cast<const bf16x8*>((char*)SB(b, h) + lds_byte(wc * 32 + n * 16 + fr, k * 32 + fq * 8))
#define MMA(ai, bj, At, Bt_) do { __builtin_amdgcn_s_setprio(1); \
    for (int m = 0; m < 4; ++m) for (int n = 0; n < 2; ++n) for (int k = 0; k < 2; ++k) \
      acc[ai][bj][m][n] = MFMA16(At[m][k], Bt_[n][k], acc[ai][bj][m][n]); \
    __builtin_amdgcn_s_setprio(0); } while (0)
#define WAIT_V(n) asm volatile("s_waitcnt vmcnt(" #n ")" ::: "memory")
#define WAIT_L(n) asm volatile("s_waitcnt lgkmcnt(" #n ")" ::: "memory")
#define BAR __builtin_amdgcn_s_barrier()
#define SCHED __builtin_amdgcn_sched_barrier(0)
  const int tid = otid();
  const int wid = __builtin_amdgcn_readfirstlane(tid >> 6), lane = tid & 63, wr = wid >> 2, wc = wid & 3, fr = lane & 15, fq = lane >> 4;
  const __amdgpu_buffer_rsrc_t rsA = __builtin_amdgcn_make_buffer_rsrc((void*)A, 0, 0x7fffffff, 0x00020000);
  const __amdgpu_buffer_rsrc_t rsB = __builtin_amdgcn_make_buffer_rsrc((void*)Bt, 0, 0x7fffffff, 0x00020000);
  unsigned so0, so1;
  { int R, C; stage_rc(tid * 16, R, C); so0 = (unsigned)(R * K + C) * 2u; stage_rc(tid * 16 + 8192, R, C); so1 = (unsigned)(R * K + C) * 2u; }
  const int nwg = nM * nN;
  for (int unit = bid; unit < nwg * SPLITS; unit += nblk) {
    const int sp = SPLITS == 1 ? 0 : unit / nwg, tile = SPLITS == 1 ? unit : unit % nwg;
    const int kt0 = SPLITS == 1 ? 0 : (sp == 0 ? 0 : sp == 1 ? 12 : sp == 2 ? 24 : 34);
    const int nt = SPLITS == 1 ? K / BK : (sp < 2 ? 12 : 10);
    int wgid = tile;
    { int q = nwg / NXCD, r = nwg % NXCD, xcd = wgid % NXCD, off = wgid / NXCD;
      wgid = (xcd < r ? xcd * (q + 1) : r * (q + 1) + (xcd - r) * q) + off; }
    int nig = WGM * nN, gid = wgid / nig, fm = gid * WGM, gsz = min(nM - fm, WGM);
    int pm = fm + ((wgid % nig) % gsz), pn = (wgid % nig) / gsz, brow = pm * BM, bcol = pn * BM;
    const int A0 = brow * K * 2, A1 = A0 + HALF * K * 2, B0p = bcol * K * 2, B1p = B0p + HALF * K * 2;
    f32x4 acc[2][2][4][2] = {};
    bf16x8 At[4][2], B0[2][2], B1[2][2];
    STAGE(SB(0, 0), rsB, B0p, 0); STAGE(SA(0, 0), rsA, A0, 0);
    STAGE(SB(0, 1), rsB, B1p, 0); STAGE(SA(0, 1), rsA, A1, 0);
    if (wr == 1) BAR;
    WAIT_V(4); BAR;
    STAGE(SB(1, 0), rsB, B0p, 1); STAGE(SA(1, 0), rsA, A0, 1); STAGE(SB(1, 1), rsB, B1p, 1);
    WAIT_V(6); BAR;
    for (int t = 0; t < nt - 2; t += 2) {
      LDB(B0, 0, 0); SCHED; LDA(At, 0, 0); STAGE(SA(1, 1), rsA, A1, t + 1);
      WAIT_L(8); BAR; WAIT_L(0); MMA(0, 0, At, B0); BAR; SCHED;
      LDB(B1, 0, 1); STAGE(SB(0, 0), rsB, B0p, t + 2);
      BAR; WAIT_L(0); MMA(0, 1, At, B1); BAR;
      LDA(At, 0, 1); STAGE(SA(0, 0), rsA, A0, t + 2);
      BAR; WAIT_L(0); MMA(1, 0, At, B0); BAR; SCHED;
      STAGE(SB(0, 1), rsB, B1p, t + 2);
      WAIT_V(6); BAR; MMA(1, 1, At, B1); BAR;
      LDB(B0, 1, 0); SCHED; LDA(At, 1, 0); STAGE(SA(0, 1), rsA, A1, t + 2);
      WAIT_L(8); BAR; WAIT_L(0); MMA(0, 0, At, B0); BAR; SCHED;
      LDB(B1, 1, 1); STAGE(SB(1, 0), rsB, B0p, t + 3);
      BAR; WAIT_L(0); MMA(0, 1, At, B1); BAR;
      LDA(At, 1, 1); STAGE(SA(1, 0), rsA, A0, t + 3);
      BAR; WAIT_L(0); MMA(1, 0, At, B0); BAR; SCHED;
      STAGE(SB(1, 1), rsB, B1p, t + 3);
      WAIT_V(6); BAR; MMA(1, 1, At, B1); BAR;
    }
    { LDB(B0, 0, 0); LDA(At, 0, 0); STAGE(SA(1, 1), rsA, A1, nt - 1);
      BAR; WAIT_L(0); MMA(0, 0, At, B0); BAR;
      LDB(B1, 0, 1); BAR; WAIT_L(0); MMA(0, 1, At, B1); BAR;
      LDA(At, 0, 1); WAIT_V(4); BAR; WAIT_L(0); MMA(1, 0, At, B0); MMA(1, 1, At, B1); BAR; }
    { LDB(B0, 1, 0); LDA(At, 1, 0); WAIT_V(2); BAR; WAIT_L(0); MMA(0, 0, At, B0); BAR;
      LDB(B1, 1, 1); WAIT_V(0); BAR; WAIT_L(0); MMA(0, 1, At, B1); BAR;
      LDA(At, 1, 1); BAR; WAIT_L(0); MMA(1, 0, At, B0); MMA(1, 1, At, B1); BAR; }
    if (wr == 0) BAR;
    const int ci = brow < NPROMPT ? 0 : 1 + (brow - NPROMPT) / 2048;
    const int te = otid(), le = te & 63, wide = te >> 6;
    const int wr = wide >> 2, wc = wide & 3, fr = le & 15, fq = le >> 4;
    const int rbase = brow + wr * 64 + fq * 4, cbase = bcol + wc * 32 + fr;
    if (MODE == EPI_SWIGLU) {
#pragma unroll
      for (int ai = 0; ai < 2; ++ai)
#pragma unroll
        for (int m = 0; m < 4; ++m)
#pragma unroll
          for (int j = 0; j < 4; ++j) {
            const int row = rbase + ai * HALF + m * 16 + j;
#pragma unroll
            for (int n = 0; n < 2; ++n) {
              float g = acc[ai][0][m][n][j], u = acc[ai][1][m][n][j];
              ea.b0[(size_t)row * DFF + pn * 128 + wc * 32 + n * 16 + fr] = f2bf(g * sigmoid_f(g) * u);
            }
          }
    } else if (MODE == EPI_RESID) {
      float gate[2][2];
#pragma unroll
      for (int bj = 0; bj < 2; ++bj)
#pragma unroll
        for (int n = 0; n < 2; ++n) gate[bj][n] = ea.w * ea.c0[ci * 9216 + cbase + bj * HALF + n * 16];
#pragma unroll
      for (int ai = 0; ai < 2; ++ai) {
        float* xb = ea.f0 + (size_t)(rbase + ai * HALF) * D + cbase;
        float xv[4][4][2][2];
#pragma unroll
        for (int m = 0; m < 4; ++m)
#pragma unroll
          for (int j = 0; j < 4; ++j)
#pragma unroll
            for (int bj = 0; bj < 2; ++bj)
#pragma unroll
              for (int n = 0; n < 2; ++n) xv[m][j][bj][n] = xb[(size_t)(m * 16 + j) * D + bj * HALF + n * 16];
#pragma unroll
        for (int m = 0; m < 4; ++m)
#pragma unroll
          for (int j = 0; j < 4; ++j)
#pragma unroll
            for (int bj = 0; bj < 2; ++bj)
#pragma unroll
              for (int n = 0; n < 2; ++n)
                xb[(size_t)(m * 16 + j) * D + bj * HALF + n * 16] = xv[m][j][bj][n] + gate[bj][n] * acc[ai][bj][m][n][j];
      }
    } else if (MODE == EPI_GLU) {
      float bg[2][2];
#pragma unroll
      for (int bj = 0; bj < 2; ++bj)
#pragma unroll
        for (int n = 0; n < 2; ++n) bg[bj][n] = ea.c0[cbase + bj * HALF + n * 16];
#pragma unroll
      for (int ai = 0; ai < 2; ++ai) {
        float gv[4][4][2][2];
        const bf16_t* gb = ea.cb + (size_t)(rbase + ai * HALF) * 256 + cbase;
#pragma unroll
        for (int m = 0; m < 4; ++m)
#pragma unroll
          for (int j = 0; j < 4; ++j)
#pragma unroll
            for (int bj = 0; bj < 2; ++bj)
#pragma unroll
              for (int n = 0; n < 2; ++n) gv[m][j][bj][n] = bf2f(gb[(size_t)(m * 16 + j) * 256 + bj * HALF + n * 16]);
        bf16_t* yb = ea.b0 + (size_t)(rbase + ai * HALF) * D + 256 + cbase;
#pragma unroll
        for (int m = 0; m < 4; ++m)
#pragma unroll
          for (int j = 0; j < 4; ++j)
#pragma unroll
            for (int bj = 0; bj < 2; ++bj)
#pragma unroll
              for (int n = 0; n < 2; ++n)
                yb[(size_t)(m * 16 + j) * D + bj * HALF + n * 16] =
                    f2bf(gv[m][j][bj][n] * sigmoid_f(acc[ai][bj][m][n][j] + bg[bj][n]));
      }
    } else {
      float ps[2][2];
#pragma unroll
      for (int bj = 0; bj < 2; ++bj)
#pragma unroll
        for (int n = 0; n < 2; ++n) ps[bj][n] = MODE == EPI_POOL ? ea.c0[cbase + bj * HALF + n * 16] : 1.f;
#pragma unroll
      for (int ai = 0; ai < 2; ++ai)
#pragma unroll
        for (int m = 0; m < 4; ++m)
#pragma unroll
          for (int j = 0; j < 4; ++j) {
            const int row = rbase + ai * HALF + m * 16 + j;
#pragma unroll
            for (int bj = 0; bj < 2; ++bj)
#pragma unroll
              for (int n = 0; n < 2; ++n) {
                const int col = cbase + bj * HALF + n * 16;
                float a = acc[ai][bj][m][n][j];
                if (MODE == EPI_F32) ea.f0[(size_t)row * DIN + col] = a;
                else ea.b0[(size_t)row * D + col] = f2bf(a * ps[bj][n]);
              }
          }
    }
  }
#undef SA
#undef SB
}

DI void prep_phase(const Params& p, char* shmc, int bid, int nblk) {
  const int tid = otid(), wid = tid >> 6, lane = tid & 63;
  char* ws = PWS;
  {
    float* tile = (float*)shmc;
    constexpr int T_W1 = 16 * 88, T_W2 = 44 * 16, T_IN = 16 * 24, T_OUT = 256, T_GLU = 16;
    constexpr int PER_L = 2 * T_W1 + 2 * T_W2 + T_IN + T_OUT + T_GLU;
    for (int it = bid; it < 2 * PER_L; it += nblk) {
      int l = it / PER_L, r = it % PER_L;
      const float* src; bf16_t* dst; int K, N, mode = 0;
      if (r < 2 * T_W1) {
        int s = r / T_W1; r %= T_W1;
        src = INP(I_W1) + (size_t)(l * 2 + s) * 1024 * 5632; dst = (bf16_t*)(ws + OFF_W1T) + (size_t)(l * 2 + s) * 5632 * 1024;
        K = 1024; N = 5632; mode = 1;
      } else if (r < 2 * T_W1 + 2 * T_W2) {
        r -= 2 * T_W1; int s = r / T_W2; r %= T_W2;
        src = INP(I_W2) + (size_t)(l * 2 + s) * 2816 * 1024; dst = (bf16_t*)(ws + OFF_W2T) + (size_t)(l * 2 + s) * 1024 * 2816;
        K = 2816; N = 1024;
      } else if (r < 2 * T_W1 + 2 * T_W2 + T_IN) {
        r -= 2 * T_W1 + 2 * T_W2;
        src = INP(I_WIN) + (size_t)l * 1024 * 1536; dst = (bf16_t*)(ws + OFF_WINT) + (size_t)l * 1536 * 1024;
        K = 1024; N = 1536;
      } else if (r < 2 * T_W1 + 2 * T_W2 + T_IN + T_OUT) {
        r -= 2 * T_W1 + 2 * T_W2 + T_IN;
        src = INP(I_WOUT) + (size_t)l * 1024 * 1024; dst = (bf16_t*)(ws + OFF_WOUTT) + (size_t)l * 1024 * 1024;
        K = 1024; N = 1024;
      } else {
        r -= 2 * T_W1 + 2 * T_W2 + T_IN + T_OUT;
        src = INP(I_WGLU) + (size_t)l * 256 * 256; dst = (bf16_t*)(ws + OFF_WGLUT) + (size_t)l * 256 * 256;
        K = 256; N = 256;
      }
      int nkt = K / 64, kt = r % nkt, ntile = r / nkt;
#pragma unroll
      for (int i = 0; i < 2; ++i) {
        int k = (tid >> 4) + 32 * i, n = (tid & 15) * 4;
        float4 v = *(const float4*)(src + (size_t)(kt * 64 + k) * N + ntile * 64 + n);
        tile[k * 65 + n] = v.x; tile[k * 65 + n + 1] = v.y; tile[k * 65 + n + 2] = v.z; tile[k * 65 + n + 3] = v.w;
      }
      __syncthreads();
      {
        int n = tid >> 3, kk = (tid & 7) * 8;
        int nsrc = ntile * 64 + n, nrow = nsrc;
        if (mode == 1) {
          if (nsrc < 2816) nrow = (nsrc >> 7) * 256 + (nsrc & 127);
          else { int mm = nsrc - 2816; nrow = (mm >> 7) * 256 + 128 + (mm & 127); }
        }
        bf16x8 o = pack8(tile[(kk + 0) * 65 + n], tile[(kk + 1) * 65 + n], tile[(kk + 2) * 65 + n], tile[(kk + 3) * 65 + n],
                         tile[(kk + 4) * 65 + n], tile[(kk + 5) * 65 + n], tile[(kk + 6) * 65 + n], tile[(kk + 7) * 65 + n]);
        *(bf16x8*)(dst + (size_t)nrow * K + kt * 64 + kk) = o;
      }
      __syncthreads();
    }
  }
  const int gtid = bid * 512 + tid, gn = nblk * 512;
  for (int i = gtid; i < 2 * 65536; i += gn) {
    int l = i >> 16, n = (i >> 8) & 255, k = i & 255;
    int gi = n >> 6, d = n & 63, gj = k >> 6, c = k & 63;
    float v = (gi == gj) ? INP(I_POOLW)[((size_t)(l * 4 + gi) * 64 + c) * 64 + d] : 0.f;
    ((bf16_t*)(ws + OFF_WPOOLT))[i] = f2bf(v);
  }
  {
    float* sc = (float*)shmc + 64 * 65;
    float* red = sc + 3 * 1024;
    for (int i = tid; i < 3 * 1024; i += 512) {
      int ci = i >> 10, k = i & 1023;
      float v = ci == 0 ? INP(I_CCTX)[k] : INP(I_C)[(ci - 1) * 1024 + k];
      sc[i] = v * sigmoid_f(v);
    }
    __syncthreads();
    for (int it = bid; it < 288; it += nblk) {
      int l = it / 144, cb = it % 144, col = cb * 64 + lane;
      const float* wp = INP(I_WMOD) + (size_t)l * 1024 * 9216 + col;
      float a0 = 0.f, a1 = 0.f, a2 = 0.f;
#pragma unroll 8
      for (int k = wid * 128; k < wid * 128 + 128; ++k) {
        float w = wp[(size_t)k * 9216];
        a0 += sc[k] * w; a1 += sc[1024 + k] * w; a2 += sc[2048 + k] * w;
      }
      red[(wid * 3 + 0) * 64 + lane] = a0; red[(wid * 3 + 1) * 64 + lane] = a1; red[(wid * 3 + 2) * 64 + lane] = a2;
      __syncthreads();
      if (tid < 192) {
        int ci = tid >> 6;
        float s = 0.f;
        for (int w = 0; w < 8; ++w) s += red[(w * 3 + ci) * 64 + lane];
        ((float*)(ws + OFF_MOD))[(size_t)(l * 3 + ci) * 9216 + col] = s + INP(I_BMOD)[l * 9216 + col];
      }
      __syncthreads();
    }
  }
  for (int i = gtid; i < 2 * 2 * 512 * 128; i += gn) {
    int c = i & 127, t = (i >> 7) & 511, b = (i >> 16) & 1, l = i >> 17;
    size_t si = ((size_t)(b * 2 + l) * 512 + t) * 128 + c;
    const size_t sb_ = (size_t)((l * 2 + b) * 2 + (c >> 6)) * 163840;
    ((bf16_t*)(ws + OFF_KS))[sb_ + kfrag_off(t, c & 63)] = f2bf(INP(I_CK)[si]);
    ((bf16_t*)(ws + OFF_VST))[sb_ + vfrag_off(t, c & 63)] = f2bf(INP(I_CV)[si]);
  }
  for (int i = gtid; i < 4096; i += gn) {
    float lre = INP(I_LRE)[i], lim = INP(I_LIM)[i];
    float dt = expf(INP(I_LSTEP)[i >> 6]);
    float e = expf(lre * dt), ang = lim * dt;
    float br = e * cosf(ang), bi = e * sinf(ang);
    float ar = br - 1.f, ai = bi, den = lre * lre + lim * lim;
    float cr = (ar * lre + ai * lim) / den, cim = (ai * lre - ar * lim) / den;
    ((float2*)(ws + OFF_LAMB))[i] = make_float2(br, bi);
    float pr = br, pi = bi;
    for (int s = 0; s < 6; ++s) { float nr = pr * pr - pi * pi, ni = 2.f * pr * pi; pr = nr; pi = ni; }
    ((float2*)(ws + OFF_LAMT))[i] = make_float2(pr, pi);
  }
  for (int i = gtid; i < 64 * 8 * 64; i += gn) {
    const int gidx = i >> 9, nt = (i >> 6) & 7, ln = i & 63, fr = ln & 15, fq = ln >> 4;
    bf16x8 o = (bf16x8){0, 0, 0, 0, 0, 0, 0, 0};
    if (fq < 2) {
      const int n = nt * 8 + (fr >> 1), idx = gidx * 64 + n;
      float lre = INP(I_LRE)[idx], lim = INP(I_LIM)[idx];
      float dt = expf(INP(I_LSTEP)[gidx]);
      float e = expf(lre * dt), ang = lim * dt;
      float br = e * cosf(ang), bi = e * sinf(ang);
      float ar = br - 1.f, ai = bi, den = lre * lre + lim * lim;
      float cr = (ar * lre + ai * lim) / den, cim = (ai * lre - ar * lim) / den;
      float v[8];
#pragma unroll
      for (int j = 0; j < 8; ++j) {
        float xr = INP(I_BRE)[(size_t)idx * 16 + fq * 8 + j], xi = INP(I_BIM)[(size_t)idx * 16 + fq * 8 + j];
        v[j] = (fr & 1) ? cr * xi + cim * xr : cr * xr - cim * xi;
      }
      o = pack8(v[0], v[1], v[2], v[3], v[4], v[5], v[6], v[7]);
    }
    ((bf16x8*)(ws + OFF_BF))[i] = o;
  }
  for (int i = gtid; i < 64 * 4 * 64; i += gn) {
    const int gidx = i >> 8, ks = (i >> 6) & 3, ln = i & 63, fr = ln & 15, fq = ln >> 4;
    const size_t co = ((size_t)gidx * 16 + fr) * 64 + ks * 16 + fq * 4;
    float4 cr = *(const float4*)(INP(I_CRE) + co), cim = *(const float4*)(INP(I_CIM) + co);
    ((bf16x8*)(ws + OFF_CF))[i] = pack8(cr.x, -cim.x, cr.y, -cim.y, cr.z, -cim.z, cr.w, -cim.w);
  }
}

DI void lnmod_phase(const Params& p, int l_ln, int ln_idx, int l_mod, int mod_idx, int bid, int nblk) {
  const int tid = otid(), wid = tid >> 6, lane = tid & 63;
  float* xy = (float*)(PWS + OFF_XY);
  bf16_t* h = (bf16_t*)(PWS + OFF_H);
  const float* modv = (const float*)(PWS + OFF_MOD);
  for (int row = bid * 8 + wid; row < NTOK; row += nblk * 8) {
    const float* src = l_ln < 0 ? (row < NPROMPT ? INP(I_XP) + (size_t)row * D : INP(I_XS) + (size_t)(row - NPROMPT) * D)
                                : xy + (size_t)row * D;
    float4 v[4];
#pragma unroll
    for (int i = 0; i < 4; ++i) v[i] = *(const float4*)(src + lane * 4 + i * 256);
    if (l_ln >= 0) {
      float s = 0.f;
#pragma unroll
      for (int i = 0; i < 4; ++i) s += v[i].x + v[i].y + v[i].z + v[i].w;
      float mean = wave_sum(s, lane) * (1.f / 1024.f);
      float q = 0.f;
#pragma unroll
      for (int i = 0; i < 4; ++i) {
        v[i].x -= mean; v[i].y -= mean; v[i].z -= mean; v[i].w -= mean;
        q += v[i].x * v[i].x + v[i].y * v[i].y + v[i].z * v[i].z + v[i].w * v[i].w;
      }
      float rstd = rsqrtf(wave_sum(q, lane) * (1.f / 1024.f) + LN_EPS);
      const float* g = INP(I_LNG) + (l_ln * 3 + ln_idx) * 1024;
      const float* b = INP(I_LNB) + (l_ln * 3 + ln_idx) * 1024;
#pragma unroll
      for (int i = 0; i < 4; ++i) {
        float4 gg = *(const float4*)(g + lane * 4 + i * 256), bb = *(const float4*)(b + lane * 4 + i * 256);
        v[i].x = v[i].x * rstd * gg.x + bb.x; v[i].y = v[i].y * rstd * gg.y + bb.y;
        v[i].z = v[i].z * rstd * gg.z + bb.z; v[i].w = v[i].w * rstd * gg.w + bb.w;
      }
    }
    float* dx = l_mod < 0 ? p.out + (size_t)row * D : xy + (size_t)row * D;
    const float xs = l_mod < 0 ? 1.f : ALPHA;
#pragma unroll
    for (int i = 0; i < 4; ++i) *(float4*)(dx + lane * 4 + i * 256) = make_float4(v[i].x * xs, v[i].y * xs, v[i].z * xs, v[i].w * xs);
    if (l_mod >= 0) {
      int ci = row < NPROMPT ? 0 : 1 + (row - NPROMPT) / 2048;
      const float* sh = modv + (size_t)(l_mod * 3 + ci) * 9216 + mod_idx * 1024;
      const float* sc = sh + 1024;
#pragma unroll
      for (int i = 0; i < 4; ++i) {
        float4 a = *(const float4*)(sh + lane * 4 + i * 256), c = *(const float4*)(sc + lane * 4 + i * 256);
        u32x2 o = {pk2(v[i].x * (1.f + c.x) + a.x, v[i].y * (1.f + c.y) + a.y),
                   pk2(v[i].z * (1.f + c.z) + a.z, v[i].w * (1.f + c.w) + a.w)};
        *(u32x2*)(h + (size_t)row * D + lane * 4 + i * 256) = o;
      }
    }
  }
}

DI void post_phase(const Params& p, int l, char* shmc, int bid, int nblk) {
  const int tid = otid(), wid = tid >> 6, lane = tid & 63;
  char* ws = PWS;
  const float* proj = (const float*)(ws + OFF_R);
  bf16_t* qb = (bf16_t*)(ws + OFF_QB);
  const float qn = INP(I_QN)[l * 64 + lane], kn = INP(I_KN)[l * 64 + lane];
  const int fi = lane & 15;
  const float inv = exp2f(-(float)fi * (13.287712379549449f / 16.f));
  for (int row = bid * 8 + wid; row < NTOK; row += nblk * 8) {
    const float* pr = proj + (size_t)row * DIN;
    const bool samp = row >= NPROMPT;
    int b, t, L;
    if (samp) { b = (row - NPROMPT) >> 11; t = (row - NPROMPT) & 2047; L = 2048; }
    else { b = row >> 8; t = row & 255; L = 256; }
    float cs = 1.f, sn = 0.f;
    if (samp) {
      float pos = (float)((lane & 31) < 16 ? (t >> 6) : (t & 63));
      float ang = pos * inv;
      cs = cosf(ang); sn = sinf(ang);
    }
#pragma unroll
    for (int hd = 0; hd < 4; ++hd) {
      float x = pr[512 + hd * 64 + lane];
      float ss = wave_sum(x * x, lane) * (1.f / 64.f);
      float xn = x * rsqrtf(ss + RMS_EPS) * qn;
      if (samp) {
        float o = shfl_x(xn, 32, lane);
        xn = lane < 32 ? xn * cs - o * sn : o * sn + xn * cs;
      }
      qb[(size_t)row * 256 + hd * 64 + lane] = f2bf(xn);
    }
#pragma unroll
    for (int hd = 0; hd < 2; ++hd) {
      float x = pr[768 + hd * 64 + lane];
      float ss = wave_sum(x * x, lane) * (1.f / 64.f);
      float xn = x * rsqrtf(ss + RMS_EPS) * kn;
      float vv = pr[896 + hd * 64 + lane];
      if (samp) {
        float o = shfl_x(xn, 32, lane);
        xn = lane < 32 ? xn * cs - o * sn : o * sn + xn * cs;
        const size_t sb_ = (size_t)((l * 2 + b) * 2 + hd) * 163840;
        ((bf16_t*)(ws + OFF_KS))[sb_ + kfrag_off(512 + t, lane)] = f2bf(xn);
        ((bf16_t*)(ws + OFF_VST))[sb_ + vfrag_off(512 + t, lane)] = f2bf(vv);
      } else {
        size_t oo = ((size_t)(b * 2 + l) * 256 + t) * 128 + hd * 64 + lane;
        p.out[OUT_K + oo] = xn;
        p.out[OUT_V + oo] = vv;
        const size_t sb_ = (size_t)(b * 2 + hd) * 16384;
        ((bf16_t*)(ws + OFF_KP))[sb_ + kfrag_off(t, lane)] = f2bf(xn);
        ((bf16_t*)(ws + OFF_VPT))[sb_ + vfrag_off(t, lane)] = f2bf(vv);
      }
    }
    {
      float z[4]; float s = 0.f;
#pragma unroll
      for (int i = 0; i < 4; ++i) { z[i] = gelu_t(pr[1280 + i * 64 + lane]); s += z[i]; }
      float mean = wave_sum(s, lane) * (1.f / 256.f);
      float q = 0.f;
#pragma unroll
      for (int i = 0; i < 4; ++i) { z[i] -= mean; q += z[i] * z[i]; }
      float rstd = rsqrtf(wave_sum(q, lane) * (1.f / 256.f) + LN_EPS);
      bf16_t* vct = (bf16_t*)(ws + OFF_VCT) + (size_t)(row >> 7) * 256 * 128 + (row & 127);
#pragma unroll
      for (int i = 0; i < 4; ++i) {
        int c = i * 64 + lane;
        float vn = z[i] * rstd * INP(I_CLG)[l * 256 + c] + INP(I_CLB)[l * 256 + c];
        vct[(size_t)c * 128] = f2bf(vn);
      }
    }
    {
      bf16_t* df = (bf16_t*)(ws + OFF_DIFF) + (size_t)row * 256;
#pragma unroll
      for (int gi = 0; gi < 4; ++gi) {
        const int hw = 1 << gi;
        int lo = max(t - hw, 0), hi = min(t + hw, L);
        float tv[16];
#pragma unroll
        for (int d = -hw; d < hw; ++d) {
          const int tt = t + d;
          const bool ok = tt >= 0 && tt < L;
          const float v = pr[(ptrdiff_t)(ok ? d : 0) * DIN + gi * 64 + lane];
          tv[d + hw] = ok ? v : 0.f;
        }
        float s = 0.f;
#pragma unroll
        for (int d = 0; d < 2 * hw; ++d) s += tv[d];
        float mean = s / (float)(hi - lo);
        df[gi * 64 + lane] = f2bf(mean - pr[gi * 64 + lane]);
      }
    }
  }
}

struct AttnState { f32x16 o0, o1; float m, l; };
#define ATT_LOADKV(KF, VF, K0) do { const int kt_ = (K0) >> 5; \
    _Pragma("unroll") for (int s_ = 0; s_ < 4; ++s_) KF[s_] = *(const bf16x8*)(Kb + ((size_t)(kt_ * 4 + s_) * 64 + lane) * 8); \
    _Pragma("unroll") for (int s_ = 0; s_ < 2; ++s_) { \
      VF[s_][0] = *(const bf16x8*)(Vt + ((size_t)((kt_ * 2 + s_) * 2 + 0) * 64 + lane) * 8); \
      VF[s_][1] = *(const bf16x8*)(Vt + ((size_t)((kt_ * 2 + s_) * 2 + 1) * 64 + lane) * 8); } } while (0)

DI void attn_core(const bf16_t* __restrict__ Q, int qrow0, int head, const bf16_t* __restrict__ Kb,
                  const bf16_t* __restrict__ Vt, int kbeg, int kend, int lane, AttnState& st) {
  const int r = lane & 31, hh = lane >> 5;
  bf16x8 qf[4];
  const bf16_t* qp = Q + (size_t)(qrow0 + r) * 256 + head * 64 + 8 * hh;
#pragma unroll
  for (int s = 0; s < 4; ++s) qf[s] = *(const bf16x8*)(qp + 16 * s);
  f32x16 o0, o1;
#pragma unroll
  for (int i = 0; i < 16; ++i) { o0[i] = 0.f; o1[i] = 0.f; }
  float m = -INFINITY, lsum = 0.f;
  const float c = 0.125f * 1.4426950408889634f;
  bf16x8 kf[4], vf[2][2];
  ATT_LOADKV(kf, vf, kbeg);
  for (int k0 = kbeg; k0 < kend; k0 += 32) {
    const int kn = min(k0 + 32, kend - 32);
    bf16x8 kfn[4], vfn[2][2];
    ATT_LOADKV(kfn, vfn, kn);
    f32x16 sa;
#pragma unroll
    for (int i = 0; i < 16; ++i) sa[i] = 0.f;
#pragma unroll
    for (int s = 0; s < 4; ++s) sa = MFMA32(kf[s], qf[s], sa);
    float mx = sa[0];
#pragma unroll
    for (int i = 1; i < 16; ++i) mx = fmaxf(mx, sa[i]);
    mx = fmaxf(mx, shfl_x(mx, 32, lane));
    float mn = fmaxf(m, mx);
    float alpha = __builtin_amdgcn_exp2f((m - mn) * c);
    m = mn;
    float pv[16]; float ps = 0.f;
#pragma unroll
    for (int i = 0; i < 16; ++i) { pv[i] = __builtin_amdgcn_exp2f((sa[i] - mn) * c); ps += pv[i]; }
    lsum = lsum * alpha + ps;
#pragma unroll
    for (int i = 0; i < 16; ++i) { o0[i] *= alpha; o1[i] *= alpha; }
#pragma unroll
    for (int s = 0; s < 2; ++s) {
      bf16x8 pf = pack8(pv[8 * s], pv[8 * s + 1], pv[8 * s + 2], pv[8 * s + 3], pv[8 * s + 4], pv[8 * s + 5], pv[8 * s + 6], pv[8 * s + 7]);
      o0 = MFMA32(vf[s][0], pf, o0);
      o1 = MFMA32(vf[s][1], pf, o1);
    }
#pragma unroll
    for (int s = 0; s < 4; ++s) kf[s] = kfn[s];
#pragma unroll
    for (int s = 0; s < 2; ++s) { vf[s][0] = vfn[s][0]; vf[s][1] = vfn[s][1]; }
  }
  lsum += shfl_x(lsum, 32, lane);
  st.o0 = o0; st.o1 = o1; st.m = m; st.l = lsum;
}

DI void attn_prompt_item(const bf16_t* Q, int qrow0, int head, const bf16_t* Kb, const bf16_t* Vt, bf16_t* Y, int lane) {
  AttnState st;
  attn_core(Q, qrow0, head, Kb, Vt, 0, 256, lane, st);
  const int r = lane & 31, hh = lane >> 5;
  const float il = 1.f / st.l;
  bf16_t* yp = Y + (size_t)(qrow0 + r) * D + 512 + head * 64 + 4 * hh;
#pragma unroll
  for (int g4 = 0; g4 < 4; ++g4) {
    u32x2 a = {pk2(st.o0[4 * g4] * il, st.o0[4 * g4 + 1] * il), pk2(st.o0[4 * g4 + 2] * il, st.o0[4 * g4 + 3] * il)};
    u32x2 b = {pk2(st.o1[4 * g4] * il, st.o1[4 * g4 + 1] * il), pk2(st.o1[4 * g4 + 2] * il, st.o1[4 * g4 + 3] * il)};
    *(u32x2*)(yp + 8 * g4) = a;
    *(u32x2*)(yp + 32 + 8 * g4) = b;
  }
}

DI void attn_sample_item(const Params& p, int l, int it, char* shmc, int wid, int lane) {
  char* ws = PWS;
  float* Osh = (float*)shmc;
  float* Msh = Osh + 8 * 32 * 64;
  float* Lsh = Msh + 8 * 64;
  const int b = it >> 7, head = (it >> 5) & 3, qpair = it & 31;
  const int qsub = wid & 1, ksplit = wid >> 1;
  const int qrow0 = NPROMPT + b * 2048 + (qpair * 2 + qsub) * 32;
  AttnState st;
  attn_core((const bf16_t*)(ws + OFF_QB), qrow0, head, (const bf16_t*)(ws + OFF_KS) + (size_t)((l * 2 + b) * 2 + (head >> 1)) * 163840,
            (const bf16_t*)(ws + OFF_VST) + (size_t)((l * 2 + b) * 2 + (head >> 1)) * 163840, ksplit * 640, ksplit * 640 + 640, lane, st);
  Msh[wid * 64 + lane] = st.m; Lsh[wid * 64 + lane] = st.l;
#pragma unroll
  for (int i = 0; i < 16; ++i) { Osh[(wid * 32 + i) * 64 + lane] = st.o0[i]; Osh[(wid * 32 + 16 + i) * 64 + lane] = st.o1[i]; }
  __syncthreads();
  {
    const float c = 0.125f * 1.4426950408889634f;
    float mm[4], M = -INFINITY;
#pragma unroll
    for (int k = 0; k < 4; ++k) { mm[k] = Msh[(2 * k + qsub) * 64 + lane]; M = fmaxf(M, mm[k]); }
    float sc[4], Lt = 0.f;
#pragma unroll
    for (int k = 0; k < 4; ++k) { sc[k] = __builtin_amdgcn_exp2f((mm[k] - M) * c); Lt += Lsh[(2 * k + qsub) * 64 + lane] * sc[k]; }
    const float il = 1.f / Lt;
    float ov[8];
#pragma unroll
    for (int e = 0; e < 8; ++e) {
      float a = 0.f;
#pragma unroll
      for (int k = 0; k < 4; ++k) a += Osh[((2 * k + qsub) * 32 + ksplit * 8 + e) * 64 + lane] * sc[k];
      ov[e] = a * il;
    }
    const int r = lane & 31, hh = lane >> 5;
    const int dblk = ksplit >> 1, g4 = (ksplit & 1) * 2;
    bf16_t* yp = (bf16_t*)(ws + OFF_YMIX) + (size_t)(qrow0 + r) * D + 512 + head * 64 + dblk * 32 + 8 * g4 + 4 * hh;
    u32x2 a = {pk2(ov[0], ov[1]), pk2(ov[2], ov[3])};
    u32x2 bq = {pk2(ov[4], ov[5]), pk2(ov[6], ov[7])};
    *(u32x2*)yp = a;
    *(u32x2*)(yp + 8) = bq;
  }
  __syncthreads();
}

DI void chunk_item(const Params& p, int l, int ch, int hd, int sp, int lane) {
  const int fr = lane & 15, fq = lane >> 4;
  char* ws = PWS;
  const float* wsrc = INP(I_CWS) + ((size_t)(l * 4 + hd) * 128 + sp * 16 + fr) * 128 + fq * 8;
  const bf16_t* vb = (const bf16_t*)(ws + OFF_VCT) + ((size_t)ch * 256 + hd * 64 + fr) * 128 + fq * 8;
  f32x4 acc[4];
#pragma unroll
  for (int i = 0; i < 4; ++i) acc[i] = (f32x4){0.f, 0.f, 0.f, 0.f};
#pragma unroll
  for (int ks = 0; ks < 4; ++ks) {
    float4 a0 = *(const float4*)(wsrc + ks * 32), a1 = *(const float4*)(wsrc + ks * 32 + 4);
    bf16x8 af = pack8(a0.x, a0.y, a0.z, a0.w, a1.x, a1.y, a1.z, a1.w);
#pragma unroll
    for (int nt = 0; nt < 4; ++nt) {
      bf16x8 bfr = *(const bf16x8*)(vb + (size_t)nt * 16 * 128 + ks * 32);
      acc[nt] = MFMA16(af, bfr, acc[nt]);
    }
  }
  const float* proj = (const float*)(ws + OFF_R);
  bf16_t* ymix = (bf16_t*)(ws + OFF_YMIX);
  float uu[4][4];
#pragma unroll
  for (int j = 0; j < 4; ++j)
#pragma unroll
    for (int nt = 0; nt < 4; ++nt)
      uu[j][nt] = proj[(size_t)(ch * 128 + sp * 16 + fq * 4 + j) * DIN + 1024 + hd * 64 + nt * 16 + fr];
#pragma unroll
  for (int j = 0; j < 4; ++j) {
    int pp = sp * 16 + fq * 4 + j, tok = ch * 128 + pp;
    float bs = INP(I_CBS)[(l * 4 + hd) * 128 + pp];
#pragma unroll
    for (int nt = 0; nt < 4; ++nt) {
      int c = hd * 64 + nt * 16 + fr;
      ymix[(size_t)tok * D + 768 + c] = f2bf(gelu_t(uu[j][nt]) * (acc[nt][j] + bs));
    }
  }
}

constexpr int SSM_BU_LD = 132, SSM_H_LD = 136;
constexpr int SSM_WAVE_LDS = 16 * SSM_BU_LD * 4 + 16 * SSM_H_LD * 2;
#define LDS_FENCE() do { asm volatile("s_waitcnt lgkmcnt(0)" ::: "memory"); __builtin_amdgcn_wave_barrier(); } while (0)

DI void ssm_load_u(const Params& p, int ck, int g, int lane, bf16x8 (&af)[4]) {
  const int fr = lane & 15, fq = lane >> 4;
  const float* ub = (const float*)(PWS + OFF_R) + (size_t)ck * 64 * DIN + 256 + g * 16;
#pragma unroll
  for (int tile = 0; tile < 4; ++tile) {
    if (fq < 2) {
      const float* up = ub + (size_t)(tile * 16 + fr) * DIN + fq * 8;
      float4 a0 = *(const float4*)up, a1 = *(const float4*)(up + 4);
      af[tile] = pack8(a0.x, a0.y, a0.z, a0.w, a1.x, a1.y, a1.z, a1.w);
    } else {
      af[tile] = (bf16x8){0, 0, 0, 0, 0, 0, 0, 0};
    }
  }
}

template <int MODE, int DIR>
DI void ssm_dir(const Params& p, int l, int ck, int g, int lane, const bf16x8 (&af)[4], f32x4 (&yacc)[4], char* wlds) {
  constexpr bool CHAIN = MODE == 1;
  const int fr = lane & 15, fq = lane >> 4;
  char* ws = PWS;
  float* BU = (float*)wlds;
  bf16_t* Hs = (bf16_t*)(wlds + 16 * SSM_BU_LD * 4);
  const int gidx = (l * 2 + DIR) * 16 + g, idx = gidx * 64 + lane;
  bf16x8 bfr[8], cf[4];
#pragma unroll
  for (int nt = 0; nt < 8; ++nt) bfr[nt] = ((const bf16x8*)(ws + OFF_BF))[(gidx * 8 + nt) * 64 + lane];
#pragma unroll
  for (int ks = 0; ks < 4; ++ks) cf[ks] = ((const bf16x8*)(ws + OFF_CF))[(gidx * 4 + ks) * 64 + lane];
  const float2 lam = ((const float2*)(ws + OFF_LAMB))[idx];
  float hr = 0.f, hi = 0.f;
  const bool samp = ck >= 128;
  const int CPS = samp ? 32 : 4;
  const int cs = samp ? ((ck - 128) & 31) : (ck & 3);
  const int b = samp ? ((ck - 128) >> 5) : (ck >> 2);
  if (CHAIN) {
    const float2 lamT = ((const float2*)(ws + OFF_LAMT))[idx];
    const float2* Eb = (const float2*)(ws + OFF_E);
    const int cbase = ck - cs;
    if (samp) {
      size_t si = ((size_t)((b * 2 + l) * 2 + DIR) * 16 + g) * 64 + lane;
      hr = INP(I_SRE)[si]; hi = INP(I_SIM)[si];
    }
    const int nstep = DIR == 0 ? cs : CPS - 1 - cs;
    for (int base = 0; base < nstep; base += 8) {
      float2 ev[8];
#pragma unroll
      for (int k = 0; k < 8; ++k) {
        const int st = min(base + k, nstep - 1);
        const int c2 = DIR == 0 ? st : CPS - 1 - st;
        ev[k] = Eb[((size_t)((cbase + c2) * 16 + g) * 2 + DIR) * 64 + lane];
      }
#pragma unroll
      for (int k = 0; k < 8; ++k)
        if (base + k < nstep) {
          float nr = lamT.x * hr - lamT.y * hi + ev[k].x, ni = lamT.x * hi + lamT.y * hr + ev[k].y; hr = nr; hi = ni;
        }
    }
  }
#pragma unroll
  for (int sb = 0; sb < 4; ++sb) {
    const int tile = DIR ? 3 - sb : sb;
#pragma unroll
    for (int nt = 0; nt < 8; ++nt) {
      f32x4 cz = MFMA16(af[tile], bfr[nt], ((f32x4){0.f, 0.f, 0.f, 0.f}));
#pragma unroll
      for (int j = 0; j < 4; ++j) BU[(fq * 4 + j) * SSM_BU_LD + nt * 16 + fr] = cz[j];
    }
    LDS_FENCE();
#pragma unroll
    for (int q = 0; q < 16; ++q) {
      const int tt = DIR ? 15 - q : q;
      const float2 bu = *(const float2*)(BU + tt * SSM_BU_LD + 2 * lane);
      float nr = lam.x * hr - lam.y * hi + bu.x, ni = lam.x * hi + lam.y * hr + bu.y; hr = nr; hi = ni;
      *(unsigned*)(Hs + tt * SSM_H_LD + 2 * lane) = pk2(hr, hi);
    }
    LDS_FENCE();
#pragma unroll
    for (int ks = 0; ks < 4; ++ks) {
      bf16x8 ah = *(const bf16x8*)(Hs + fr * SSM_H_LD + ks * 32 + fq * 8);
      yacc[tile] = MFMA16(ah, cf[ks], yacc[tile]);
    }
    LDS_FENCE();
  }
  if (!CHAIN) {
    ((float2*)(ws + OFF_E))[((size_t)(ck * 16 + g) * 2 + DIR) * 64 + lane] = make_float2(hr, hi);
  } else if (!samp && ((DIR == 0 && cs == 3) || (DIR == 1 && cs == 0))) {
    size_t so = ((size_t)((b * 2 + l) * 2 + DIR) * 16 + g) * 64 + lane;
    p.out[OUT_SRE + so] = hr; p.out[OUT_SIM + so] = hi;
  }
}

#define SSM1_MODE 2
DI void ssm1_item(const Params& p, int l, int ck, int g, int dir, int lane, char* wlds) {
  bf16x8 af[4]; f32x4 yacc[4];
#pragma unroll
  for (int i = 0; i < 4; ++i) yacc[i] = (f32x4){0.f, 0.f, 0.f, 0.f};
  ssm_load_u(p, ck, g, lane, af);
  if (dir) ssm_dir<SSM1_MODE, 1>(p, l, ck, g, lane, af, yacc, wlds);
  else ssm_dir<SSM1_MODE, 0>(p, l, ck, g, lane, af, yacc, wlds);
}

DI void ssm2_item(const Params& p, int l, int ck, int g, int lane, char* wlds) {
  const int fr = lane & 15, fq = lane >> 4;
  bf16x8 af[4]; f32x4 yacc[4];
#pragma unroll
  for (int i = 0; i < 4; ++i) yacc[i] = (f32x4){0.f, 0.f, 0.f, 0.f};
  ssm_load_u(p, ck, g, lane, af);
  ssm_dir<1, 0>(p, l, ck, g, lane, af, yacc, wlds);
  ssm_dir<1, 1>(p, l, ck, g, lane, af, yacc, wlds);
  char* ws = PWS;
  const float* ub = (const float*)(ws + OFF_R) + (size_t)ck * 64 * DIN + 256 + g * 16;
  bf16_t* sg = (bf16_t*)(ws + OFF_SG);
  const int c = g * 16 + fr;
  const float dd = INP(I_SSMD)[l * 256 + c];
  float uv[4][4];
#pragma unroll
  for (int t4 = 0; t4 < 4; ++t4)
#pragma unroll
    for (int j = 0; j < 4; ++j) uv[t4][j] = ub[(size_t)(t4 * 16 + fq * 4 + j) * DIN + fr];
#pragma unroll
  for (int t4 = 0; t4 < 4; ++t4)
#pragma unroll
    for (int j = 0; j < 4; ++j) {
      size_t row = (size_t)ck * 64 + t4 * 16 + fq * 4 + j;
      sg[row * 256 + c] = f2bf(gelu_t(yacc[t4][j] + dd * uv[t4][j]));
    }
}

DI void ssm1_phase(const Params& p, int l, char* shmc, int bid, int nblk) {
  const int tid = otid(), wid = __builtin_amdgcn_readfirstlane(tid >> 6), lane = tid & 63;
  char* wlds = shmc + wid * SSM_WAVE_LDS;
  for (int it = wid * nblk + bid; it < 6144; it += nblk * 8) ssm1_item(p, l, it >> 5, (it >> 1) & 15, it & 1, lane, wlds);
}

DI void mix_phase(const Params& p, int l, char* shmc, int bid, int nblk) {
  const int tid = otid(), wid = __builtin_amdgcn_readfirstlane(tid >> 6), lane = tid & 63;
  char* ws = PWS;
  for (int it = bid; it < 256; it += nblk) attn_sample_item(p, l, it, shmc, wid, lane);
  for (int it = bid * 8 + wid; it < 1024; it += nblk * 8) {
    int b = it >> 5, head = (it >> 3) & 3, qt = it & 7;
    attn_prompt_item((const bf16_t*)(ws + OFF_QB), b * 256 + qt * 32, head, (const bf16_t*)(ws + OFF_KP) + (size_t)(b * 2 + (head >> 1)) * 16384,
                     (const bf16_t*)(ws + OFF_VPT) + (size_t)(b * 2 + (head >> 1)) * 16384, (bf16_t*)(ws + OFF_YMIX), lane);
  }
  __syncthreads();
  char* wlds = shmc + wid * SSM_WAVE_LDS;
  const int slot = wid * nblk + bid, nslot = nblk * 8;
  for (int it = slot; it < 6144; it += nslot) {
    if (it < 3072) ssm2_item(p, l, it >> 4, it & 15, lane, wlds);
    else { int j = it - 3072; chunk_item(p, l, j >> 5, (j >> 3) & 3, j & 7, lane); }
  }
}

constexpr int N_PHASE = 26;
DI void run_phase(const Params& p, int ph, char* shm, int bid, int nblk) {
  char* ws = PWS;
  if (ph == 0) { prep_phase(p, shm, bid, nblk); return; }
  if (ph == 25) { lnmod_phase(p, 1, 2, -1, 0, bid, nblk); return; }
  const int l = (ph - 1) / 12, s = (ph - 1) % 12;
  const bf16_t* hA = (const bf16_t*)(ws + OFF_H);
  bf16_t* hid = (bf16_t*)(ws + OFF_R);
  float* xy = (float*)(ws + OFF_XY);
  const float* modl = (const float*)(ws + OFF_MOD) + (size_t)l * 3 * 9216;
  EpiArgs ea; ea.f0 = nullptr; ea.b0 = nullptr; ea.c0 = nullptr; ea.cb = nullptr; ea.w = 0.f;
  switch (s) {
    case 0: if (l == 0) lnmod_phase(p, -1, 0, 0, 0, bid, nblk); else lnmod_phase(p, l - 1, 2, l, 0, bid, nblk); break;
    case 1: case 10: {
      int sI = s == 1 ? 0 : 1;
      ea.b0 = hid;
      gemm_phase<1024, EPI_SWIGLU>(hA, (const bf16_t*)(ws + OFF_W1T) + (size_t)(l * 2 + sI) * 5632 * 1024, 48, 22, ea, shm, bid, nblk);
    } break;
    case 2: case 11: {
      int sI = s == 2 ? 0 : 1;
      ea.f0 = xy; ea.c0 = modl + (s == 2 ? 2 : 8) * 1024; ea.w = 0.5f;
      gemm_phase<2816, EPI_RESID>(hid, (const bf16_t*)(ws + OFF_W2T) + (size_t)(l * 2 + sI) * 1024 * 2816, 48, 4, ea, shm, bid, nblk);
    } break;
    case 3: lnmod_phase(p, l, 0, l, 3, bid, nblk); break;
    case 4: {
      ea.f0 = (float*)(ws + OFF_R);
      gemm_phase<1024, EPI_F32>(hA, (const bf16_t*)(ws + OFF_WINT) + (size_t)l * 1536 * 1024, 48, 6, ea, shm, bid, nblk);
    } break;
    case 5: post_phase(p, l, shm, bid, nblk); ssm1_phase(p, l, shm, bid, nblk); break;
    case 6: mix_phase(p, l, shm, bid, nblk); break;
    case 7: {
      ea.b0 = (bf16_t*)(ws + OFF_YMIX); ea.cb = (const bf16_t*)(ws + OFF_SG); ea.c0 = INP(I_BGLU) + l * 256;
      gemm_phase<256, EPI_GLU>((const bf16_t*)(ws + OFF_SG), (const bf16_t*)(ws + OFF_WGLUT) + (size_t)l * 65536, 48, 1, ea, shm, bid, nblk);
      ea.c0 = INP(I_POOLS) + l * 256;
      int bid2 = (bid + nblk - (nblk >> 1)) % nblk;
      gemm_phase<256, EPI_POOL>((const bf16_t*)(ws + OFF_DIFF), (const bf16_t*)(ws + OFF_WPOOLT) + (size_t)l * 65536, 48, 1, ea, shm, bid2, nblk);
    } break;
    case 8: {
      ea.f0 = xy; ea.c0 = modl + 5 * 1024; ea.w = 1.0f;
      gemm_phase<1024, EPI_RESID>((const bf16_t*)(ws + OFF_YMIX), (const bf16_t*)(ws + OFF_WOUTT) + (size_t)l * 1024 * 1024, 48, 4, ea, shm, bid, nblk);
    } break;
    case 9: lnmod_phase(p, l, 1, l, 6, bid, nblk); break;
  }
}

__global__ __launch_bounds__(512, 2) void mega(Params p, int ph_lo, int ph_hi) {
  extern __shared__ __attribute__((aligned(16))) char shm[];
  __shared__ uint4 xb_words;
  const int bid = blockIdx.x, nblk = gridDim.x;
  if (threadIdx.x == 0) xb_words = make_uint4(0u, 0u, 0u, 0u);
  __syncthreads();
  const XcdBarrier xb = xcd_barrier_post((unsigned*)(p.ws + OFF_BAR), (volatile LAS unsigned*)&xb_words);
  for (int ph = ph_lo; ph < ph_hi; ++ph) {
    if (ph > ph_lo) {
      if (ph == ph_lo + 1) cg::this_grid().sync();
      else xcd_barrier(xb);
    }
    run_phase(p, ph, shm, bid, nblk);
  }
}

extern "C" void kernel_launch(void* const* d_in, const int* in_sizes, int n_in, void* d_out, int out_size, void* d_ws,
                              size_t ws_size, hipStream_t stream) {
  static int grid_blocks = 0;
  if (!grid_blocks) {
    hipFuncSetAttribute((const void*)mega, hipFuncAttributeMaxDynamicSharedMemorySize, GEMM_LDS);
    int dev = 0, cus = 0, per_cu = 0;
    hipGetDevice(&dev);
    hipDeviceGetAttribute(&cus, hipDeviceAttributeMultiprocessorCount, dev);
    hipOccupancyMaxActiveBlocksPerMultiprocessor(&per_cu, mega, 512, GEMM_LDS);
    if (per_cu < 1) per_cu = 1;
    if (per_cu > 1) per_cu = 1;
    grid_blocks = cus * per_cu;
  }
  Params p{};
  for (int i = 0; i < N_IN; ++i) p.in[i] = (const float*)d_in[i];
  p.out = (float*)d_out;
  p.ws = (char*)d_ws;
  hipMemsetAsync((char*)d_ws + OFF_BAR, 0, 16384, stream);
#if ONE_LAUNCH
  int lo = 0, hi = N_PHASE;
  void* args[] = {&p, &lo, &hi};
  hipError_t e = hipLaunchCooperativeKernel((const void*)mega, dim3(grid_blocks), dim3(512), args, GEMM_LDS, stream);
  if (e != hipSuccess) fprintf(stderr, "cooperative launch failed: %s (grid %d)\n", hipGetErrorString(e), grid_blocks);
#else
  for (int ph = 0; ph < N_PHASE; ++ph) mega<<<grid_blocks, 512, GEMM_LDS, stream>>>(p, ph, ph + 1);
#endif
}
```

```cpp
#include <hip/hip_runtime.h>
#include <hip/hip_cooperative_groups.h>
#include <cstdio>
namespace cg = cooperative_groups;

#define DI __device__ __forceinline__
typedef unsigned short bf16_t;
typedef __attribute__((ext_vector_type(8))) short bf16x8;
typedef __attribute__((ext_vector_type(4))) short s16x4;
typedef __attribute__((ext_vector_type(4))) float f32x4;
typedef __attribute__((ext_vector_type(16))) float f32x16;
typedef __attribute__((ext_vector_type(2))) float f32x2;
typedef __attribute__((ext_vector_type(2))) __bf16 bf16x2v;
typedef __attribute__((ext_vector_type(4))) unsigned u32x4;
typedef __attribute__((ext_vector_type(2))) unsigned u32x2;

#ifndef ONE_LAUNCH
#define ONE_LAUNCH 1
#endif

constexpr int D = 1024, NTOK = 12288, NPROMPT = 8192, DFF = 2816, DIN = 1536;
constexpr float ALPHA = 1.4142135623730951f;
constexpr float LN_EPS = 1e-5f, RMS_EPS = 1e-6f;
enum { I_XP = 0, I_XS, I_CK, I_CV, I_SRE, I_SIM, I_C, I_CCTX, I_WMOD, I_BMOD, I_LNG, I_LNB, I_W1, I_W2, I_WIN, I_WOUT,
       I_POOLW, I_POOLS, I_LRE, I_LIM, I_LSTEP, I_BRE, I_BIM, I_CRE, I_CIM, I_SSMD, I_WGLU, I_BGLU, I_QN, I_KN,
       I_CLG, I_CLB, I_CWS, I_CBS, N_IN };
constexpr size_t OUT_K = 12582912, OUT_V = 14680064, OUT_SRE = 16777216, OUT_SIM = 16908288;

constexpr size_t OFF_W1T = 0;
constexpr size_t OFF_W2T = OFF_W1T + 46137344;
constexpr size_t OFF_WINT = OFF_W2T + 23068672;
constexpr size_t OFF_WOUTT = OFF_WINT + 6291456;
constexpr size_t OFF_WGLUT = OFF_WOUTT + 4194304;
constexpr size_t OFF_WPOOLT = OFF_WGLUT + 262144;
constexpr size_t OFF_MOD = OFF_WPOOLT + 262144;
constexpr size_t OFF_XY = OFF_MOD + 221184;
constexpr size_t OFF_H = OFF_XY + 50331648;
constexpr size_t OFF_YMIX = OFF_H + 25165824;
constexpr size_t OFF_R = OFF_YMIX + 25165824;
constexpr size_t OFF_QB = OFF_R + 75497472;
constexpr size_t OFF_KP = OFF_QB + 6291456;
constexpr size_t OFF_KS = OFF_KP + 2097152;
constexpr size_t OFF_VPT = OFF_KS + 2621440;
constexpr size_t OFF_VST = OFF_VPT + 2097152;
constexpr size_t OFF_VCT = OFF_VST + 2621440;
constexpr size_t OFF_DIFF = OFF_VCT + 6291456;
constexpr size_t OFF_SG = OFF_DIFF + 6291456;
constexpr size_t OFF_E = OFF_SG + 6291456;
constexpr size_t OFF_LAMB = OFF_E + 3145728;
constexpr size_t OFF_LAMT = OFF_LAMB + 32768;
constexpr size_t OFF_BBAR = OFF_LAMT + 32768;
constexpr size_t OFF_BAR = OFF_BBAR + 524288;
constexpr size_t OFF_BF = OFF_BAR + 16384;
constexpr size_t OFF_CF = OFF_BF + 524288;
constexpr size_t WS_TOTAL = OFF_CF + 262144;

struct Params { const float* in[N_IN]; float* out; char* ws; };

DI int otid() {
  int z = 0; asm volatile("" : "+s"(z));
  int lane = __builtin_amdgcn_mbcnt_hi(-1, __builtin_amdgcn_mbcnt_lo(-1, z));
  int w = __builtin_amdgcn_readfirstlane(threadIdx.x >> 6);
  return w * 64 + lane;
}
DI int osgpr(int i) { asm volatile("" : "+s"(i)); return i; }
#define INP(i) (p.in[osgpr(i)])
DI char* ows(char* w) { asm volatile("" : "+s"(w)); return w; }
#define PWS ows(p.ws)
DI unsigned pk2(float a, float b) { f32x2 v = {a, b}; bf16x2v r = __builtin_convertvector(v, bf16x2v); return __builtin_bit_cast(unsigned, r); }
DI bf16_t f2bf(float a) { return (bf16_t)(pk2(a, 0.f) & 0xffffu); }
DI float bf2f(bf16_t v) { return __uint_as_float(((unsigned)v) << 16); }
DI bf16x8 pack8(float a0, float a1, float a2, float a3, float a4, float a5, float a6, float a7) {
  u32x4 u = {pk2(a0, a1), pk2(a2, a3), pk2(a4, a5), pk2(a6, a7)};
  return __builtin_bit_cast(bf16x8, u);
}
DI float gelu_t(float x) {
  float z = 0.7978845608028654f * (x + 0.044715f * x * x * x);
  float e = __expf(2.f * z);
  float th = 1.f - 2.f / (e + 1.f);
  return 0.5f * x * (1.f + th);
}
DI float sigmoid_f(float x) { return 1.f / (1.f + __expf(-x)); }
DI float shfl_x(float v, int mask, int lane) {
  return __int_as_float(__builtin_amdgcn_ds_bpermute((lane ^ mask) << 2, __float_as_int(v)));
}
template <int CTRL> DI float dpp_f(float v) {
  return __int_as_float(__builtin_amdgcn_update_dpp(0, __float_as_int(v), CTRL, 0xf, 0xf, true));
}
DI float wave_sum(float v, int lane) {
  (void)lane;
  v += dpp_f<0xB1>(v);
  v += dpp_f<0x4E>(v);
  v += dpp_f<0x141>(v);
  v += dpp_f<0x140>(v);
  const int iv = __float_as_int(v);
  float r0 = __int_as_float(__builtin_amdgcn_readlane(iv, 0)), r1 = __int_as_float(__builtin_amdgcn_readlane(iv, 16));
  float r2 = __int_as_float(__builtin_amdgcn_readlane(iv, 32)), r3 = __int_as_float(__builtin_amdgcn_readlane(iv, 48));
  return (r0 + r1) + (r2 + r3);
}
DI size_t kfrag_off(int key, int d) {
  return ((size_t)((key >> 5) * 4 + (d >> 4)) * 64 + ((d >> 3) & 1) * 32 + (key & 31)) * 8 + (d & 7);
}
DI size_t vfrag_off(int key, int d) {
  const int kk = key & 31, w = kk & 15;
  return ((size_t)(((key >> 5) * 2 + (kk >> 4)) * 2 + (d >> 5)) * 64 + ((w >> 2) & 1) * 32 + (d & 31)) * 8 + (((w >> 3) << 2) | (w & 3));
}

#define MFMA16(a, b, c) __builtin_amdgcn_mfma_f32_16x16x32_bf16((a), (b), (c), 0, 0, 0)
#define MFMA32(a, b, c) __builtin_amdgcn_mfma_f32_32x32x16_bf16((a), (b), (c), 0, 0, 0)


#define XB_TMO      128
#define XB_XCNT(j)  (256  + 64 * (j))
#define XB_XSUB(j)  (1280 + 64 * (j))
#define XB_XGEN(j)  (2304 + 64 * (j))
#define XB_TOP      3328
#define XB_TOPGEN   3392
#define XCD_BAR_WORDS 3456
#define XB_SPIN_CAP (1u << 18)
#define LAS __attribute__((address_space(3)))
DI unsigned xb_ld(unsigned* p) { return __hip_atomic_load(p, __ATOMIC_RELAXED, __HIP_MEMORY_SCOPE_AGENT); }
DI unsigned xb_add(unsigned* p, unsigned v) { return __hip_atomic_fetch_add(p, v, __ATOMIC_RELAXED, __HIP_MEMORY_SCOPE_AGENT); }
DI unsigned xb_xcc_id() { return (unsigned)__builtin_amdgcn_s_getreg((3 << 11) | 20) & 0xFu; }
#define XB_SPIN(cond, bar) do { unsigned _sp = 0; while (cond) { __builtin_amdgcn_s_sleep(1); \
    if ((++_sp & 255u) == 0u) { if (xb_ld(&(bar)[XB_TMO])) break; if (_sp > XB_SPIN_CAP) { atomicAdd(&(bar)[XB_TMO], 1u); break; } } } } while (0)
struct XcdBarrier { unsigned* bar; unsigned x; volatile LAS unsigned* st; };
DI XcdBarrier xcd_barrier_post(unsigned* bar, volatile LAS unsigned* st) {
  XcdBarrier b; b.bar = bar; b.x = xb_xcc_id(); b.st = st;
  if (threadIdx.x == 0) (void)xb_add(&bar[XB_XCNT(b.x)], 1u);
  return b;
}
DI void xcd_barrier_complete(unsigned* bar, unsigned x, unsigned& nloc, unsigned& nx) {
  const unsigned G = gridDim.x * gridDim.y * gridDim.z;
  unsigned sum, cnt, mine, sp = 0u;
  for (;;) {
    sum = 0u; cnt = 0u; mine = 0u;
#pragma unroll
    for (unsigned j = 0; j < 16; ++j) { const unsigned c = xb_ld(&bar[XB_XCNT(j)]); sum += c; cnt += (c > 0u) ? 1u : 0u; mine = (j == x) ? c : mine; }
    if (sum == G) break;
    __builtin_amdgcn_s_sleep(1);
    if ((++sp & 255u) == 0u) { if (xb_ld(&bar[XB_TMO])) break; if (sp > XB_SPIN_CAP) { atomicAdd(&bar[XB_TMO], 1u); break; } }
  }
  nloc = mine > 0u ? mine : 1u; nx = cnt > 0u ? cnt : 1u;
}
DI void xcd_barrier(const XcdBarrier& b) {
  asm volatile("s_waitcnt vmcnt(0)" ::: "memory");
  __syncthreads();
  if (threadIdx.x == 0) {
    unsigned* bar = b.bar;
    __builtin_amdgcn_s_waitcnt(0);
    unsigned nloc = b.st[0], nx = b.st[1];
    if (nloc == 0u) { xcd_barrier_complete(bar, b.x, nloc, nx); b.st[0] = nloc; b.st[1] = nx; }
    const unsigned old = xb_add(&bar[XB_XSUB(b.x)], 1u);
    const unsigned gen = old / nloc;
    if (old + 1u == (gen + 1u) * nloc) {
      __builtin_amdgcn_fence(__ATOMIC_RELEASE, "agent");
      asm volatile("s_waitcnt vmcnt(0)" ::: "memory");
      const unsigned og = xb_add(&bar[XB_TOP], 1u);
      const unsigned tg = og / nx;
      if (og + 1u == (tg + 1u) * nx) xb_add(&bar[XB_TOPGEN], 1u);
      else XB_SPIN(xb_ld(&bar[XB_TOPGEN]) == tg, bar);
      __builtin_amdgcn_fence(__ATOMIC_ACQUIRE, "agent");
      xb_add(&bar[XB_XGEN(b.x)], 1u);
      asm volatile("s_waitcnt vmcnt(0)" ::: "memory");
    } else {
      XB_SPIN(xb_ld(&bar[XB_XGEN(b.x)]) == gen, bar);
      __builtin_amdgcn_fence(__ATOMIC_ACQUIRE, "agent");
      asm volatile("s_waitcnt vmcnt(0)" ::: "memory");
    }
  }
  __syncthreads();
}

constexpr int BM = 256, BK = 64, HALF = 128, NXCD = 8, WGM = 8, HT = HALF * BK;
constexpr int GEMM_LDS = 8 * HT * 2;

DI int lds_byte(int r, int c) {
  int st = (r >> 4) * 2 + (c >> 5), rr = r & 15, cc = c & 31, ob = rr * 64 + cc * 2;
  return st * 1024 + (ob ^ (((ob >> 9) & 1) << 5));
}
DI void stage_rc(int b, int& R, int& C) {
  int st = b / 1024, sb = b % 1024, swz = sb ^ (((sb >> 9) & 1) << 5);
  R = (st >> 1) * 16 + swz / 64; C = (st & 1) * 32 + (swz % 64) / 2;
}

enum { EPI_SWIGLU = 0, EPI_RESID, EPI_F32, EPI_GLU, EPI_POOL };
struct EpiArgs {
  float* f0;
  bf16_t* b0;
  const float* c0;
  const bf16_t* cb;
  float w;
};

template <int K, int MODE, int SPLITS = 1>
DI void gemm_phase(const bf16_t* __restrict__ A, const bf16_t* __restrict__ Bt, int nM, int nN, EpiArgs ea,
                   char* shmc, int bid, int nblk) {
  bf16_t* shm = (bf16_t*)shmc;
#define SA(b, h) (shm + ((b) * 2 + (h)) * HT)
#define SB(b, h) (shm + (4 + (b) * 2 + (h)) * HT)
#define STAGE(P, RS, SOFF, kt) do { const int _so = (SOFF) + (kt0 + (kt)) * (BK * 2); \
    __builtin_amdgcn_raw_ptr_buffer_load_lds(RS, (__attribute__((address_space(3))) void*)((char*)(P) + wid * 1024), 16, so0, _so, 0, 0); \
    __builtin_amdgcn_raw_ptr_buffer_load_lds(RS, (__attribute__((address_space(3))) void*)((char*)(P) + wid * 1024 + 8192), 16, so1, _so, 0, 0); } while (0)
#define LDA(dst, b, h) for (int m = 0; m < 4; ++m) for (int k = 0; k < 2; ++k) \
    dst[m][k] = *reinterpret_cast<const bf16x8*>((char*)SA(b, h) + lds_byte(wr * 64 + m * 16 + fr, k * 32 + fq * 8))
#define LDB(dst, b, h) for (int n = 0; n < 2; ++n) for (int k = 0; k < 2; ++k) \
    dst[n][k] = *reinterpret_cast<const bf16x8*>((char*)SB(b, h) + lds_byte(wc * 32 + n * 16 + fr, k * 32 + fq * 8))
#define MMA(ai, bj, At, Bt_) do { __builtin_amdgcn_s_setprio(1); \
    for (int m = 0; m < 4; ++m) for (int n = 0; n < 2; ++n) for (int k = 0; k < 2; ++k) \
      acc[ai][bj][m][n] = MFMA16(At[m][k], Bt_[n][k], acc[ai][bj][m][n]); \
    __builtin_amdgcn_s_setprio(0); } while (0)
#define WAIT_V(n) asm volatile("s_waitcnt vmcnt(" #n ")" ::: "memory")
#define WAIT_L(n) asm volatile("s_waitcnt lgkmcnt(" #n ")" ::: "memory")
#define BAR __builtin_amdgcn_s_barrier()
#define SCHED __builtin_amdgcn_sched_barrier(0)
  const int tid = otid();
  const int wid = __builtin_amdgcn_readfirstlane(tid >> 6), lane = tid & 63, wr = wid >> 2, wc = wid & 3, fr = lane & 15, fq = lane >> 4;
  const __amdgpu_buffer_rsrc_t rsA = __builtin_amdgcn_make_buffer_rsrc((void*)A, 0, 0x7fffffff, 0x00020000);
  const __amdgpu_buffer_rsrc_t rsB = __builtin_amdgcn_make_buffer_rsrc((void*)Bt, 0, 0x7fffffff, 0x00020000);
  unsigned so0, so1;
  { int R, C; stage_rc(tid * 16, R, C); so0 = (unsigned)(R * K + C) * 2u; stage_rc(tid * 16 + 8192, R, C); so1 = (unsigned)(R * K + C) * 2u; }
  const int nwg = nM * nN;
  for (int unit = bid; unit < nwg * SPLITS; unit += nblk) {
    const int sp = SPLITS == 1 ? 0 : unit / nwg, tile = SPLITS == 1 ? unit : unit % nwg;
    const int kt0 = SPLITS == 1 ? 0 : (sp == 0 ? 0 : sp == 1 ? 12 : sp == 2 ? 24 : 34);
    const int nt = SPLITS == 1 ? K / BK : (sp < 2 ? 12 : 10);
    int wgid = tile;
    { int q = nwg / NXCD, r = nwg % NXCD, xcd = wgid % NXCD, off = wgid / NXCD;
      wgid = (xcd < r ? xcd * (q + 1) : r * (q + 1) + (xcd - r) * q) + off; }
    int nig = WGM * nN, gid = wgid / nig, fm = gid * WGM, gsz = min(nM - fm, WGM);
    int pm = fm + ((wgid % nig) % gsz), pn = (wgid % nig) / gsz, brow = pm * BM, bcol = pn * BM;
    const int A0 = brow * K * 2, A1 = A0 + HALF * K * 2, B0p = bcol * K * 2, B1p = B0p + HALF * K * 2;
    f32x4 acc[2][2][4][2] = {};
    bf16x8 At[4][2], B0[2][2], B1[2][2];
    STAGE(SB(0, 0), rsB, B0p, 0); STAGE(SA(0, 0), rsA, A0, 0);
    STAGE(SB(0, 1), rsB, B1p, 0); STAGE(SA(0, 1), rsA, A1, 0);
    if (wr == 1) BAR;
    WAIT_V(4); BAR;
    STAGE(SB(1, 0), rsB, B0p, 1); STAGE(SA(1, 0), rsA, A0, 1); STAGE(SB(1, 1), rsB, B1p, 1);
    WAIT_V(6); BAR;
    for (int t = 0; t < nt - 2; t += 2) {
      LDB(B0, 0, 0); SCHED; LDA(At, 0, 0); STAGE(SA(1, 1), rsA, A1, t + 1);
      WAIT_L(8); BAR; WAIT_L(0); MMA(0, 0, At, B0); BAR; SCHED;
      LDB(B1, 0, 1); STAGE(SB(0, 0), rsB, B0p, t + 2);
      BAR; WAIT_L(0); MMA(0, 1, At, B1); BAR;
      LDA(At, 0, 1); STAGE(SA(0, 0), rsA, A0, t + 2);
      BAR; WAIT_L(0); MMA(1, 0, At, B0); BAR; SCHED;
      STAGE(SB(0, 1), rsB, B1p, t + 2);
      WAIT_V(6); BAR; MMA(1, 1, At, B1); BAR;
      LDB(B0, 1, 0); SCHED; LDA(At, 1, 0); STAGE(SA(0, 1), rsA, A1, t + 2);
      WAIT_L(8); BAR; WAIT_L(0); MMA(0, 0, At, B0); BAR; SCHED;
      LDB(B1, 1, 1); STAGE(SB(1, 0), rsB, B0p, t + 3);
      BAR; WAIT_L(0); MMA(0, 1, At, B1); BAR;
      LDA(At, 1, 1); STAGE(SA(1, 0), rsA, A0, t + 3);
      BAR; WAIT_L(0); MMA(1, 0, At, B0); BAR; SCHED;
      STAGE(SB(1, 1), rsB, B1p, t + 3);
      WAIT_V(6); BAR; MMA(1, 1, At, B1); BAR;
    }
    { LDB(B0, 0, 0); LDA(At, 0, 0); STAGE(SA(1, 1), rsA, A1, nt - 1);
      BAR; WAIT_L(0); MMA(0, 0, At, B0); BAR;
      LDB(B1, 0, 1); BAR; WAIT_L(0); MMA(0, 1, At, B1); BAR;
      LDA(At, 0, 1); WAIT_V(4); BAR; WAIT_L(0); MMA(1, 0, At, B0); MMA(1, 1, At, B1); BAR; }
    { LDB(B0, 1, 0); LDA(At, 1, 0); WAIT_V(2); BAR; WAIT_L(0); MMA(0, 0, At, B0); BAR;
      LDB(B1, 1, 1); WAIT_V(0); BAR; WAIT_L(0); MMA(0, 1, At, B1); BAR;
      LDA(At, 1, 1); BAR; WAIT_L(0); MMA(1, 0, At, B0); MMA(1, 1, At, B1); BAR; }
    if (wr == 0) BAR;
    const int ci = brow < NPROMPT ? 0 : 1 + (brow - NPROMPT) / 2048;
    const int te = otid(), le = te & 63, wide = te >> 6;
    const int wr = wide >> 2, wc = wide & 3, fr = le & 15, fq = le >> 4;
    const int rbase = brow + wr * 64 + fq * 4, cbase = bcol + wc * 32 + fr;
    if (MODE == EPI_SWIGLU) {
#pragma unroll
      for (int ai = 0; ai < 2; ++ai)
#pragma unroll
        for (int m = 0; m < 4; ++m)
#pragma unroll
          for (int j = 0; j < 4; ++j) {
            const int row = rbase + ai * HALF + m * 16 + j;
#pragma unroll
            for (int n = 0; n < 2; ++n) {
              float g = acc[ai][0][m][n][j], u = acc[ai][1][m][n][j];
              ea.b0[(size_t)row * DFF + pn * 128 + wc * 32 + n * 16 + fr] = f2bf(g * sigmoid_f(g) * u);
            }
          }
    } else if (MODE == EPI_RESID) {
      float gate[2][2];
#pragma unroll
      for (int bj = 0; bj < 2; ++bj)
#pragma unroll
        for (int n = 0; n < 2; ++n) gate[bj][n] = ea.w * ea.c0[ci * 9216 + cbase + bj * HALF + n * 16];
#pragma unroll
      for (int ai = 0; ai < 2; ++ai) {
        float* xb = ea.f0 + (size_t)(rbase + ai * HALF) * D + cbase;
        float xv[4][4][2][2];
#pragma unroll
        for (int m = 0; m < 4; ++m)
#pragma unroll
          for (int j = 0; j < 4; ++j)
#pragma unroll
            for (int bj = 0; bj < 2; ++bj)
#pragma unroll
              for (int n = 0; n < 2; ++n) xv[m][j][bj][n] = xb[(size_t)(m * 16 + j) * D + bj * HALF + n * 16];
#pragma unroll
        for (int m = 0; m < 4; ++m)
#pragma unroll
          for (int j = 0; j < 4; ++j)
#pragma unroll
            for (int bj = 0; bj < 2; ++bj)
#pragma unroll
              for (int n = 0; n < 2; ++n)
                xb[(size_t)(m * 16 + j) * D + bj * HALF + n * 16] = xv[m][j][bj][n] + gate[bj][n] * acc[ai][bj][m][n][j];
      }
    } else if (MODE == EPI_GLU) {
      float bg[2][2];
#pragma unroll
      for (int bj = 0; bj < 2; ++bj)
#pragma unroll
        for (int n = 0; n < 2; ++n) bg[bj][n] = ea.c0[cbase + bj * HALF + n * 16];
#pragma unroll
      for (int ai = 0; ai < 2; ++ai) {
        float gv[4][4][2][2];
        const bf16_t* gb = ea.cb + (size_t)(rbase + ai * HALF) * 256 + cbase;
#pragma unroll
        for (int m = 0; m < 4; ++m)
#pragma unroll
          for (int j = 0; j < 4; ++j)
#pragma unroll
            for (int bj = 0; bj < 2; ++bj)
#pragma unroll
              for (int n = 0; n < 2; ++n) gv[m][j][bj][n] = bf2f(gb[(size_t)(m * 16 + j) * 256 + bj * HALF + n * 16]);
        bf16_t* yb = ea.b0 + (size_t)(rbase + ai * HALF) * D + 256 + cbase;
#pragma unroll
        for (int m = 0; m < 4; ++m)
#pragma unroll
          for (int j = 0; j < 4; ++j)
#pragma unroll
            for (int bj = 0; bj < 2; ++bj)
#pragma unroll
              for (int n = 0; n < 2; ++n)
                yb[(size_t)(m * 16 + j) * D + bj * HALF + n * 16] =
                    f2bf(gv[m][j][bj][n] * sigmoid_f(acc[ai][bj][m][n][j] + bg[bj][n]));
      }
    } else {
      float ps[2][2];
#pragma unroll
      for (int bj = 0; bj < 2; ++bj)
#pragma unroll
        for (int n = 0; n < 2; ++n) ps[bj][n] = MODE == EPI_POOL ? ea.c0[cbase + bj * HALF + n * 16] : 1.f;
#pragma unroll
      for (int ai = 0; ai < 2; ++ai)
#pragma unroll
        for (int m = 0; m < 4; ++m)
#pragma unroll
          for (int j = 0; j < 4; ++j) {
            const int row = rbase + ai * HALF + m * 16 + j;
#pragma unroll
            for (int bj = 0; bj < 2; ++bj)
#pragma unroll
              for (int n = 0; n < 2; ++n) {
                const int col = cbase + bj * HALF + n * 16;
                float a = acc[ai][bj][m][n][j];
                if (MODE == EPI_F32) ea.f0[(size_t)row * DIN + col] = a;
                else ea.b0[(size_t)row * D + col] = f2bf(a * ps[bj][n]);
              }
          }
    }
  }
#undef SA
#undef SB
}

DI void prep_phase(const Params& p, char* shmc, int bid, int nblk) {
  const int tid = otid(), wid = tid >> 6, lane = tid & 63;
  char* ws = PWS;
  {
    float* tile = (float*)shmc;
    constexpr int T_W1 = 16 * 88, T_W2 = 44 * 16, T_IN = 16 * 24, T_OUT = 256, T_GLU = 16;
    constexpr int PER_L = 2 * T_W1 + 2 * T_W2 + T_IN + T_OUT + T_GLU;
    for (int it = bid; it < 2 * PER_L; it += nblk) {
      int l = it / PER_L, r = it % PER_L;
      const float* src; bf16_t* dst; int K, N, mode = 0;
      if (r < 2 * T_W1) {
        int s = r / T_W1; r %= T_W1;
        src = INP(I_W1) + (size_t)(l * 2 + s) * 1024 * 5632; dst = (bf16_t*)(ws + OFF_W1T) + (size_t)(l * 2 + s) * 5632 * 1024;
        K = 1024; N = 5632; mode = 1;
      } else if (r < 2 * T_W1 + 2 * T_W2) {
        r -= 2 * T_W1; int s = r / T_W2; r %= T_W2;
        src = INP(I_W2) + (size_t)(l * 2 + s) * 2816 * 1024; dst = (bf16_t*)(ws + OFF_W2T) + (size_t)(l * 2 + s) * 1024 * 2816;
        K = 2816; N = 1024;
      } else if (r < 2 * T_W1 + 2 * T_W2 + T_IN) {
        r -= 2 * T_W1 + 2 * T_W2;
        src = INP(I_WIN) + (size_t)l * 1024 * 1536; dst = (bf16_t*)(ws + OFF_WINT) + (size_t)l * 1536 * 1024;
        K = 1024; N = 1536;
      } else if (r < 2 * T_W1 + 2 * T_W2 + T_IN + T_OUT) {
        r -= 2 * T_W1 + 2 * T_W2 + T_IN;
        src = INP(I_WOUT) + (size_t)l * 1024 * 1024; dst = (bf16_t*)(ws + OFF_WOUTT) + (size_t)l * 1024 * 1024;
        K = 1024; N = 1024;
      } else {
        r -= 2 * T_W1 + 2 * T_W2 + T_IN + T_OUT;
        src = INP(I_WGLU) + (size_t)l * 256 * 256; dst = (bf16_t*)(ws + OFF_WGLUT) + (size_t)l * 256 * 256;
        K = 256; N = 256;
      }
      int nkt = K / 64, kt = r % nkt, ntile = r / nkt;
#pragma unroll
      for (int i = 0; i < 2; ++i) {
        int k = (tid >> 4) + 32 * i, n = (tid & 15) * 4;
        float4 v = *(const float4*)(src + (size_t)(kt * 64 + k) * N + ntile * 64 + n);
        tile[k * 65 + n] = v.x; tile[k * 65 + n + 1] = v.y; tile[k * 65 + n + 2] = v.z; tile[k * 65 + n + 3] = v.w;
      }
      __syncthreads();
      {
        int n = tid >> 3, kk = (tid & 7) * 8;
        int nsrc = ntile * 64 + n, nrow = nsrc;
        if (mode == 1) {
          if (nsrc < 2816) nrow = (nsrc >> 7) * 256 + (nsrc & 127);
          else { int mm = nsrc - 2816; nrow = (mm >> 7) * 256 + 128 + (mm & 127); }
        }
        bf16x8 o = pack8(tile[(kk + 0) * 65 + n], tile[(kk + 1) * 65 + n], tile[(kk + 2) * 65 + n], tile[(kk + 3) * 65 + n],
                         tile[(kk + 4) * 65 + n], tile[(kk + 5) * 65 + n], tile[(kk + 6) * 65 + n], tile[(kk + 7) * 65 + n]);
        *(bf16x8*)(dst + (size_t)nrow * K + kt * 64 + kk) = o;
      }
      __syncthreads();
    }
  }
  const int gtid = bid * 512 + tid, gn = nblk * 512;
  for (int i = gtid; i < 2 * 65536; i += gn) {
    int l = i >> 16, n = (i >> 8) & 255, k = i & 255;
    int gi = n >> 6, d = n & 63, gj = k >> 6, c = k & 63;
    float v = (gi == gj) ? INP(I_POOLW)[((size_t)(l * 4 + gi) * 64 + c) * 64 + d] : 0.f;
    ((bf16_t*)(ws + OFF_WPOOLT))[i] = f2bf(v);
  }
  {
    float* sc = (float*)shmc + 64 * 65;
    float* red = sc + 3 * 1024;
    for (int i = tid; i < 3 * 1024; i += 512) {
      int ci = i >> 10, k = i & 1023;
      float v = ci == 0 ? INP(I_CCTX)[k] : INP(I_C)[(ci - 1) * 1024 + k];
      sc[i] = v * sigmoid_f(v);
    }
    __syncthreads();
    for (int it = bid; it < 288; it += nblk) {
      int l = it / 144, cb = it % 144, col = cb * 64 + lane;
      const float* wp = INP(I_WMOD) + (size_t)l * 1024 * 9216 + col;
      float a0 = 0.f, a1 = 0.f, a2 = 0.f;
#pragma unroll 8
      for (int k = wid * 128; k < wid * 128 + 128; ++k) {
        float w = wp[(size_t)k * 9216];
        a0 += sc[k] * w; a1 += sc[1024 + k] * w; a2 += sc[2048 + k] * w;
      }
      red[(wid * 3 + 0) * 64 + lane] = a0; red[(wid * 3 + 1) * 64 + lane] = a1; red[(wid * 3 + 2) * 64 + lane] = a2;
      __syncthreads();
      if (tid < 192) {
        int ci = tid >> 6;
        float s = 0.f;
        for (int w = 0; w < 8; ++w) s += red[(w * 3 + ci) * 64 + lane];
        ((float*)(ws + OFF_MOD))[(size_t)(l * 3 + ci) * 9216 + col] = s + INP(I_BMOD)[l * 9216 + col];
      }
      __syncthreads();
    }
  }
  for (int i = gtid; i < 2 * 2 * 512 * 128; i += gn) {
    int c = i & 127, t = (i >> 7) & 511, b = (i >> 16) & 1, l = i >> 17;
    size_t si = ((size_t)(b * 2 + l) * 512 + t) * 128 + c;
    const size_t sb_ = (size_t)((l * 2 + b) * 2 + (c >> 6)) * 163840;
    ((bf16_t*)(ws + OFF_KS))[sb_ + kfrag_off(t, c & 63)] = f2bf(INP(I_CK)[si]);
    ((bf16_t*)(ws + OFF_VST))[sb_ + vfrag_off(t, c & 63)] = f2bf(INP(I_CV)[si]);
  }
  for (int i = gtid; i < 4096; i += gn) {
    float lre = INP(I_LRE)[i], lim = INP(I_LIM)[i];
    float dt = expf(INP(I_LSTEP)[i >> 6]);
    float e = expf(lre * dt), ang = lim * dt;
    float br = e * cosf(ang), bi = e * sinf(ang);
    float ar = br - 1.f, ai = bi, den = lre * lre + lim * lim;
    float cr = (ar * lre + ai * lim) / den, cim = (ai * lre - ar * lim) / den;
    ((float2*)(ws + OFF_LAMB))[i] = make_float2(br, bi);
    float pr = br, pi = bi;
    for (int s = 0; s < 6; ++s) { float nr = pr * pr - pi * pi, ni = 2.f * pr * pi; pr = nr; pi = ni; }
    ((float2*)(ws + OFF_LAMT))[i] = make_float2(pr, pi);
  }
  for (int i = gtid; i < 64 * 8 * 64; i += gn) {
    const int gidx = i >> 9, nt = (i >> 6) & 7, ln = i & 63, fr = ln & 15, fq = ln >> 4;
    bf16x8 o = (bf16x8){0, 0, 0, 0, 0, 0, 0, 0};
    if (fq < 2) {
      const int n = nt * 8 + (fr >> 1), idx = gidx * 64 + n;
      float lre = INP(I_LRE)[idx], lim = INP(I_LIM)[idx];
      float dt = expf(INP(I_LSTEP)[gidx]);
      float e = expf(lre * dt), ang = lim * dt;
      float br = e * cosf(ang), bi = e * sinf(ang);
      float ar = br - 1.f, ai = bi, den = lre * lre + lim * lim;
      float cr = (ar * lre + ai * lim) / den, cim = (ai * lre - ar * lim) / den;
      float v[8];
#pragma unroll
      for (int j = 0; j < 8; ++j) {
        float xr = INP(I_BRE)[(size_t)idx * 16 + fq * 8 + j], xi = INP(I_BIM)[(size_t)idx * 16 + fq * 8 + j];
        v[j] = (fr & 1) ? cr * xi + cim * xr : cr * xr - cim * xi;
      }
      o = pack8(v[0], v[1], v[2], v[3], v[4], v[5], v[6], v[7]);
    }
    ((bf16x8*)(ws + OFF_BF))[i] = o;
  }
  for (int i = gtid; i < 64 * 4 * 64; i += gn) {
    const int gidx = i >> 8, ks = (i >> 6) & 3, ln = i & 63, fr = ln & 15, fq = ln >> 4;
    const size_t co = ((size_t)gidx * 16 + fr) * 64 + ks * 16 + fq * 4;
    float4 cr = *(const float4*)(INP(I_CRE) + co), cim = *(const float4*)(INP(I_CIM) + co);
    ((bf16x8*)(ws + OFF_CF))[i] = pack8(cr.x, -cim.x, cr.y, -cim.y, cr.z, -cim.z, cr.w, -cim.w);
  }
}

DI void lnmod_phase(const Params& p, int l_ln, int ln_idx, int l_mod, int mod_idx, int bid, int nblk) {
  const int tid = otid(), wid = tid >> 6, lane = tid & 63;
  float* xy = (float*)(PWS + OFF_XY);
  bf16_t* h = (bf16_t*)(PWS + OFF_H);
  const float* modv = (const float*)(PWS + OFF_MOD);
  const int stride = nblk * 8;
  float4 gg[4], bb[4];
  if (l_ln >= 0) {
    const float* g = INP(I_LNG) + (l_ln * 3 + ln_idx) * 1024;
    const float* b = INP(I_LNB) + (l_ln * 3 + ln_idx) * 1024;
#pragma unroll
    for (int i = 0; i < 4; ++i) { gg[i] = *(const float4*)(g + lane * 4 + i * 256); bb[i] = *(const float4*)(b + lane * 4 + i * 256); }
  }
#define LN_SRC(R) (l_ln < 0 ? ((R) < NPROMPT ? INP(I_XP) + (size_t)(R) * D : INP(I_XS) + (size_t)((R) - NPROMPT) * D) : xy + (size_t)(R) * D)
  int row = bid * 8 + wid;
  float4 nv[4];
  if (row < NTOK) {
    const float* src = LN_SRC(row);
#pragma unroll
    for (int i = 0; i < 4; ++i) nv[i] = *(const float4*)(src + lane * 4 + i * 256);
  }
  for (; row < NTOK; row += stride) {
    float4 v[4];
#pragma unroll
    for (int i = 0; i < 4; ++i) v[i] = nv[i];
    if (row + stride < NTOK) {
      const float* src = LN_SRC(row + stride);
#pragma unroll
      for (int i = 0; i < 4; ++i) nv[i] = *(const float4*)(src + lane * 4 + i * 256);
    }
    float4 ma[4], mc[4];
    if (l_mod >= 0) {
      int ci = row < NPROMPT ? 0 : 1 + (row - NPROMPT) / 2048;
      const float* sh = modv + (size_t)(l_mod * 3 + ci) * 9216 + mod_idx * 1024;
#pragma unroll
      for (int i = 0; i < 4; ++i) { ma[i] = *(const float4*)(sh + lane * 4 + i * 256); mc[i] = *(const float4*)(sh + 1024 + lane * 4 + i * 256); }
    }
    if (l_ln >= 0) {
      float s = 0.f;
#pragma unroll
      for (int i = 0; i < 4; ++i) s += v[i].x + v[i].y + v[i].z + v[i].w;
      float mean = wave_sum(s, lane) * (1.f / 1024.f);
      float q = 0.f;
#pragma unroll
      for (int i = 0; i < 4; ++i) {
        v[i].x -= mean; v[i].y -= mean; v[i].z -= mean; v[i].w -= mean;
        q += v[i].x * v[i].x + v[i].y * v[i].y + v[i].z * v[i].z + v[i].w * v[i].w;
      }
      float rstd = rsqrtf(wave_sum(q, lane) * (1.f / 1024.f) + LN_EPS);
#pragma unroll
      for (int i = 0; i < 4; ++i) {
        v[i].x = v[i].x * rstd * gg[i].x + bb[i].x; v[i].y = v[i].y * rstd * gg[i].y + bb[i].y;
        v[i].z = v[i].z * rstd * gg[i].z + bb[i].z; v[i].w = v[i].w * rstd * gg[i].w + bb[i].w;
      }
    }
    float* dx = l_mod < 0 ? p.out + (size_t)row * D : xy + (size_t)row * D;
    const float xs = l_mod < 0 ? 1.f : ALPHA;
#pragma unroll
    for (int i = 0; i < 4; ++i) *(float4*)(dx + lane * 4 + i * 256) = make_float4(v[i].x * xs, v[i].y * xs, v[i].z * xs, v[i].w * xs);
    if (l_mod >= 0) {
#pragma unroll
      for (int i = 0; i < 4; ++i) {
        u32x2 o = {pk2(v[i].x * (1.f + mc[i].x) + ma[i].x, v[i].y * (1.f + mc[i].y) + ma[i].y),
                   pk2(v[i].z * (1.f + mc[i].z) + ma[i].z, v[i].w * (1.f + mc[i].w) + ma[i].w)};
        *(u32x2*)(h + (size_t)row * D + lane * 4 + i * 256) = o;
      }
    }
  }
#undef LN_SRC
}

DI void post_phase(const Params& p, int l, char* shmc, int bid, int nblk) {
  const int tid = otid(), wid = tid >> 6, lane = tid & 63;
  char* ws = PWS;
  const float* proj = (const float*)(ws + OFF_R);
  bf16_t* qb = (bf16_t*)(ws + OFF_QB);
  const float qn = INP(I_QN)[l * 64 + lane], kn = INP(I_KN)[l * 64 + lane];
  const int fi = lane & 15;
  const float inv = exp2f(-(float)fi * (13.287712379549449f / 16.f));
  for (int row = bid * 8 + wid; row < NTOK; row += nblk * 8) {
    const float* pr = proj + (size_t)row * DIN;
    const bool samp = row >= NPROMPT;
    int b, t, L;
    if (samp) { b = (row - NPROMPT) >> 11; t = (row - NPROMPT) & 2047; L = 2048; }
    else { b = row >> 8; t = row & 255; L = 256; }
    float cs = 1.f, sn = 0.f;
    if (samp) {
      float pos = (float)((lane & 31) < 16 ? (t >> 6) : (t & 63));
      float ang = pos * inv;
      cs = cosf(ang); sn = sinf(ang);
    }
    float xq[4], xk[2], xv2[2], xz[4];
#pragma unroll
    for (int i = 0; i < 4; ++i) { xq[i] = pr[512 + i * 64 + lane]; xz[i] = pr[1280 + i * 64 + lane]; }
#pragma unroll
    for (int i = 0; i < 2; ++i) { xk[i] = pr[768 + i * 64 + lane]; xv2[i] = pr[896 + i * 64 + lane]; }
    {
      bf16_t* df = (bf16_t*)(ws + OFF_DIFF) + (size_t)row * 256;
#pragma unroll
      for (int gi = 0; gi < 4; ++gi) {
        const int hw = 1 << gi;
        int lo = max(t - hw, 0), hi = min(t + hw, L);
        float tv[16];
#pragma unroll
        for (int d = -hw; d < hw; ++d) {
          const int tt = t + d;
          const bool ok = tt >= 0 && tt < L;
          const float v = pr[(ptrdiff_t)(ok ? d : 0) * DIN + gi * 64 + lane];
          tv[d + hw] = ok ? v : 0.f;
        }
        float s = 0.f;
#pragma unroll
        for (int d = 0; d < 2 * hw; ++d) s += tv[d];
        float mean = s / (float)(hi - lo);
        df[gi * 64 + lane] = f2bf(mean - pr[gi * 64 + lane]);
      }
    }
#pragma unroll
    for (int hd = 0; hd < 4; ++hd) {
      float x = xq[hd];
      float ss = wave_sum(x * x, lane) * (1.f / 64.f);
      float xn = x * rsqrtf(ss + RMS_EPS) * qn;
      if (samp) {
        float o = shfl_x(xn, 32, lane);
        xn = lane < 32 ? xn * cs - o * sn : o * sn + xn * cs;
      }
      qb[(size_t)row * 256 + hd * 64 + lane] = f2bf(xn);
    }
#pragma unroll
    for (int hd = 0; hd < 2; ++hd) {
      float x = xk[hd];
      float ss = wave_sum(x * x, lane) * (1.f / 64.f);
      float xn = x * rsqrtf(ss + RMS_EPS) * kn;
      float vv = xv2[hd];
      if (samp) {
        float o = shfl_x(xn, 32, lane);
        xn = lane < 32 ? xn * cs - o * sn : o * sn + xn * cs;
        const size_t sb_ = (size_t)((l * 2 + b) * 2 + hd) * 163840;
        ((bf16_t*)(ws + OFF_KS))[sb_ + kfrag_off(512 + t, lane)] = f2bf(xn);
        ((bf16_t*)(ws + OFF_VST))[sb_ + vfrag_off(512 + t, lane)] = f2bf(vv);
      } else {
        size_t oo = ((size_t)(b * 2 + l) * 256 + t) * 128 + hd * 64 + lane;
        p.out[OUT_K + oo] = xn;
        p.out[OUT_V + oo] = vv;
        const size_t sb_ = (size_t)(b * 2 + hd) * 16384;
        ((bf16_t*)(ws + OFF_KP))[sb_ + kfrag_off(t, lane)] = f2bf(xn);
        ((bf16_t*)(ws + OFF_VPT))[sb_ + vfrag_off(t, lane)] = f2bf(vv);
      }
    }
    {
      float z[4]; float s = 0.f;
#pragma unroll
      for (int i = 0; i < 4; ++i) { z[i] = gelu_t(xz[i]); s += z[i]; }
      float mean = wave_sum(s, lane) * (1.f / 256.f);
      float q = 0.f;
#pragma unroll
      for (int i = 0; i < 4; ++i) { z[i] -= mean; q += z[i] * z[i]; }
      float rstd = rsqrtf(wave_sum(q, lane) * (1.f / 256.f) + LN_EPS);
      bf16_t* vct = (bf16_t*)(ws + OFF_VCT) + (size_t)(row >> 7) * 256 * 128 + (row & 127);
#pragma unroll
      for (int i = 0; i < 4; ++i) {
        int c = i * 64 + lane;
        float vn = z[i] * rstd * INP(I_CLG)[l * 256 + c] + INP(I_CLB)[l * 256 + c];
        vct[(size_t)c * 128] = f2bf(vn);
      }
    }
  }
}

struct AttnState { f32x16 o0, o1; float m, l; };
#define ATT_LOADKV(KF, VF, K0) do { const int kt_ = (K0) >> 5; \
    _Pragma("unroll") for (int s_ = 0; s_ < 4; ++s_) KF[s_] = *(const bf16x8*)(Kb + ((size_t)(kt_ * 4 + s_) * 64 + lane) * 8); \
    _Pragma("unroll") for (int s_ = 0; s_ < 2; ++s_) { \
      VF[s_][0] = *(const bf16x8*)(Vt + ((size_t)((kt_ * 2 + s_) * 2 + 0) * 64 + lane) * 8); \
      VF[s_][1] = *(const bf16x8*)(Vt + ((size_t)((kt_ * 2 + s_) * 2 + 1) * 64 + lane) * 8); } } while (0)

DI void attn_core(const bf16_t* __restrict__ Q, int qrow0, int head, const bf16_t* __restrict__ Kb,
                  const bf16_t* __restrict__ Vt, int kbeg, int kend, int lane, AttnState& st) {
  const int r = lane & 31, hh = lane >> 5;
  bf16x8 qf[4];
  const bf16_t* qp = Q + (size_t)(qrow0 + r) * 256 + head * 64 + 8 * hh;
#pragma unroll
  for (int s = 0; s < 4; ++s) qf[s] = *(const bf16x8*)(qp + 16 * s);
  f32x16 o0, o1;
#pragma unroll
  for (int i = 0; i < 16; ++i) { o0[i] = 0.f; o1[i] = 0.f; }
  float m = -INFINITY, lsum = 0.f;
  const float c = 0.125f * 1.4426950408889634f;
  bf16x8 kf[4], vf[2][2];
  ATT_LOADKV(kf, vf, kbeg);
  for (int k0 = kbeg; k0 < kend; k0 += 32) {
    const int kn = min(k0 + 32, kend - 32);
    bf16x8 kfn[4], vfn[2][2];
    ATT_LOADKV(kfn, vfn, kn);
    f32x16 sa;
#pragma unroll
    for (int i = 0; i < 16; ++i) sa[i] = 0.f;
#pragma unroll
    for (int s = 0; s < 4; ++s) sa = MFMA32(kf[s], qf[s], sa);
    float mx = sa[0];
#pragma unroll
    for (int i = 1; i < 16; ++i) mx = fmaxf(mx, sa[i]);
    mx = fmaxf(mx, shfl_x(mx, 32, lane));
    float mn = fmaxf(m, mx);
    float alpha = __builtin_amdgcn_exp2f((m - mn) * c);
    m = mn;
    float pv[16]; float ps = 0.f;
#pragma unroll
    for (int i = 0; i < 16; ++i) { pv[i] = __builtin_amdgcn_exp2f((sa[i] - mn) * c); ps += pv[i]; }
    lsum = lsum * alpha + ps;
#pragma unroll
    for (int i = 0; i < 16; ++i) { o0[i] *= alpha; o1[i] *= alpha; }
#pragma unroll
    for (int s = 0; s < 2; ++s) {
      bf16x8 pf = pack8(pv[8 * s], pv[8 * s + 1], pv[8 * s + 2], pv[8 * s + 3], pv[8 * s + 4], pv[8 * s + 5], pv[8 * s + 6], pv[8 * s + 7]);
      o0 = MFMA32(vf[s][0], pf, o0);
      o1 = MFMA32(vf[s][1], pf, o1);
    }
#pragma unroll
    for (int s = 0; s < 4; ++s) kf[s] = kfn[s];
#pragma unroll
    for (int s = 0; s < 2; ++s) { vf[s][0] = vfn[s][0]; vf[s][1] = vfn[s][1]; }
  }
  lsum += shfl_x(lsum, 32, lane);
  st.o0 = o0; st.o1 = o1; st.m = m; st.l = lsum;
}

DI void attn_prompt_item(const bf16_t* Q, int qrow0, int head, const bf16_t* Kb, const bf16_t* Vt, bf16_t* Y, int lane) {
  AttnState st;
  attn_core(Q, qrow0, head, Kb, Vt, 0, 256, lane, st);
  const int r = lane & 31, hh = lane >> 5;
  const float il = 1.f / st.l;
  bf16_t* yp = Y + (size_t)(qrow0 + r) * D + 512 + head * 64 + 4 * hh;
#pragma unroll
  for (int g4 = 0; g4 < 4; ++g4) {
    u32x2 a = {pk2(st.o0[4 * g4] * il, st.o0[4 * g4 + 1] * il), pk2(st.o0[4 * g4 + 2] * il, st.o0[4 * g4 + 3] * il)};
    u32x2 b = {pk2(st.o1[4 * g4] * il, st.o1[4 * g4 + 1] * il), pk2(st.o1[4 * g4 + 2] * il, st.o1[4 * g4 + 3] * il)};
    *(u32x2*)(yp + 8 * g4) = a;
    *(u32x2*)(yp + 32 + 8 * g4) = b;
  }
}

DI void attn_sample_item(const Params& p, int l, int it, char* shmc, int wid, int lane) {
  char* ws = PWS;
  float* Osh = (float*)shmc;
  float* Msh = Osh + 8 * 32 * 64;
  float* Lsh = Msh + 8 * 64;
  const int b = it >> 7, head = (it >> 5) & 3, qpair = it & 31;
  const int qsub = wid & 1, ksplit = wid >> 1;
  const int qrow0 = NPROMPT + b * 2048 + (qpair * 2 + qsub) * 32;
  AttnState st;
  attn_core((const bf16_t*)(ws + OFF_QB), qrow0, head, (const bf16_t*)(ws + OFF_KS) + (size_t)((l * 2 + b) * 2 + (head >> 1)) * 163840,
            (const bf16_t*)(ws + OFF_VST) + (size_t)((l * 2 + b) * 2 + (head >> 1)) * 163840, ksplit * 640, ksplit * 640 + 640, lane, st);
  Msh[wid * 64 + lane] = st.m; Lsh[wid * 64 + lane] = st.l;
#pragma unroll
  for (int i = 0; i < 16; ++i) { Osh[(wid * 32 + i) * 64 + lane] = st.o0[i]; Osh[(wid * 32 + 16 + i) * 64 + lane] = st.o1[i]; }
  __syncthreads();
  {
    const float c = 0.125f * 1.4426950408889634f;
    float mm[4], M = -INFINITY;
#pragma unroll
    for (int k = 0; k < 4; ++k) { mm[k] = Msh[(2 * k + qsub) * 64 + lane]; M = fmaxf(M, mm[k]); }
    float sc[4], Lt = 0.f;
#pragma unroll
    for (int k = 0; k < 4; ++k) { sc[k] = __builtin_amdgcn_exp2f((mm[k] - M) * c); Lt += Lsh[(2 * k + qsub) * 64 + lane] * sc[k]; }
    const float il = 1.f / Lt;
    float ov[8];
#pragma unroll
    for (int e = 0; e < 8; ++e) {
      float a = 0.f;
#pragma unroll
      for (int k = 0; k < 4; ++k) a += Osh[((2 * k + qsub) * 32 + ksplit * 8 + e) * 64 + lane] * sc[k];
      ov[e] = a * il;
    }
    const int r = lane & 31, hh = lane >> 5;
    const int dblk = ksplit >> 1, g4 = (ksplit & 1) * 2;
    bf16_t* yp = (bf16_t*)(ws + OFF_YMIX) + (size_t)(qrow0 + r) * D + 512 + head * 64 + dblk * 32 + 8 * g4 + 4 * hh;
    u32x2 a = {pk2(ov[0], ov[1]), pk2(ov[2], ov[3])};
    u32x2 bq = {pk2(ov[4], ov[5]), pk2(ov[6], ov[7])};
    *(u32x2*)yp = a;
    *(u32x2*)(yp + 8) = bq;
  }
  __syncthreads();
}

DI void chunk_item(const Params& p, int l, int ch, int hd, int sp, int lane) {
  const int fr = lane & 15, fq = lane >> 4;
  char* ws = PWS;
  const float* wsrc = INP(I_CWS) + ((size_t)(l * 4 + hd) * 128 + sp * 16 + fr) * 128 + fq * 8;
  const bf16_t* vb = (const bf16_t*)(ws + OFF_VCT) + ((size_t)ch * 256 + hd * 64 + fr) * 128 + fq * 8;
  f32x4 acc[4];
#pragma unroll
  for (int i = 0; i < 4; ++i) acc[i] = (f32x4){0.f, 0.f, 0.f, 0.f};
#pragma unroll
  for (int ks = 0; ks < 4; ++ks) {
    float4 a0 = *(const float4*)(wsrc + ks * 32), a1 = *(const float4*)(wsrc + ks * 32 + 4);
    bf16x8 af = pack8(a0.x, a0.y, a0.z, a0.w, a1.x, a1.y, a1.z, a1.w);
#pragma unroll
    for (int nt = 0; nt < 4; ++nt) {
      bf16x8 bfr = *(const bf16x8*)(vb + (size_t)nt * 16 * 128 + ks * 32);
      acc[nt] = MFMA16(af, bfr, acc[nt]);
    }
  }
  const float* proj = (const float*)(ws + OFF_R);
  bf16_t* ymix = (bf16_t*)(ws + OFF_YMIX);
  float uu[4][4];
#pragma unroll
  for (int j = 0; j < 4; ++j)
#pragma unroll
    for (int nt = 0; nt < 4; ++nt)
      uu[j][nt] = proj[(size_t)(ch * 128 + sp * 16 + fq * 4 + j) * DIN + 1024 + hd * 64 + nt * 16 + fr];
#pragma unroll
  for (int j = 0; j < 4; ++j) {
    int pp = sp * 16 + fq * 4 + j, tok = ch * 128 + pp;
    float bs = INP(I_CBS)[(l * 4 + hd) * 128 + pp];
#pragma unroll
    for (int nt = 0; nt < 4; ++nt) {
      int c = hd * 64 + nt * 16 + fr;
      ymix[(size_t)tok * D + 768 + c] = f2bf(gelu_t(uu[j][nt]) * (acc[nt][j] + bs));
    }
  }
}

constexpr int SSM_BU_LD = 132, SSM_H_LD = 136;
constexpr int SSM_WAVE_LDS = 16 * SSM_BU_LD * 4 + 16 * SSM_H_LD * 2;
#define LDS_FENCE() do { asm volatile("s_waitcnt lgkmcnt(0)" ::: "memory"); __builtin_amdgcn_wave_barrier(); } while (0)

DI void ssm_load_u(const Params& p, int ck, int g, int lane, bf16x8 (&af)[4]) {
  const int fr = lane & 15, fq = lane >> 4;
  const float* ub = (const float*)(PWS + OFF_R) + (size_t)ck * 64 * DIN + 256 + g * 16;
#pragma unroll
  for (int tile = 0; tile < 4; ++tile) {
    if (fq < 2) {
      const float* up = ub + (size_t)(tile * 16 + fr) * DIN + fq * 8;
      float4 a0 = *(const float4*)up, a1 = *(const float4*)(up + 4);
      af[tile] = pack8(a0.x, a0.y, a0.z, a0.w, a1.x, a1.y, a1.z, a1.w);
    } else {
      af[tile] = (bf16x8){0, 0, 0, 0, 0, 0, 0, 0};
    }
  }
}

template <int MODE, int DIR>
DI void ssm_dir(const Params& p, int l, int ck, int g, int lane, const bf16x8 (&af)[4], f32x4 (&yacc)[4], char* wlds) {
  constexpr bool CHAIN = MODE == 1;
  const int fr = lane & 15, fq = lane >> 4;
  char* ws = PWS;
  float* BU = (float*)wlds;
  bf16_t* Hs = (bf16_t*)(wlds + 16 * SSM_BU_LD * 4);
  const int gidx = (l * 2 + DIR) * 16 + g, idx = gidx * 64 + lane;
  bf16x8 bfr[8], cf[4];
#pragma unroll
  for (int nt = 0; nt < 8; ++nt) bfr[nt] = ((const bf16x8*)(ws + OFF_BF))[(gidx * 8 + nt) * 64 + lane];
#pragma unroll
  for (int ks = 0; ks < 4; ++ks) cf[ks] = ((const bf16x8*)(ws + OFF_CF))[(gidx * 4 + ks) * 64 + lane];
  const float2 lam = ((const float2*)(ws + OFF_LAMB))[idx];
  float hr = 0.f, hi = 0.f;
  const bool samp = ck >= 128;
  const int CPS = samp ? 32 : 4;
  const int cs = samp ? ((ck - 128) & 31) : (ck & 3);
  const int b = samp ? ((ck - 128) >> 5) : (ck >> 2);
  if (CHAIN) {
    const float2 lamT = ((const float2*)(ws + OFF_LAMT))[idx];
    const float2* Eb = (const float2*)(ws + OFF_E);
    const int cbase = ck - cs;
    if (samp) {
      size_t si = ((size_t)((b * 2 + l) * 2 + DIR) * 16 + g) * 64 + lane;
      hr = INP(I_SRE)[si]; hi = INP(I_SIM)[si];
    }
    const int nstep = DIR == 0 ? cs : CPS - 1 - cs;
    for (int base = 0; base < nstep; base += 8) {
      float2 ev[8];
#pragma unroll
      for (int k = 0; k < 8; ++k) {
        const int st = min(base + k, nstep - 1);
        const int c2 = DIR == 0 ? st : CPS - 1 - st;
        ev[k] = Eb[((size_t)((cbase + c2) * 16 + g) * 2 + DIR) * 64 + lane];
      }
#pragma unroll
      for (int k = 0; k < 8; ++k)
        if (base + k < nstep) {
          float nr = lamT.x * hr - lamT.y * hi + ev[k].x, ni = lamT.x * hi + lamT.y * hr + ev[k].y; hr = nr; hi = ni;
        }
    }
  }
#pragma unroll
  for (int sb = 0; sb < 4; ++sb) {
    const int tile = DIR ? 3 - sb : sb;
#pragma unroll
    for (int nt = 0; nt < 8; ++nt) {
      f32x4 cz = MFMA16(af[tile], bfr[nt], ((f32x4){0.f, 0.f, 0.f, 0.f}));
#pragma unroll
      for (int j = 0; j < 4; ++j) BU[(fq * 4 + j) * SSM_BU_LD + nt * 16 + fr] = cz[j];
    }
    LDS_FENCE();
#pragma unroll
    for (int q = 0; q < 16; ++q) {
      const int tt = DIR ? 15 - q : q;
      const float2 bu = *(const float2*)(BU + tt * SSM_BU_LD + 2 * lane);
      float nr = lam.x * hr - lam.y * hi + bu.x, ni = lam.x * hi + lam.y * hr + bu.y; hr = nr; hi = ni;
      *(unsigned*)(Hs + tt * SSM_H_LD + 2 * lane) = pk2(hr, hi);
    }
    LDS_FENCE();
#pragma unroll
    for (int ks = 0; ks < 4; ++ks) {
      bf16x8 ah = *(const bf16x8*)(Hs + fr * SSM_H_LD + ks * 32 + fq * 8);
      yacc[tile] = MFMA16(ah, cf[ks], yacc[tile]);
    }
    LDS_FENCE();
  }
  if (!CHAIN) {
    ((float2*)(ws + OFF_E))[((size_t)(ck * 16 + g) * 2 + DIR) * 64 + lane] = make_float2(hr, hi);
  } else if (!samp && ((DIR == 0 && cs == 3) || (DIR == 1 && cs == 0))) {
    size_t so = ((size_t)((b * 2 + l) * 2 + DIR) * 16 + g) * 64 + lane;
    p.out[OUT_SRE + so] = hr; p.out[OUT_SIM + so] = hi;
  }
}

#define SSM1_MODE 2
DI void ssm1_item(const Params& p, int l, int ck, int g, int dir, int lane, char* wlds) {
  bf16x8 af[4]; f32x4 yacc[4];
#pragma unroll
  for (int i = 0; i < 4; ++i) yacc[i] = (f32x4){0.f, 0.f, 0.f, 0.f};
  ssm_load_u(p, ck, g, lane, af);
  if (dir) ssm_dir<SSM1_MODE, 1>(p, l, ck, g, lane, af, yacc, wlds);
  else ssm_dir<SSM1_MODE, 0>(p, l, ck, g, lane, af, yacc, wlds);
}

DI void ssm2_item(const Params& p, int l, int ck, int g, int lane, char* wlds) {
  const int fr = lane & 15, fq = lane >> 4;
  bf16x8 af[4]; f32x4 yacc[4];
#pragma unroll
  for (int i = 0; i < 4; ++i) yacc[i] = (f32x4){0.f, 0.f, 0.f, 0.f};
  ssm_load_u(p, ck, g, lane, af);
  ssm_dir<1, 0>(p, l, ck, g, lane, af, yacc, wlds);
  ssm_dir<1, 1>(p, l, ck, g, lane, af, yacc, wlds);
  char* ws = PWS;
  const float* ub = (const float*)(ws + OFF_R) + (size_t)ck * 64 * DIN + 256 + g * 16;
  bf16_t* sg = (bf16_t*)(ws + OFF_SG);
  const int c = g * 16 + fr;
  const float dd = INP(I_SSMD)[l * 256 + c];
  float uv[4][4];
#pragma unroll
  for (int t4 = 0; t4 < 4; ++t4)
#pragma unroll
    for (int j = 0; j < 4; ++j) uv[t4][j] = ub[(size_t)(t4 * 16 + fq * 4 + j) * DIN + fr];
#pragma unroll
  for (int t4 = 0; t4 < 4; ++t4)
#pragma unroll
    for (int j = 0; j < 4; ++j) {
      size_t row = (size_t)ck * 64 + t4 * 16 + fq * 4 + j;
      sg[row * 256 + c] = f2bf(gelu_t(yacc[t4][j] + dd * uv[t4][j]));
    }
}

DI void ssm1_phase(const Params& p, int l, char* shmc, int bid, int nblk) {
  const int tid = otid(), wid = __builtin_amdgcn_readfirstlane(tid >> 6), lane = tid & 63;
  char* wlds = shmc + wid * SSM_WAVE_LDS;
  for (int it = wid * nblk + bid; it < 6144; it += nblk * 8) ssm1_item(p, l, it >> 5, (it >> 1) & 15, it & 1, lane, wlds);
}

DI void mix_phase(const Params& p, int l, char* shmc, int bid, int nblk) {
  const int tid = otid(), wid = __builtin_amdgcn_readfirstlane(tid >> 6), lane = tid & 63;
  char* ws = PWS;
  for (int it = bid; it < 256; it += nblk) attn_sample_item(p, l, it, shmc, wid, lane);
  for (int it = bid * 8 + wid; it < 1024; it += nblk * 8) {
    int b = it >> 5, head = (it >> 3) & 3, qt = it & 7;
    attn_prompt_item((const bf16_t*)(ws + OFF_QB), b * 256 + qt * 32, head, (const bf16_t*)(ws + OFF_KP) + (size_t)(b * 2 + (head >> 1)) * 16384,
                     (const bf16_t*)(ws + OFF_VPT) + (size_t)(b * 2 + (head >> 1)) * 16384, (bf16_t*)(ws + OFF_YMIX), lane);
  }
  __syncthreads();
  char* wlds = shmc + wid * SSM_WAVE_LDS;
  const int slot = wid * nblk + bid, nslot = nblk * 8;
  for (int it = slot; it < 6144; it += nslot) {
    if (it < 3072) ssm2_item(p, l, it >> 4, it & 15, lane, wlds);
    else { int j = it - 3072; chunk_item(p, l, j >> 5, (j >> 3) & 3, j & 7, lane); }
  }
}

constexpr int N_PHASE = 26;
DI void run_phase(const Params& p, int ph, char* shm, int bid, int nblk) {
  char* ws = PWS;
  if (ph == 0) { prep_phase(p, shm, bid, nblk); return; }
  if (ph == 25) { lnmod_phase(p, 1, 2, -1, 0, bid, nblk); return; }
  const int l = (ph - 1) / 12, s = (ph - 1) % 12;
  const bf16_t* hA = (const bf16_t*)(ws + OFF_H);
  bf16_t* hid = (bf16_t*)(ws + OFF_R);
  float* xy = (float*)(ws + OFF_XY);
  const float* modl = (const float*)(ws + OFF_MOD) + (size_t)l * 3 * 9216;
  EpiArgs ea; ea.f0 = nullptr; ea.b0 = nullptr; ea.c0 = nullptr; ea.cb = nullptr; ea.w = 0.f;
  switch (s) {
    case 0: if (l == 0) lnmod_phase(p, -1, 0, 0, 0, bid, nblk); else lnmod_phase(p, l - 1, 2, l, 0, bid, nblk); break;
    case 1: case 10: {
      int sI = s == 1 ? 0 : 1;
      ea.b0 = hid;
      gemm_phase<1024, EPI_SWIGLU>(hA, (const bf16_t*)(ws + OFF_W1T) + (size_t)(l * 2 + sI) * 5632 * 1024, 48, 22, ea, shm, bid, nblk);
    } break;
    case 2: case 11: {
      int sI = s == 2 ? 0 : 1;
      ea.f0 = xy; ea.c0 = modl + (s == 2 ? 2 : 8) * 1024; ea.w = 0.5f;
      gemm_phase<2816, EPI_RESID>(hid, (const bf16_t*)(ws + OFF_W2T) + (size_t)(l * 2 + sI) * 1024 * 2816, 48, 4, ea, shm, bid, nblk);
    } break;
    case 3: lnmod_phase(p, l, 0, l, 3, bid, nblk); break;
    case 4: {
      ea.f0 = (float*)(ws + OFF_R);
      gemm_phase<1024, EPI_F32>(hA, (const bf16_t*)(ws + OFF_WINT) + (size_t)l * 1536 * 1024, 48, 6, ea, shm, bid, nblk);
    } break;
    case 5: post_phase(p, l, shm, bid, nblk); ssm1_phase(p, l, shm, bid, nblk); break;
    case 6: mix_phase(p, l, shm, bid, nblk); break;
    case 7: {
      ea.b0 = (bf16_t*)(ws + OFF_YMIX); ea.cb = (const bf16_t*)(ws + OFF_SG); ea.c0 = INP(I_BGLU) + l * 256;
      gemm_phase<256, EPI_GLU>((const bf16_t*)(ws + OFF_SG), (const bf16_t*)(ws + OFF_WGLUT) + (size_t)l * 65536, 48, 1, ea, shm, bid, nblk);
      ea.c0 = INP(I_POOLS) + l * 256;
      int bid2 = (bid + nblk - (nblk >> 1)) % nblk;
      gemm_phase<256, EPI_POOL>((const bf16_t*)(ws + OFF_DIFF), (const bf16_t*)(ws + OFF_WPOOLT) + (size_t)l * 65536, 48, 1, ea, shm, bid2, nblk);
    } break;
    case 8: {
      ea.f0 = xy; ea.c0 = modl + 5 * 1024; ea.w = 1.0f;
      gemm_phase<1024, EPI_RESID>((const bf16_t*)(ws + OFF_YMIX), (const bf16_t*)(ws + OFF_WOUTT) + (size_t)l * 1024 * 1024, 48, 4, ea, shm, bid, nblk);
    } break;
    case 9: lnmod_phase(p, l, 1, l, 6, bid, nblk); break;
  }
}

__global__ __launch_bounds__(512, 2) void mega(Params p, int ph_lo, int ph_hi) {
  extern __shared__ __attribute__((aligned(16))) char shm[];
  __shared__ uint4 xb_words;
  const int bid = blockIdx.x, nblk = gridDim.x;
  if (threadIdx.x == 0) xb_words = make_uint4(0u, 0u, 0u, 0u);
  __syncthreads();
  const XcdBarrier xb = xcd_barrier_post((unsigned*)(p.ws + OFF_BAR), (volatile LAS unsigned*)&xb_words);
  for (int ph = ph_lo; ph < ph_hi; ++ph) {
    if (ph > ph_lo) {
      if (ph == ph_lo + 1) cg::this_grid().sync();
      else xcd_barrier(xb);
    }
    run_phase(p, ph, shm, bid, nblk);
  }
}

extern "C" void kernel_launch(void* const* d_in, const int* in_sizes, int n_in, void* d_out, int out_size, void* d_ws,
                              size_t ws_size, hipStream_t stream) {
  static int grid_blocks = 0;
  if (!grid_blocks) {
    hipFuncSetAttribute((const void*)mega, hipFuncAttributeMaxDynamicSharedMemorySize, GEMM_LDS);
    int dev = 0, cus = 0, per_cu = 0;
    hipGetDevice(&dev);
    hipDeviceGetAttribute(&cus, hipDeviceAttributeMultiprocessorCount, dev);
    hipOccupancyMaxActiveBlocksPerMultiprocessor(&per_cu, mega, 512, GEMM_LDS);
    if (per_cu < 1) per_cu = 1;
    if (per_cu > 1) per_cu = 1;
    grid_blocks = cus * per_cu;
  }
  Params p{};
  for (int i = 0; i < N_IN; ++i) p.in[i] = (const float*)d_in[i];
  p.out = (float*)d_out;
  p.ws = (char*)d_ws;
  hipMemsetAsync((char*)d_ws + OFF_BAR, 0, 16384, stream);
#if ONE_LAUNCH
  int lo = 0, hi = N_PHASE;
  void* args[] = {&p, &lo, &hi};
  hipError_t e = hipLaunchCooperativeKernel((const void*)mega, dim3(grid_blocks), dim3(512), args, GEMM_LDS, stream);
  if (e != hipSuccess) fprintf(stderr, "cooperative launch failed: %s (grid %d)\n", hipGetErrorString(e), grid_blocks);
#else
  for (int ph = 0; ph < N_PHASE; ++ph) mega<<<grid_blocks, 512, GEMM_LDS, stream>>>(p, ph, ph + 1);
#endif
}
```

```cpp
#include <hip/hip_runtime.h>
#include <hip/hip_cooperative_groups.h>
#include <cstdio>
namespace cg = cooperative_groups;

#define DI __device__ __forceinline__
typedef unsigned short bf16_t;
typedef __attribute__((ext_vector_type(8))) short bf16x8;
typedef __attribute__((ext_vector_type(4))) short s16x4;
typedef __attribute__((ext_vector_type(4))) float f32x4;
typedef __attribute__((ext_vector_type(16))) float f32x16;
typedef __attribute__((ext_vector_type(2))) float f32x2;
typedef __attribute__((ext_vector_type(2))) __bf16 bf16x2v;
typedef __attribute__((ext_vector_type(4))) unsigned u32x4;
typedef __attribute__((ext_vector_type(2))) unsigned u32x2;

#ifndef ONE_LAUNCH
#define ONE_LAUNCH 1
#endif

constexpr int D = 1024, NTOK = 12288, NPROMPT = 8192, DFF = 2816, DIN = 1536;
constexpr float ALPHA = 1.4142135623730951f;
constexpr float LN_EPS = 1e-5f, RMS_EPS = 1e-6f;
enum { I_XP = 0, I_XS, I_CK, I_CV, I_SRE, I_SIM, I_C, I_CCTX, I_WMOD, I_BMOD, I_LNG, I_LNB, I_W1, I_W2, I_WIN, I_WOUT,
       I_POOLW, I_POOLS, I_LRE, I_LIM, I_LSTEP, I_BRE, I_BIM, I_CRE, I_CIM, I_SSMD, I_WGLU, I_BGLU, I_QN, I_KN,
       I_CLG, I_CLB, I_CWS, I_CBS, N_IN };
constexpr size_t OUT_K = 12582912, OUT_V = 14680064, OUT_SRE = 16777216, OUT_SIM = 16908288;

constexpr size_t OFF_W1T = 0;
constexpr size_t OFF_W2T = OFF_W1T + 46137344;
constexpr size_t OFF_WINT = OFF_W2T + 23068672;
constexpr size_t OFF_WOUTT = OFF_WINT + 6291456;
constexpr size_t OFF_WGLUT = OFF_WOUTT + 4194304;
constexpr size_t OFF_WPOOLT = OFF_WGLUT + 262144;
constexpr size_t OFF_MOD = OFF_WPOOLT + 262144;
constexpr size_t OFF_XY = OFF_MOD + 221184;
constexpr size_t OFF_H = OFF_XY + 50331648;
constexpr size_t OFF_YMIX = OFF_H + 25165824;
constexpr size_t OFF_R = OFF_YMIX + 25165824;
constexpr size_t OFF_QB = OFF_R + 75497472;
constexpr size_t OFF_KP = OFF_QB + 6291456;
constexpr size_t OFF_KS = OFF_KP + 2097152;
constexpr size_t OFF_VPT = OFF_KS + 2621440;
constexpr size_t OFF_VST = OFF_VPT + 2097152;
constexpr size_t OFF_VCT = OFF_VST + 2621440;
constexpr size_t OFF_DIFF = OFF_VCT + 6291456;
constexpr size_t OFF_SG = OFF_DIFF + 6291456;
constexpr size_t OFF_E = OFF_SG + 6291456;
constexpr size_t OFF_LAMB = OFF_E + 3145728;
constexpr size_t OFF_LAMT = OFF_LAMB + 32768;
constexpr size_t OFF_BBAR = OFF_LAMT + 32768;
constexpr size_t OFF_BAR = OFF_BBAR + 524288;
constexpr size_t OFF_BF = OFF_BAR + 16384;
constexpr size_t OFF_CF = OFF_BF + 524288;
constexpr size_t WS_TOTAL = OFF_CF + 262144;

struct Params { const float* in[N_IN]; float* out; char* ws; };

DI int otid() {
  int z = 0; asm volatile("" : "+s"(z));
  int lane = __builtin_amdgcn_mbcnt_hi(-1, __builtin_amdgcn_mbcnt_lo(-1, z));
  int w = __builtin_amdgcn_readfirstlane(threadIdx.x >> 6);
  return w * 64 + lane;
}
DI int osgpr(int i) { asm volatile("" : "+s"(i)); return i; }
#define INP(i) (p.in[osgpr(i)])
DI char* ows(char* w) { asm volatile("" : "+s"(w)); return w; }
#define PWS ows(p.ws)
DI unsigned pk2(float a, float b) { f32x2 v = {a, b}; bf16x2v r = __builtin_convertvector(v, bf16x2v); return __builtin_bit_cast(unsigned, r); }
DI bf16_t f2bf(float a) { return (bf16_t)(pk2(a, 0.f) & 0xffffu); }
DI float bf2f(bf16_t v) { return __uint_as_float(((unsigned)v) << 16); }
DI bf16x8 pack8(float a0, float a1, float a2, float a3, float a4, float a5, float a6, float a7) {
  u32x4 u = {pk2(a0, a1), pk2(a2, a3), pk2(a4, a5), pk2(a6, a7)};
  return __builtin_bit_cast(bf16x8, u);
}
DI float gelu_t(float x) {
  float z = 0.7978845608028654f * (x + 0.044715f * x * x * x);
  float e = __expf(2.f * z);
  float th = 1.f - 2.f / (e + 1.f);
  return 0.5f * x * (1.f + th);
}
DI float sigmoid_f(float x) { return 1.f / (1.f + __expf(-x)); }
DI float shfl_x(float v, int mask, int lane) {
  return __int_as_float(__builtin_amdgcn_ds_bpermute((lane ^ mask) << 2, __float_as_int(v)));
}
template <int CTRL> DI float dpp_f(float v) {
  return __int_as_float(__builtin_amdgcn_update_dpp(0, __float_as_int(v), CTRL, 0xf, 0xf, true));
}
DI float wave_sum(float v, int lane) {
  (void)lane;
  v += dpp_f<0xB1>(v);
  v += dpp_f<0x4E>(v);
  v += dpp_f<0x141>(v);
  v += dpp_f<0x140>(v);
  const int iv = __float_as_int(v);
  float r0 = __int_as_float(__builtin_amdgcn_readlane(iv, 0)), r1 = __int_as_float(__builtin_amdgcn_readlane(iv, 16));
  float r2 = __int_as_float(__builtin_amdgcn_readlane(iv, 32)), r3 = __int_as_float(__builtin_amdgcn_readlane(iv, 48));
  return (r0 + r1) + (r2 + r3);
}
DI size_t kfrag_off(int key, int d) {
  return ((size_t)((key >> 5) * 4 + (d >> 4)) * 64 + ((d >> 3) & 1) * 32 + (key & 31)) * 8 + (d & 7);
}
DI size_t vfrag_off(int key, int d) {
  const int kk = key & 31, w = kk & 15;
  return ((size_t)(((key >> 5) * 2 + (kk >> 4)) * 2 + (d >> 5)) * 64 + ((w >> 2) & 1) * 32 + (d & 31)) * 8 + (((w >> 3) << 2) | (w & 3));
}

#define MFMA16(a, b, c) __builtin_amdgcn_mfma_f32_16x16x32_bf16((a), (b), (c), 0, 0, 0)
#define MFMA32(a, b, c) __builtin_amdgcn_mfma_f32_32x32x16_bf16((a), (b), (c), 0, 0, 0)


#define XB_TMO      128
#define XB_XCNT(j)  (256  + 64 * (j))
#define XB_XSUB(j)  (1280 + 64 * (j))
#define XB_XGEN(j)  (2304 + 64 * (j))
#define XB_TOP      3328
#define XB_TOPGEN   3392
#define XCD_BAR_WORDS 3456
#define XB_SPIN_CAP (1u << 18)
#define LAS __attribute__((address_space(3)))
DI unsigned xb_ld(unsigned* p) { return __hip_atomic_load(p, __ATOMIC_RELAXED, __HIP_MEMORY_SCOPE_AGENT); }
DI unsigned xb_add(unsigned* p, unsigned v) { return __hip_atomic_fetch_add(p, v, __ATOMIC_RELAXED, __HIP_MEMORY_SCOPE_AGENT); }
DI unsigned xb_xcc_id() { return (unsigned)__builtin_amdgcn_s_getreg((3 << 11) | 20) & 0xFu; }
#define XB_SPIN(cond, bar) do { unsigned _sp = 0; while (cond) { __builtin_amdgcn_s_sleep(1); \
    if ((++_sp & 255u) == 0u) { if (xb_ld(&(bar)[XB_TMO])) break; if (_sp > XB_SPIN_CAP) { atomicAdd(&(bar)[XB_TMO], 1u); break; } } } } while (0)
struct XcdBarrier { unsigned* bar; unsigned x; volatile LAS unsigned* st; };
DI XcdBarrier xcd_barrier_post(unsigned* bar, volatile LAS unsigned* st) {
  XcdBarrier b; b.bar = bar; b.x = xb_xcc_id(); b.st = st;
  if (threadIdx.x == 0) (void)xb_add(&bar[XB_XCNT(b.x)], 1u);
  return b;
}
DI void xcd_barrier_complete(unsigned* bar, unsigned x, unsigned& nloc, unsigned& nx) {
  const unsigned G = gridDim.x * gridDim.y * gridDim.z;
  unsigned sum, cnt, mine, sp = 0u;
  for (;;) {
    sum = 0u; cnt = 0u; mine = 0u;
#pragma unroll
    for (unsigned j = 0; j < 16; ++j) { const unsigned c = xb_ld(&bar[XB_XCNT(j)]); sum += c; cnt += (c > 0u) ? 1u : 0u; mine = (j == x) ? c : mine; }
    if (sum == G) break;
    __builtin_amdgcn_s_sleep(1);
    if ((++sp & 255u) == 0u) { if (xb_ld(&bar[XB_TMO])) break; if (sp > XB_SPIN_CAP) { atomicAdd(&bar[XB_TMO], 1u); break; } }
  }
  nloc = mine > 0u ? mine : 1u; nx = cnt > 0u ? cnt : 1u;
}
DI void xcd_barrier(const XcdBarrier& b) {
  asm volatile("s_waitcnt vmcnt(0)" ::: "memory");
  __syncthreads();
  if (threadIdx.x == 0) {
    unsigned* bar = b.bar;
    __builtin_amdgcn_s_waitcnt(0);
    unsigned nloc = b.st[0], nx = b.st[1];
    if (nloc == 0u) { xcd_barrier_complete(bar, b.x, nloc, nx); b.st[0] = nloc; b.st[1] = nx; }
    const unsigned old = xb_add(&bar[XB_XSUB(b.x)], 1u);
    const unsigned gen = old / nloc;
    if (old + 1u == (gen + 1u) * nloc) {
      __builtin_amdgcn_fence(__ATOMIC_RELEASE, "agent");
      asm volatile("s_waitcnt vmcnt(0)" ::: "memory");
      const unsigned og = xb_add(&bar[XB_TOP], 1u);
      const unsigned tg = og / nx;
      if (og + 1u == (tg + 1u) * nx) xb_add(&bar[XB_TOPGEN], 1u);
      else XB_SPIN(xb_ld(&bar[XB_TOPGEN]) == tg, bar);
      __builtin_amdgcn_fence(__ATOMIC_ACQUIRE, "agent");
      xb_add(&bar[XB_XGEN(b.x)], 1u);
      asm volatile("s_waitcnt vmcnt(0)" ::: "memory");
    } else {
      XB_SPIN(xb_ld(&bar[XB_XGEN(b.x)]) == gen, bar);
      __builtin_amdgcn_fence(__ATOMIC_ACQUIRE, "agent");
      asm volatile("s_waitcnt vmcnt(0)" ::: "memory");
    }
  }
  __syncthreads();
}

constexpr int BM = 256, BK = 64, HALF = 128, NXCD = 8, WGM = 8, HT = HALF * BK;
constexpr int GEMM_LDS = 8 * HT * 2;

DI int lds_byte(int r, int c) {
  int st = (r >> 4) * 2 + (c >> 5), rr = r & 15, cc = c & 31, ob = rr * 64 + cc * 2;
  return st * 1024 + (ob ^ (((ob >> 9) & 1) << 5));
}
DI void stage_rc(int b, int& R, int& C) {
  int st = b / 1024, sb = b % 1024, swz = sb ^ (((sb >> 9) & 1) << 5);
  R = (st >> 1) * 16 + swz / 64; C = (st & 1) * 32 + (swz % 64) / 2;
}

enum { EPI_SWIGLU = 0, EPI_RESID, EPI_F32, EPI_GLU, EPI_POOL };
struct EpiArgs {
  float* f0;
  bf16_t* b0;
  const float* c0;
  const bf16_t* cb;
  float w;
};

template <int K, int MODE, int SPLITS = 1>
DI void gemm_phase(const bf16_t* __restrict__ A, const bf16_t* __restrict__ Bt, int nM, int nN, EpiArgs ea,
                   char* shmc, int bid, int nblk) {
  bf16_t* shm = (bf16_t*)shmc;
#define SA(b, h) (shm + ((b) * 2 + (h)) * HT)
#define SB(b, h) (shm + (4 + (b) * 2 + (h)) * HT)
#define STAGE(P, RS, SOFF, kt) do { const int _so = (SOFF) + (kt0 + (kt)) * (BK * 2); \
    __builtin_amdgcn_raw_ptr_buffer_load_lds(RS, (__attribute__((address_space(3))) void*)((char*)(P) + wid * 1024), 16, so0, _so, 0, 0); \
    __builtin_amdgcn_raw_ptr_buffer_load_lds(RS, (__attribute__((address_space(3))) void*)((char*)(P) + wid * 1024 + 8192), 16, so1, _so, 0, 0); } while (0)
#define LDA(dst, b, h) for (int m = 0; m < 4; ++m) for (int k = 0; k < 2; ++k) \
    dst[m][k] = *reinterpret_cast<const bf16x8*>((char*)SA(b, h) + lds_byte(wr * 64 + m * 16 + fr, k * 32 + fq * 8))
#define LDB(dst, b, h) for (int n = 0; n < 2; ++n) for (int k = 0; k < 2; ++k) \
    dst[n][k] = *reinterpret_cast<const bf16x8*>((char*)SB(b, h) + lds_byte(wc * 32 + n * 16 + fr, k * 32 + fq * 8))
#define MMA(ai, bj, At, Bt_) do { __builtin_amdgcn_s_setprio(1); \
    for (int m = 0; m < 4; ++m) for (int n = 0; n < 2; ++n) for (int k = 0; k < 2; ++k) \
      acc[ai][bj][m][n] = MFMA16(At[m][k], Bt_[n][k], acc[ai][bj][m][n]); \
    __builtin_amdgcn_s_setprio(0); } while (0)
#define WAIT_V(n) asm volatile("s_waitcnt vmcnt(" #n ")" ::: "memory")
#define WAIT_L(n) asm volatile("s_waitcnt lgkmcnt(" #n ")" ::: "memory")
#define BAR __builtin_amdgcn_s_barrier()
#define SCHED __builtin_amdgcn_sched_barrier(0)
  const int tid = otid();
  const int wid = __builtin_amdgcn_readfirstlane(tid >> 6), lane = tid & 63, wr = wid >> 2, wc = wid & 3, fr = lane & 15, fq = lane >> 4;
  const __amdgpu_buffer_rsrc_t rsA = __builtin_amdgcn_make_buffer_rsrc((void*)A, 0, 0x7fffffff, 0x00020000);
  const __amdgpu_buffer_rsrc_t rsB = __builtin_amdgcn_make_buffer_rsrc((void*)Bt, 0, 0x7fffffff, 0x00020000);
  unsigned so0, so1;
  { int R, C; stage_rc(tid * 16, R, C); so0 = (unsigned)(R * K + C) * 2u; stage_rc(tid * 16 + 8192, R, C); so1 = (unsigned)(R * K + C) * 2u; }
  const int nwg = nM * nN;
  for (int unit = bid; unit < nwg * SPLITS; unit += nblk) {
    const int sp = SPLITS == 1 ? 0 : unit / nwg, tile = SPLITS == 1 ? unit : unit % nwg;
    const int kt0 = SPLITS == 1 ? 0 : (sp == 0 ? 0 : sp == 1 ? 12 : sp == 2 ? 24 : 34);
    const int nt = SPLITS == 1 ? K / BK : (sp < 2 ? 12 : 10);
    int wgid = tile;
    { int q = nwg / NXCD, r = nwg % NXCD, xcd = wgid % NXCD, off = wgid / NXCD;
      wgid = (xcd < r ? xcd * (q + 1) : r * (q + 1) + (xcd - r) * q) + off; }
    int nig = WGM * nN, gid = wgid / nig, fm = gid * WGM, gsz = min(nM - fm, WGM);
    int pm = fm + ((wgid % nig) % gsz), pn = (wgid % nig) / gsz, brow = pm * BM, bcol = pn * BM;
    const int A0 = brow * K * 2, A1 = A0 + HALF * K * 2, B0p = bcol * K * 2, B1p = B0p + HALF * K * 2;
    f32x4 acc[2][2][4][2] = {};
    bf16x8 At[4][2], B0[2][2], B1[2][2];
    STAGE(SB(0, 0), rsB, B0p, 0); STAGE(SA(0, 0), rsA, A0, 0);
    STAGE(SB(0, 1), rsB, B1p, 0); STAGE(SA(0, 1), rsA, A1, 0);
    if (wr == 1) BAR;
    WAIT_V(4); BAR;
    STAGE(SB(1, 0), rsB, B0p, 1); STAGE(SA(1, 0), rsA, A0, 1); STAGE(SB(1, 1), rsB, B1p, 1);
    WAIT_V(6); BAR;
    for (int t = 0; t < nt - 2; t += 2) {
      LDB(B0, 0, 0); SCHED; LDA(At, 0, 0); STAGE(SA(1, 1), rsA, A1, t + 1);
      WAIT_L(8); BAR; WAIT_L(0); MMA(0, 0, At, B0); BAR; SCHED;
      LDB(B1, 0, 1); STAGE(SB(0, 0), rsB, B0p, t + 2);
      BAR; WAIT_L(0); MMA(0, 1, At, B1); BAR;
      LDA(At, 0, 1); STAGE(SA(0, 0), rsA, A0, t + 2);
      BAR; WAIT_L(0); MMA(1, 0, At, B0); BAR; SCHED;
      STAGE(SB(0, 1), rsB, B1p, t + 2);
      WAIT_V(6); BAR; MMA(1, 1, At, B1); BAR;
      LDB(B0, 1, 0); SCHED; LDA(At, 1, 0); STAGE(SA(0, 1), rsA, A1, t + 2);
      WAIT_L(8); BAR; WAIT_L(0); MMA(0, 0, At, B0); BAR; SCHED;
      LDB(B1, 1, 1); STAGE(SB(1, 0), rsB, B0p, t + 3);
      BAR; WAIT_L(0); MMA(0, 1, At, B1); BAR;
      LDA(At, 1, 1); STAGE(SA(1, 0), rsA, A0, t + 3);
      BAR; WAIT_L(0); MMA(1, 0, At, B0); BAR; SCHED;
      STAGE(SB(1, 1), rsB, B1p, t + 3);
      WAIT_V(6); BAR; MMA(1, 1, At, B1); BAR;
    }
    { LDB(B0, 0, 0); LDA(At, 0, 0); STAGE(SA(1, 1), rsA, A1, nt - 1);
      BAR; WAIT_L(0); MMA(0, 0, At, B0); BAR;
      LDB(B1, 0, 1); BAR; WAIT_L(0); MMA(0, 1, At, B1); BAR;
      LDA(At, 0, 1); WAIT_V(4); BAR; WAIT_L(0); MMA(1, 0, At, B0); MMA(1, 1, At, B1); BAR; }
    { LDB(B0, 1, 0); LDA(At, 1, 0); WAIT_V(2); BAR; WAIT_L(0); MMA(0, 0, At, B0); BAR;
      LDB(B1, 1, 1); WAIT_V(0); BAR; WAIT_L(0); MMA(0, 1, At, B1); BAR;
      LDA(At, 1, 1); BAR; WAIT_L(0); MMA(1, 0, At, B0); MMA(1, 1, At, B1); BAR; }
    if (wr == 0) BAR;
    const int ci = brow < NPROMPT ? 0 : 1 + (brow - NPROMPT) / 2048;
    const int te = otid(), le = te & 63, wide = te >> 6;
    const int wr = wide >> 2, wc = wide & 3, fr = le & 15, fq = le >> 4;
    const int rbase = brow + wr * 64 + fq * 4, cbase = bcol + wc * 32 + fr;
    if (MODE == EPI_SWIGLU) {
#pragma unroll
      for (int ai = 0; ai < 2; ++ai)
#pragma unroll
        for (int m = 0; m < 4; ++m)
#pragma unroll
          for (int j = 0; j < 4; ++j) {
            const int row = rbase + ai * HALF + m * 16 + j;
#pragma unroll
            for (int n = 0; n < 2; ++n) {
              float g = acc[ai][0][m][n][j], u = acc[ai][1][m][n][j];
              ea.b0[(size_t)row * DFF + pn * 128 + wc * 32 + n * 16 + fr] = f2bf(g * sigmoid_f(g) * u);
            }
          }
    } else if (MODE == EPI_RESID) {
      float gate[2][2];
#pragma unroll
      for (int bj = 0; bj < 2; ++bj)
#pragma unroll
        for (int n = 0; n < 2; ++n) gate[bj][n] = ea.w * ea.c0[ci * 9216 + cbase + bj * HALF + n * 16];
#pragma unroll
      for (int ai = 0; ai < 2; ++ai) {
        float* xb = ea.f0 + (size_t)(rbase + ai * HALF) * D + cbase;
        float xv[4][4][2][2];
#pragma unroll
        for (int m = 0; m < 4; ++m)
#pragma unroll
          for (int j = 0; j < 4; ++j)
#pragma unroll
            for (int bj = 0; bj < 2; ++bj)
#pragma unroll
              for (int n = 0; n < 2; ++n) xv[m][j][bj][n] = xb[(size_t)(m * 16 + j) * D + bj * HALF + n * 16];
#pragma unroll
        for (int m = 0; m < 4; ++m)
#pragma unroll
          for (int j = 0; j < 4; ++j)
#pragma unroll
            for (int bj = 0; bj < 2; ++bj)
#pragma unroll
              for (int n = 0; n < 2; ++n)
                xb[(size_t)(m * 16 + j) * D + bj * HALF + n * 16] = xv[m][j][bj][n] + gate[bj][n] * acc[ai][bj][m][n][j];
      }
    } else if (MODE == EPI_GLU) {
      float bg[2][2];
#pragma unroll
      for (int bj = 0; bj < 2; ++bj)
#pragma unroll
        for (int n = 0; n < 2; ++n) bg[bj][n] = ea.c0[cbase + bj * HALF + n * 16];
#pragma unroll
      for (int ai = 0; ai < 2; ++ai) {
        float gv[4][4][2][2];
        const bf16_t* gb = ea.cb + (size_t)(rbase + ai * HALF) * 256 + cbase;
#pragma unroll
        for (int m = 0; m < 4; ++m)
#pragma unroll
          for (int j = 0; j < 4; ++j)
#pragma unroll
            for (int bj = 0; bj < 2; ++bj)
#pragma unroll
              for (int n = 0; n < 2; ++n) gv[m][j][bj][n] = bf2f(gb[(size_t)(m * 16 + j) * 256 + bj * HALF + n * 16]);
        bf16_t* yb = ea.b0 + (size_t)(rbase + ai * HALF) * D + 256 + cbase;
#pragma unroll
        for (int m = 0; m < 4; ++m)
#pragma unroll
          for (int j = 0; j < 4; ++j)
#pragma unroll
            for (int bj = 0; bj < 2; ++bj)
#pragma unroll
              for (int n = 0; n < 2; ++n)
                yb[(size_t)(m * 16 + j) * D + bj * HALF + n * 16] =
                    f2bf(gv[m][j][bj][n] * sigmoid_f(acc[ai][bj][m][n][j] + bg[bj][n]));
      }
    } else {
      float ps[2][2];
#pragma unroll
      for (int bj = 0; bj < 2; ++bj)
#pragma unroll
        for (int n = 0; n < 2; ++n) ps[bj][n] = MODE == EPI_POOL ? ea.c0[cbase + bj * HALF + n * 16] : 1.f;
#pragma unroll
      for (int ai = 0; ai < 2; ++ai)
#pragma unroll
        for (int m = 0; m < 4; ++m)
#pragma unroll
          for (int j = 0; j < 4; ++j) {
            const int row = rbase + ai * HALF + m * 16 + j;
#pragma unroll
            for (int bj = 0; bj < 2; ++bj)
#pragma unroll
              for (int n = 0; n < 2; ++n) {
                const int col = cbase + bj * HALF + n * 16;
                float a = acc[ai][bj][m][n][j];
                if (MODE == EPI_F32) ea.f0[(size_t)row * DIN + col] = a;
                else ea.b0[(size_t)row * D + col] = f2bf(a * ps[bj][n]);
              }
          }
    }
  }
#undef SA
#undef SB
}

constexpr int T_W1 = 16 * 88, T_W2 = 44 * 16, T_IN = 16 * 24, T_OUT = 256, T_GLU = 16;
constexpr int PER_L = 2 * T_W1 + 2 * T_W2 + T_IN + T_OUT + T_GLU;
DI void convert_units(const Params& p, char* shmc, int unit_begin, int unit_end, int worker, int nworkers) {
  const int tid = otid();
  char* ws = PWS;
  constexpr int NTL = 4;
  __syncthreads();
  for (int u = unit_begin + worker; u < unit_end; u += nworkers) {
    const int it0 = u * NTL;
    bf16_t* dsts[NTL]; int Ks[NTL], modes[NTL], kts[NTL], ntiles[NTL];
    float4 v[NTL][2];
#pragma unroll
    for (int q = 0; q < NTL; ++q) {
      const int it = it0 + q;
      int l = it / PER_L, r = it % PER_L;
      const float* src; bf16_t* dst; int K, N, mode = 0;
      if (r < 2 * T_W1) {
        int s2 = r / T_W1; r %= T_W1;
        src = INP(I_W1) + (size_t)(l * 2 + s2) * 1024 * 5632; dst = (bf16_t*)(ws + OFF_W1T) + (size_t)(l * 2 + s2) * 5632 * 1024;
        K = 1024; N = 5632; mode = 1;
      } else if (r < 2 * T_W1 + 2 * T_W2) {
        r -= 2 * T_W1; int s2 = r / T_W2; r %= T_W2;
        src = INP(I_W2) + (size_t)(l * 2 + s2) * 2816 * 1024; dst = (bf16_t*)(ws + OFF_W2T) + (size_t)(l * 2 + s2) * 1024 * 2816;
        K = 2816; N = 1024;
      } else if (r < 2 * T_W1 + 2 * T_W2 + T_IN) {
        r -= 2 * T_W1 + 2 * T_W2;
        src = INP(I_WIN) + (size_t)l * 1024 * 1536; dst = (bf16_t*)(ws + OFF_WINT) + (size_t)l * 1536 * 1024;
        K = 1024; N = 1536;
      } else if (r < 2 * T_W1 + 2 * T_W2 + T_IN + T_OUT) {
        r -= 2 * T_W1 + 2 * T_W2 + T_IN;
        src = INP(I_WOUT) + (size_t)l * 1024 * 1024; dst = (bf16_t*)(ws + OFF_WOUTT) + (size_t)l * 1024 * 1024;
        K = 1024; N = 1024;
      } else {
        r -= 2 * T_W1 + 2 * T_W2 + T_IN + T_OUT;
        src = INP(I_WGLU) + (size_t)l * 256 * 256; dst = (bf16_t*)(ws + OFF_WGLUT) + (size_t)l * 256 * 256;
        K = 256; N = 256;
      }
      const int nkt = K / 64, kt = r % nkt, ntile = r / nkt;
      dsts[q] = dst; Ks[q] = K; modes[q] = mode; kts[q] = kt; ntiles[q] = ntile;
#pragma unroll
      for (int i = 0; i < 2; ++i) {
        int k = (tid >> 4) + 32 * i, n = (tid & 15) * 4;
        v[q][i] = *(const float4*)(src + (size_t)(kt * 64 + k) * N + ntile * 64 + n);
      }
    }
#pragma unroll
    for (int q = 0; q < NTL; ++q) {
      float* tile = (float*)shmc + q * (64 * 65);
#pragma unroll
      for (int i = 0; i < 2; ++i) {
        int k = (tid >> 4) + 32 * i, n = (tid & 15) * 4;
        tile[k * 65 + n] = v[q][i].x; tile[k * 65 + n + 1] = v[q][i].y; tile[k * 65 + n + 2] = v[q][i].z; tile[k * 65 + n + 3] = v[q][i].w;
      }
    }
    __syncthreads();
#pragma unroll
    for (int q = 0; q < NTL; ++q) {
      const float* tile = (const float*)shmc + q * (64 * 65);
      int n = tid >> 3, kk = (tid & 7) * 8;
      int nsrc = ntiles[q] * 64 + n, nrow = nsrc;
      if (modes[q] == 1) {
        if (nsrc < 2816) nrow = (nsrc >> 7) * 256 + (nsrc & 127);
        else { int mm = nsrc - 2816; nrow = (mm >> 7) * 256 + 128 + (mm & 127); }
      }
      bf16x8 o = pack8(tile[(kk + 0) * 65 + n], tile[(kk + 1) * 65 + n], tile[(kk + 2) * 65 + n], tile[(kk + 3) * 65 + n],
                       tile[(kk + 4) * 65 + n], tile[(kk + 5) * 65 + n], tile[(kk + 6) * 65 + n], tile[(kk + 7) * 65 + n]);
      *(bf16x8*)(dsts[q] + (size_t)nrow * Ks[q] + kts[q] * 64 + kk) = o;
    }
    __syncthreads();
  }
}

DI void prep_phase(const Params& p, char* shmc, int bid, int nblk) {
  const int tid = otid(), wid = tid >> 6, lane = tid & 63;
  char* ws = PWS;
  convert_units(p, shmc, 0, T_W1 / 4, bid, nblk);
  const int gtid = bid * 512 + tid, gn = nblk * 512;
  for (int i = gtid; i < 2 * 65536; i += gn) {
    int l = i >> 16, n = (i >> 8) & 255, k = i & 255;
    int gi = n >> 6, d = n & 63, gj = k >> 6, c = k & 63;
    float v = (gi == gj) ? INP(I_POOLW)[((size_t)(l * 4 + gi) * 64 + c) * 64 + d] : 0.f;
    ((bf16_t*)(ws + OFF_WPOOLT))[i] = f2bf(v);
  }
  {
    float* sc = (float*)shmc + 4 * 64 * 65;
    float* red = sc + 3 * 1024;
    for (int i = tid; i < 3 * 1024; i += 512) {
      int ci = i >> 10, k = i & 1023;
      float v = ci == 0 ? INP(I_CCTX)[k] : INP(I_C)[(ci - 1) * 1024 + k];
      sc[i] = v * sigmoid_f(v);
    }
    __syncthreads();
    for (int it = bid; it < 288; it += nblk) {
      int l = it / 144, cb = it % 144, col = cb * 64 + lane;
      const float* wp = INP(I_WMOD) + (size_t)l * 1024 * 9216 + col;
      float a0 = 0.f, a1 = 0.f, a2 = 0.f;
#pragma unroll 8
      for (int k = wid * 128; k < wid * 128 + 128; ++k) {
        float w = wp[(size_t)k * 9216];
        a0 += sc[k] * w; a1 += sc[1024 + k] * w; a2 += sc[2048 + k] * w;
      }
      red[(wid * 3 + 0) * 64 + lane] = a0; red[(wid * 3 + 1) * 64 + lane] = a1; red[(wid * 3 + 2) * 64 + lane] = a2;
      __syncthreads();
      if (tid < 192) {
        int ci = tid >> 6;
        float s = 0.f;
        for (int w = 0; w < 8; ++w) s += red[(w * 3 + ci) * 64 + lane];
        ((float*)(ws + OFF_MOD))[(size_t)(l * 3 + ci) * 9216 + col] = s + INP(I_BMOD)[l * 9216 + col];
      }
      __syncthreads();
    }
  }
  for (int i = gtid; i < 2 * 2 * 512 * 128; i += gn) {
    int c = i & 127, t = (i >> 7) & 511, b = (i >> 16) & 1, l = i >> 17;
    size_t si = ((size_t)(b * 2 + l) * 512 + t) * 128 + c;
    const size_t sb_ = (size_t)((l * 2 + b) * 2 + (c >> 6)) * 163840;
    ((bf16_t*)(ws + OFF_KS))[sb_ + kfrag_off(t, c & 63)] = f2bf(INP(I_CK)[si]);
    ((bf16_t*)(ws + OFF_VST))[sb_ + vfrag_off(t, c & 63)] = f2bf(INP(I_CV)[si]);
  }
  for (int i = gtid; i < 4096; i += gn) {
    float lre = INP(I_LRE)[i], lim = INP(I_LIM)[i];
    float dt = expf(INP(I_LSTEP)[i >> 6]);
    float e = expf(lre * dt), ang = lim * dt;
    float br = e * cosf(ang), bi = e * sinf(ang);
    float ar = br - 1.f, ai = bi, den = lre * lre + lim * lim;
    float cr = (ar * lre + ai * lim) / den, cim = (ai * lre - ar * lim) / den;
    ((float2*)(ws + OFF_LAMB))[i] = make_float2(br, bi);
    float pr = br, pi = bi;
    for (int s = 0; s < 6; ++s) { float nr = pr * pr - pi * pi, ni = 2.f * pr * pi; pr = nr; pi = ni; }
    ((float2*)(ws + OFF_LAMT))[i] = make_float2(pr, pi);
  }
  for (int i = gtid; i < 64 * 8 * 64; i += gn) {
    const int gidx = i >> 9, nt = (i >> 6) & 7, ln = i & 63, fr = ln & 15, fq = ln >> 4;
    bf16x8 o = (bf16x8){0, 0, 0, 0, 0, 0, 0, 0};
    if (fq < 2) {
      const int n = nt * 8 + (fr >> 1), idx = gidx * 64 + n;
      float lre = INP(I_LRE)[idx], lim = INP(I_LIM)[idx];
      float dt = expf(INP(I_LSTEP)[gidx]);
      float e = expf(lre * dt), ang = lim * dt;
      float br = e * cosf(ang), bi = e * sinf(ang);
      float ar = br - 1.f, ai = bi, den = lre * lre + lim * lim;
      float cr = (ar * lre + ai * lim) / den, cim = (ai * lre - ar * lim) / den;
      float v[8];
#pragma unroll
      for (int j = 0; j < 8; ++j) {
        float xr = INP(I_BRE)[(size_t)idx * 16 + fq * 8 + j], xi = INP(I_BIM)[(size_t)idx * 16 + fq * 8 + j];
        v[j] = (fr & 1) ? cr * xi + cim * xr : cr * xr - cim * xi;
      }
      o = pack8(v[0], v[1], v[2], v[3], v[4], v[5], v[6], v[7]);
    }
    ((bf16x8*)(ws + OFF_BF))[i] = o;
  }
  for (int i = gtid; i < 64 * 4 * 64; i += gn) {
    const int gidx = i >> 8, ks = (i >> 6) & 3, ln = i & 63, fr = ln & 15, fq = ln >> 4;
    const size_t co = ((size_t)gidx * 16 + fr) * 64 + ks * 16 + fq * 4;
    float4 cr = *(const float4*)(INP(I_CRE) + co), cim = *(const float4*)(INP(I_CIM) + co);
    ((bf16x8*)(ws + OFF_CF))[i] = pack8(cr.x, -cim.x, cr.y, -cim.y, cr.z, -cim.z, cr.w, -cim.w);
  }
}

DI void lnmod_phase(const Params& p, int l_ln, int ln_idx, int l_mod, int mod_idx, int bid, int nblk) {
  const int tid = otid(), wid = tid >> 6, lane = tid & 63;
  float* xy = (float*)(PWS + OFF_XY);
  bf16_t* h = (bf16_t*)(PWS + OFF_H);
  const float* modv = (const float*)(PWS + OFF_MOD);
  const int stride = nblk * 8;
  float4 gg[4], bb[4];
  if (l_ln >= 0) {
    const float* g = INP(I_LNG) + (l_ln * 3 + ln_idx) * 1024;
    const float* b = INP(I_LNB) + (l_ln * 3 + ln_idx) * 1024;
#pragma unroll
    for (int i = 0; i < 4; ++i) { gg[i] = *(const float4*)(g + lane * 4 + i * 256); bb[i] = *(const float4*)(b + lane * 4 + i * 256); }
  }
#define LN_SRC(R) (l_ln < 0 ? ((R) < NPROMPT ? INP(I_XP) + (size_t)(R) * D : INP(I_XS) + (size_t)((R) - NPROMPT) * D) : xy + (size_t)(R) * D)
  int row = bid * 8 + wid;
  float4 nv[4];
  if (row < NTOK) {
    const float* src = LN_SRC(row);
#pragma unroll
    for (int i = 0; i < 4; ++i) nv[i] = *(const float4*)(src + lane * 4 + i * 256);
  }
  for (; row < NTOK; row += stride) {
    float4 v[4];
#pragma unroll
    for (int i = 0; i < 4; ++i) v[i] = nv[i];
    if (row + stride < NTOK) {
      const float* src = LN_SRC(row + stride);
#pragma unroll
      for (int i = 0; i < 4; ++i) nv[i] = *(const float4*)(src + lane * 4 + i * 256);
    }
    float4 ma[4], mc[4];
    if (l_mod >= 0) {
      int ci = row < NPROMPT ? 0 : 1 + (row - NPROMPT) / 2048;
      const float* sh = modv + (size_t)(l_mod * 3 + ci) * 9216 + mod_idx * 1024;
#pragma unroll
      for (int i = 0; i < 4; ++i) { ma[i] = *(const float4*)(sh + lane * 4 + i * 256); mc[i] = *(const float4*)(sh + 1024 + lane * 4 + i * 256); }
    }
    if (l_ln >= 0) {
      float s = 0.f;
#pragma unroll
      for (int i = 0; i < 4; ++i) s += v[i].x + v[i].y + v[i].z + v[i].w;
      float mean = wave_sum(s, lane) * (1.f / 1024.f);
      float q = 0.f;
#pragma unroll
      for (int i = 0; i < 4; ++i) {
        v[i].x -= mean; v[i].y -= mean; v[i].z -= mean; v[i].w -= mean;
        q += v[i].x * v[i].x + v[i].y * v[i].y + v[i].z * v[i].z + v[i].w * v[i].w;
      }
      float rstd = rsqrtf(wave_sum(q, lane) * (1.f / 1024.f) + LN_EPS);
#pragma unroll
      for (int i = 0; i < 4; ++i) {
        v[i].x = v[i].x * rstd * gg[i].x + bb[i].x; v[i].y = v[i].y * rstd * gg[i].y + bb[i].y;
        v[i].z = v[i].z * rstd * gg[i].z + bb[i].z; v[i].w = v[i].w * rstd * gg[i].w + bb[i].w;
      }
    }
    float* dx = l_mod < 0 ? p.out + (size_t)row * D : xy + (size_t)row * D;
    const float xs = l_mod < 0 ? 1.f : ALPHA;
#pragma unroll
    for (int i = 0; i < 4; ++i) *(float4*)(dx + lane * 4 + i * 256) = make_float4(v[i].x * xs, v[i].y * xs, v[i].z * xs, v[i].w * xs);
    if (l_mod >= 0) {
#pragma unroll
      for (int i = 0; i < 4; ++i) {
        u32x2 o = {pk2(v[i].x * (1.f + mc[i].x) + ma[i].x, v[i].y * (1.f + mc[i].y) + ma[i].y),
                   pk2(v[i].z * (1.f + mc[i].z) + ma[i].z, v[i].w * (1.f + mc[i].w) + ma[i].w)};
        *(u32x2*)(h + (size_t)row * D + lane * 4 + i * 256) = o;
      }
    }
  }
#undef LN_SRC
}

DI void post_phase(const Params& p, int l, char* shmc, int bid, int nblk) {
  const int tid = otid(), wid = tid >> 6, lane = tid & 63;
  char* ws = PWS;
  const float* proj = (const float*)(ws + OFF_R);
  bf16_t* qb = (bf16_t*)(ws + OFF_QB);
  const float qn = INP(I_QN)[l * 64 + lane], kn = INP(I_KN)[l * 64 + lane];
  const int fi = lane & 15;
  const float inv = exp2f(-(float)fi * (13.287712379549449f / 16.f));
  for (int row = bid * 8 + wid; row < NTOK; row += nblk * 8) {
    const float* pr = proj + (size_t)row * DIN;
    const bool samp = row >= NPROMPT;
    int b, t, L;
    if (samp) { b = (row - NPROMPT) >> 11; t = (row - NPROMPT) & 2047; L = 2048; }
    else { b = row >> 8; t = row & 255; L = 256; }
    float cs = 1.f, sn = 0.f;
    if (samp) {
      float pos = (float)((lane & 31) < 16 ? (t >> 6) : (t & 63));
      float ang = pos * inv;
      cs = cosf(ang); sn = sinf(ang);
    }
    float xq[4], xk[2], xv2[2], xz[4];
#pragma unroll
    for (int i = 0; i < 4; ++i) { xq[i] = pr[512 + i * 64 + lane]; xz[i] = pr[1280 + i * 64 + lane]; }
#pragma unroll
    for (int i = 0; i < 2; ++i) { xk[i] = pr[768 + i * 64 + lane]; xv2[i] = pr[896 + i * 64 + lane]; }
    {
      bf16_t* df = (bf16_t*)(ws + OFF_DIFF) + (size_t)row * 256;
#pragma unroll
      for (int gi = 0; gi < 4; ++gi) {
        const int hw = 1 << gi;
        int lo = max(t - hw, 0), hi = min(t + hw, L);
        float tv[16];
#pragma unroll
        for (int d = -hw; d < hw; ++d) {
          const int tt = t + d;
          const bool ok = tt >= 0 && tt < L;
          const float v = pr[(ptrdiff_t)(ok ? d : 0) * DIN + gi * 64 + lane];
          tv[d + hw] = ok ? v : 0.f;
        }
        float s = 0.f;
#pragma unroll
        for (int d = 0; d < 2 * hw; ++d) s += tv[d];
        float mean = s / (float)(hi - lo);
        df[gi * 64 + lane] = f2bf(mean - pr[gi * 64 + lane]);
      }
    }
#pragma unroll
    for (int hd = 0; hd < 4; ++hd) {
      float x = xq[hd];
      float ss = wave_sum(x * x, lane) * (1.f / 64.f);
      float xn = x * rsqrtf(ss + RMS_EPS) * qn;
      if (samp) {
        float o = shfl_x(xn, 32, lane);
        xn = lane < 32 ? xn * cs - o * sn : o * sn + xn * cs;
      }
      qb[(size_t)row * 256 + hd * 64 + lane] = f2bf(xn);
    }
#pragma unroll
    for (int hd = 0; hd < 2; ++hd) {
      float x = xk[hd];
      float ss = wave_sum(x * x, lane) * (1.f / 64.f);
      float xn = x * rsqrtf(ss + RMS_EPS) * kn;
      float vv = xv2[hd];
      if (samp) {
        float o = shfl_x(xn, 32, lane);
        xn = lane < 32 ? xn * cs - o * sn : o * sn + xn * cs;
        const size_t sb_ = (size_t)((l * 2 + b) * 2 + hd) * 163840;
        ((bf16_t*)(ws + OFF_KS))[sb_ + kfrag_off(512 + t, lane)] = f2bf(xn);
        ((bf16_t*)(ws + OFF_VST))[sb_ + vfrag_off(512 + t, lane)] = f2bf(vv);
      } else {
        size_t oo = ((size_t)(b * 2 + l) * 256 + t) * 128 + hd * 64 + lane;
        p.out[OUT_K + oo] = xn;
        p.out[OUT_V + oo] = vv;
        const size_t sb_ = (size_t)(b * 2 + hd) * 16384;
        ((bf16_t*)(ws + OFF_KP))[sb_ + kfrag_off(t, lane)] = f2bf(xn);
        ((bf16_t*)(ws + OFF_VPT))[sb_ + vfrag_off(t, lane)] = f2bf(vv);
      }
    }
    {
      float z[4]; float s = 0.f;
#pragma unroll
      for (int i = 0; i < 4; ++i) { z[i] = gelu_t(xz[i]); s += z[i]; }
      float mean = wave_sum(s, lane) * (1.f / 256.f);
      float q = 0.f;
#pragma unroll
      for (int i = 0; i < 4; ++i) { z[i] -= mean; q += z[i] * z[i]; }
      float rstd = rsqrtf(wave_sum(q, lane) * (1.f / 256.f) + LN_EPS);
      bf16_t* vct = (bf16_t*)(ws + OFF_VCT) + (size_t)(row >> 7) * 256 * 128 + (row & 127);
#pragma unroll
      for (int i = 0; i < 4; ++i) {
        int c = i * 64 + lane;
        float vn = z[i] * rstd * INP(I_CLG)[l * 256 + c] + INP(I_CLB)[l * 256 + c];
        vct[(size_t)c * 128] = f2bf(vn);
      }
    }
  }
}

struct AttnState { f32x16 o0, o1; float m, l; };
#define ATT_LOADKV(KF, VF, K0) do { const int kt_ = (K0) >> 5; \
    _Pragma("unroll") for (int s_ = 0; s_ < 4; ++s_) KF[s_] = *(const bf16x8*)(Kb + ((size_t)(kt_ * 4 + s_) * 64 + lane) * 8); \
    _Pragma("unroll") for (int s_ = 0; s_ < 2; ++s_) { \
      VF[s_][0] = *(const bf16x8*)(Vt + ((size_t)((kt_ * 2 + s_) * 2 + 0) * 64 + lane) * 8); \
      VF[s_][1] = *(const bf16x8*)(Vt + ((size_t)((kt_ * 2 + s_) * 2 + 1) * 64 + lane) * 8); } } while (0)

DI void attn_core(const bf16_t* __restrict__ Q, int qrow0, int head, const bf16_t* __restrict__ Kb,
                  const bf16_t* __restrict__ Vt, int kbeg, int kend, int lane, AttnState& st) {
  const int r = lane & 31, hh = lane >> 5;
  bf16x8 qf[4];
  const bf16_t* qp = Q + (size_t)(qrow0 + r) * 256 + head * 64 + 8 * hh;
#pragma unroll
  for (int s = 0; s < 4; ++s) qf[s] = *(const bf16x8*)(qp + 16 * s);
  f32x16 o0, o1;
#pragma unroll
  for (int i = 0; i < 16; ++i) { o0[i] = 0.f; o1[i] = 0.f; }
  float m = -INFINITY, lsum = 0.f;
  const float c = 0.125f * 1.4426950408889634f;
  bf16x8 kf[4], vf[2][2];
  ATT_LOADKV(kf, vf, kbeg);
  for (int k0 = kbeg; k0 < kend; k0 += 32) {
    const int kn = min(k0 + 32, kend - 32);
    bf16x8 kfn[4], vfn[2][2];
    ATT_LOADKV(kfn, vfn, kn);
    f32x16 sa;
#pragma unroll
    for (int i = 0; i < 16; ++i) sa[i] = 0.f;
#pragma unroll
    for (int s = 0; s < 4; ++s) sa = MFMA32(kf[s], qf[s], sa);
    float mx = sa[0];
#pragma unroll
    for (int i = 1; i < 16; ++i) mx = fmaxf(mx, sa[i]);
    mx = fmaxf(mx, shfl_x(mx, 32, lane));
    float mn = fmaxf(m, mx);
    float alpha = __builtin_amdgcn_exp2f((m - mn) * c);
    m = mn;
    float pv[16]; float ps = 0.f;
#pragma unroll
    for (int i = 0; i < 16; ++i) { pv[i] = __builtin_amdgcn_exp2f((sa[i] - mn) * c); ps += pv[i]; }
    lsum = lsum * alpha + ps;
#pragma unroll
    for (int i = 0; i < 16; ++i) { o0[i] *= alpha; o1[i] *= alpha; }
#pragma unroll
    for (int s = 0; s < 2; ++s) {
      bf16x8 pf = pack8(pv[8 * s], pv[8 * s + 1], pv[8 * s + 2], pv[8 * s + 3], pv[8 * s + 4], pv[8 * s + 5], pv[8 * s + 6], pv[8 * s + 7]);
      o0 = MFMA32(vf[s][0], pf, o0);
      o1 = MFMA32(vf[s][1], pf, o1);
    }
#pragma unroll
    for (int s = 0; s < 4; ++s) kf[s] = kfn[s];
#pragma unroll
    for (int s = 0; s < 2; ++s) { vf[s][0] = vfn[s][0]; vf[s][1] = vfn[s][1]; }
  }
  lsum += shfl_x(lsum, 32, lane);
  st.o0 = o0; st.o1 = o1; st.m = m; st.l = lsum;
}

DI void attn_prompt_item(const bf16_t* Q, int qrow0, int head, const bf16_t* Kb, const bf16_t* Vt, bf16_t* Y, int lane) {
  AttnState st;
  attn_core(Q, qrow0, head, Kb, Vt, 0, 256, lane, st);
  const int r = lane & 31, hh = lane >> 5;
  const float il = 1.f / st.l;
  bf16_t* yp = Y + (size_t)(qrow0 + r) * D + 512 + head * 64 + 4 * hh;
#pragma unroll
  for (int g4 = 0; g4 < 4; ++g4) {
    u32x2 a = {pk2(st.o0[4 * g4] * il, st.o0[4 * g4 + 1] * il), pk2(st.o0[4 * g4 + 2] * il, st.o0[4 * g4 + 3] * il)};
    u32x2 b = {pk2(st.o1[4 * g4] * il, st.o1[4 * g4 + 1] * il), pk2(st.o1[4 * g4 + 2] * il, st.o1[4 * g4 + 3] * il)};
    *(u32x2*)(yp + 8 * g4) = a;
    *(u32x2*)(yp + 32 + 8 * g4) = b;
  }
}

DI void attn_sample_item(const Params& p, int l, int it, char* shmc, int wid, int lane) {
  char* ws = PWS;
  float* Osh = (float*)shmc;
  float* Msh = Osh + 8 * 32 * 64;
  float* Lsh = Msh + 8 * 64;
  const int b = it >> 7, head = (it >> 5) & 3, qpair = it & 31;
  const int qsub = wid & 1, ksplit = wid >> 1;
  const int qrow0 = NPROMPT + b * 2048 + (qpair * 2 + qsub) * 32;
  AttnState st;
  attn_core((const bf16_t*)(ws + OFF_QB), qrow0, head, (const bf16_t*)(ws + OFF_KS) + (size_t)((l * 2 + b) * 2 + (head >> 1)) * 163840,
            (const bf16_t*)(ws + OFF_VST) + (size_t)((l * 2 + b) * 2 + (head >> 1)) * 163840, ksplit * 640, ksplit * 640 + 640, lane, st);
  Msh[wid * 64 + lane] = st.m; Lsh[wid * 64 + lane] = st.l;
#pragma unroll
  for (int i = 0; i < 16; ++i) { Osh[(wid * 32 + i) * 64 + lane] = st.o0[i]; Osh[(wid * 32 + 16 + i) * 64 + lane] = st.o1[i]; }
  __syncthreads();
  {
    const float c = 0.125f * 1.4426950408889634f;
    float mm[4], M = -INFINITY;
#pragma unroll
    for (int k = 0; k < 4; ++k) { mm[k] = Msh[(2 * k + qsub) * 64 + lane]; M = fmaxf(M, mm[k]); }
    float sc[4], Lt = 0.f;
#pragma unroll
    for (int k = 0; k < 4; ++k) { sc[k] = __builtin_amdgcn_exp2f((mm[k] - M) * c); Lt += Lsh[(2 * k + qsub) * 64 + lane] * sc[k]; }
    const float il = 1.f / Lt;
    float ov[8];
#pragma unroll
    for (int e = 0; e < 8; ++e) {
      float a = 0.f;
#pragma unroll
      for (int k = 0; k < 4; ++k) a += Osh[((2 * k + qsub) * 32 + ksplit * 8 + e) * 64 + lane] * sc[k];
      ov[e] = a * il;
    }
    const int r = lane & 31, hh = lane >> 5;
    const int dblk = ksplit >> 1, g4 = (ksplit & 1) * 2;
    bf16_t* yp = (bf16_t*)(ws + OFF_YMIX) + (size_t)(qrow0 + r) * D + 512 + head * 64 + dblk * 32 + 8 * g4 + 4 * hh;
    u32x2 a = {pk2(ov[0], ov[1]), pk2(ov[2], ov[3])};
    u32x2 bq = {pk2(ov[4], ov[5]), pk2(ov[6], ov[7])};
    *(u32x2*)yp = a;
    *(u32x2*)(yp + 8) = bq;
  }
  __syncthreads();
}

DI void chunk_item(const Params& p, int l, int ch, int hd, int sp, int lane) {
  const int fr = lane & 15, fq = lane >> 4;
  char* ws = PWS;
  const float* wsrc = INP(I_CWS) + ((size_t)(l * 4 + hd) * 128 + sp * 16 + fr) * 128 + fq * 8;
  const bf16_t* vb = (const bf16_t*)(ws + OFF_VCT) + ((size_t)ch * 256 + hd * 64 + fr) * 128 + fq * 8;
  f32x4 acc[4];
#pragma unroll
  for (int i = 0; i < 4; ++i) acc[i] = (f32x4){0.f, 0.f, 0.f, 0.f};
#pragma unroll
  for (int ks = 0; ks < 4; ++ks) {
    float4 a0 = *(const float4*)(wsrc + ks * 32), a1 = *(const float4*)(wsrc + ks * 32 + 4);
    bf16x8 af = pack8(a0.x, a0.y, a0.z, a0.w, a1.x, a1.y, a1.z, a1.w);
#pragma unroll
    for (int nt = 0; nt < 4; ++nt) {
      bf16x8 bfr = *(const bf16x8*)(vb + (size_t)nt * 16 * 128 + ks * 32);
      acc[nt] = MFMA16(af, bfr, acc[nt]);
    }
  }
  const float* proj = (const float*)(ws + OFF_R);
  bf16_t* ymix = (bf16_t*)(ws + OFF_YMIX);
  float uu[4][4];
#pragma unroll
  for (int j = 0; j < 4; ++j)
#pragma unroll
    for (int nt = 0; nt < 4; ++nt)
      uu[j][nt] = proj[(size_t)(ch * 128 + sp * 16 + fq * 4 + j) * DIN + 1024 + hd * 64 + nt * 16 + fr];
#pragma unroll
  for (int j = 0; j < 4; ++j) {
    int pp = sp * 16 + fq * 4 + j, tok = ch * 128 + pp;
    float bs = INP(I_CBS)[(l * 4 + hd) * 128 + pp];
#pragma unroll
    for (int nt = 0; nt < 4; ++nt) {
      int c = hd * 64 + nt * 16 + fr;
      ymix[(size_t)tok * D + 768 + c] = f2bf(gelu_t(uu[j][nt]) * (acc[nt][j] + bs));
    }
  }
}

constexpr int SSM_BU_LD = 132, SSM_H_LD = 136;
constexpr int SSM_WAVE_LDS = 16 * SSM_BU_LD * 4 + 16 * SSM_H_LD * 2;
#define LDS_FENCE() do { asm volatile("s_waitcnt lgkmcnt(0)" ::: "memory"); __builtin_amdgcn_wave_barrier(); } while (0)

DI void ssm_load_u(const Params& p, int ck, int g, int lane, bf16x8 (&af)[4]) {
  const int fr = lane & 15, fq = lane >> 4;
  const float* ub = (const float*)(PWS + OFF_R) + (size_t)ck * 64 * DIN + 256 + g * 16;
#pragma unroll
  for (int tile = 0; tile < 4; ++tile) {
    if (fq < 2) {
      const float* up = ub + (size_t)(tile * 16 + fr) * DIN + fq * 8;
      float4 a0 = *(const float4*)up, a1 = *(const float4*)(up + 4);
      af[tile] = pack8(a0.x, a0.y, a0.z, a0.w, a1.x, a1.y, a1.z, a1.w);
    } else {
      af[tile] = (bf16x8){0, 0, 0, 0, 0, 0, 0, 0};
    }
  }
}

template <int MODE, int DIR>
DI void ssm_dir(const Params& p, int l, int ck, int g, int lane, const bf16x8 (&af)[4], f32x4 (&yacc)[4], char* wlds) {
  constexpr bool CHAIN = MODE == 1;
  const int fr = lane & 15, fq = lane >> 4;
  char* ws = PWS;
  float* BU = (float*)wlds;
  bf16_t* Hs = (bf16_t*)(wlds + 16 * SSM_BU_LD * 4);
  const int gidx = (l * 2 + DIR) * 16 + g, idx = gidx * 64 + lane;
  bf16x8 bfr[8], cf[4];
#pragma unroll
  for (int nt = 0; nt < 8; ++nt) bfr[nt] = ((const bf16x8*)(ws + OFF_BF))[(gidx * 8 + nt) * 64 + lane];
#pragma unroll
  for (int ks = 0; ks < 4; ++ks) cf[ks] = ((const bf16x8*)(ws + OFF_CF))[(gidx * 4 + ks) * 64 + lane];
  const float2 lam = ((const float2*)(ws + OFF_LAMB))[idx];
  float hr = 0.f, hi = 0.f;
  const bool samp = ck >= 128;
  const int CPS = samp ? 32 : 4;
  const int cs = samp ? ((ck - 128) & 31) : (ck & 3);
  const int b = samp ? ((ck - 128) >> 5) : (ck >> 2);
  if (CHAIN) {
    const float2 lamT = ((const float2*)(ws + OFF_LAMT))[idx];
    const float2* Eb = (const float2*)(ws + OFF_E);
    const int cbase = ck - cs;
    if (samp) {
      size_t si = ((size_t)((b * 2 + l) * 2 + DIR) * 16 + g) * 64 + lane;
      hr = INP(I_SRE)[si]; hi = INP(I_SIM)[si];
    }
    const int nstep = DIR == 0 ? cs : CPS - 1 - cs;
    for (int base = 0; base < nstep; base += 8) {
      float2 ev[8];
#pragma unroll
      for (int k = 0; k < 8; ++k) {
        const int st = min(base + k, nstep - 1);
        const int c2 = DIR == 0 ? st : CPS - 1 - st;
        ev[k] = Eb[((size_t)((cbase + c2) * 16 + g) * 2 + DIR) * 64 + lane];
      }
#pragma unroll
      for (int k = 0; k < 8; ++k)
        if (base + k < nstep) {
          float nr = lamT.x * hr - lamT.y * hi + ev[k].x, ni = lamT.x * hi + lamT.y * hr + ev[k].y; hr = nr; hi = ni;
        }
    }
  }
#pragma unroll
  for (int sb = 0; sb < 4; ++sb) {
    const int tile = DIR ? 3 - sb : sb;
#pragma unroll
    for (int nt = 0; nt < 8; ++nt) {
      f32x4 cz = MFMA16(af[tile], bfr[nt], ((f32x4){0.f, 0.f, 0.f, 0.f}));
#pragma unroll
      for (int j = 0; j < 4; ++j) BU[(fq * 4 + j) * SSM_BU_LD + nt * 16 + fr] = cz[j];
    }
    LDS_FENCE();
#pragma unroll
    for (int q = 0; q < 16; ++q) {
      const int tt = DIR ? 15 - q : q;
      const float2 bu = *(const float2*)(BU + tt * SSM_BU_LD + 2 * lane);
      float nr = lam.x * hr - lam.y * hi + bu.x, ni = lam.x * hi + lam.y * hr + bu.y; hr = nr; hi = ni;
      *(unsigned*)(Hs + tt * SSM_H_LD + 2 * lane) = pk2(hr, hi);
    }
    LDS_FENCE();
#pragma unroll
    for (int ks = 0; ks < 4; ++ks) {
      bf16x8 ah = *(const bf16x8*)(Hs + fr * SSM_H_LD + ks * 32 + fq * 8);
      yacc[tile] = MFMA16(ah, cf[ks], yacc[tile]);
    }
    LDS_FENCE();
  }
  if (!CHAIN) {
    ((float2*)(ws + OFF_E))[((size_t)(ck * 16 + g) * 2 + DIR) * 64 + lane] = make_float2(hr, hi);
  } else if (!samp && ((DIR == 0 && cs == 3) || (DIR == 1 && cs == 0))) {
    size_t so = ((size_t)((b * 2 + l) * 2 + DIR) * 16 + g) * 64 + lane;
    p.out[OUT_SRE + so] = hr; p.out[OUT_SIM + so] = hi;
  }
}

#define SSM1_MODE 2
DI void ssm1_item(const Params& p, int l, int ck, int g, int dir, int lane, char* wlds) {
  bf16x8 af[4]; f32x4 yacc[4];
#pragma unroll
  for (int i = 0; i < 4; ++i) yacc[i] = (f32x4){0.f, 0.f, 0.f, 0.f};
  ssm_load_u(p, ck, g, lane, af);
  if (dir) ssm_dir<SSM1_MODE, 1>(p, l, ck, g, lane, af, yacc, wlds);
  else ssm_dir<SSM1_MODE, 0>(p, l, ck, g, lane, af, yacc, wlds);
}

DI void ssm2_item(const Params& p, int l, int ck, int g, int lane, char* wlds) {
  const int fr = lane & 15, fq = lane >> 4;
  bf16x8 af[4]; f32x4 yacc[4];
#pragma unroll
  for (int i = 0; i < 4; ++i) yacc[i] = (f32x4){0.f, 0.f, 0.f, 0.f};
  ssm_load_u(p, ck, g, lane, af);
  ssm_dir<1, 0>(p, l, ck, g, lane, af, yacc, wlds);
  ssm_dir<1, 1>(p, l, ck, g, lane, af, yacc, wlds);
  char* ws = PWS;
  const float* ub = (const float*)(ws + OFF_R) + (size_t)ck * 64 * DIN + 256 + g * 16;
  bf16_t* sg = (bf16_t*)(ws + OFF_SG);
  const int c = g * 16 + fr;
  const float dd = INP(I_SSMD)[l * 256 + c];
  float uv[4][4];
#pragma unroll
  for (int t4 = 0; t4 < 4; ++t4)
#pragma unroll
    for (int j = 0; j < 4; ++j) uv[t4][j] = ub[(size_t)(t4 * 16 + fq * 4 + j) * DIN + fr];
#pragma unroll
  for (int t4 = 0; t4 < 4; ++t4)
#pragma unroll
    for (int j = 0; j < 4; ++j) {
      size_t row = (size_t)ck * 64 + t4 * 16 + fq * 4 + j;
      sg[row * 256 + c] = f2bf(gelu_t(yacc[t4][j] + dd * uv[t4][j]));
    }
}

DI void ssm1_phase(const Params& p, int l, char* shmc, int bid, int nblk) {
  const int tid = otid(), wid = __builtin_amdgcn_readfirstlane(tid >> 6), lane = tid & 63;
  char* wlds = shmc + wid * SSM_WAVE_LDS;
  for (int it = wid * nblk + bid; it < 6144; it += nblk * 8) ssm1_item(p, l, it >> 5, (it >> 1) & 15, it & 1, lane, wlds);
}

DI void mix_phase(const Params& p, int l, char* shmc, int bid, int nblk) {
  const int tid = otid(), wid = __builtin_amdgcn_readfirstlane(tid >> 6), lane = tid & 63;
  char* ws = PWS;
  for (int it = bid; it < 256; it += nblk) attn_sample_item(p, l, it, shmc, wid, lane);
  for (int it = bid * 8 + wid; it < 1024; it += nblk * 8) {
    int b = it >> 5, head = (it >> 3) & 3, qt = it & 7;
    attn_prompt_item((const bf16_t*)(ws + OFF_QB), b * 256 + qt * 32, head, (const bf16_t*)(ws + OFF_KP) + (size_t)(b * 2 + (head >> 1)) * 16384,
                     (const bf16_t*)(ws + OFF_VPT) + (size_t)(b * 2 + (head >> 1)) * 16384, (bf16_t*)(ws + OFF_YMIX), lane);
  }
  __syncthreads();
  char* wlds = shmc + wid * SSM_WAVE_LDS;
  const int slot = wid * nblk + bid, nslot = nblk * 8;
  for (int it = slot; it < 6144; it += nslot) {
    if (it < 3072) ssm2_item(p, l, it >> 4, it & 15, lane, wlds);
    else { int j = it - 3072; chunk_item(p, l, j >> 5, (j >> 3) & 3, j & 7, lane); }
  }
}

constexpr int N_PHASE = 26;
DI void run_phase(const Params& p, int ph, char* shm, int bid, int nblk) {
  char* ws = PWS;
  if (ph == 0) { prep_phase(p, shm, bid, nblk); return; }
  if (ph == 25) { lnmod_phase(p, 1, 2, -1, 0, bid, nblk); return; }
  const int l = (ph - 1) / 12, s = (ph - 1) % 12;
  const bf16_t* hA = (const bf16_t*)(ws + OFF_H);
  bf16_t* hid = (bf16_t*)(ws + OFF_R);
  float* xy = (float*)(ws + OFF_XY);
  const float* modl = (const float*)(ws + OFF_MOD) + (size_t)l * 3 * 9216;
  EpiArgs ea; ea.f0 = nullptr; ea.b0 = nullptr; ea.c0 = nullptr; ea.cb = nullptr; ea.w = 0.f;
  switch (s) {
    case 0: if (l == 0) lnmod_phase(p, -1, 0, 0, 0, bid, nblk); else lnmod_phase(p, l - 1, 2, l, 0, bid, nblk); break;
    case 1: case 10: {
      int sI = s == 1 ? 0 : 1;
      ea.b0 = hid;
      gemm_phase<1024, EPI_SWIGLU>(hA, (const bf16_t*)(ws + OFF_W1T) + (size_t)(l * 2 + sI) * 5632 * 1024, 48, 22, ea, shm, bid, nblk);
      if (l == 0 && nblk == 256 && bid >= 32) {
        if (sI == 0) convert_units(p, shm, T_W1 / 4, PER_L / 4, bid - 32, 224);
        else convert_units(p, shm, PER_L / 4, (PER_L + 2 * T_W1 + T_W2) / 4, bid - 32, 224);
      } else if (l == 0 && nblk != 256 && sI == 0) {
        convert_units(p, shm, T_W1 / 4, 2 * PER_L / 4, bid, nblk);
      }
    } break;
    case 2: case 11: {
      int sI = s == 2 ? 0 : 1;
      ea.f0 = xy; ea.c0 = modl + (s == 2 ? 2 : 8) * 1024; ea.w = 0.5f;
      gemm_phase<2816, EPI_RESID>(hid, (const bf16_t*)(ws + OFF_W2T) + (size_t)(l * 2 + sI) * 1024 * 2816, 48, 4, ea, shm, bid, nblk);
      if (l == 0 && sI == 1 && nblk == 256 && bid >= 192) convert_units(p, shm, (PER_L + 2 * T_W1 + T_W2) / 4, 2 * PER_L / 4, bid - 192, 64);
    } break;
    case 3: lnmod_phase(p, l, 0, l, 3, bid, nblk); break;
    case 4: {
      ea.f0 = (float*)(ws + OFF_R);
      gemm_phase<1024, EPI_F32>(hA, (const bf16_t*)(ws + OFF_WINT) + (size_t)l * 1536 * 1024, 48, 6, ea, shm, bid, nblk);
    } break;
    case 5: post_phase(p, l, shm, bid, nblk); ssm1_phase(p, l, shm, bid, nblk); break;
    case 6: mix_phase(p, l, shm, bid, nblk); break;
    case 7: {
      ea.b0 = (bf16_t*)(ws + OFF_YMIX); ea.cb = (const bf16_t*)(ws + OFF_SG); ea.c0 = INP(I_BGLU) + l * 256;
      gemm_phase<256, EPI_GLU>((const bf16_t*)(ws + OFF_SG), (const bf16_t*)(ws + OFF_WGLUT) + (size_t)l * 65536, 48, 1, ea, shm, bid, nblk);
      ea.c0 = INP(I_POOLS) + l * 256;
      int bid2 = (bid + nblk - (nblk >> 1)) % nblk;
      gemm_phase<256, EPI_POOL>((const bf16_t*)(ws + OFF_DIFF), (const bf16_t*)(ws + OFF_WPOOLT) + (size_t)l * 65536, 48, 1, ea, shm, bid2, nblk);
    } break;
    case 8: {
      ea.f0 = xy; ea.c0 = modl + 5 * 1024; ea.w = 1.0f;
      gemm_phase<1024, EPI_RESID>((const bf16_t*)(ws + OFF_YMIX), (const bf16_t*)(ws + OFF_WOUTT) + (size_t)l * 1024 * 1024, 48, 4, ea, shm, bid, nblk);
    } break;
    case 9: lnmod_phase(p, l, 1, l, 6, bid, nblk); break;
  }
}

__global__ __launch_bounds__(512, 2) void mega(Params p, int ph_lo, int ph_hi) {
  extern __shared__ __attribute__((aligned(16))) char shm[];
  __shared__ uint4 xb_words;
  const int bid = blockIdx.x, nblk = gridDim.x;
  if (threadIdx.x == 0) xb_words = make_uint4(0u, 0u, 0u, 0u);
  __syncthreads();
  const XcdBarrier xb = xcd_barrier_post((unsigned*)(p.ws + OFF_BAR), (volatile LAS unsigned*)&xb_words);
  for (int ph = ph_lo; ph < ph_hi; ++ph) {
    if (ph > ph_lo) {
      if (ph_hi < 0) cg::this_grid().sync();
      xcd_barrier(xb);
    }
    run_phase(p, ph, shm, bid, nblk);
  }
}

extern "C" void kernel_launch(void* const* d_in, const int* in_sizes, int n_in, void* d_out, int out_size, void* d_ws,
                              size_t ws_size, hipStream_t stream) {
  static int grid_blocks = 0;
  if (!grid_blocks) {
    hipFuncSetAttribute((const void*)mega, hipFuncAttributeMaxDynamicSharedMemorySize, GEMM_LDS);
    int dev = 0, cus = 0, per_cu = 0;
    hipGetDevice(&dev);
    hipDeviceGetAttribute(&cus, hipDeviceAttributeMultiprocessorCount, dev);
    hipOccupancyMaxActiveBlocksPerMultiprocessor(&per_cu, mega, 512, GEMM_LDS);
    if (per_cu < 1) per_cu = 1;
    if (per_cu > 1) per_cu = 1;
    grid_blocks = cus * per_cu;
  }
  Params p{};
  for (int i = 0; i < N_IN; ++i) p.in[i] = (const float*)d_in[i];
  p.out = (float*)d_out;
  p.ws = (char*)d_ws;
  hipMemsetAsync((char*)d_ws + OFF_BAR, 0, 16384, stream);
#if ONE_LAUNCH
  int lo = 0, hi = N_PHASE;
  void* args[] = {&p, &lo, &hi};
  hipError_t e = hipLaunchCooperativeKernel((const void*)mega, dim3(grid_blocks), dim3(512), args, GEMM_LDS, stream);
  if (e != hipSuccess) fprintf(stderr, "cooperative launch failed: %s (grid %d)\n", hipGetErrorString(e), grid_blocks);
#else
  for (int ph = 0; ph < N_PHASE; ++ph) mega<<<grid_blocks, 512, GEMM_LDS, stream>>>(p, ph, ph + 1);
#endif
}
```

```cpp
#include <hip/hip_runtime.h>
#include <hip/hip_cooperative_groups.h>
#include <cstdio>
namespace cg = cooperative_groups;

#define DI __device__ __forceinline__
typedef unsigned short bf16_t;
typedef __attribute__((ext_vector_type(8))) short bf16x8;
typedef __attribute__((ext_vector_type(4))) short s16x4;
typedef __attribute__((ext_vector_type(4))) float f32x4;
typedef __attribute__((ext_vector_type(16))) float f32x16;
typedef __attribute__((ext_vector_type(2))) float f32x2;
typedef __attribute__((ext_vector_type(2))) __bf16 bf16x2v;
typedef __attribute__((ext_vector_type(4))) unsigned u32x4;
typedef __attribute__((ext_vector_type(2))) unsigned u32x2;

#ifndef ONE_LAUNCH
#define ONE_LAUNCH 1
#endif

constexpr int D = 1024, NTOK = 12288, NPROMPT = 8192, DFF = 2816, DIN = 1536;
constexpr float ALPHA = 1.4142135623730951f;
constexpr float LN_EPS = 1e-5f, RMS_EPS = 1e-6f;
enum { I_XP = 0, I_XS, I_CK, I_CV, I_SRE, I_SIM, I_C, I_CCTX, I_WMOD, I_BMOD, I_LNG, I_LNB, I_W1, I_W2, I_WIN, I_WOUT,
       I_POOLW, I_POOLS, I_LRE, I_LIM, I_LSTEP, I_BRE, I_BIM, I_CRE, I_CIM, I_SSMD, I_WGLU, I_BGLU, I_QN, I_KN,
       I_CLG, I_CLB, I_CWS, I_CBS, N_IN };
constexpr size_t OUT_K = 12582912, OUT_V = 14680064, OUT_SRE = 16777216, OUT_SIM = 16908288;

constexpr size_t OFF_W1T = 0;
constexpr size_t OFF_W2T = OFF_W1T + 46137344;
constexpr size_t OFF_WINT = OFF_W2T + 23068672;
constexpr size_t OFF_WOUTT = OFF_WINT + 6291456;
constexpr size_t OFF_WGLUT = OFF_WOUTT + 4194304;
constexpr size_t OFF_WPOOLT = OFF_WGLUT + 262144;
constexpr size_t OFF_MOD = OFF_WPOOLT + 262144;
constexpr size_t OFF_XY = OFF_MOD + 221184;
constexpr size_t OFF_H = OFF_XY + 50331648;
constexpr size_t OFF_YMIX = OFF_H + 25165824;
constexpr size_t OFF_R = OFF_YMIX + 25165824;
constexpr size_t OFF_QB = OFF_R + 75497472;
constexpr size_t OFF_KP = OFF_QB + 6291456;
constexpr size_t OFF_KS = OFF_KP + 2097152;
constexpr size_t OFF_VPT = OFF_KS + 2621440;
constexpr size_t OFF_VST = OFF_VPT + 2097152;
constexpr size_t OFF_VCT = OFF_VST + 2621440;
constexpr size_t OFF_DIFF = OFF_VCT + 6291456;
constexpr size_t OFF_SG = OFF_DIFF + 6291456;
constexpr size_t OFF_E = OFF_SG + 6291456;
constexpr size_t OFF_LAMB = OFF_E + 3145728;
constexpr size_t OFF_LAMT = OFF_LAMB + 32768;
constexpr size_t OFF_BBAR = OFF_LAMT + 32768;
constexpr size_t OFF_BAR = OFF_BBAR + 524288;
constexpr size_t OFF_BF = OFF_BAR + 16384;
constexpr size_t OFF_CF = OFF_BF + 524288;
constexpr size_t WS_TOTAL = OFF_CF + 262144;

struct Params { const float* in[N_IN]; float* out; char* ws; };

DI int otid() {
  int z = 0; asm volatile("" : "+s"(z));
  int lane = __builtin_amdgcn_mbcnt_hi(-1, __builtin_amdgcn_mbcnt_lo(-1, z));
  int w = __builtin_amdgcn_readfirstlane(threadIdx.x >> 6);
  return w * 64 + lane;
}
DI int osgpr(int i) { asm volatile("" : "+s"(i)); return i; }
#define INP(i) (p.in[osgpr(i)])
DI char* ows(char* w) { asm volatile("" : "+s"(w)); return w; }
#define PWS ows(p.ws)
DI unsigned pk2(float a, float b) { f32x2 v = {a, b}; bf16x2v r = __builtin_convertvector(v, bf16x2v); return __builtin_bit_cast(unsigned, r); }
DI bf16_t f2bf(float a) { return (bf16_t)(pk2(a, 0.f) & 0xffffu); }
DI float bf2f(bf16_t v) { return __uint_as_float(((unsigned)v) << 16); }
DI bf16x8 pack8(float a0, float a1, float a2, float a3, float a4, float a5, float a6, float a7) {
  u32x4 u = {pk2(a0, a1), pk2(a2, a3), pk2(a4, a5), pk2(a6, a7)};
  return __builtin_bit_cast(bf16x8, u);
}
DI float gelu_t(float x) {
  float z = 0.7978845608028654f * (x + 0.044715f * x * x * x);
  float e = __expf(2.f * z);
  float th = 1.f - 2.f / (e + 1.f);
  return 0.5f * x * (1.f + th);
}
DI float sigmoid_f(float x) { return 1.f / (1.f + __expf(-x)); }
DI float shfl_x(float v, int mask, int lane) {
  return __int_as_float(__builtin_amdgcn_ds_bpermute((lane ^ mask) << 2, __float_as_int(v)));
}
template <int CTRL> DI float dpp_f(float v) {
  return __int_as_float(__builtin_amdgcn_update_dpp(0, __float_as_int(v), CTRL, 0xf, 0xf, true));
}
DI float wave_sum(float v, int lane) {
  (void)lane;
  v += dpp_f<0xB1>(v);
  v += dpp_f<0x4E>(v);
  v += dpp_f<0x141>(v);
  v += dpp_f<0x140>(v);
  const int iv = __float_as_int(v);
  float r0 = __int_as_float(__builtin_amdgcn_readlane(iv, 0)), r1 = __int_as_float(__builtin_amdgcn_readlane(iv, 16));
  float r2 = __int_as_float(__builtin_amdgcn_readlane(iv, 32)), r3 = __int_as_float(__builtin_amdgcn_readlane(iv, 48));
  return (r0 + r1) + (r2 + r3);
}
DI size_t kfrag_off(int key, int d) {
  return ((size_t)((key >> 5) * 4 + (d >> 4)) * 64 + ((d >> 3) & 1) * 32 + (key & 31)) * 8 + (d & 7);
}
DI size_t vfrag_off(int key, int d) {
  const int kk = key & 31, w = kk & 15;
  return ((size_t)(((key >> 5) * 2 + (kk >> 4)) * 2 + (d >> 5)) * 64 + ((w >> 2) & 1) * 32 + (d & 31)) * 8 + (((w >> 3) << 2) | (w & 3));
}

#define MFMA16(a, b, c) __builtin_amdgcn_mfma_f32_16x16x32_bf16((a), (b), (c), 0, 0, 0)
#define MFMA32(a, b, c) __builtin_amdgcn_mfma_f32_32x32x16_bf16((a), (b), (c), 0, 0, 0)


#define XB_TMO      128
#define XB_XCNT(j)  (256  + 64 * (j))
#define XB_XSUB(j)  (1280 + 64 * (j))
#define XB_XGEN(j)  (2304 + 64 * (j))
#define XB_TOP      3328
#define XB_TOPGEN   3392
#define XCD_BAR_WORDS 3456
#define XB_SPIN_CAP (1u << 18)
#define LAS __attribute__((address_space(3)))
DI unsigned xb_ld(unsigned* p) { return __hip_atomic_load(p, __ATOMIC_RELAXED, __HIP_MEMORY_SCOPE_AGENT); }
DI unsigned xb_add(unsigned* p, unsigned v) { return __hip_atomic_fetch_add(p, v, __ATOMIC_RELAXED, __HIP_MEMORY_SCOPE_AGENT); }
DI unsigned xb_xcc_id() { return (unsigned)__builtin_amdgcn_s_getreg((3 << 11) | 20) & 0xFu; }
#define XB_SPIN(cond, bar) do { unsigned _sp = 0; while (cond) { __builtin_amdgcn_s_sleep(1); \
    if ((++_sp & 255u) == 0u) { if (xb_ld(&(bar)[XB_TMO])) break; if (_sp > XB_SPIN_CAP) { atomicAdd(&(bar)[XB_TMO], 1u); break; } } } } while (0)
struct XcdBarrier { unsigned* bar; unsigned x; volatile LAS unsigned* st; };
DI XcdBarrier xcd_barrier_post(unsigned* bar, volatile LAS unsigned* st) {
  XcdBarrier b; b.bar = bar; b.x = xb_xcc_id(); b.st = st;
  if (threadIdx.x == 0) (void)xb_add(&bar[XB_XCNT(b.x)], 1u);
  return b;
}
DI void xcd_barrier_complete(unsigned* bar, unsigned x, unsigned& nloc, unsigned& nx) {
  const unsigned G = gridDim.x * gridDim.y * gridDim.z;
  unsigned sum, cnt, mine, sp = 0u;
  for (;;) {
    sum = 0u; cnt = 0u; mine = 0u;
#pragma unroll
    for (unsigned j = 0; j < 16; ++j) { const unsigned c = xb_ld(&bar[XB_XCNT(j)]); sum += c; cnt += (c > 0u) ? 1u : 0u; mine = (j == x) ? c : mine; }
    if (sum == G) break;
    __builtin_amdgcn_s_sleep(1);
    if ((++sp & 255u) == 0u) { if (xb_ld(&bar[XB_TMO])) break; if (sp > XB_SPIN_CAP) { atomicAdd(&bar[XB_TMO], 1u); break; } }
  }
  nloc = mine > 0u ? mine : 1u; nx = cnt > 0u ? cnt : 1u;
}
DI void xcd_barrier(const XcdBarrier& b) {
  asm volatile("s_waitcnt vmcnt(0)" ::: "memory");
  __syncthreads();
  if (threadIdx.x == 0) {
    unsigned* bar = b.bar;
    __builtin_amdgcn_s_waitcnt(0);
    unsigned nloc = b.st[0], nx = b.st[1];
    if (nloc == 0u) { xcd_barrier_complete(bar, b.x, nloc, nx); b.st[0] = nloc; b.st[1] = nx; }
    const unsigned old = xb_add(&bar[XB_XSUB(b.x)], 1u);
    const unsigned gen = old / nloc;
    if (old + 1u == (gen + 1u) * nloc) {
      __builtin_amdgcn_fence(__ATOMIC_RELEASE, "agent");
      asm volatile("s_waitcnt vmcnt(0)" ::: "memory");
      const unsigned og = xb_add(&bar[XB_TOP], 1u);
      const unsigned tg = og / nx;
      if (og + 1u == (tg + 1u) * nx) xb_add(&bar[XB_TOPGEN], 1u);
      else XB_SPIN(xb_ld(&bar[XB_TOPGEN]) == tg, bar);
      __builtin_amdgcn_fence(__ATOMIC_ACQUIRE, "agent");
      xb_add(&bar[XB_XGEN(b.x)], 1u);
      asm volatile("s_waitcnt vmcnt(0)" ::: "memory");
    } else {
      XB_SPIN(xb_ld(&bar[XB_XGEN(b.x)]) == gen, bar);
      __builtin_amdgcn_fence(__ATOMIC_ACQUIRE, "agent");
      asm volatile("s_waitcnt vmcnt(0)" ::: "memory");
    }
  }
  __syncthreads();
}

constexpr int BM = 256, BK = 64, HALF = 128, NXCD = 8, WGM = 8, HT = HALF * BK;
constexpr int GEMM_LDS = 8 * HT * 2;

DI int lds_byte(int r, int c) {
  int st = (r >> 4) * 2 + (c >> 5), rr = r & 15, cc = c & 31, ob = rr * 64 + cc * 2;
  return st * 1024 + (ob ^ (((ob >> 9) & 1) << 5));
}
DI void stage_rc(int b, int& R, int& C) {
  int st = b / 1024, sb = b % 1024, swz = sb ^ (((sb >> 9) & 1) << 5);
  R = (st >> 1) * 16 + swz / 64; C = (st & 1) * 32 + (swz % 64) / 2;
}

enum { EPI_SWIGLU = 0, EPI_RESID, EPI_F32, EPI_GLU, EPI_POOL };
struct EpiArgs {
  float* f0;
  bf16_t* b0;
  const float* c0;
  const bf16_t* cb;
  float w;
};

template <int K, int MODE, int SPLITS = 1, int RH = 128>
DI void gemm_phase(const bf16_t* __restrict__ A, const bf16_t* __restrict__ Bt, int nM, int nN, EpiArgs ea,
                   char* shmc, int bid, int nblk) {
  bf16_t* shm = (bf16_t*)shmc;
#define SA(b, h) (shm + ((b) * 2 + (h)) * HT)
#define SB(b, h) (shm + (4 + (b) * 2 + (h)) * HT)
#define STAGE(P, RS, SOFF, kt) do { const int _so = (SOFF) + (kt0 + (kt)) * (BK * 2); \
    __builtin_amdgcn_raw_ptr_buffer_load_lds(RS, (__attribute__((address_space(3))) void*)((char*)(P) + wid * 1024), 16, so0, _so, 0, 0); \
    __builtin_amdgcn_raw_ptr_buffer_load_lds(RS, (__attribute__((address_space(3))) void*)((char*)(P) + wid * 1024 + 8192), 16, so1, _so, 0, 0); } while (0)
#define LDA(dst, b, h) for (int m = 0; m < MT; ++m) for (int k = 0; k < 2; ++k) \
    dst[m][k] = *reinterpret_cast<const bf16x8*>((char*)SA(b, h) + lds_byte(wr * (RH / 2) + m * 16 + fr, k * 32 + fq * 8))
#define LDB(dst, b, h) for (int n = 0; n < 2; ++n) for (int k = 0; k < 2; ++k) \
    dst[n][k] = *reinterpret_cast<const bf16x8*>((char*)SB(b, h) + lds_byte(wc * 32 + n * 16 + fr, k * 32 + fq * 8))
#define MMA(ai, bj, At, Bt_) do { __builtin_amdgcn_s_setprio(1); \
    for (int m = 0; m < MT; ++m) for (int n = 0; n < 2; ++n) for (int k = 0; k < 2; ++k) \
      acc[ai][bj][m][n] = MFMA16(At[m][k], Bt_[n][k], acc[ai][bj][m][n]); \
    __builtin_amdgcn_s_setprio(0); } while (0)
#define WAIT_V(n) asm volatile("s_waitcnt vmcnt(" #n ")" ::: "memory")
#define WAIT_L(n) asm volatile("s_waitcnt lgkmcnt(" #n ")" ::: "memory")
#define BAR __builtin_amdgcn_s_barrier()
#define SCHED __builtin_amdgcn_sched_barrier(0)
  constexpr int MT = RH / 32;
  constexpr int TM = 2 * RH;
  const int tid = otid();
  const int wid = __builtin_amdgcn_readfirstlane(tid >> 6), lane = tid & 63, wr = wid >> 2, wc = wid & 3, fr = lane & 15, fq = lane >> 4;
  const __amdgpu_buffer_rsrc_t rsA = __builtin_amdgcn_make_buffer_rsrc((void*)A, 0, 0x7fffffff, 0x00020000);
  const __amdgpu_buffer_rsrc_t rsB = __builtin_amdgcn_make_buffer_rsrc((void*)Bt, 0, 0x7fffffff, 0x00020000);
  unsigned so0, so1;
  { int R, C; stage_rc(tid * 16, R, C); so0 = (unsigned)(R * K + C) * 2u; stage_rc(tid * 16 + 8192, R, C); so1 = (unsigned)(R * K + C) * 2u; }
  const int nwg = nM * nN;
  for (int unit = bid; unit < nwg * SPLITS; unit += nblk) {
    const int sp = SPLITS == 1 ? 0 : unit / nwg, tile = SPLITS == 1 ? unit : unit % nwg;
    const int kt0 = SPLITS == 1 ? 0 : (sp == 0 ? 0 : sp == 1 ? 12 : sp == 2 ? 24 : 34);
    const int nt = SPLITS == 1 ? K / BK : (sp < 2 ? 12 : 10);
    int wgid = tile;
    { int q = nwg / NXCD, r = nwg % NXCD, xcd = wgid % NXCD, off = wgid / NXCD;
      wgid = (xcd < r ? xcd * (q + 1) : r * (q + 1) + (xcd - r) * q) + off; }
    int nig = WGM * nN, gid = wgid / nig, fm = gid * WGM, gsz = min(nM - fm, WGM);
    int pm = fm + ((wgid % nig) % gsz), pn = (wgid % nig) / gsz, brow = pm * TM, bcol = pn * BM;
    const int A0 = brow * K * 2, A1 = A0 + RH * K * 2, B0p = bcol * K * 2, B1p = B0p + HALF * K * 2;
    f32x4 acc[2][2][MT][2] = {};
    bf16x8 At[MT][2], B0[2][2], B1[2][2];
    STAGE(SB(0, 0), rsB, B0p, 0); STAGE(SA(0, 0), rsA, A0, 0);
    STAGE(SB(0, 1), rsB, B1p, 0); STAGE(SA(0, 1), rsA, A1, 0);
    if (wr == 1) BAR;
    WAIT_V(4); BAR;
    STAGE(SB(1, 0), rsB, B0p, 1); STAGE(SA(1, 0), rsA, A0, 1); STAGE(SB(1, 1), rsB, B1p, 1);
    WAIT_V(6); BAR;
    for (int t = 0; t < nt - 2; t += 2) {
      LDB(B0, 0, 0); SCHED; LDA(At, 0, 0); STAGE(SA(1, 1), rsA, A1, t + 1);
      if (MT == 4) WAIT_L(8); else WAIT_L(6); BAR; WAIT_L(0); MMA(0, 0, At, B0); BAR; SCHED;
      LDB(B1, 0, 1); STAGE(SB(0, 0), rsB, B0p, t + 2);
      BAR; WAIT_L(0); MMA(0, 1, At, B1); BAR;
      LDA(At, 0, 1); STAGE(SA(0, 0), rsA, A0, t + 2);
      BAR; WAIT_L(0); MMA(1, 0, At, B0); BAR; SCHED;
      STAGE(SB(0, 1), rsB, B1p, t + 2);
      WAIT_V(6); BAR; MMA(1, 1, At, B1); BAR;
      LDB(B0, 1, 0); SCHED; LDA(At, 1, 0); STAGE(SA(0, 1), rsA, A1, t + 2);
      if (MT == 4) WAIT_L(8); else WAIT_L(6); BAR; WAIT_L(0); MMA(0, 0, At, B0); BAR; SCHED;
      LDB(B1, 1, 1); STAGE(SB(1, 0), rsB, B0p, t + 3);
      BAR; WAIT_L(0); MMA(0, 1, At, B1); BAR;
      LDA(At, 1, 1); STAGE(SA(1, 0), rsA, A0, t + 3);
      BAR; WAIT_L(0); MMA(1, 0, At, B0); BAR; SCHED;
      STAGE(SB(1, 1), rsB, B1p, t + 3);
      WAIT_V(6); BAR; MMA(1, 1, At, B1); BAR;
    }
    { LDB(B0, 0, 0); LDA(At, 0, 0); STAGE(SA(1, 1), rsA, A1, nt - 1);
      BAR; WAIT_L(0); MMA(0, 0, At, B0); BAR;
      LDB(B1, 0, 1); BAR; WAIT_L(0); MMA(0, 1, At, B1); BAR;
      LDA(At, 0, 1); WAIT_V(4); BAR; WAIT_L(0); MMA(1, 0, At, B0); MMA(1, 1, At, B1); BAR; }
    { LDB(B0, 1, 0); LDA(At, 1, 0); WAIT_V(2); BAR; WAIT_L(0); MMA(0, 0, At, B0); BAR;
      LDB(B1, 1, 1); WAIT_V(0); BAR; WAIT_L(0); MMA(0, 1, At, B1); BAR;
      LDA(At, 1, 1); BAR; WAIT_L(0); MMA(1, 0, At, B0); MMA(1, 1, At, B1); BAR; }
    if (wr == 0) BAR;
    const int ci = brow < NPROMPT ? 0 : 1 + (brow - NPROMPT) / 2048;
    const int ci2 = (brow + TM - 1) < NPROMPT ? 0 : 1 + (brow + TM - 1 - NPROMPT) / 2048;
    const int rsplit = ci2 == 1 ? NPROMPT : NPROMPT + 2048;
    const int te = otid(), le = te & 63, wide = te >> 6;
    const int wr = wide >> 2, wc = wide & 3, fr = le & 15, fq = le >> 4;
    const int rbase = brow + wr * (RH / 2) + fq * 4, cbase = bcol + wc * 32 + fr;
    if (MODE == EPI_SWIGLU) {
#pragma unroll
      for (int ai = 0; ai < 2; ++ai)
#pragma unroll
        for (int m = 0; m < MT; ++m)
#pragma unroll
          for (int j = 0; j < 4; ++j) {
            const int row = rbase + ai * RH + m * 16 + j;
#pragma unroll
            for (int n = 0; n < 2; ++n) {
              float g = acc[ai][0][m][n][j], u = acc[ai][1][m][n][j];
              ea.b0[(size_t)row * DFF + pn * 128 + wc * 32 + n * 16 + fr] = f2bf(g * sigmoid_f(g) * u);
            }
          }
    } else if (MODE == EPI_RESID) {
      float gate[2][2], gate2[2][2];
#pragma unroll
      for (int bj = 0; bj < 2; ++bj)
#pragma unroll
        for (int n = 0; n < 2; ++n) {
          gate[bj][n] = ea.w * ea.c0[ci * 9216 + cbase + bj * HALF + n * 16];
          gate2[bj][n] = ea.w * ea.c0[ci2 * 9216 + cbase + bj * HALF + n * 16];
        }
#pragma unroll
      for (int ai = 0; ai < 2; ++ai) {
        float* xb = ea.f0 + (size_t)(rbase + ai * RH) * D + cbase;
        float xv[MT][4][2][2];
#pragma unroll
        for (int m = 0; m < MT; ++m)
#pragma unroll
          for (int j = 0; j < 4; ++j)
#pragma unroll
            for (int bj = 0; bj < 2; ++bj)
#pragma unroll
              for (int n = 0; n < 2; ++n) xv[m][j][bj][n] = xb[(size_t)(m * 16 + j) * D + bj * HALF + n * 16];
#pragma unroll
        for (int m = 0; m < MT; ++m)
#pragma unroll
          for (int j = 0; j < 4; ++j)
#pragma unroll
            for (int bj = 0; bj < 2; ++bj)
#pragma unroll
              for (int n = 0; n < 2; ++n)
                xb[(size_t)(m * 16 + j) * D + bj * HALF + n * 16] =
                    xv[m][j][bj][n] + ((rbase + ai * RH + m * 16 + j) >= rsplit ? gate2[bj][n] : gate[bj][n]) * acc[ai][bj][m][n][j];
      }
    } else if (MODE == EPI_GLU) {
      float bg[2][2];
#pragma unroll
      for (int bj = 0; bj < 2; ++bj)
#pragma unroll
        for (int n = 0; n < 2; ++n) bg[bj][n] = ea.c0[cbase + bj * HALF + n * 16];
#pragma unroll
      for (int ai = 0; ai < 2; ++ai) {
        float gv[MT][4][2][2];
        const bf16_t* gb = ea.cb + (size_t)(rbase + ai * RH) * 256 + cbase;
#pragma unroll
        for (int m = 0; m < MT; ++m)
#pragma unroll
          for (int j = 0; j < 4; ++j)
#pragma unroll
            for (int bj = 0; bj < 2; ++bj)
#pragma unroll
              for (int n = 0; n < 2; ++n) gv[m][j][bj][n] = bf2f(gb[(size_t)(m * 16 + j) * 256 + bj * HALF + n * 16]);
        bf16_t* yb = ea.b0 + (size_t)(rbase + ai * RH) * D + 256 + cbase;
#pragma unroll
        for (int m = 0; m < MT; ++m)
#pragma unroll
          for (int j = 0; j < 4; ++j)
#pragma unroll
            for (int bj = 0; bj < 2; ++bj)
#pragma unroll
              for (int n = 0; n < 2; ++n)
                yb[(size_t)(m * 16 + j) * D + bj * HALF + n * 16] =
                    f2bf(gv[m][j][bj][n] * sigmoid_f(acc[ai][bj][m][n][j] + bg[bj][n]));
      }
    } else {
      float ps[2][2];
#pragma unroll
      for (int bj = 0; bj < 2; ++bj)
#pragma unroll
        for (int n = 0; n < 2; ++n) ps[bj][n] = MODE == EPI_POOL ? ea.c0[cbase + bj * HALF + n * 16] : 1.f;
#pragma unroll
      for (int ai = 0; ai < 2; ++ai)
#pragma unroll
        for (int m = 0; m < MT; ++m)
#pragma unroll
          for (int j = 0; j < 4; ++j) {
            const int row = rbase + ai * RH + m * 16 + j;
#pragma unroll
            for (int bj = 0; bj < 2; ++bj)
#pragma unroll
              for (int n = 0; n < 2; ++n) {
                const int col = cbase + bj * HALF + n * 16;
                float a = acc[ai][bj][m][n][j];
                if (MODE == EPI_F32) ea.f0[(size_t)row * DIN + col] = a;
                else ea.b0[(size_t)row * D + col] = f2bf(a * ps[bj][n]);
              }
          }
    }
  }
#undef SA
#undef SB
}

constexpr int T_W1 = 16 * 88, T_W2 = 44 * 16, T_IN = 16 * 24, T_OUT = 256, T_GLU = 16;
constexpr int PER_L = 2 * T_W1 + 2 * T_W2 + T_IN + T_OUT + T_GLU;
DI void convert_units(const Params& p, char* shmc, int unit_begin, int unit_end, int worker, int nworkers) {
  const int tid = otid();
  char* ws = PWS;
  constexpr int NTL = 4;
  __syncthreads();
  for (int u = unit_begin + worker; u < unit_end; u += nworkers) {
    const int it0 = u * NTL;
    bf16_t* dsts[NTL]; int Ks[NTL], modes[NTL], kts[NTL], ntiles[NTL];
    float4 v[NTL][2];
#pragma unroll
    for (int q = 0; q < NTL; ++q) {
      const int it = it0 + q;
      int l = it / PER_L, r = it % PER_L;
      const float* src; bf16_t* dst; int K, N, mode = 0;
      if (r < 2 * T_W1) {
        int s2 = r / T_W1; r %= T_W1;
        src = INP(I_W1) + (size_t)(l * 2 + s2) * 1024 * 5632; dst = (bf16_t*)(ws + OFF_W1T) + (size_t)(l * 2 + s2) * 5632 * 1024;
        K = 1024; N = 5632; mode = 1;
      } else if (r < 2 * T_W1 + 2 * T_W2) {
        r -= 2 * T_W1; int s2 = r / T_W2; r %= T_W2;
        src = INP(I_W2) + (size_t)(l * 2 + s2) * 2816 * 1024; dst = (bf16_t*)(ws + OFF_W2T) + (size_t)(l * 2 + s2) * 1024 * 2816;
        K = 2816; N = 1024;
      } else if (r < 2 * T_W1 + 2 * T_W2 + T_IN) {
        r -= 2 * T_W1 + 2 * T_W2;
        src = INP(I_WIN) + (size_t)l * 1024 * 1536; dst = (bf16_t*)(ws + OFF_WINT) + (size_t)l * 1536 * 1024;
        K = 1024; N = 1536;
      } else if (r < 2 * T_W1 + 2 * T_W2 + T_IN + T_OUT) {
        r -= 2 * T_W1 + 2 * T_W2 + T_IN;
        src = INP(I_WOUT) + (size_t)l * 1024 * 1024; dst = (bf16_t*)(ws + OFF_WOUTT) + (size_t)l * 1024 * 1024;
        K = 1024; N = 1024;
      } else {
        r -= 2 * T_W1 + 2 * T_W2 + T_IN + T_OUT;
        src = INP(I_WGLU) + (size_t)l * 256 * 256; dst = (bf16_t*)(ws + OFF_WGLUT) + (size_t)l * 256 * 256;
        K = 256; N = 256;
      }
      const int nkt = K / 64, kt = r % nkt, ntile = r / nkt;
      dsts[q] = dst; Ks[q] = K; modes[q] = mode; kts[q] = kt; ntiles[q] = ntile;
#pragma unroll
      for (int i = 0; i < 2; ++i) {
        int k = (tid >> 4) + 32 * i, n = (tid & 15) * 4;
        v[q][i] = *(const float4*)(src + (size_t)(kt * 64 + k) * N + ntile * 64 + n);
      }
    }
#pragma unroll
    for (int q = 0; q < NTL; ++q) {
      float* tile = (float*)shmc + q * (64 * 65);
#pragma unroll
      for (int i = 0; i < 2; ++i) {
        int k = (tid >> 4) + 32 * i, n = (tid & 15) * 4;
        tile[k * 65 + n] = v[q][i].x; tile[k * 65 + n + 1] = v[q][i].y; tile[k * 65 + n + 2] = v[q][i].z; tile[k * 65 + n + 3] = v[q][i].w;
      }
    }
    __syncthreads();
#pragma unroll
    for (int q = 0; q < NTL; ++q) {
      const float* tile = (const float*)shmc + q * (64 * 65);
      int n = tid >> 3, kk = (tid & 7) * 8;
      int nsrc = ntiles[q] * 64 + n, nrow = nsrc;
      if (modes[q] == 1) {
        if (nsrc < 2816) nrow = (nsrc >> 7) * 256 + (nsrc & 127);
        else { int mm = nsrc - 2816; nrow = (mm >> 7) * 256 + 128 + (mm & 127); }
      }
      bf16x8 o = pack8(tile[(kk + 0) * 65 + n], tile[(kk + 1) * 65 + n], tile[(kk + 2) * 65 + n], tile[(kk + 3) * 65 + n],
                       tile[(kk + 4) * 65 + n], tile[(kk + 5) * 65 + n], tile[(kk + 6) * 65 + n], tile[(kk + 7) * 65 + n]);
      *(bf16x8*)(dsts[q] + (size_t)nrow * Ks[q] + kts[q] * 64 + kk) = o;
    }
    __syncthreads();
  }
}

DI void prep_phase(const Params& p, char* shmc, int bid, int nblk) {
  const int tid = otid(), wid = tid >> 6, lane = tid & 63;
  char* ws = PWS;
  convert_units(p, shmc, 0, T_W1 / 4, bid, nblk);
  const int gtid = bid * 512 + tid, gn = nblk * 512;
  for (int i = gtid; i < 2 * 65536; i += gn) {
    int l = i >> 16, n = (i >> 8) & 255, k = i & 255;
    int gi = n >> 6, d = n & 63, gj = k >> 6, c = k & 63;
    float v = (gi == gj) ? INP(I_POOLW)[((size_t)(l * 4 + gi) * 64 + c) * 64 + d] : 0.f;
    ((bf16_t*)(ws + OFF_WPOOLT))[i] = f2bf(v);
  }
  {
    float* sc = (float*)shmc + 4 * 64 * 65;
    float* red = sc + 3 * 1024;
    for (int i = tid; i < 3 * 1024; i += 512) {
      int ci = i >> 10, k = i & 1023;
      float v = ci == 0 ? INP(I_CCTX)[k] : INP(I_C)[(ci - 1) * 1024 + k];
      sc[i] = v * sigmoid_f(v);
    }
    __syncthreads();
    for (int it = bid; it < 288; it += nblk) {
      int l = it / 144, cb = it % 144, col = cb * 64 + lane;
      const float* wp = INP(I_WMOD) + (size_t)l * 1024 * 9216 + col;
      float a0 = 0.f, a1 = 0.f, a2 = 0.f;
#pragma unroll 8
      for (int k = wid * 128; k < wid * 128 + 128; ++k) {
        float w = wp[(size_t)k * 9216];
        a0 += sc[k] * w; a1 += sc[1024 + k] * w; a2 += sc[2048 + k] * w;
      }
      red[(wid * 3 + 0) * 64 + lane] = a0; red[(wid * 3 + 1) * 64 + lane] = a1; red[(wid * 3 + 2) * 64 + lane] = a2;
      __syncthreads();
      if (tid < 192) {
        int ci = tid >> 6;
        float s = 0.f;
        for (int w = 0; w < 8; ++w) s += red[(w * 3 + ci) * 64 + lane];
        ((float*)(ws + OFF_MOD))[(size_t)(l * 3 + ci) * 9216 + col] = s + INP(I_BMOD)[l * 9216 + col];
      }
      __syncthreads();
    }
  }
  for (int i = gtid; i < 2 * 2 * 512 * 128; i += gn) {
    int c = i & 127, t = (i >> 7) & 511, b = (i >> 16) & 1, l = i >> 17;
    size_t si = ((size_t)(b * 2 + l) * 512 + t) * 128 + c;
    const size_t sb_ = (size_t)((l * 2 + b) * 2 + (c >> 6)) * 163840;
    ((bf16_t*)(ws + OFF_KS))[sb_ + kfrag_off(t, c & 63)] = f2bf(INP(I_CK)[si]);
    ((bf16_t*)(ws + OFF_VST))[sb_ + vfrag_off(t, c & 63)] = f2bf(INP(I_CV)[si]);
  }
  for (int i = gtid; i < 4096; i += gn) {
    float lre = INP(I_LRE)[i], lim = INP(I_LIM)[i];
    float dt = expf(INP(I_LSTEP)[i >> 6]);
    float e = expf(lre * dt), ang = lim * dt;
    float br = e * cosf(ang), bi = e * sinf(ang);
    float ar = br - 1.f, ai = bi, den = lre * lre + lim * lim;
    float cr = (ar * lre + ai * lim) / den, cim = (ai * lre - ar * lim) / den;
    ((float2*)(ws + OFF_LAMB))[i] = make_float2(br, bi);
    float pr = br, pi = bi;
    for (int s = 0; s < 6; ++s) { float nr = pr * pr - pi * pi, ni = 2.f * pr * pi; pr = nr; pi = ni; }
    ((float2*)(ws + OFF_LAMT))[i] = make_float2(pr, pi);
  }
  for (int i = gtid; i < 64 * 8 * 64; i += gn) {
    const int gidx = i >> 9, nt = (i >> 6) & 7, ln = i & 63, fr = ln & 15, fq = ln >> 4;
    bf16x8 o = (bf16x8){0, 0, 0, 0, 0, 0, 0, 0};
    if (fq < 2) {
      const int n = nt * 8 + (fr >> 1), idx = gidx * 64 + n;
      float lre = INP(I_LRE)[idx], lim = INP(I_LIM)[idx];
      float dt = expf(INP(I_LSTEP)[gidx]);
      float e = expf(lre * dt), ang = lim * dt;
      float br = e * cosf(ang), bi = e * sinf(ang);
      float ar = br - 1.f, ai = bi, den = lre * lre + lim * lim;
      float cr = (ar * lre + ai * lim) / den, cim = (ai * lre - ar * lim) / den;
      float v[8];
#pragma unroll
      for (int j = 0; j < 8; ++j) {
        float xr = INP(I_BRE)[(size_t)idx * 16 + fq * 8 + j], xi = INP(I_BIM)[(size_t)idx * 16 + fq * 8 + j];
        v[j] = (fr & 1) ? cr * xi + cim * xr : cr * xr - cim * xi;
      }
      o = pack8(v[0], v[1], v[2], v[3], v[4], v[5], v[6], v[7]);
    }
    ((bf16x8*)(ws + OFF_BF))[i] = o;
  }
  for (int i = gtid; i < 64 * 4 * 64; i += gn) {
    const int gidx = i >> 8, ks = (i >> 6) & 3, ln = i & 63, fr = ln & 15, fq = ln >> 4;
    const size_t co = ((size_t)gidx * 16 + fr) * 64 + ks * 16 + fq * 4;
    float4 cr = *(const float4*)(INP(I_CRE) + co), cim = *(const float4*)(INP(I_CIM) + co);
    ((bf16x8*)(ws + OFF_CF))[i] = pack8(cr.x, -cim.x, cr.y, -cim.y, cr.z, -cim.z, cr.w, -cim.w);
  }
}

DI void lnmod_phase(const Params& p, int l_ln, int ln_idx, int l_mod, int mod_idx, int bid, int nblk) {
  const int tid = otid(), wid = tid >> 6, lane = tid & 63;
  float* xy = (float*)(PWS + OFF_XY);
  bf16_t* h = (bf16_t*)(PWS + OFF_H);
  const float* modv = (const float*)(PWS + OFF_MOD);
  const int stride = nblk * 8;
  float4 gg[4], bb[4];
  if (l_ln >= 0) {
    const float* g = INP(I_LNG) + (l_ln * 3 + ln_idx) * 1024;
    const float* b = INP(I_LNB) + (l_ln * 3 + ln_idx) * 1024;
#pragma unroll
    for (int i = 0; i < 4; ++i) { gg[i] = *(const float4*)(g + lane * 4 + i * 256); bb[i] = *(const float4*)(b + lane * 4 + i * 256); }
  }
#define LN_SRC(R) (l_ln < 0 ? ((R) < NPROMPT ? INP(I_XP) + (size_t)(R) * D : INP(I_XS) + (size_t)((R) - NPROMPT) * D) : xy + (size_t)(R) * D)
  int row = bid * 8 + wid;
  float4 nv[4];
  if (row < NTOK) {
    const float* src = LN_SRC(row);
#pragma unroll
    for (int i = 0; i < 4; ++i) nv[i] = *(const float4*)(src + lane * 4 + i * 256);
  }
  for (; row < NTOK; row += stride) {
    float4 v[4];
#pragma unroll
    for (int i = 0; i < 4; ++i) v[i] = nv[i];
    if (row + stride < NTOK) {
      const float* src = LN_SRC(row + stride);
#pragma unroll
      for (int i = 0; i < 4; ++i) nv[i] = *(const float4*)(src + lane * 4 + i * 256);
    }
    float4 ma[4], mc[4];
    if (l_mod >= 0) {
      int ci = row < NPROMPT ? 0 : 1 + (row - NPROMPT) / 2048;
      const float* sh = modv + (size_t)(l_mod * 3 + ci) * 9216 + mod_idx * 1024;
#pragma unroll
      for (int i = 0; i < 4; ++i) { ma[i] = *(const float4*)(sh + lane * 4 + i * 256); mc[i] = *(const float4*)(sh + 1024 + lane * 4 + i * 256); }
    }
    if (l_ln >= 0) {
      float s = 0.f;
#pragma unroll
      for (int i = 0; i < 4; ++i) s += v[i].x + v[i].y + v[i].z + v[i].w;
      float mean = wave_sum(s, lane) * (1.f / 1024.f);
      float q = 0.f;
#pragma unroll
      for (int i = 0; i < 4; ++i) {
        v[i].x -= mean; v[i].y -= mean; v[i].z -= mean; v[i].w -= mean;
        q += v[i].x * v[i].x + v[i].y * v[i].y + v[i].z * v[i].z + v[i].w * v[i].w;
      }
      float rstd = rsqrtf(wave_sum(q, lane) * (1.f / 1024.f) + LN_EPS);
#pragma unroll
      for (int i = 0; i < 4; ++i) {
        v[i].x = v[i].x * rstd * gg[i].x + bb[i].x; v[i].y = v[i].y * rstd * gg[i].y + bb[i].y;
        v[i].z = v[i].z * rstd * gg[i].z + bb[i].z; v[i].w = v[i].w * rstd * gg[i].w + bb[i].w;
      }
    }
    float* dx = l_mod < 0 ? p.out + (size_t)row * D : xy + (size_t)row * D;
    const float xs = l_mod < 0 ? 1.f : ALPHA;
#pragma unroll
    for (int i = 0; i < 4; ++i) *(float4*)(dx + lane * 4 + i * 256) = make_float4(v[i].x * xs, v[i].y * xs, v[i].z * xs, v[i].w * xs);
    if (l_mod >= 0) {
#pragma unroll
      for (int i = 0; i < 4; ++i) {
        u32x2 o = {pk2(v[i].x * (1.f + mc[i].x) + ma[i].x, v[i].y * (1.f + mc[i].y) + ma[i].y),
                   pk2(v[i].z * (1.f + mc[i].z) + ma[i].z, v[i].w * (1.f + mc[i].w) + ma[i].w)};
        *(u32x2*)(h + (size_t)row * D + lane * 4 + i * 256) = o;
      }
    }
  }
#undef LN_SRC
}

DI void post_phase(const Params& p, int l, char* shmc, int bid, int nblk) {
  const int tid = otid(), wid = tid >> 6, lane = tid & 63;
  char* ws = PWS;
  const float* proj = (const float*)(ws + OFF_R);
  bf16_t* qb = (bf16_t*)(ws + OFF_QB);
  const float qn = INP(I_QN)[l * 64 + lane], kn = INP(I_KN)[l * 64 + lane];
  const int fi = lane & 15;
  const float inv = exp2f(-(float)fi * (13.287712379549449f / 16.f));
  for (int row = bid * 8 + wid; row < NTOK; row += nblk * 8) {
    const float* pr = proj + (size_t)row * DIN;
    const bool samp = row >= NPROMPT;
    int b, t, L;
    if (samp) { b = (row - NPROMPT) >> 11; t = (row - NPROMPT) & 2047; L = 2048; }
    else { b = row >> 8; t = row & 255; L = 256; }
    float cs = 1.f, sn = 0.f;
    if (samp) {
      float pos = (float)((lane & 31) < 16 ? (t >> 6) : (t & 63));
      float ang = pos * inv;
      cs = cosf(ang); sn = sinf(ang);
    }
    float xq[4], xk[2], xv2[2], xz[4];
#pragma unroll
    for (int i = 0; i < 4; ++i) { xq[i] = pr[512 + i * 64 + lane]; xz[i] = pr[1280 + i * 64 + lane]; }
#pragma unroll
    for (int i = 0; i < 2; ++i) { xk[i] = pr[768 + i * 64 + lane]; xv2[i] = pr[896 + i * 64 + lane]; }
    {
      bf16_t* df = (bf16_t*)(ws + OFF_DIFF) + (size_t)row * 256;
#pragma unroll
      for (int gi = 0; gi < 4; ++gi) {
        const int hw = 1 << gi;
        int lo = max(t - hw, 0), hi = min(t + hw, L);
        float tv[16];
#pragma unroll
        for (int d = -hw; d < hw; ++d) {
          const int tt = t + d;
          const bool ok = tt >= 0 && tt < L;
          const float v = pr[(ptrdiff_t)(ok ? d : 0) * DIN + gi * 64 + lane];
          tv[d + hw] = ok ? v : 0.f;
        }
        float s = 0.f;
#pragma unroll
        for (int d = 0; d < 2 * hw; ++d) s += tv[d];
        float mean = s / (float)(hi - lo);
        df[gi * 64 + lane] = f2bf(mean - pr[gi * 64 + lane]);
      }
    }
#pragma unroll
    for (int hd = 0; hd < 4; ++hd) {
      float x = xq[hd];
      float ss = wave_sum(x * x, lane) * (1.f / 64.f);
      float xn = x * rsqrtf(ss + RMS_EPS) * qn;
      if (samp) {
        float o = shfl_x(xn, 32, lane);
        xn = lane < 32 ? xn * cs - o * sn : o * sn + xn * cs;
      }
      qb[(size_t)row * 256 + hd * 64 + lane] = f2bf(xn);
    }
#pragma unroll
    for (int hd = 0; hd < 2; ++hd) {
      float x = xk[hd];
      float ss = wave_sum(x * x, lane) * (1.f / 64.f);
      float xn = x * rsqrtf(ss + RMS_EPS) * kn;
      float vv = xv2[hd];
      if (samp) {
        float o = shfl_x(xn, 32, lane);
        xn = lane < 32 ? xn * cs - o * sn : o * sn + xn * cs;
        const size_t sb_ = (size_t)((l * 2 + b) * 2 + hd) * 163840;
        ((bf16_t*)(ws + OFF_KS))[sb_ + kfrag_off(512 + t, lane)] = f2bf(xn);
        ((bf16_t*)(ws + OFF_VST))[sb_ + vfrag_off(512 + t, lane)] = f2bf(vv);
      } else {
        size_t oo = ((size_t)(b * 2 + l) * 256 + t) * 128 + hd * 64 + lane;
        p.out[OUT_K + oo] = xn;
        p.out[OUT_V + oo] = vv;
        const size_t sb_ = (size_t)(b * 2 + hd) * 16384;
        ((bf16_t*)(ws + OFF_KP))[sb_ + kfrag_off(t, lane)] = f2bf(xn);
        ((bf16_t*)(ws + OFF_VPT))[sb_ + vfrag_off(t, lane)] = f2bf(vv);
      }
    }
    {
      float z[4]; float s = 0.f;
#pragma unroll
      for (int i = 0; i < 4; ++i) { z[i] = gelu_t(xz[i]); s += z[i]; }
      float mean = wave_sum(s, lane) * (1.f / 256.f);
      float q = 0.f;
#pragma unroll
      for (int i = 0; i < 4; ++i) { z[i] -= mean; q += z[i] * z[i]; }
      float rstd = rsqrtf(wave_sum(q, lane) * (1.f / 256.f) + LN_EPS);
      bf16_t* vct = (bf16_t*)(ws + OFF_VCT) + (size_t)(row >> 7) * 256 * 128 + (row & 127);
#pragma unroll
      for (int i = 0; i < 4; ++i) {
        int c = i * 64 + lane;
        float vn = z[i] * rstd * INP(I_CLG)[l * 256 + c] + INP(I_CLB)[l * 256 + c];
        vct[(size_t)c * 128] = f2bf(vn);
      }
    }
  }
}

struct AttnState { f32x16 o0, o1; float m, l; };
#define ATT_LOADKV(KF, VF, K0) do { const int kt_ = (K0) >> 5; \
    _Pragma("unroll") for (int s_ = 0; s_ < 4; ++s_) KF[s_] = *(const bf16x8*)(Kb + ((size_t)(kt_ * 4 + s_) * 64 + lane) * 8); \
    _Pragma("unroll") for (int s_ = 0; s_ < 2; ++s_) { \
      VF[s_][0] = *(const bf16x8*)(Vt + ((size_t)((kt_ * 2 + s_) * 2 + 0) * 64 + lane) * 8); \
      VF[s_][1] = *(const bf16x8*)(Vt + ((size_t)((kt_ * 2 + s_) * 2 + 1) * 64 + lane) * 8); } } while (0)

DI void attn_core(const bf16_t* __restrict__ Q, int qrow0, int head, const bf16_t* __restrict__ Kb,
                  const bf16_t* __restrict__ Vt, int kbeg, int kend, int lane, AttnState& st) {
  const int r = lane & 31, hh = lane >> 5;
  bf16x8 qf[4];
  const bf16_t* qp = Q + (size_t)(qrow0 + r) * 256 + head * 64 + 8 * hh;
#pragma unroll
  for (int s = 0; s < 4; ++s) qf[s] = *(const bf16x8*)(qp + 16 * s);
  f32x16 o0, o1;
#pragma unroll
  for (int i = 0; i < 16; ++i) { o0[i] = 0.f; o1[i] = 0.f; }
  float m = -INFINITY, lsum = 0.f;
  const float c = 0.125f * 1.4426950408889634f;
  bf16x8 kf[4], vf[2][2];
  ATT_LOADKV(kf, vf, kbeg);
  for (int k0 = kbeg; k0 < kend; k0 += 32) {
    const int kn = min(k0 + 32, kend - 32);
    bf16x8 kfn[4], vfn[2][2];
    ATT_LOADKV(kfn, vfn, kn);
    f32x16 sa;
#pragma unroll
    for (int i = 0; i < 16; ++i) sa[i] = 0.f;
#pragma unroll
    for (int s = 0; s < 4; ++s) sa = MFMA32(kf[s], qf[s], sa);
    float mx = sa[0];
#pragma unroll
    for (int i = 1; i < 16; ++i) mx = fmaxf(mx, sa[i]);
    mx = fmaxf(mx, shfl_x(mx, 32, lane));
    float mn = fmaxf(m, mx);
    float alpha = __builtin_amdgcn_exp2f((m - mn) * c);
    m = mn;
    float pv[16]; float ps = 0.f;
#pragma unroll
    for (int i = 0; i < 16; ++i) { pv[i] = __builtin_amdgcn_exp2f((sa[i] - mn) * c); ps += pv[i]; }
    lsum = lsum * alpha + ps;
#pragma unroll
    for (int i = 0; i < 16; ++i) { o0[i] *= alpha; o1[i] *= alpha; }
#pragma unroll
    for (int s = 0; s < 2; ++s) {
      bf16x8 pf = pack8(pv[8 * s], pv[8 * s + 1], pv[8 * s + 2], pv[8 * s + 3], pv[8 * s + 4], pv[8 * s + 5], pv[8 * s + 6], pv[8 * s + 7]);
      o0 = MFMA32(vf[s][0], pf, o0);
      o1 = MFMA32(vf[s][1], pf, o1);
    }
#pragma unroll
    for (int s = 0; s < 4; ++s) kf[s] = kfn[s];
#pragma unroll
    for (int s = 0; s < 2; ++s) { vf[s][0] = vfn[s][0]; vf[s][1] = vfn[s][1]; }
  }
  lsum += shfl_x(lsum, 32, lane);
  st.o0 = o0; st.o1 = o1; st.m = m; st.l = lsum;
}

DI void attn_prompt_item(const bf16_t* Q, int qrow0, int head, const bf16_t* Kb, const bf16_t* Vt, bf16_t* Y, int lane) {
  AttnState st;
  attn_core(Q, qrow0, head, Kb, Vt, 0, 256, lane, st);
  const int r = lane & 31, hh = lane >> 5;
  const float il = 1.f / st.l;
  bf16_t* yp = Y + (size_t)(qrow0 + r) * D + 512 + head * 64 + 4 * hh;
#pragma unroll
  for (int g4 = 0; g4 < 4; ++g4) {
    u32x2 a = {pk2(st.o0[4 * g4] * il, st.o0[4 * g4 + 1] * il), pk2(st.o0[4 * g4 + 2] * il, st.o0[4 * g4 + 3] * il)};
    u32x2 b = {pk2(st.o1[4 * g4] * il, st.o1[4 * g4 + 1] * il), pk2(st.o1[4 * g4 + 2] * il, st.o1[4 * g4 + 3] * il)};
    *(u32x2*)(yp + 8 * g4) = a;
    *(u32x2*)(yp + 32 + 8 * g4) = b;
  }
}

DI void attn_sample_item(const Params& p, int l, int it, char* shmc, int wid, int lane) {
  char* ws = PWS;
  float* Osh = (float*)shmc;
  float* Msh = Osh + 8 * 32 * 64;
  float* Lsh = Msh + 8 * 64;
  const int b = it >> 7, head = (it >> 5) & 3, qpair = it & 31;
  const int qsub = wid & 1, ksplit = wid >> 1;
  const int qrow0 = NPROMPT + b * 2048 + (qpair * 2 + qsub) * 32;
  AttnState st;
  attn_core((const bf16_t*)(ws + OFF_QB), qrow0, head, (const bf16_t*)(ws + OFF_KS) + (size_t)((l * 2 + b) * 2 + (head >> 1)) * 163840,
            (const bf16_t*)(ws + OFF_VST) + (size_t)((l * 2 + b) * 2 + (head >> 1)) * 163840, ksplit * 640, ksplit * 640 + 640, lane, st);
  Msh[wid * 64 + lane] = st.m; Lsh[wid * 64 + lane] = st.l;
#pragma unroll
  for (int i = 0; i < 16; ++i) { Osh[(wid * 32 + i) * 64 + lane] = st.o0[i]; Osh[(wid * 32 + 16 + i) * 64 + lane] = st.o1[i]; }
  __syncthreads();
  {
    const float c = 0.125f * 1.4426950408889634f;
    float mm[4], M = -INFINITY;
#pragma unroll
    for (int k = 0; k < 4; ++k) { mm[k] = Msh[(2 * k + qsub) * 64 + lane]; M = fmaxf(M, mm[k]); }
    float sc[4], Lt = 0.f;
#pragma unroll
    for (int k = 0; k < 4; ++k) { sc[k] = __builtin_amdgcn_exp2f((mm[k] - M) * c); Lt += Lsh[(2 * k + qsub) * 64 + lane] * sc[k]; }
    const float il = 1.f / Lt;
    float ov[8];
#pragma unroll
    for (int e = 0; e < 8; ++e) {
      float a = 0.f;
#pragma unroll
      for (int k = 0; k < 4; ++k) a += Osh[((2 * k + qsub) * 32 + ksplit * 8 + e) * 64 + lane] * sc[k];
      ov[e] = a * il;
    }
    const int r = lane & 31, hh = lane >> 5;
    const int dblk = ksplit >> 1, g4 = (ksplit & 1) * 2;
    bf16_t* yp = (bf16_t*)(ws + OFF_YMIX) + (size_t)(qrow0 + r) * D + 512 + head * 64 + dblk * 32 + 8 * g4 + 4 * hh;
    u32x2 a = {pk2(ov[0], ov[1]), pk2(ov[2], ov[3])};
    u32x2 bq = {pk2(ov[4], ov[5]), pk2(ov[6], ov[7])};
    *(u32x2*)yp = a;
    *(u32x2*)(yp + 8) = bq;
  }
  __syncthreads();
}

DI void chunk_item(const Params& p, int l, int ch, int hd, int sp, int lane) {
  const int fr = lane & 15, fq = lane >> 4;
  char* ws = PWS;
  const float* wsrc = INP(I_CWS) + ((size_t)(l * 4 + hd) * 128 + sp * 16 + fr) * 128 + fq * 8;
  const bf16_t* vb = (const bf16_t*)(ws + OFF_VCT) + ((size_t)ch * 256 + hd * 64 + fr) * 128 + fq * 8;
  f32x4 acc[4];
#pragma unroll
  for (int i = 0; i < 4; ++i) acc[i] = (f32x4){0.f, 0.f, 0.f, 0.f};
#pragma unroll
  for (int ks = 0; ks < 4; ++ks) {
    float4 a0 = *(const float4*)(wsrc + ks * 32), a1 = *(const float4*)(wsrc + ks * 32 + 4);
    bf16x8 af = pack8(a0.x, a0.y, a0.z, a0.w, a1.x, a1.y, a1.z, a1.w);
#pragma unroll
    for (int nt = 0; nt < 4; ++nt) {
      bf16x8 bfr = *(const bf16x8*)(vb + (size_t)nt * 16 * 128 + ks * 32);
      acc[nt] = MFMA16(af, bfr, acc[nt]);
    }
  }
  const float* proj = (const float*)(ws + OFF_R);
  bf16_t* ymix = (bf16_t*)(ws + OFF_YMIX);
  float uu[4][4];
#pragma unroll
  for (int j = 0; j < 4; ++j)
#pragma unroll
    for (int nt = 0; nt < 4; ++nt)
      uu[j][nt] = proj[(size_t)(ch * 128 + sp * 16 + fq * 4 + j) * DIN + 1024 + hd * 64 + nt * 16 + fr];
#pragma unroll
  for (int j = 0; j < 4; ++j) {
    int pp = sp * 16 + fq * 4 + j, tok = ch * 128 + pp;
    float bs = INP(I_CBS)[(l * 4 + hd) * 128 + pp];
#pragma unroll
    for (int nt = 0; nt < 4; ++nt) {
      int c = hd * 64 + nt * 16 + fr;
      ymix[(size_t)tok * D + 768 + c] = f2bf(gelu_t(uu[j][nt]) * (acc[nt][j] + bs));
    }
  }
}

constexpr int SSM_BU_LD = 132, SSM_H_LD = 136;
constexpr int SSM_WAVE_LDS = 16 * SSM_BU_LD * 4 + 16 * SSM_H_LD * 2;
#define LDS_FENCE() do { asm volatile("s_waitcnt lgkmcnt(0)" ::: "memory"); __builtin_amdgcn_wave_barrier(); } while (0)

DI void ssm_load_u(const Params& p, int ck, int g, int lane, bf16x8 (&af)[4]) {
  const int fr = lane & 15, fq = lane >> 4;
  const float* ub = (const float*)(PWS + OFF_R) + (size_t)ck * 64 * DIN + 256 + g * 16;
#pragma unroll
  for (int tile = 0; tile < 4; ++tile) {
    if (fq < 2) {
      const float* up = ub + (size_t)(tile * 16 + fr) * DIN + fq * 8;
      float4 a0 = *(const float4*)up, a1 = *(const float4*)(up + 4);
      af[tile] = pack8(a0.x, a0.y, a0.z, a0.w, a1.x, a1.y, a1.z, a1.w);
    } else {
      af[tile] = (bf16x8){0, 0, 0, 0, 0, 0, 0, 0};
    }
  }
}

template <int MODE, int DIR>
DI void ssm_dir(const Params& p, int l, int ck, int g, int lane, const bf16x8 (&af)[4], f32x4 (&yacc)[4], char* wlds) {
  constexpr bool CHAIN = MODE == 1;
  const int fr = lane & 15, fq = lane >> 4;
  char* ws = PWS;
  float* BU = (float*)wlds;
  bf16_t* Hs = (bf16_t*)(wlds + 16 * SSM_BU_LD * 4);
  const int gidx = (l * 2 + DIR) * 16 + g, idx = gidx * 64 + lane;
  bf16x8 bfr[8], cf[4];
#pragma unroll
  for (int nt = 0; nt < 8; ++nt) bfr[nt] = ((const bf16x8*)(ws + OFF_BF))[(gidx * 8 + nt) * 64 + lane];
#pragma unroll
  for (int ks = 0; ks < 4; ++ks) cf[ks] = ((const bf16x8*)(ws + OFF_CF))[(gidx * 4 + ks) * 64 + lane];
  const float2 lam = ((const float2*)(ws + OFF_LAMB))[idx];
  float hr = 0.f, hi = 0.f;
  const bool samp = ck >= 128;
  const int CPS = samp ? 32 : 4;
  const int cs = samp ? ((ck - 128) & 31) : (ck & 3);
  const int b = samp ? ((ck - 128) >> 5) : (ck >> 2);
  if (CHAIN) {
    const float2 lamT = ((const float2*)(ws + OFF_LAMT))[idx];
    const float2* Eb = (const float2*)(ws + OFF_E);
    const int cbase = ck - cs;
    if (samp) {
      size_t si = ((size_t)((b * 2 + l) * 2 + DIR) * 16 + g) * 64 + lane;
      hr = INP(I_SRE)[si]; hi = INP(I_SIM)[si];
    }
    const int nstep = DIR == 0 ? cs : CPS - 1 - cs;
    for (int base = 0; base < nstep; base += 8) {
      float2 ev[8];
#pragma unroll
      for (int k = 0; k < 8; ++k) {
        const int st = min(base + k, nstep - 1);
        const int c2 = DIR == 0 ? st : CPS - 1 - st;
        ev[k] = Eb[((size_t)((cbase + c2) * 16 + g) * 2 + DIR) * 64 + lane];
      }
#pragma unroll
      for (int k = 0; k < 8; ++k)
        if (base + k < nstep) {
          float nr = lamT.x * hr - lamT.y * hi + ev[k].x, ni = lamT.x * hi + lamT.y * hr + ev[k].y; hr = nr; hi = ni;
        }
    }
  }
#pragma unroll
  for (int sb = 0; sb < 4; ++sb) {
    const int tile = DIR ? 3 - sb : sb;
#pragma unroll
    for (int nt = 0; nt < 8; ++nt) {
      f32x4 cz = MFMA16(af[tile], bfr[nt], ((f32x4){0.f, 0.f, 0.f, 0.f}));
#pragma unroll
      for (int j = 0; j < 4; ++j) BU[(fq * 4 + j) * SSM_BU_LD + nt * 16 + fr] = cz[j];
    }
    LDS_FENCE();
#pragma unroll
    for (int q = 0; q < 16; ++q) {
      const int tt = DIR ? 15 - q : q;
      const float2 bu = *(const float2*)(BU + tt * SSM_BU_LD + 2 * lane);
      float nr = lam.x * hr - lam.y * hi + bu.x, ni = lam.x * hi + lam.y * hr + bu.y; hr = nr; hi = ni;
      *(unsigned*)(Hs + tt * SSM_H_LD + 2 * lane) = pk2(hr, hi);
    }
    LDS_FENCE();
#pragma unroll
    for (int ks = 0; ks < 4; ++ks) {
      bf16x8 ah = *(const bf16x8*)(Hs + fr * SSM_H_LD + ks * 32 + fq * 8);
      yacc[tile] = MFMA16(ah, cf[ks], yacc[tile]);
    }
    LDS_FENCE();
  }
  if (!CHAIN) {
    ((float2*)(ws + OFF_E))[((size_t)(ck * 16 + g) * 2 + DIR) * 64 + lane] = make_float2(hr, hi);
  } else if (!samp && ((DIR == 0 && cs == 3) || (DIR == 1 && cs == 0))) {
    size_t so = ((size_t)((b * 2 + l) * 2 + DIR) * 16 + g) * 64 + lane;
    p.out[OUT_SRE + so] = hr; p.out[OUT_SIM + so] = hi;
  }
}

#define SSM1_MODE 2
DI void ssm1_item(const Params& p, int l, int ck, int g, int dir, int lane, char* wlds) {
  bf16x8 af[4]; f32x4 yacc[4];
#pragma unroll
  for (int i = 0; i < 4; ++i) yacc[i] = (f32x4){0.f, 0.f, 0.f, 0.f};
  ssm_load_u(p, ck, g, lane, af);
  if (dir) ssm_dir<SSM1_MODE, 1>(p, l, ck, g, lane, af, yacc, wlds);
  else ssm_dir<SSM1_MODE, 0>(p, l, ck, g, lane, af, yacc, wlds);
}

DI void ssm2_item(const Params& p, int l, int ck, int g, int lane, char* wlds) {
  const int fr = lane & 15, fq = lane >> 4;
  bf16x8 af[4]; f32x4 yacc[4];
#pragma unroll
  for (int i = 0; i < 4; ++i) yacc[i] = (f32x4){0.f, 0.f, 0.f, 0.f};
  ssm_load_u(p, ck, g, lane, af);
  ssm_dir<1, 0>(p, l, ck, g, lane, af, yacc, wlds);
  ssm_dir<1, 1>(p, l, ck, g, lane, af, yacc, wlds);
  char* ws = PWS;
  const float* ub = (const float*)(ws + OFF_R) + (size_t)ck * 64 * DIN + 256 + g * 16;
  bf16_t* sg = (bf16_t*)(ws + OFF_SG);
  const int c = g * 16 + fr;
  const float dd = INP(I_SSMD)[l * 256 + c];
  float uv[4][4];
#pragma unroll
  for (int t4 = 0; t4 < 4; ++t4)
#pragma unroll
    for (int j = 0; j < 4; ++j) uv[t4][j] = ub[(size_t)(t4 * 16 + fq * 4 + j) * DIN + fr];
#pragma unroll
  for (int t4 = 0; t4 < 4; ++t4)
#pragma unroll
    for (int j = 0; j < 4; ++j) {
      size_t row = (size_t)ck * 64 + t4 * 16 + fq * 4 + j;
      sg[row * 256 + c] = f2bf(gelu_t(yacc[t4][j] + dd * uv[t4][j]));
    }
}

DI void ssm1_phase(const Params& p, int l, char* shmc, int bid, int nblk) {
  const int tid = otid(), wid = __builtin_amdgcn_readfirstlane(tid >> 6), lane = tid & 63;
  char* wlds = shmc + wid * SSM_WAVE_LDS;
  for (int it = wid * nblk + bid; it < 6144; it += nblk * 8) ssm1_item(p, l, it >> 5, (it >> 1) & 15, it & 1, lane, wlds);
}

DI void mix_phase(const Params& p, int l, char* shmc, int bid, int nblk) {
  const int tid = otid(), wid = __builtin_amdgcn_readfirstlane(tid >> 6), lane = tid & 63;
  char* ws = PWS;
  for (int it = bid; it < 256; it += nblk) attn_sample_item(p, l, it, shmc, wid, lane);
  for (int it = bid * 8 + wid; it < 1024; it += nblk * 8) {
    int b = it >> 5, head = (it >> 3) & 3, qt = it & 7;
    attn_prompt_item((const bf16_t*)(ws + OFF_QB), b * 256 + qt * 32, head, (const bf16_t*)(ws + OFF_KP) + (size_t)(b * 2 + (head >> 1)) * 16384,
                     (const bf16_t*)(ws + OFF_VPT) + (size_t)(b * 2 + (head >> 1)) * 16384, (bf16_t*)(ws + OFF_YMIX), lane);
  }
  __syncthreads();
  char* wlds = shmc + wid * SSM_WAVE_LDS;
  const int slot = wid * nblk + bid, nslot = nblk * 8;
  for (int it = slot; it < 6144; it += nslot) {
    if (it < 3072) ssm2_item(p, l, it >> 4, it & 15, lane, wlds);
    else { int j = it - 3072; chunk_item(p, l, j >> 5, (j >> 3) & 3, j & 7, lane); }
  }
}

constexpr int N_PHASE = 26;
DI void run_phase(const Params& p, int ph, char* shm, int bid, int nblk) {
  char* ws = PWS;
  if (ph == 0) { prep_phase(p, shm, bid, nblk); return; }
  if (ph == 25) { lnmod_phase(p, 1, 2, -1, 0, bid, nblk); return; }
  const int l = (ph - 1) / 12, s = (ph - 1) % 12;
  const bf16_t* hA = (const bf16_t*)(ws + OFF_H);
  bf16_t* hid = (bf16_t*)(ws + OFF_R);
  float* xy = (float*)(ws + OFF_XY);
  const float* modl = (const float*)(ws + OFF_MOD) + (size_t)l * 3 * 9216;
  EpiArgs ea; ea.f0 = nullptr; ea.b0 = nullptr; ea.c0 = nullptr; ea.cb = nullptr; ea.w = 0.f;
  switch (s) {
    case 0: if (l == 0) lnmod_phase(p, -1, 0, 0, 0, bid, nblk); else lnmod_phase(p, l - 1, 2, l, 0, bid, nblk); break;
    case 1: case 10: {
      int sI = s == 1 ? 0 : 1;
      ea.b0 = hid;
      gemm_phase<1024, EPI_SWIGLU>(hA, (const bf16_t*)(ws + OFF_W1T) + (size_t)(l * 2 + sI) * 5632 * 1024, 48, 22, ea, shm, bid, nblk);
      if (l == 0 && nblk == 256 && bid >= 32) {
        if (sI == 0) convert_units(p, shm, T_W1 / 4, PER_L / 4, bid - 32, 224);
        else convert_units(p, shm, PER_L / 4, 2 * PER_L / 4, bid - 32, 224);
      } else if (l == 0 && nblk != 256 && sI == 0) {
        convert_units(p, shm, T_W1 / 4, 2 * PER_L / 4, bid, nblk);
      }
    } break;
    case 2: case 11: {
      int sI = s == 2 ? 0 : 1;
      ea.f0 = xy; ea.c0 = modl + (s == 2 ? 2 : 8) * 1024; ea.w = 0.5f;
      gemm_phase<2816, EPI_RESID, 1, 96>(hid, (const bf16_t*)(ws + OFF_W2T) + (size_t)(l * 2 + sI) * 1024 * 2816, 64, 4, ea, shm, bid, nblk);
    } break;
    case 3: lnmod_phase(p, l, 0, l, 3, bid, nblk); break;
    case 4: {
      ea.f0 = (float*)(ws + OFF_R);
      gemm_phase<1024, EPI_F32, 1, 96>(hA, (const bf16_t*)(ws + OFF_WINT) + (size_t)l * 1536 * 1024, 64, 6, ea, shm, bid, nblk);
    } break;
    case 5: post_phase(p, l, shm, bid, nblk); ssm1_phase(p, l, shm, bid, nblk); break;
    case 6: mix_phase(p, l, shm, bid, nblk); break;
    case 7: {
      ea.b0 = (bf16_t*)(ws + OFF_YMIX); ea.cb = (const bf16_t*)(ws + OFF_SG); ea.c0 = INP(I_BGLU) + l * 256;
      gemm_phase<256, EPI_GLU>((const bf16_t*)(ws + OFF_SG), (const bf16_t*)(ws + OFF_WGLUT) + (size_t)l * 65536, 48, 1, ea, shm, bid, nblk);
      ea.c0 = INP(I_POOLS) + l * 256;
      int bid2 = (bid + nblk - (nblk >> 1)) % nblk;
      gemm_phase<256, EPI_POOL>((const bf16_t*)(ws + OFF_DIFF), (const bf16_t*)(ws + OFF_WPOOLT) + (size_t)l * 65536, 48, 1, ea, shm, bid2, nblk);
    } break;
    case 8: {
      ea.f0 = xy; ea.c0 = modl + 5 * 1024; ea.w = 1.0f;
      gemm_phase<1024, EPI_RESID, 1, 96>((const bf16_t*)(ws + OFF_YMIX), (const bf16_t*)(ws + OFF_WOUTT) + (size_t)l * 1024 * 1024, 64, 4, ea, shm, bid, nblk);
    } break;
    case 9: lnmod_phase(p, l, 1, l, 6, bid, nblk); break;
  }
}

__global__ __launch_bounds__(512, 2) void mega(Params p, int ph_lo, int ph_hi) {
  extern __shared__ __attribute__((aligned(16))) char shm[];
  __shared__ uint4 xb_words;
  const int bid = blockIdx.x, nblk = gridDim.x;
  if (threadIdx.x == 0) xb_words = make_uint4(0u, 0u, 0u, 0u);
  __syncthreads();
  const XcdBarrier xb = xcd_barrier_post((unsigned*)(p.ws + OFF_BAR), (volatile LAS unsigned*)&xb_words);
  for (int ph = ph_lo; ph < ph_hi; ++ph) {
    if (ph > ph_lo) {
      if (ph_hi < 0) cg::this_grid().sync();
      xcd_barrier(xb);
    }
    run_phase(p, ph, shm, bid, nblk);
  }
}

extern "C" void kernel_launch(void* const* d_in, const int* in_sizes, int n_in, void* d_out, int out_size, void* d_ws,
                              size_t ws_size, hipStream_t stream) {
  static int grid_blocks = 0;
  if (!grid_blocks) {
    hipFuncSetAttribute((const void*)mega, hipFuncAttributeMaxDynamicSharedMemorySize, GEMM_LDS);
    int dev = 0, cus = 0, per_cu = 0;
    hipGetDevice(&dev);
    hipDeviceGetAttribute(&cus, hipDeviceAttributeMultiprocessorCount, dev);
    hipOccupancyMaxActiveBlocksPerMultiprocessor(&per_cu, mega, 512, GEMM_LDS);
    if (per_cu < 1) per_cu = 1;
    if (per_cu > 1) per_cu = 1;
    grid_blocks = cus * per_cu;
  }
  Params p{};
  for (int i = 0; i < N_IN; ++i) p.in[i] = (const float*)d_in[i];
  p.out = (float*)d_out;
  p.ws = (char*)d_ws;
  hipMemsetAsync((char*)d_ws + OFF_BAR, 0, 16384, stream);
#if ONE_LAUNCH
  int lo = 0, hi = N_PHASE;
  void* args[] = {&p, &lo, &hi};
  hipError_t e = hipLaunchCooperativeKernel((const void*)mega, dim3(grid_blocks), dim3(512), args, GEMM_LDS, stream);
  if (e != hipSuccess) fprintf(stderr, "cooperative launch failed: %s (grid %d)\n", hipGetErrorString(e), grid_blocks);
#else
  for (int ph = 0; ph < N_PHASE; ++ph) mega<<<grid_blocks, 512, GEMM_LDS, stream>>>(p, ph, ph + 1);
#endif
}
```

```cpp
#include <hip/hip_runtime.h>
#include <hip/hip_cooperative_groups.h>
#include <cstdio>
namespace cg = cooperative_groups;

#define DI __device__ __forceinline__
typedef unsigned short bf16_t;
typedef __attribute__((ext_vector_type(8))) short bf16x8;
typedef __attribute__((ext_vector_type(4))) short s16x4;
typedef __attribute__((ext_vector_type(4))) float f32x4;
typedef __attribute__((ext_vector_type(16))) float f32x16;
typedef __attribute__((ext_vector_type(2))) float f32x2;
typedef __attribute__((ext_vector_type(2))) __bf16 bf16x2v;
typedef __attribute__((ext_vector_type(4))) unsigned u32x4;
typedef __attribute__((ext_vector_type(2))) unsigned u32x2;

#ifndef ONE_LAUNCH
#define ONE_LAUNCH 1
#endif

constexpr int D = 1024, NTOK = 12288, NPROMPT = 8192, DFF = 2816, DIN = 1536;
constexpr float ALPHA = 1.4142135623730951f;
constexpr float LN_EPS = 1e-5f, RMS_EPS = 1e-6f;
enum { I_XP = 0, I_XS, I_CK, I_CV, I_SRE, I_SIM, I_C, I_CCTX, I_WMOD, I_BMOD, I_LNG, I_LNB, I_W1, I_W2, I_WIN, I_WOUT,
       I_POOLW, I_POOLS, I_LRE, I_LIM, I_LSTEP, I_BRE, I_BIM, I_CRE, I_CIM, I_SSMD, I_WGLU, I_BGLU, I_QN, I_KN,
       I_CLG, I_CLB, I_CWS, I_CBS, N_IN };
constexpr size_t OUT_K = 12582912, OUT_V = 14680064, OUT_SRE = 16777216, OUT_SIM = 16908288;

constexpr size_t OFF_W1T = 0;
constexpr size_t OFF_W2T = OFF_W1T + 46137344;
constexpr size_t OFF_WINT = OFF_W2T + 23068672;
constexpr size_t OFF_WOUTT = OFF_WINT + 6291456;
constexpr size_t OFF_WGLUT = OFF_WOUTT + 4194304;
constexpr size_t OFF_WPOOLT = OFF_WGLUT + 262144;
constexpr size_t OFF_MOD = OFF_WPOOLT + 262144;
constexpr size_t OFF_XY = OFF_MOD + 221184;
constexpr size_t OFF_H = OFF_XY + 50331648;
constexpr size_t OFF_YMIX = OFF_H + 25165824;
constexpr size_t OFF_R = OFF_YMIX + 25165824;
constexpr size_t OFF_QB = OFF_R + 75497472;
constexpr size_t OFF_KP = OFF_QB + 6291456;
constexpr size_t OFF_KS = OFF_KP + 2097152;
constexpr size_t OFF_VPT = OFF_KS + 2621440;
constexpr size_t OFF_VST = OFF_VPT + 2097152;
constexpr size_t OFF_VCT = OFF_VST + 2621440;
constexpr size_t OFF_DIFF = OFF_VCT + 6291456;
constexpr size_t OFF_SG = OFF_DIFF + 6291456;
constexpr size_t OFF_E = OFF_SG + 6291456;
constexpr size_t OFF_LAMB = OFF_E + 3145728;
constexpr size_t OFF_LAMT = OFF_LAMB + 32768;
constexpr size_t OFF_BBAR = OFF_LAMT + 32768;
constexpr size_t OFF_BAR = OFF_BBAR + 524288;
constexpr size_t OFF_BF = OFF_BAR + 16384;
constexpr size_t OFF_CF = OFF_BF + 524288;
constexpr size_t OFF_STATS = OFF_CF + 262144;
constexpr size_t WS_TOTAL = OFF_STATS + 98304;

struct Params { const float* in[N_IN]; float* out; char* ws; };

DI int otid() {
  int z = 0; asm volatile("" : "+s"(z));
  int lane = __builtin_amdgcn_mbcnt_hi(-1, __builtin_amdgcn_mbcnt_lo(-1, z));
  int w = __builtin_amdgcn_readfirstlane(threadIdx.x >> 6);
  return w * 64 + lane;
}
DI int osgpr(int i) { asm volatile("" : "+s"(i)); return i; }
#define INP(i) (p.in[osgpr(i)])
DI char* ows(char* w) { asm volatile("" : "+s"(w)); return w; }
#define PWS ows(p.ws)
DI unsigned pk2(float a, float b) { f32x2 v = {a, b}; bf16x2v r = __builtin_convertvector(v, bf16x2v); return __builtin_bit_cast(unsigned, r); }
DI bf16_t f2bf(float a) { return (bf16_t)(pk2(a, 0.f) & 0xffffu); }
DI float bf2f(bf16_t v) { return __uint_as_float(((unsigned)v) << 16); }
DI bf16x8 pack8(float a0, float a1, float a2, float a3, float a4, float a5, float a6, float a7) {
  u32x4 u = {pk2(a0, a1), pk2(a2, a3), pk2(a4, a5), pk2(a6, a7)};
  return __builtin_bit_cast(bf16x8, u);
}
DI float gelu_t(float x) {
  float z = 0.7978845608028654f * (x + 0.044715f * x * x * x);
  float e = __expf(2.f * z);
  float th = 1.f - 2.f / (e + 1.f);
  return 0.5f * x * (1.f + th);
}
DI float sigmoid_f(float x) { return 1.f / (1.f + __expf(-x)); }
DI float shfl_x(float v, int mask, int lane) {
  return __int_as_float(__builtin_amdgcn_ds_bpermute((lane ^ mask) << 2, __float_as_int(v)));
}
template <int CTRL> DI float dpp_f(float v) {
  return __int_as_float(__builtin_amdgcn_update_dpp(0, __float_as_int(v), CTRL, 0xf, 0xf, true));
}
DI float wave_sum(float v, int lane) {
  (void)lane;
  v += dpp_f<0xB1>(v);
  v += dpp_f<0x4E>(v);
  v += dpp_f<0x141>(v);
  v += dpp_f<0x140>(v);
  const int iv = __float_as_int(v);
  float r0 = __int_as_float(__builtin_amdgcn_readlane(iv, 0)), r1 = __int_as_float(__builtin_amdgcn_readlane(iv, 16));
  float r2 = __int_as_float(__builtin_amdgcn_readlane(iv, 32)), r3 = __int_as_float(__builtin_amdgcn_readlane(iv, 48));
  return (r0 + r1) + (r2 + r3);
}
DI size_t kfrag_off(int key, int d) {
  return ((size_t)((key >> 5) * 4 + (d >> 4)) * 64 + ((d >> 3) & 1) * 32 + (key & 31)) * 8 + (d & 7);
}
DI size_t vfrag_off(int key, int d) {
  const int kk = key & 31, w = kk & 15;
  return ((size_t)(((key >> 5) * 2 + (kk >> 4)) * 2 + (d >> 5)) * 64 + ((w >> 2) & 1) * 32 + (d & 31)) * 8 + (((w >> 3) << 2) | (w & 3));
}

#define MFMA16(a, b, c) __builtin_amdgcn_mfma_f32_16x16x32_bf16((a), (b), (c), 0, 0, 0)
#define MFMA32(a, b, c) __builtin_amdgcn_mfma_f32_32x32x16_bf16((a), (b), (c), 0, 0, 0)


#define XB_TMO      128
#define XB_XCNT(j)  (256  + 64 * (j))
#define XB_XSUB(j)  (1280 + 64 * (j))
#define XB_XGEN(j)  (2304 + 64 * (j))
#define XB_TOP      3328
#define XB_TOPGEN   3392
#define XCD_BAR_WORDS 3456
#define XB_SPIN_CAP (1u << 18)
#define LAS __attribute__((address_space(3)))
DI unsigned xb_ld(unsigned* p) { return __hip_atomic_load(p, __ATOMIC_RELAXED, __HIP_MEMORY_SCOPE_AGENT); }
DI unsigned xb_add(unsigned* p, unsigned v) { return __hip_atomic_fetch_add(p, v, __ATOMIC_RELAXED, __HIP_MEMORY_SCOPE_AGENT); }
DI unsigned xb_xcc_id() { return (unsigned)__builtin_amdgcn_s_getreg((3 << 11) | 20) & 0xFu; }
#define XB_SPIN(cond, bar) do { unsigned _sp = 0; while (cond) { __builtin_amdgcn_s_sleep(1); \
    if ((++_sp & 255u) == 0u) { if (xb_ld(&(bar)[XB_TMO])) break; if (_sp > XB_SPIN_CAP) { atomicAdd(&(bar)[XB_TMO], 1u); break; } } } } while (0)
struct XcdBarrier { unsigned* bar; unsigned x; volatile LAS unsigned* st; };
DI XcdBarrier xcd_barrier_post(unsigned* bar, volatile LAS unsigned* st) {
  XcdBarrier b; b.bar = bar; b.x = xb_xcc_id(); b.st = st;
  if (threadIdx.x == 0) (void)xb_add(&bar[XB_XCNT(b.x)], 1u);
  return b;
}
DI void xcd_barrier_complete(unsigned* bar, unsigned x, unsigned& nloc, unsigned& nx) {
  const unsigned G = gridDim.x * gridDim.y * gridDim.z;
  unsigned sum, cnt, mine, sp = 0u;
  for (;;) {
    sum = 0u; cnt = 0u; mine = 0u;
#pragma unroll
    for (unsigned j = 0; j < 16; ++j) { const unsigned c = xb_ld(&bar[XB_XCNT(j)]); sum += c; cnt += (c > 0u) ? 1u : 0u; mine = (j == x) ? c : mine; }
    if (sum == G) break;
    __builtin_amdgcn_s_sleep(1);
    if ((++sp & 255u) == 0u) { if (xb_ld(&bar[XB_TMO])) break; if (sp > XB_SPIN_CAP) { atomicAdd(&bar[XB_TMO], 1u); break; } }
  }
  nloc = mine > 0u ? mine : 1u; nx = cnt > 0u ? cnt : 1u;
}
DI void xcd_barrier(const XcdBarrier& b) {
  asm volatile("s_waitcnt vmcnt(0)" ::: "memory");
  __syncthreads();
  if (threadIdx.x == 0) {
    unsigned* bar = b.bar;
    __builtin_amdgcn_s_waitcnt(0);
    unsigned nloc = b.st[0], nx = b.st[1];
    if (nloc == 0u) { xcd_barrier_complete(bar, b.x, nloc, nx); b.st[0] = nloc; b.st[1] = nx; }
    const unsigned old = xb_add(&bar[XB_XSUB(b.x)], 1u);
    const unsigned gen = old / nloc;
    if (old + 1u == (gen + 1u) * nloc) {
      __builtin_amdgcn_fence(__ATOMIC_RELEASE, "agent");
      asm volatile("s_waitcnt vmcnt(0)" ::: "memory");
      const unsigned og = xb_add(&bar[XB_TOP], 1u);
      const unsigned tg = og / nx;
      if (og + 1u == (tg + 1u) * nx) xb_add(&bar[XB_TOPGEN], 1u);
      else XB_SPIN(xb_ld(&bar[XB_TOPGEN]) == tg, bar);
      __builtin_amdgcn_fence(__ATOMIC_ACQUIRE, "agent");
      xb_add(&bar[XB_XGEN(b.x)], 1u);
      asm volatile("s_waitcnt vmcnt(0)" ::: "memory");
    } else {
      XB_SPIN(xb_ld(&bar[XB_XGEN(b.x)]) == gen, bar);
      __builtin_amdgcn_fence(__ATOMIC_ACQUIRE, "agent");
      asm volatile("s_waitcnt vmcnt(0)" ::: "memory");
    }
  }
  __syncthreads();
}

constexpr int BM = 256, BK = 64, HALF = 128, NXCD = 8, WGM = 8, HT = HALF * BK;
constexpr int GEMM_LDS = 8 * HT * 2;

DI int lds_byte(int r, int c) {
  int st = (r >> 4) * 2 + (c >> 5), rr = r & 15, cc = c & 31, ob = rr * 64 + cc * 2;
  return st * 1024 + (ob ^ (((ob >> 9) & 1) << 5));
}
DI void stage_rc(int b, int& R, int& C) {
  int st = b / 1024, sb = b % 1024, swz = sb ^ (((sb >> 9) & 1) << 5);
  R = (st >> 1) * 16 + swz / 64; C = (st & 1) * 32 + (swz % 64) / 2;
}

enum { EPI_SWIGLU = 0, EPI_RESID, EPI_F32, EPI_GLU, EPI_POOL };
struct EpiArgs {
  float* f0;
  bf16_t* b0;
  const float* c0;
  const bf16_t* cb;
  float w;
  const float* lng; const float* lnb; const float2* stats; const float* xin0; const float* xin1;
};

template <int K, int MODE, int SPLITS = 1, int RH = 128>
DI void gemm_phase(const bf16_t* __restrict__ A, const bf16_t* __restrict__ Bt, int nM, int nN, EpiArgs ea,
                   char* shmc, int bid, int nblk) {
  bf16_t* shm = (bf16_t*)shmc;
#define SA(b, h) (shm + ((b) * 2 + (h)) * HT)
#define SB(b, h) (shm + (4 + (b) * 2 + (h)) * HT)
#define STAGE(P, RS, SOFF, kt) do { const int _so = (SOFF) + (kt0 + (kt)) * (BK * 2); \
    __builtin_amdgcn_raw_ptr_buffer_load_lds(RS, (__attribute__((address_space(3))) void*)((char*)(P) + wid * 1024), 16, so0, _so, 0, 0); \
    __builtin_amdgcn_raw_ptr_buffer_load_lds(RS, (__attribute__((address_space(3))) void*)((char*)(P) + wid * 1024 + 8192), 16, so1, _so, 0, 0); } while (0)
#define LDA(dst, b, h) for (int m = 0; m < MT; ++m) for (int k = 0; k < 2; ++k) \
    dst[m][k] = *reinterpret_cast<const bf16x8*>((char*)SA(b, h) + lds_byte(wr * (RH / 2) + m * 16 + fr, k * 32 + fq * 8))
#define LDB(dst, b, h) for (int n = 0; n < 2; ++n) for (int k = 0; k < 2; ++k) \
    dst[n][k] = *reinterpret_cast<const bf16x8*>((char*)SB(b, h) + lds_byte(wc * 32 + n * 16 + fr, k * 32 + fq * 8))
#define MMA(ai, bj, At, Bt_) do { __builtin_amdgcn_s_setprio(1); \
    for (int m = 0; m < MT; ++m) for (int n = 0; n < 2; ++n) for (int k = 0; k < 2; ++k) \
      acc[ai][bj][m][n] = MFMA16(At[m][k], Bt_[n][k], acc[ai][bj][m][n]); \
    __builtin_amdgcn_s_setprio(0); } while (0)
#define WAIT_V(n) asm volatile("s_waitcnt vmcnt(" #n ")" ::: "memory")
#define WAIT_L(n) asm volatile("s_waitcnt lgkmcnt(" #n ")" ::: "memory")
#define BAR __builtin_amdgcn_s_barrier()
#define SCHED __builtin_amdgcn_sched_barrier(0)
  constexpr int MT = RH / 32;
  constexpr int TM = 2 * RH;
  const int tid = otid();
  const int wid = __builtin_amdgcn_readfirstlane(tid >> 6), lane = tid & 63, wr = wid >> 2, wc = wid & 3, fr = lane & 15, fq = lane >> 4;
  const __amdgpu_buffer_rsrc_t rsA = __builtin_amdgcn_make_buffer_rsrc((void*)A, 0, 0x7fffffff, 0x00020000);
  const __amdgpu_buffer_rsrc_t rsB = __builtin_amdgcn_make_buffer_rsrc((void*)Bt, 0, 0x7fffffff, 0x00020000);
  unsigned so0, so1;
  { int R, C; stage_rc(tid * 16, R, C); so0 = (unsigned)(R * K + C) * 2u; stage_rc(tid * 16 + 8192, R, C); so1 = (unsigned)(R * K + C) * 2u; }
  const int nwg = nM * nN;
  for (int unit = bid; unit < nwg * SPLITS; unit += nblk) {
    const int sp = SPLITS == 1 ? 0 : unit / nwg, tile = SPLITS == 1 ? unit : unit % nwg;
    const int kt0 = SPLITS == 1 ? 0 : (sp == 0 ? 0 : sp == 1 ? 12 : sp == 2 ? 24 : 34);
    const int nt = SPLITS == 1 ? K / BK : (sp < 2 ? 12 : 10);
    int wgid = tile;
    { int q = nwg / NXCD, r = nwg % NXCD, xcd = wgid % NXCD, off = wgid / NXCD;
      wgid = (xcd < r ? xcd * (q + 1) : r * (q + 1) + (xcd - r) * q) + off; }
    int nig = WGM * nN, gid = wgid / nig, fm = gid * WGM, gsz = min(nM - fm, WGM);
    int pm = fm + ((wgid % nig) % gsz), pn = (wgid % nig) / gsz, brow = pm * TM, bcol = pn * BM;
    const int A0 = brow * K * 2, A1 = A0 + RH * K * 2, B0p = bcol * K * 2, B1p = B0p + HALF * K * 2;
    f32x4 acc[2][2][MT][2] = {};
    bf16x8 At[MT][2], B0[2][2], B1[2][2];
    STAGE(SB(0, 0), rsB, B0p, 0); STAGE(SA(0, 0), rsA, A0, 0);
    STAGE(SB(0, 1), rsB, B1p, 0); STAGE(SA(0, 1), rsA, A1, 0);
    if (wr == 1) BAR;
    WAIT_V(4); BAR;
    STAGE(SB(1, 0), rsB, B0p, 1); STAGE(SA(1, 0), rsA, A0, 1); STAGE(SB(1, 1), rsB, B1p, 1);
    WAIT_V(6); BAR;
    for (int t = 0; t < nt - 2; t += 2) {
      LDB(B0, 0, 0); SCHED; LDA(At, 0, 0); STAGE(SA(1, 1), rsA, A1, t + 1);
      if (MT == 4) WAIT_L(8); else WAIT_L(6); BAR; WAIT_L(0); MMA(0, 0, At, B0); BAR; SCHED;
      LDB(B1, 0, 1); STAGE(SB(0, 0), rsB, B0p, t + 2);
      BAR; WAIT_L(0); MMA(0, 1, At, B1); BAR;
      LDA(At, 0, 1); STAGE(SA(0, 0), rsA, A0, t + 2);
      BAR; WAIT_L(0); MMA(1, 0, At, B0); BAR; SCHED;
      STAGE(SB(0, 1), rsB, B1p, t + 2);
      WAIT_V(6); BAR; MMA(1, 1, At, B1); BAR;
      LDB(B0, 1, 0); SCHED; LDA(At, 1, 0); STAGE(SA(0, 1), rsA, A1, t + 2);
      if (MT == 4) WAIT_L(8); else WAIT_L(6); BAR; WAIT_L(0); MMA(0, 0, At, B0); BAR; SCHED;
      LDB(B1, 1, 1); STAGE(SB(1, 0), rsB, B0p, t + 3);
      BAR; WAIT_L(0); MMA(0, 1, At, B1); BAR;
      LDA(At, 1, 1); STAGE(SA(1, 0), rsA, A0, t + 3);
      BAR; WAIT_L(0); MMA(1, 0, At, B0); BAR; SCHED;
      STAGE(SB(1, 1), rsB, B1p, t + 3);
      WAIT_V(6); BAR; MMA(1, 1, At, B1); BAR;
    }
    { LDB(B0, 0, 0); LDA(At, 0, 0); STAGE(SA(1, 1), rsA, A1, nt - 1);
      BAR; WAIT_L(0); MMA(0, 0, At, B0); BAR;
      LDB(B1, 0, 1); BAR; WAIT_L(0); MMA(0, 1, At, B1); BAR;
      LDA(At, 0, 1); WAIT_V(4); BAR; WAIT_L(0); MMA(1, 0, At, B0); MMA(1, 1, At, B1); BAR; }
    { LDB(B0, 1, 0); LDA(At, 1, 0); WAIT_V(2); BAR; WAIT_L(0); MMA(0, 0, At, B0); BAR;
      LDB(B1, 1, 1); WAIT_V(0); BAR; WAIT_L(0); MMA(0, 1, At, B1); BAR;
      LDA(At, 1, 1); BAR; WAIT_L(0); MMA(1, 0, At, B0); MMA(1, 1, At, B1); BAR; }
    if (wr == 0) BAR;
    const int ci = brow < NPROMPT ? 0 : 1 + (brow - NPROMPT) / 2048;
    const int ci2 = (brow + TM - 1) < NPROMPT ? 0 : 1 + (brow + TM - 1 - NPROMPT) / 2048;
    const int rsplit = ci2 == 1 ? NPROMPT : NPROMPT + 2048;
    const int te = otid(), le = te & 63, wide = te >> 6;
    const int wr = wide >> 2, wc = wide & 3, fr = le & 15, fq = le >> 4;
    const int rbase = brow + wr * (RH / 2) + fq * 4, cbase = bcol + wc * 32 + fr;
    if (MODE == EPI_SWIGLU) {
#pragma unroll
      for (int ai = 0; ai < 2; ++ai)
#pragma unroll
        for (int m = 0; m < MT; ++m)
#pragma unroll
          for (int j = 0; j < 4; ++j) {
            const int row = rbase + ai * RH + m * 16 + j;
#pragma unroll
            for (int n = 0; n < 2; ++n) {
              float g = acc[ai][0][m][n][j], u = acc[ai][1][m][n][j];
              ea.b0[(size_t)row * DFF + pn * 128 + wc * 32 + n * 16 + fr] = f2bf(g * sigmoid_f(g) * u);
            }
          }
    } else if (MODE == EPI_RESID) {
      float gate[2][2], gate2[2][2], lg[2][2], lb[2][2];
      const bool raw = ea.lng == nullptr;
#pragma unroll
      for (int bj = 0; bj < 2; ++bj)
#pragma unroll
        for (int n = 0; n < 2; ++n) {
          const int col = cbase + bj * HALF + n * 16;
          gate[bj][n] = ea.w * ea.c0[ci * 9216 + col];
          gate2[bj][n] = ea.w * ea.c0[ci2 * 9216 + col];
          lg[bj][n] = raw ? 1.f : ea.lng[col];
          lb[bj][n] = raw ? 0.f : ea.lnb[col];
        }
#pragma unroll
      for (int ai = 0; ai < 2; ++ai)
#pragma unroll
        for (int m = 0; m < MT; ++m) {
          const int r0 = rbase + ai * RH + m * 16;
          float* xb = ea.f0 + (size_t)r0 * D + cbase;
          float xv[4][2][2];
          float2 st[4];
#pragma unroll
          for (int j = 0; j < 4; ++j) {
            const int row = r0 + j;
            const float* src = raw ? (row < NPROMPT ? ea.xin0 + (size_t)row * D : ea.xin1 + (size_t)(row - NPROMPT) * D) + cbase
                                   : xb + (size_t)j * D;
            st[j] = raw ? make_float2(0.f, 1.f) : ea.stats[row];
#pragma unroll
            for (int bj = 0; bj < 2; ++bj)
#pragma unroll
              for (int n = 0; n < 2; ++n) xv[j][bj][n] = src[bj * HALF + n * 16];
          }
#pragma unroll
          for (int j = 0; j < 4; ++j)
#pragma unroll
            for (int bj = 0; bj < 2; ++bj)
#pragma unroll
              for (int n = 0; n < 2; ++n) {
                const float x = (xv[j][bj][n] - st[j].x) * st[j].y * lg[bj][n] + lb[bj][n];
                xb[(size_t)j * D + bj * HALF + n * 16] =
                    ALPHA * x + ((r0 + j) >= rsplit ? gate2[bj][n] : gate[bj][n]) * acc[ai][bj][m][n][j];
              }
        }
    } else if (MODE == EPI_GLU) {
      float bg[2][2];
#pragma unroll
      for (int bj = 0; bj < 2; ++bj)
#pragma unroll
        for (int n = 0; n < 2; ++n) bg[bj][n] = ea.c0[cbase + bj * HALF + n * 16];
#pragma unroll
      for (int ai = 0; ai < 2; ++ai) {
        float gv[MT][4][2][2];
        const bf16_t* gb = ea.cb + (size_t)(rbase + ai * RH) * 256 + cbase;
#pragma unroll
        for (int m = 0; m < MT; ++m)
#pragma unroll
          for (int j = 0; j < 4; ++j)
#pragma unroll
            for (int bj = 0; bj < 2; ++bj)
#pragma unroll
              for (int n = 0; n < 2; ++n) gv[m][j][bj][n] = bf2f(gb[(size_t)(m * 16 + j) * 256 + bj * HALF + n * 16]);
        bf16_t* yb = ea.b0 + (size_t)(rbase + ai * RH) * D + 256 + cbase;
#pragma unroll
        for (int m = 0; m < MT; ++m)
#pragma unroll
          for (int j = 0; j < 4; ++j)
#pragma unroll
            for (int bj = 0; bj < 2; ++bj)
#pragma unroll
              for (int n = 0; n < 2; ++n)
                yb[(size_t)(m * 16 + j) * D + bj * HALF + n * 16] =
                    f2bf(gv[m][j][bj][n] * sigmoid_f(acc[ai][bj][m][n][j] + bg[bj][n]));
      }
    } else {
      float ps[2][2];
#pragma unroll
      for (int bj = 0; bj < 2; ++bj)
#pragma unroll
        for (int n = 0; n < 2; ++n) ps[bj][n] = MODE == EPI_POOL ? ea.c0[cbase + bj * HALF + n * 16] : 1.f;
#pragma unroll
      for (int ai = 0; ai < 2; ++ai)
#pragma unroll
        for (int m = 0; m < MT; ++m)
#pragma unroll
          for (int j = 0; j < 4; ++j) {
            const int row = rbase + ai * RH + m * 16 + j;
#pragma unroll
            for (int bj = 0; bj < 2; ++bj)
#pragma unroll
              for (int n = 0; n < 2; ++n) {
                const int col = cbase + bj * HALF + n * 16;
                float a = acc[ai][bj][m][n][j];
                if (MODE == EPI_F32) ea.f0[(size_t)row * DIN + col] = a;
                else ea.b0[(size_t)row * D + col] = f2bf(a * ps[bj][n]);
              }
          }
    }
  }
#undef SA
#undef SB
}

constexpr int T_W1 = 16 * 88, T_W2 = 44 * 16, T_IN = 16 * 24, T_OUT = 256, T_GLU = 16;
constexpr int PER_L = 2 * T_W1 + 2 * T_W2 + T_IN + T_OUT + T_GLU;
DI void convert_units(const Params& p, char* shmc, int unit_begin, int unit_end, int worker, int nworkers) {
  const int tid = otid();
  char* ws = PWS;
  constexpr int NTL = 4;
  __syncthreads();
  for (int u = unit_begin + worker; u < unit_end; u += nworkers) {
    const int it0 = u * NTL;
    bf16_t* dsts[NTL]; int Ks[NTL], modes[NTL], kts[NTL], ntiles[NTL];
    float4 v[NTL][2];
#pragma unroll
    for (int q = 0; q < NTL; ++q) {
      const int it = it0 + q;
      int l = it / PER_L, r = it % PER_L;
      const float* src; bf16_t* dst; int K, N, mode = 0;
      if (r < 2 * T_W1) {
        int s2 = r / T_W1; r %= T_W1;
        src = INP(I_W1) + (size_t)(l * 2 + s2) * 1024 * 5632; dst = (bf16_t*)(ws + OFF_W1T) + (size_t)(l * 2 + s2) * 5632 * 1024;
        K = 1024; N = 5632; mode = 1;
      } else if (r < 2 * T_W1 + 2 * T_W2) {
        r -= 2 * T_W1; int s2 = r / T_W2; r %= T_W2;
        src = INP(I_W2) + (size_t)(l * 2 + s2) * 2816 * 1024; dst = (bf16_t*)(ws + OFF_W2T) + (size_t)(l * 2 + s2) * 1024 * 2816;
        K = 2816; N = 1024;
      } else if (r < 2 * T_W1 + 2 * T_W2 + T_IN) {
        r -= 2 * T_W1 + 2 * T_W2;
        src = INP(I_WIN) + (size_t)l * 1024 * 1536; dst = (bf16_t*)(ws + OFF_WINT) + (size_t)l * 1536 * 1024;
        K = 1024; N = 1536;
      } else if (r < 2 * T_W1 + 2 * T_W2 + T_IN + T_OUT) {
        r -= 2 * T_W1 + 2 * T_W2 + T_IN;
        src = INP(I_WOUT) + (size_t)l * 1024 * 1024; dst = (bf16_t*)(ws + OFF_WOUTT) + (size_t)l * 1024 * 1024;
        K = 1024; N = 1024;
      } else {
        r -= 2 * T_W1 + 2 * T_W2 + T_IN + T_OUT;
        src = INP(I_WGLU) + (size_t)l * 256 * 256; dst = (bf16_t*)(ws + OFF_WGLUT) + (size_t)l * 256 * 256;
        K = 256; N = 256;
      }
      const int nkt = K / 64, kt = r % nkt, ntile = r / nkt;
      dsts[q] = dst; Ks[q] = K; modes[q] = mode; kts[q] = kt; ntiles[q] = ntile;
#pragma unroll
      for (int i = 0; i < 2; ++i) {
        int k = (tid >> 4) + 32 * i, n = (tid & 15) * 4;
        v[q][i] = *(const float4*)(src + (size_t)(kt * 64 + k) * N + ntile * 64 + n);
      }
    }
#pragma unroll
    for (int q = 0; q < NTL; ++q) {
      float* tile = (float*)shmc + q * (64 * 65);
#pragma unroll
      for (int i = 0; i < 2; ++i) {
        int k = (tid >> 4) + 32 * i, n = (tid & 15) * 4;
        tile[k * 65 + n] = v[q][i].x; tile[k * 65 + n + 1] = v[q][i].y; tile[k * 65 + n + 2] = v[q][i].z; tile[k * 65 + n + 3] = v[q][i].w;
      }
    }
    __syncthreads();
#pragma unroll
    for (int q = 0; q < NTL; ++q) {
      const float* tile = (const float*)shmc + q * (64 * 65);
      int n = tid >> 3, kk = (tid & 7) * 8;
      int nsrc = ntiles[q] * 64 + n, nrow = nsrc;
      if (modes[q] == 1) {
        if (nsrc < 2816) nrow = (nsrc >> 7) * 256 + (nsrc & 127);
        else { int mm = nsrc - 2816; nrow = (mm >> 7) * 256 + 128 + (mm & 127); }
      }
      bf16x8 o = pack8(tile[(kk + 0) * 65 + n], tile[(kk + 1) * 65 + n], tile[(kk + 2) * 65 + n], tile[(kk + 3) * 65 + n],
                       tile[(kk + 4) * 65 + n], tile[(kk + 5) * 65 + n], tile[(kk + 6) * 65 + n], tile[(kk + 7) * 65 + n]);
      *(bf16x8*)(dsts[q] + (size_t)nrow * Ks[q] + kts[q] * 64 + kk) = o;
    }
    __syncthreads();
  }
}

DI void prep_phase(const Params& p, char* shmc, int bid, int nblk) {
  const int tid = otid(), wid = tid >> 6, lane = tid & 63;
  char* ws = PWS;
  convert_units(p, shmc, 0, T_W1 / 4, bid, nblk);
  const int gtid = bid * 512 + tid, gn = nblk * 512;
  for (int i = gtid; i < 2 * 65536; i += gn) {
    int l = i >> 16, n = (i >> 8) & 255, k = i & 255;
    int gi = n >> 6, d = n & 63, gj = k >> 6, c = k & 63;
    float v = (gi == gj) ? INP(I_POOLW)[((size_t)(l * 4 + gi) * 64 + c) * 64 + d] : 0.f;
    ((bf16_t*)(ws + OFF_WPOOLT))[i] = f2bf(v);
  }
  {
    float* sc = (float*)shmc + 4 * 64 * 65;
    float* red = sc + 3 * 1024;
    for (int i = tid; i < 3 * 1024; i += 512) {
      int ci = i >> 10, k = i & 1023;
      float v = ci == 0 ? INP(I_CCTX)[k] : INP(I_C)[(ci - 1) * 1024 + k];
      sc[i] = v * sigmoid_f(v);
    }
    __syncthreads();
    for (int it = bid; it < 288; it += nblk) {
      int l = it / 144, cb = it % 144, col = cb * 64 + lane;
      const float* wp = INP(I_WMOD) + (size_t)l * 1024 * 9216 + col;
      float a0 = 0.f, a1 = 0.f, a2 = 0.f;
#pragma unroll 8
      for (int k = wid * 128; k < wid * 128 + 128; ++k) {
        float w = wp[(size_t)k * 9216];
        a0 += sc[k] * w; a1 += sc[1024 + k] * w; a2 += sc[2048 + k] * w;
      }
      red[(wid * 3 + 0) * 64 + lane] = a0; red[(wid * 3 + 1) * 64 + lane] = a1; red[(wid * 3 + 2) * 64 + lane] = a2;
      __syncthreads();
      if (tid < 192) {
        int ci = tid >> 6;
        float s = 0.f;
        for (int w = 0; w < 8; ++w) s += red[(w * 3 + ci) * 64 + lane];
        ((float*)(ws + OFF_MOD))[(size_t)(l * 3 + ci) * 9216 + col] = s + INP(I_BMOD)[l * 9216 + col];
      }
      __syncthreads();
    }
  }
  for (int i = gtid; i < 2 * 2 * 512 * 128; i += gn) {
    int c = i & 127, t = (i >> 7) & 511, b = (i >> 16) & 1, l = i >> 17;
    size_t si = ((size_t)(b * 2 + l) * 512 + t) * 128 + c;
    const size_t sb_ = (size_t)((l * 2 + b) * 2 + (c >> 6)) * 163840;
    ((bf16_t*)(ws + OFF_KS))[sb_ + kfrag_off(t, c & 63)] = f2bf(INP(I_CK)[si]);
    ((bf16_t*)(ws + OFF_VST))[sb_ + vfrag_off(t, c & 63)] = f2bf(INP(I_CV)[si]);
  }
  for (int i = gtid; i < 4096; i += gn) {
    float lre = INP(I_LRE)[i], lim = INP(I_LIM)[i];
    float dt = expf(INP(I_LSTEP)[i >> 6]);
    float e = expf(lre * dt), ang = lim * dt;
    float br = e * cosf(ang), bi = e * sinf(ang);
    float ar = br - 1.f, ai = bi, den = lre * lre + lim * lim;
    float cr = (ar * lre + ai * lim) / den, cim = (ai * lre - ar * lim) / den;
    ((float2*)(ws + OFF_LAMB))[i] = make_float2(br, bi);
    float pr = br, pi = bi;
    for (int s = 0; s < 6; ++s) { float nr = pr * pr - pi * pi, ni = 2.f * pr * pi; pr = nr; pi = ni; }
    ((float2*)(ws + OFF_LAMT))[i] = make_float2(pr, pi);
  }
  for (int i = gtid; i < 64 * 8 * 64; i += gn) {
    const int gidx = i >> 9, nt = (i >> 6) & 7, ln = i & 63, fr = ln & 15, fq = ln >> 4;
    bf16x8 o = (bf16x8){0, 0, 0, 0, 0, 0, 0, 0};
    if (fq < 2) {
      const int n = nt * 8 + (fr >> 1), idx = gidx * 64 + n;
      float lre = INP(I_LRE)[idx], lim = INP(I_LIM)[idx];
      float dt = expf(INP(I_LSTEP)[gidx]);
      float e = expf(lre * dt), ang = lim * dt;
      float br = e * cosf(ang), bi = e * sinf(ang);
      float ar = br - 1.f, ai = bi, den = lre * lre + lim * lim;
      float cr = (ar * lre + ai * lim) / den, cim = (ai * lre - ar * lim) / den;
      float v[8];
#pragma unroll
      for (int j = 0; j < 8; ++j) {
        float xr = INP(I_BRE)[(size_t)idx * 16 + fq * 8 + j], xi = INP(I_BIM)[(size_t)idx * 16 + fq * 8 + j];
        v[j] = (fr & 1) ? cr * xi + cim * xr : cr * xr - cim * xi;
      }
      o = pack8(v[0], v[1], v[2], v[3], v[4], v[5], v[6], v[7]);
    }
    ((bf16x8*)(ws + OFF_BF))[i] = o;
  }
  for (int i = gtid; i < 64 * 4 * 64; i += gn) {
    const int gidx = i >> 8, ks = (i >> 6) & 3, ln = i & 63, fr = ln & 15, fq = ln >> 4;
    const size_t co = ((size_t)gidx * 16 + fr) * 64 + ks * 16 + fq * 4;
    float4 cr = *(const float4*)(INP(I_CRE) + co), cim = *(const float4*)(INP(I_CIM) + co);
    ((bf16x8*)(ws + OFF_CF))[i] = pack8(cr.x, -cim.x, cr.y, -cim.y, cr.z, -cim.z, cr.w, -cim.w);
  }
}

DI void lnmod_phase(const Params& p, int l_ln, int ln_idx, int l_mod, int mod_idx, int bid, int nblk) {
  const int tid = otid(), wid = tid >> 6, lane = tid & 63;
  float* xy = (float*)(PWS + OFF_XY);
  bf16_t* h = (bf16_t*)(PWS + OFF_H);
  const float* modv = (const float*)(PWS + OFF_MOD);
  const int stride = nblk * 8;
  float4 gg[4], bb[4];
  if (l_ln >= 0) {
    const float* g = INP(I_LNG) + (l_ln * 3 + ln_idx) * 1024;
    const float* b = INP(I_LNB) + (l_ln * 3 + ln_idx) * 1024;
#pragma unroll
    for (int i = 0; i < 4; ++i) { gg[i] = *(const float4*)(g + lane * 4 + i * 256); bb[i] = *(const float4*)(b + lane * 4 + i * 256); }
  }
#define LN_SRC(R) (l_ln < 0 ? ((R) < NPROMPT ? INP(I_XP) + (size_t)(R) * D : INP(I_XS) + (size_t)((R) - NPROMPT) * D) : xy + (size_t)(R) * D)
  int row = bid * 8 + wid;
  float4 nv[4];
  if (row < NTOK) {
    const float* src = LN_SRC(row);
#pragma unroll
    for (int i = 0; i < 4; ++i) nv[i] = *(const float4*)(src + lane * 4 + i * 256);
  }
  for (; row < NTOK; row += stride) {
    float4 v[4];
#pragma unroll
    for (int i = 0; i < 4; ++i) v[i] = nv[i];
    if (row + stride < NTOK) {
      const float* src = LN_SRC(row + stride);
#pragma unroll
      for (int i = 0; i < 4; ++i) nv[i] = *(const float4*)(src + lane * 4 + i * 256);
    }
    float4 ma[4], mc[4];
    if (l_mod >= 0) {
      int ci = row < NPROMPT ? 0 : 1 + (row - NPROMPT) / 2048;
      const float* sh = modv + (size_t)(l_mod * 3 + ci) * 9216 + mod_idx * 1024;
#pragma unroll
      for (int i = 0; i < 4; ++i) { ma[i] = *(const float4*)(sh + lane * 4 + i * 256); mc[i] = *(const float4*)(sh + 1024 + lane * 4 + i * 256); }
    }
    if (l_ln >= 0) {
      float s = 0.f;
#pragma unroll
      for (int i = 0; i < 4; ++i) s += v[i].x + v[i].y + v[i].z + v[i].w;
      float mean = wave_sum(s, lane) * (1.f / 1024.f);
      float q = 0.f;
#pragma unroll
      for (int i = 0; i < 4; ++i) {
        v[i].x -= mean; v[i].y -= mean; v[i].z -= mean; v[i].w -= mean;
        q += v[i].x * v[i].x + v[i].y * v[i].y + v[i].z * v[i].z + v[i].w * v[i].w;
      }
      float rstd = rsqrtf(wave_sum(q, lane) * (1.f / 1024.f) + LN_EPS);
      if (lane == 0) ((float2*)(PWS + OFF_STATS))[row] = make_float2(mean, rstd);
#pragma unroll
      for (int i = 0; i < 4; ++i) {
        v[i].x = v[i].x * rstd * gg[i].x + bb[i].x; v[i].y = v[i].y * rstd * gg[i].y + bb[i].y;
        v[i].z = v[i].z * rstd * gg[i].z + bb[i].z; v[i].w = v[i].w * rstd * gg[i].w + bb[i].w;
      }
    }
    if (l_mod < 0) {
      float* dx = p.out + (size_t)row * D;
#pragma unroll
      for (int i = 0; i < 4; ++i) *(float4*)(dx + lane * 4 + i * 256) = v[i];
    }
    if (l_mod >= 0) {
#pragma unroll
      for (int i = 0; i < 4; ++i) {
        u32x2 o = {pk2(v[i].x * (1.f + mc[i].x) + ma[i].x, v[i].y * (1.f + mc[i].y) + ma[i].y),
                   pk2(v[i].z * (1.f + mc[i].z) + ma[i].z, v[i].w * (1.f + mc[i].w) + ma[i].w)};
        *(u32x2*)(h + (size_t)row * D + lane * 4 + i * 256) = o;
      }
    }
  }
#undef LN_SRC
}

DI void post_phase(const Params& p, int l, char* shmc, int bid, int nblk) {
  const int tid = otid(), wid = tid >> 6, lane = tid & 63;
  char* ws = PWS;
  const float* proj = (const float*)(ws + OFF_R);
  bf16_t* qb = (bf16_t*)(ws + OFF_QB);
  const float qn = INP(I_QN)[l * 64 + lane], kn = INP(I_KN)[l * 64 + lane];
  const int fi = lane & 15;
  const float inv = exp2f(-(float)fi * (13.287712379549449f / 16.f));
  for (int row = bid * 8 + wid; row < NTOK; row += nblk * 8) {
    const float* pr = proj + (size_t)row * DIN;
    const bool samp = row >= NPROMPT;
    int b, t, L;
    if (samp) { b = (row - NPROMPT) >> 11; t = (row - NPROMPT) & 2047; L = 2048; }
    else { b = row >> 8; t = row & 255; L = 256; }
    float cs = 1.f, sn = 0.f;
    if (samp) {
      float pos = (float)((lane & 31) < 16 ? (t >> 6) : (t & 63));
      float ang = pos * inv;
      cs = cosf(ang); sn = sinf(ang);
    }
    float xq[4], xk[2], xv2[2], xz[4];
#pragma unroll
    for (int i = 0; i < 4; ++i) { xq[i] = pr[512 + i * 64 + lane]; xz[i] = pr[1280 + i * 64 + lane]; }
#pragma unroll
    for (int i = 0; i < 2; ++i) { xk[i] = pr[768 + i * 64 + lane]; xv2[i] = pr[896 + i * 64 + lane]; }
    {
      bf16_t* df = (bf16_t*)(ws + OFF_DIFF) + (size_t)row * 256;
#pragma unroll
      for (int gi = 0; gi < 4; ++gi) {
        const int hw = 1 << gi;
        int lo = max(t - hw, 0), hi = min(t + hw, L);
        float tv[16];
#pragma unroll
        for (int d = -hw; d < hw; ++d) {
          const int tt = t + d;
          const bool ok = tt >= 0 && tt < L;
          const float v = pr[(ptrdiff_t)(ok ? d : 0) * DIN + gi * 64 + lane];
          tv[d + hw] = ok ? v : 0.f;
        }
        float s = 0.f;
#pragma unroll
        for (int d = 0; d < 2 * hw; ++d) s += tv[d];
        float mean = s / (float)(hi - lo);
        df[gi * 64 + lane] = f2bf(mean - pr[gi * 64 + lane]);
      }
    }
#pragma unroll
    for (int hd = 0; hd < 4; ++hd) {
      float x = xq[hd];
      float ss = wave_sum(x * x, lane) * (1.f / 64.f);
      float xn = x * rsqrtf(ss + RMS_EPS) * qn;
      if (samp) {
        float o = shfl_x(xn, 32, lane);
        xn = lane < 32 ? xn * cs - o * sn : o * sn + xn * cs;
      }
      qb[(size_t)row * 256 + hd * 64 + lane] = f2bf(xn);
    }
#pragma unroll
    for (int hd = 0; hd < 2; ++hd) {
      float x = xk[hd];
      float ss = wave_sum(x * x, lane) * (1.f / 64.f);
      float xn = x * rsqrtf(ss + RMS_EPS) * kn;
      float vv = xv2[hd];
      if (samp) {
        float o = shfl_x(xn, 32, lane);
        xn = lane < 32 ? xn * cs - o * sn : o * sn + xn * cs;
        const size_t sb_ = (size_t)((l * 2 + b) * 2 + hd) * 163840;
        ((bf16_t*)(ws + OFF_KS))[sb_ + kfrag_off(512 + t, lane)] = f2bf(xn);
        ((bf16_t*)(ws + OFF_VST))[sb_ + vfrag_off(512 + t, lane)] = f2bf(vv);
      } else {
        size_t oo = ((size_t)(b * 2 + l) * 256 + t) * 128 + hd * 64 + lane;
        p.out[OUT_K + oo] = xn;
        p.out[OUT_V + oo] = vv;
        const size_t sb_ = (size_t)(b * 2 + hd) * 16384;
        ((bf16_t*)(ws + OFF_KP))[sb_ + kfrag_off(t, lane)] = f2bf(xn);
        ((bf16_t*)(ws + OFF_VPT))[sb_ + vfrag_off(t, lane)] = f2bf(vv);
      }
    }
    {
      float z[4]; float s = 0.f;
#pragma unroll
      for (int i = 0; i < 4; ++i) { z[i] = gelu_t(xz[i]); s += z[i]; }
      float mean = wave_sum(s, lane) * (1.f / 256.f);
      float q = 0.f;
#pragma unroll
      for (int i = 0; i < 4; ++i) { z[i] -= mean; q += z[i] * z[i]; }
      float rstd = rsqrtf(wave_sum(q, lane) * (1.f / 256.f) + LN_EPS);
      bf16_t* vct = (bf16_t*)(ws + OFF_VCT) + (size_t)(row >> 7) * 256 * 128 + (row & 127);
#pragma unroll
      for (int i = 0; i < 4; ++i) {
        int c = i * 64 + lane;
        float vn = z[i] * rstd * INP(I_CLG)[l * 256 + c] + INP(I_CLB)[l * 256 + c];
        vct[(size_t)c * 128] = f2bf(vn);
      }
    }
  }
}

struct AttnState { f32x16 o0, o1; float m, l; };
#define ATT_LOADKV(KF, VF, K0) do { const int kt_ = (K0) >> 5; \
    _Pragma("unroll") for (int s_ = 0; s_ < 4; ++s_) KF[s_] = *(const bf16x8*)(Kb + ((size_t)(kt_ * 4 + s_) * 64 + lane) * 8); \
    _Pragma("unroll") for (int s_ = 0; s_ < 2; ++s_) { \
      VF[s_][0] = *(const bf16x8*)(Vt + ((size_t)((kt_ * 2 + s_) * 2 + 0) * 64 + lane) * 8); \
      VF[s_][1] = *(const bf16x8*)(Vt + ((size_t)((kt_ * 2 + s_) * 2 + 1) * 64 + lane) * 8); } } while (0)

DI void attn_core(const bf16_t* __restrict__ Q, int qrow0, int head, const bf16_t* __restrict__ Kb,
                  const bf16_t* __restrict__ Vt, int kbeg, int kend, int lane, AttnState& st) {
  const int r = lane & 31, hh = lane >> 5;
  bf16x8 qf[4];
  const bf16_t* qp = Q + (size_t)(qrow0 + r) * 256 + head * 64 + 8 * hh;
#pragma unroll
  for (int s = 0; s < 4; ++s) qf[s] = *(const bf16x8*)(qp + 16 * s);
  f32x16 o0, o1;
#pragma unroll
  for (int i = 0; i < 16; ++i) { o0[i] = 0.f; o1[i] = 0.f; }
  float m = -INFINITY, lsum = 0.f;
  const float c = 0.125f * 1.4426950408889634f;
  bf16x8 kf[4], vf[2][2];
  ATT_LOADKV(kf, vf, kbeg);
  for (int k0 = kbeg; k0 < kend; k0 += 32) {
    const int kn = min(k0 + 32, kend - 32);
    bf16x8 kfn[4], vfn[2][2];
    ATT_LOADKV(kfn, vfn, kn);
    f32x16 sa;
#pragma unroll
    for (int i = 0; i < 16; ++i) sa[i] = 0.f;
#pragma unroll
    for (int s = 0; s < 4; ++s) sa = MFMA32(kf[s], qf[s], sa);
    float mx = sa[0];
#pragma unroll
    for (int i = 1; i < 16; ++i) mx = fmaxf(mx, sa[i]);
    mx = fmaxf(mx, shfl_x(mx, 32, lane));
    float mn = fmaxf(m, mx);
    float alpha = __builtin_amdgcn_exp2f((m - mn) * c);
    m = mn;
    float pv[16]; float ps = 0.f;
#pragma unroll
    for (int i = 0; i < 16; ++i) { pv[i] = __builtin_amdgcn_exp2f((sa[i] - mn) * c); ps += pv[i]; }
    lsum = lsum * alpha + ps;
#pragma unroll
    for (int i = 0; i < 16; ++i) { o0[i] *= alpha; o1[i] *= alpha; }
#pragma unroll
    for (int s = 0; s < 2; ++s) {
      bf16x8 pf = pack8(pv[8 * s], pv[8 * s + 1], pv[8 * s + 2], pv[8 * s + 3], pv[8 * s + 4], pv[8 * s + 5], pv[8 * s + 6], pv[8 * s + 7]);
      o0 = MFMA32(vf[s][0], pf, o0);
      o1 = MFMA32(vf[s][1], pf, o1);
    }
#pragma unroll
    for (int s = 0; s < 4; ++s) kf[s] = kfn[s];
#pragma unroll
    for (int s = 0; s < 2; ++s) { vf[s][0] = vfn[s][0]; vf[s][1] = vfn[s][1]; }
  }
  lsum += shfl_x(lsum, 32, lane);
  st.o0 = o0; st.o1 = o1; st.m = m; st.l = lsum;
}

DI void attn_prompt_item(const bf16_t* Q, int qrow0, int head, const bf16_t* Kb, const bf16_t* Vt, bf16_t* Y, int lane) {
  AttnState st;
  attn_core(Q, qrow0, head, Kb, Vt, 0, 256, lane, st);
  const int r = lane & 31, hh = lane >> 5;
  const float il = 1.f / st.l;
  bf16_t* yp = Y + (size_t)(qrow0 + r) * D + 512 + head * 64 + 4 * hh;
#pragma unroll
  for (int g4 = 0; g4 < 4; ++g4) {
    u32x2 a = {pk2(st.o0[4 * g4] * il, st.o0[4 * g4 + 1] * il), pk2(st.o0[4 * g4 + 2] * il, st.o0[4 * g4 + 3] * il)};
    u32x2 b = {pk2(st.o1[4 * g4] * il, st.o1[4 * g4 + 1] * il), pk2(st.o1[4 * g4 + 2] * il, st.o1[4 * g4 + 3] * il)};
    *(u32x2*)(yp + 8 * g4) = a;
    *(u32x2*)(yp + 32 + 8 * g4) = b;
  }
}

DI void attn_sample_item(const Params& p, int l, int it, char* shmc, int wid, int lane) {
  char* ws = PWS;
  float* Osh = (float*)shmc;
  float* Msh = Osh + 8 * 32 * 64;
  float* Lsh = Msh + 8 * 64;
  const int b = it >> 7, head = (it >> 5) & 3, qpair = it & 31;
  const int qsub = wid & 1, ksplit = wid >> 1;
  const int qrow0 = NPROMPT + b * 2048 + (qpair * 2 + qsub) * 32;
  AttnState st;
  attn_core((const bf16_t*)(ws + OFF_QB), qrow0, head, (const bf16_t*)(ws + OFF_KS) + (size_t)((l * 2 + b) * 2 + (head >> 1)) * 163840,
            (const bf16_t*)(ws + OFF_VST) + (size_t)((l * 2 + b) * 2 + (head >> 1)) * 163840, ksplit * 640, ksplit * 640 + 640, lane, st);
  Msh[wid * 64 + lane] = st.m; Lsh[wid * 64 + lane] = st.l;
#pragma unroll
  for (int i = 0; i < 16; ++i) { Osh[(wid * 32 + i) * 64 + lane] = st.o0[i]; Osh[(wid * 32 + 16 + i) * 64 + lane] = st.o1[i]; }
  __syncthreads();
  {
    const float c = 0.125f * 1.4426950408889634f;
    float mm[4], M = -INFINITY;
#pragma unroll
    for (int k = 0; k < 4; ++k) { mm[k] = Msh[(2 * k + qsub) * 64 + lane]; M = fmaxf(M, mm[k]); }
    float sc[4], Lt = 0.f;
#pragma unroll
    for (int k = 0; k < 4; ++k) { sc[k] = __builtin_amdgcn_exp2f((mm[k] - M) * c); Lt += Lsh[(2 * k + qsub) * 64 + lane] * sc[k]; }
    const float il = 1.f / Lt;
    float ov[8];
#pragma unroll
    for (int e = 0; e < 8; ++e) {
      float a = 0.f;
#pragma unroll
      for (int k = 0; k < 4; ++k) a += Osh[((2 * k + qsub) * 32 + ksplit * 8 + e) * 64 + lane] * sc[k];
      ov[e] = a * il;
    }
    const int r = lane & 31, hh = lane >> 5;
    const int dblk = ksplit >> 1, g4 = (ksplit & 1) * 2;
    bf16_t* yp = (bf16_t*)(ws + OFF_YMIX) + (size_t)(qrow0 + r) * D + 512 + head * 64 + dblk * 32 + 8 * g4 + 4 * hh;
    u32x2 a = {pk2(ov[0], ov[1]), pk2(ov[2], ov[3])};
    u32x2 bq = {pk2(ov[4], ov[5]), pk2(ov[6], ov[7])};
    *(u32x2*)yp = a;
    *(u32x2*)(yp + 8) = bq;
  }
  __syncthreads();
}

DI void chunk_item(const Params& p, int l, int ch, int hd, int sp, int lane) {
  const int fr = lane & 15, fq = lane >> 4;
  char* ws = PWS;
  const float* wsrc = INP(I_CWS) + ((size_t)(l * 4 + hd) * 128 + sp * 16 + fr) * 128 + fq * 8;
  const bf16_t* vb = (const bf16_t*)(ws + OFF_VCT) + ((size_t)ch * 256 + hd * 64 + fr) * 128 + fq * 8;
  f32x4 acc[4];
#pragma unroll
  for (int i = 0; i < 4; ++i) acc[i] = (f32x4){0.f, 0.f, 0.f, 0.f};
#pragma unroll
  for (int ks = 0; ks < 4; ++ks) {
    float4 a0 = *(const float4*)(wsrc + ks * 32), a1 = *(const float4*)(wsrc + ks * 32 + 4);
    bf16x8 af = pack8(a0.x, a0.y, a0.z, a0.w, a1.x, a1.y, a1.z, a1.w);
#pragma unroll
    for (int nt = 0; nt < 4; ++nt) {
      bf16x8 bfr = *(const bf16x8*)(vb + (size_t)nt * 16 * 128 + ks * 32);
      acc[nt] = MFMA16(af, bfr, acc[nt]);
    }
  }
  const float* proj = (const float*)(ws + OFF_R);
  bf16_t* ymix = (bf16_t*)(ws + OFF_YMIX);
  float uu[4][4];
#pragma unroll
  for (int j = 0; j < 4; ++j)
#pragma unroll
    for (int nt = 0; nt < 4; ++nt)
      uu[j][nt] = proj[(size_t)(ch * 128 + sp * 16 + fq * 4 + j) * DIN + 1024 + hd * 64 + nt * 16 + fr];
#pragma unroll
  for (int j = 0; j < 4; ++j) {
    int pp = sp * 16 + fq * 4 + j, tok = ch * 128 + pp;
    float bs = INP(I_CBS)[(l * 4 + hd) * 128 + pp];
#pragma unroll
    for (int nt = 0; nt < 4; ++nt) {
      int c = hd * 64 + nt * 16 + fr;
      ymix[(size_t)tok * D + 768 + c] = f2bf(gelu_t(uu[j][nt]) * (acc[nt][j] + bs));
    }
  }
}

constexpr int SSM_BU_LD = 132, SSM_H_LD = 136;
constexpr int SSM_WAVE_LDS = 16 * SSM_BU_LD * 4 + 16 * SSM_H_LD * 2;
#define LDS_FENCE() do { asm volatile("s_waitcnt lgkmcnt(0)" ::: "memory"); __builtin_amdgcn_wave_barrier(); } while (0)

DI void ssm_load_u(const Params& p, int ck, int g, int lane, bf16x8 (&af)[4]) {
  const int fr = lane & 15, fq = lane >> 4;
  const float* ub = (const float*)(PWS + OFF_R) + (size_t)ck * 64 * DIN + 256 + g * 16;
#pragma unroll
  for (int tile = 0; tile < 4; ++tile) {
    if (fq < 2) {
      const float* up = ub + (size_t)(tile * 16 + fr) * DIN + fq * 8;
      float4 a0 = *(const float4*)up, a1 = *(const float4*)(up + 4);
      af[tile] = pack8(a0.x, a0.y, a0.z, a0.w, a1.x, a1.y, a1.z, a1.w);
    } else {
      af[tile] = (bf16x8){0, 0, 0, 0, 0, 0, 0, 0};
    }
  }
}

template <int MODE, int DIR>
DI void ssm_dir(const Params& p, int l, int ck, int g, int lane, const bf16x8 (&af)[4], f32x4 (&yacc)[4], char* wlds) {
  constexpr bool CHAIN = MODE == 1;
  const int fr = lane & 15, fq = lane >> 4;
  char* ws = PWS;
  float* BU = (float*)wlds;
  bf16_t* Hs = (bf16_t*)(wlds + 16 * SSM_BU_LD * 4);
  const int gidx = (l * 2 + DIR) * 16 + g, idx = gidx * 64 + lane;
  bf16x8 bfr[8], cf[4];
#pragma unroll
  for (int nt = 0; nt < 8; ++nt) bfr[nt] = ((const bf16x8*)(ws + OFF_BF))[(gidx * 8 + nt) * 64 + lane];
#pragma unroll
  for (int ks = 0; ks < 4; ++ks) cf[ks] = ((const bf16x8*)(ws + OFF_CF))[(gidx * 4 + ks) * 64 + lane];
  const float2 lam = ((const float2*)(ws + OFF_LAMB))[idx];
  float hr = 0.f, hi = 0.f;
  const bool samp = ck >= 128;
  const int CPS = samp ? 32 : 4;
  const int cs = samp ? ((ck - 128) & 31) : (ck & 3);
  const int b = samp ? ((ck - 128) >> 5) : (ck >> 2);
  if (CHAIN) {
    const float2 lamT = ((const float2*)(ws + OFF_LAMT))[idx];
    const float2* Eb = (const float2*)(ws + OFF_E);
    const int cbase = ck - cs;
    if (samp) {
      size_t si = ((size_t)((b * 2 + l) * 2 + DIR) * 16 + g) * 64 + lane;
      hr = INP(I_SRE)[si]; hi = INP(I_SIM)[si];
    }
    const int nstep = DIR == 0 ? cs : CPS - 1 - cs;
    for (int base = 0; base < nstep; base += 8) {
      float2 ev[8];
#pragma unroll
      for (int k = 0; k < 8; ++k) {
        const int st = min(base + k, nstep - 1);
        const int c2 = DIR == 0 ? st : CPS - 1 - st;
        ev[k] = Eb[((size_t)((cbase + c2) * 16 + g) * 2 + DIR) * 64 + lane];
      }
#pragma unroll
      for (int k = 0; k < 8; ++k)
        if (base + k < nstep) {
          float nr = lamT.x * hr - lamT.y * hi + ev[k].x, ni = lamT.x * hi + lamT.y * hr + ev[k].y; hr = nr; hi = ni;
        }
    }
  }
#pragma unroll
  for (int sb = 0; sb < 4; ++sb) {
    const int tile = DIR ? 3 - sb : sb;
#pragma unroll
    for (int nt = 0; nt < 8; ++nt) {
      f32x4 cz = MFMA16(af[tile], bfr[nt], ((f32x4){0.f, 0.f, 0.f, 0.f}));
#pragma unroll
      for (int j = 0; j < 4; ++j) BU[(fq * 4 + j) * SSM_BU_LD + nt * 16 + fr] = cz[j];
    }
    LDS_FENCE();
#pragma unroll
    for (int q = 0; q < 16; ++q) {
      const int tt = DIR ? 15 - q : q;
      const float2 bu = *(const float2*)(BU + tt * SSM_BU_LD + 2 * lane);
      float nr = lam.x * hr - lam.y * hi + bu.x, ni = lam.x * hi + lam.y * hr + bu.y; hr = nr; hi = ni;
      *(unsigned*)(Hs + tt * SSM_H_LD + 2 * lane) = pk2(hr, hi);
    }
    LDS_FENCE();
#pragma unroll
    for (int ks = 0; ks < 4; ++ks) {
      bf16x8 ah = *(const bf16x8*)(Hs + fr * SSM_H_LD + ks * 32 + fq * 8);
      yacc[tile] = MFMA16(ah, cf[ks], yacc[tile]);
    }
    LDS_FENCE();
  }
  if (!CHAIN) {
    ((float2*)(ws + OFF_E))[((size_t)(ck * 16 + g) * 2 + DIR) * 64 + lane] = make_float2(hr, hi);
  } else if (!samp && ((DIR == 0 && cs == 3) || (DIR == 1 && cs == 0))) {
    size_t so = ((size_t)((b * 2 + l) * 2 + DIR) * 16 + g) * 64 + lane;
    p.out[OUT_SRE + so] = hr; p.out[OUT_SIM + so] = hi;
  }
}

#define SSM1_MODE 2
DI void ssm1_item(const Params& p, int l, int ck, int g, int dir, int lane, char* wlds) {
  bf16x8 af[4]; f32x4 yacc[4];
#pragma unroll
  for (int i = 0; i < 4; ++i) yacc[i] = (f32x4){0.f, 0.f, 0.f, 0.f};
  ssm_load_u(p, ck, g, lane, af);
  if (dir) ssm_dir<SSM1_MODE, 1>(p, l, ck, g, lane, af, yacc, wlds);
  else ssm_dir<SSM1_MODE, 0>(p, l, ck, g, lane, af, yacc, wlds);
}

DI void ssm2_item(const Params& p, int l, int ck, int g, int lane, char* wlds) {
  const int fr = lane & 15, fq = lane >> 4;
  bf16x8 af[4]; f32x4 yacc[4];
#pragma unroll
  for (int i = 0; i < 4; ++i) yacc[i] = (f32x4){0.f, 0.f, 0.f, 0.f};
  ssm_load_u(p, ck, g, lane, af);
  ssm_dir<1, 0>(p, l, ck, g, lane, af, yacc, wlds);
  ssm_dir<1, 1>(p, l, ck, g, lane, af, yacc, wlds);
  char* ws = PWS;
  const float* ub = (const float*)(ws + OFF_R) + (size_t)ck * 64 * DIN + 256 + g * 16;
  bf16_t* sg = (bf16_t*)(ws + OFF_SG);
  const int c = g * 16 + fr;
  const float dd = INP(I_SSMD)[l * 256 + c];
  float uv[4][4];
#pragma unroll
  for (int t4 = 0; t4 < 4; ++t4)
#pragma unroll
    for (int j = 0; j < 4; ++j) uv[t4][j] = ub[(size_t)(t4 * 16 + fq * 4 + j) * DIN + fr];
#pragma unroll
  for (int t4 = 0; t4 < 4; ++t4)
#pragma unroll
    for (int j = 0; j < 4; ++j) {
      size_t row = (size_t)ck * 64 + t4 * 16 + fq * 4 + j;
      sg[row * 256 + c] = f2bf(gelu_t(yacc[t4][j] + dd * uv[t4][j]));
    }
}

DI void ssm1_phase(const Params& p, int l, char* shmc, int bid, int nblk) {
  const int tid = otid(), wid = __builtin_amdgcn_readfirstlane(tid >> 6), lane = tid & 63;
  char* wlds = shmc + wid * SSM_WAVE_LDS;
  for (int it = wid * nblk + bid; it < 6144; it += nblk * 8) ssm1_item(p, l, it >> 5, (it >> 1) & 15, it & 1, lane, wlds);
}

DI void mix_phase(const Params& p, int l, char* shmc, int bid, int nblk) {
  const int tid = otid(), wid = __builtin_amdgcn_readfirstlane(tid >> 6), lane = tid & 63;
  char* ws = PWS;
  for (int it = bid; it < 256; it += nblk) attn_sample_item(p, l, it, shmc, wid, lane);
  for (int it = bid * 8 + wid; it < 1024; it += nblk * 8) {
    int b = it >> 5, head = (it >> 3) & 3, qt = it & 7;
    attn_prompt_item((const bf16_t*)(ws + OFF_QB), b * 256 + qt * 32, head, (const bf16_t*)(ws + OFF_KP) + (size_t)(b * 2 + (head >> 1)) * 16384,
                     (const bf16_t*)(ws + OFF_VPT) + (size_t)(b * 2 + (head >> 1)) * 16384, (bf16_t*)(ws + OFF_YMIX), lane);
  }
  __syncthreads();
  char* wlds = shmc + wid * SSM_WAVE_LDS;
  const int slot = wid * nblk + bid, nslot = nblk * 8;
  for (int it = slot; it < 6144; it += nslot) {
    if (it < 3072) ssm2_item(p, l, it >> 4, it & 15, lane, wlds);
    else { int j = it - 3072; chunk_item(p, l, j >> 5, (j >> 3) & 3, j & 7, lane); }
  }
}

constexpr int N_PHASE = 26;
DI void run_phase(const Params& p, int ph, char* shm, int bid, int nblk) {
  char* ws = PWS;
  if (ph == 0) { prep_phase(p, shm, bid, nblk); return; }
  if (ph == 25) { lnmod_phase(p, 1, 2, -1, 0, bid, nblk); return; }
  const int l = (ph - 1) / 12, s = (ph - 1) % 12;
  const bf16_t* hA = (const bf16_t*)(ws + OFF_H);
  bf16_t* hid = (bf16_t*)(ws + OFF_R);
  float* xy = (float*)(ws + OFF_XY);
  const float* modl = (const float*)(ws + OFF_MOD) + (size_t)l * 3 * 9216;
  EpiArgs ea; ea.f0 = nullptr; ea.b0 = nullptr; ea.c0 = nullptr; ea.cb = nullptr; ea.w = 0.f;
  ea.lng = nullptr; ea.lnb = nullptr; ea.stats = (const float2*)(ws + OFF_STATS); ea.xin0 = nullptr; ea.xin1 = nullptr;
  switch (s) {
    case 0: if (l == 0) lnmod_phase(p, -1, 0, 0, 0, bid, nblk); else lnmod_phase(p, l - 1, 2, l, 0, bid, nblk); break;
    case 1: case 10: {
      int sI = s == 1 ? 0 : 1;
      ea.b0 = hid;
      gemm_phase<1024, EPI_SWIGLU>(hA, (const bf16_t*)(ws + OFF_W1T) + (size_t)(l * 2 + sI) * 5632 * 1024, 48, 22, ea, shm, bid, nblk);
      if (l == 0 && nblk == 256 && bid >= 32) {
        if (sI == 0) convert_units(p, shm, T_W1 / 4, PER_L / 4, bid - 32, 224);
        else convert_units(p, shm, PER_L / 4, 2 * PER_L / 4, bid - 32, 224);
      } else if (l == 0 && nblk != 256 && sI == 0) {
        convert_units(p, shm, T_W1 / 4, 2 * PER_L / 4, bid, nblk);
      }
    } break;
    case 2: case 11: {
      int sI = s == 2 ? 0 : 1;
      ea.f0 = xy; ea.c0 = modl + (s == 2 ? 2 : 8) * 1024; ea.w = 0.5f;
      if (s == 2) {
        if (l == 0) { ea.xin0 = INP(I_XP); ea.xin1 = INP(I_XS); }
        else { ea.lng = INP(I_LNG) + ((l - 1) * 3 + 2) * 1024; ea.lnb = INP(I_LNB) + ((l - 1) * 3 + 2) * 1024; }
      } else { ea.lng = INP(I_LNG) + (l * 3 + 1) * 1024; ea.lnb = INP(I_LNB) + (l * 3 + 1) * 1024; }
      gemm_phase<2816, EPI_RESID, 1, 96>(hid, (const bf16_t*)(ws + OFF_W2T) + (size_t)(l * 2 + sI) * 1024 * 2816, 64, 4, ea, shm, bid, nblk);
    } break;
    case 3: lnmod_phase(p, l, 0, l, 3, bid, nblk); break;
    case 4: {
      ea.f0 = (float*)(ws + OFF_R);
      gemm_phase<1024, EPI_F32, 1, 96>(hA, (const bf16_t*)(ws + OFF_WINT) + (size_t)l * 1536 * 1024, 64, 6, ea, shm, bid, nblk);
    } break;
    case 5: post_phase(p, l, shm, bid, nblk); ssm1_phase(p, l, shm, bid, nblk); break;
    case 6: mix_phase(p, l, shm, bid, nblk); break;
    case 7: {
      ea.b0 = (bf16_t*)(ws + OFF_YMIX); ea.cb = (const bf16_t*)(ws + OFF_SG); ea.c0 = INP(I_BGLU) + l * 256;
      gemm_phase<256, EPI_GLU>((const bf16_t*)(ws + OFF_SG), (const bf16_t*)(ws + OFF_WGLUT) + (size_t)l * 65536, 48, 1, ea, shm, bid, nblk);
      ea.c0 = INP(I_POOLS) + l * 256;
      int bid2 = (bid + nblk - (nblk >> 1)) % nblk;
      gemm_phase<256, EPI_POOL>((const bf16_t*)(ws + OFF_DIFF), (const bf16_t*)(ws + OFF_WPOOLT) + (size_t)l * 65536, 48, 1, ea, shm, bid2, nblk);
    } break;
    case 8: {
      ea.f0 = xy; ea.c0 = modl + 5 * 1024; ea.w = 1.0f;
      ea.lng = INP(I_LNG) + (l * 3 + 0) * 1024; ea.lnb = INP(I_LNB) + (l * 3 + 0) * 1024;
      gemm_phase<1024, EPI_RESID, 1, 96>((const bf16_t*)(ws + OFF_YMIX), (const bf16_t*)(ws + OFF_WOUTT) + (size_t)l * 1024 * 1024, 64, 4, ea, shm, bid, nblk);
    } break;
    case 9: lnmod_phase(p, l, 1, l, 6, bid, nblk); break;
  }
}

__global__ __launch_bounds__(512, 2) void mega(Params p, int ph_lo, int ph_hi) {
  extern __shared__ __attribute__((aligned(16))) char shm[];
  __shared__ uint4 xb_words;
  const int bid = blockIdx.x, nblk = gridDim.x;
  if (threadIdx.x == 0) xb_words = make_uint4(0u, 0u, 0u, 0u);
  __syncthreads();
  const XcdBarrier xb = xcd_barrier_post((unsigned*)(p.ws + OFF_BAR), (volatile LAS unsigned*)&xb_words);
  for (int ph = ph_lo; ph < ph_hi; ++ph) {
    if (ph > ph_lo) {
      if (ph_hi < 0) cg::this_grid().sync();
      xcd_barrier(xb);
    }
    run_phase(p, ph, shm, bid, nblk);
  }
}

extern "C" void kernel_launch(void* const* d_in, const int* in_sizes, int n_in, void* d_out, int out_size, void* d_ws,
                              size_t ws_size, hipStream_t stream) {
  static int grid_blocks = 0;
  if (!grid_blocks) {
    hipFuncSetAttribute((const void*)mega, hipFuncAttributeMaxDynamicSharedMemorySize, GEMM_LDS);
    int dev = 0, cus = 0, per_cu = 0;
    hipGetDevice(&dev);
    hipDeviceGetAttribute(&cus, hipDeviceAttributeMultiprocessorCount, dev);
    hipOccupancyMaxActiveBlocksPerMultiprocessor(&per_cu, mega, 512, GEMM_LDS);
    if (per_cu < 1) per_cu = 1;
    if (per_cu > 1) per_cu = 1;
    grid_blocks = cus * per_cu;
  }
  Params p{};
  for (int i = 0; i < N_IN; ++i) p.in[i] = (const float*)d_in[i];
  p.out = (float*)d_out;
  p.ws = (char*)d_ws;
  hipMemsetAsync((char*)d_ws + OFF_BAR, 0, 16384, stream);
#if ONE_LAUNCH
  int lo = 0, hi = N_PHASE;
  void* args[] = {&p, &lo, &hi};
  hipError_t e = hipLaunchCooperativeKernel((const void*)mega, dim3(grid_blocks), dim3(512), args, GEMM_LDS, stream);
  if (e != hipSuccess) fprintf(stderr, "cooperative launch failed: %s (grid %d)\n", hipGetErrorString(e), grid_blocks);
#else
  for (int ph = 0; ph < N_PHASE; ++ph) mega<<<grid_blocks, 512, GEMM_LDS, stream>>>(p, ph, ph + 1);
#endif
}
```

```cpp
#include <hip/hip_runtime.h>
#include <hip/hip_cooperative_groups.h>
#include <cstdio>
namespace cg = cooperative_groups;

#define DI __device__ __forceinline__
typedef unsigned short bf16_t;
typedef __attribute__((ext_vector_type(8))) short bf16x8;
typedef __attribute__((ext_vector_type(4))) short s16x4;
typedef __attribute__((ext_vector_type(4))) float f32x4;
typedef __attribute__((ext_vector_type(16))) float f32x16;
typedef __attribute__((ext_vector_type(2))) float f32x2;
typedef __attribute__((ext_vector_type(2))) __bf16 bf16x2v;
typedef __attribute__((ext_vector_type(4))) unsigned u32x4;
typedef __attribute__((ext_vector_type(2))) unsigned u32x2;

#ifndef ONE_LAUNCH
#define ONE_LAUNCH 1
#endif

constexpr int D = 1024, NTOK = 12288, NPROMPT = 8192, DFF = 2816, DIN = 1536;
constexpr float ALPHA = 1.4142135623730951f;
constexpr float LN_EPS = 1e-5f, RMS_EPS = 1e-6f;
enum { I_XP = 0, I_XS, I_CK, I_CV, I_SRE, I_SIM, I_C, I_CCTX, I_WMOD, I_BMOD, I_LNG, I_LNB, I_W1, I_W2, I_WIN, I_WOUT,
       I_POOLW, I_POOLS, I_LRE, I_LIM, I_LSTEP, I_BRE, I_BIM, I_CRE, I_CIM, I_SSMD, I_WGLU, I_BGLU, I_QN, I_KN,
       I_CLG, I_CLB, I_CWS, I_CBS, N_IN };
constexpr size_t OUT_K = 12582912, OUT_V = 14680064, OUT_SRE = 16777216, OUT_SIM = 16908288;

constexpr size_t OFF_W1T = 0;
constexpr size_t OFF_W2T = OFF_W1T + 46137344;
constexpr size_t OFF_WINT = OFF_W2T + 23068672;
constexpr size_t OFF_WOUTT = OFF_WINT + 6291456;
constexpr size_t OFF_WGLUT = OFF_WOUTT + 4194304;
constexpr size_t OFF_WPOOLT = OFF_WGLUT + 262144;
constexpr size_t OFF_MOD = OFF_WPOOLT + 262144;
constexpr size_t OFF_XY = OFF_MOD + 221184;
constexpr size_t OFF_H = OFF_XY + 50331648;
constexpr size_t OFF_YMIX = OFF_H + 25165824;
constexpr size_t OFF_R = OFF_YMIX + 25165824;
constexpr size_t OFF_QB = OFF_R + 75497472;
constexpr size_t OFF_KP = OFF_QB + 6291456;
constexpr size_t OFF_KS = OFF_KP + 2097152;
constexpr size_t OFF_VPT = OFF_KS + 2621440;
constexpr size_t OFF_VST = OFF_VPT + 2097152;
constexpr size_t OFF_VCT = OFF_VST + 2621440;
constexpr size_t OFF_DIFF = OFF_VCT + 6291456;
constexpr size_t OFF_SG = OFF_DIFF + 6291456;
constexpr size_t OFF_E = OFF_SG + 6291456;
constexpr size_t OFF_LAMB = OFF_E + 3145728;
constexpr size_t OFF_LAMT = OFF_LAMB + 32768;
constexpr size_t OFF_BBAR = OFF_LAMT + 32768;
constexpr size_t OFF_BAR = OFF_BBAR + 524288;
constexpr size_t OFF_BF = OFF_BAR + 16384;
constexpr size_t OFF_CF = OFF_BF + 524288;
constexpr size_t OFF_STATS = OFF_CF + 262144;
constexpr size_t WS_TOTAL = OFF_STATS + 98304;

struct Params { const float* in[N_IN]; float* out; char* ws; };

DI int otid() {
  int z = 0; asm volatile("" : "+s"(z));
  int lane = __builtin_amdgcn_mbcnt_hi(-1, __builtin_amdgcn_mbcnt_lo(-1, z));
  int w = __builtin_amdgcn_readfirstlane(threadIdx.x >> 6);
  return w * 64 + lane;
}
DI int osgpr(int i) { asm volatile("" : "+s"(i)); return i; }
#define INP(i) (p.in[osgpr(i)])
DI char* ows(char* w) { asm volatile("" : "+s"(w)); return w; }
#define PWS ows(p.ws)
DI unsigned pk2(float a, float b) { f32x2 v = {a, b}; bf16x2v r = __builtin_convertvector(v, bf16x2v); return __builtin_bit_cast(unsigned, r); }
DI bf16_t f2bf(float a) { return (bf16_t)(pk2(a, 0.f) & 0xffffu); }
DI float bf2f(bf16_t v) { return __uint_as_float(((unsigned)v) << 16); }
DI bf16x8 pack8(float a0, float a1, float a2, float a3, float a4, float a5, float a6, float a7) {
  u32x4 u = {pk2(a0, a1), pk2(a2, a3), pk2(a4, a5), pk2(a6, a7)};
  return __builtin_bit_cast(bf16x8, u);
}
DI float gelu_t(float x) {
  float z = 0.7978845608028654f * (x + 0.044715f * x * x * x);
  float e = __expf(2.f * z);
  float th = 1.f - 2.f / (e + 1.f);
  return 0.5f * x * (1.f + th);
}
DI float sigmoid_f(float x) { return 1.f / (1.f + __expf(-x)); }
DI float shfl_x(float v, int mask, int lane) {
  return __int_as_float(__builtin_amdgcn_ds_bpermute((lane ^ mask) << 2, __float_as_int(v)));
}
template <int CTRL> DI float dpp_f(float v) {
  return __int_as_float(__builtin_amdgcn_update_dpp(0, __float_as_int(v), CTRL, 0xf, 0xf, true));
}
DI float wave_sum(float v, int lane) {
  (void)lane;
  v += dpp_f<0xB1>(v);
  v += dpp_f<0x4E>(v);
  v += dpp_f<0x141>(v);
  v += dpp_f<0x140>(v);
  const int iv = __float_as_int(v);
  float r0 = __int_as_float(__builtin_amdgcn_readlane(iv, 0)), r1 = __int_as_float(__builtin_amdgcn_readlane(iv, 16));
  float r2 = __int_as_float(__builtin_amdgcn_readlane(iv, 32)), r3 = __int_as_float(__builtin_amdgcn_readlane(iv, 48));
  return (r0 + r1) + (r2 + r3);
}
DI size_t kfrag_off(int key, int d) {
  return ((size_t)((key >> 5) * 4 + (d >> 4)) * 64 + ((d >> 3) & 1) * 32 + (key & 31)) * 8 + (d & 7);
}
DI size_t vfrag_off(int key, int d) {
  const int kk = key & 31, w = kk & 15;
  return ((size_t)(((key >> 5) * 2 + (kk >> 4)) * 2 + (d >> 5)) * 64 + ((w >> 2) & 1) * 32 + (d & 31)) * 8 + (((w >> 3) << 2) | (w & 3));
}

#define MFMA16(a, b, c) __builtin_amdgcn_mfma_f32_16x16x32_bf16((a), (b), (c), 0, 0, 0)
#define MFMA32(a, b, c) __builtin_amdgcn_mfma_f32_32x32x16_bf16((a), (b), (c), 0, 0, 0)


#define XB_TMO      128
#define XB_XCNT(j)  (256  + 64 * (j))
#define XB_XSUB(j)  (1280 + 64 * (j))
#define XB_XGEN(j)  (2304 + 64 * (j))
#define XB_TOP      3328
#define XB_TOPGEN   3392
#define XCD_BAR_WORDS 3456
#define XB_SPIN_CAP (1u << 18)
#define LAS __attribute__((address_space(3)))
DI unsigned xb_ld(unsigned* p) { return __hip_atomic_load(p, __ATOMIC_RELAXED, __HIP_MEMORY_SCOPE_AGENT); }
DI unsigned xb_add(unsigned* p, unsigned v) { return __hip_atomic_fetch_add(p, v, __ATOMIC_RELAXED, __HIP_MEMORY_SCOPE_AGENT); }
DI unsigned xb_xcc_id() { return (unsigned)__builtin_amdgcn_s_getreg((3 << 11) | 20) & 0xFu; }
#define XB_SPIN(cond, bar) do { unsigned _sp = 0; while (cond) { __builtin_amdgcn_s_sleep(1); \
    if ((++_sp & 255u) == 0u) { if (xb_ld(&(bar)[XB_TMO])) break; if (_sp > XB_SPIN_CAP) { atomicAdd(&(bar)[XB_TMO], 1u); break; } } } } while (0)
struct XcdBarrier { unsigned* bar; unsigned x; volatile LAS unsigned* st; };
DI XcdBarrier xcd_barrier_post(unsigned* bar, volatile LAS unsigned* st) {
  XcdBarrier b; b.bar = bar; b.x = xb_xcc_id(); b.st = st;
  if (threadIdx.x == 0) (void)xb_add(&bar[XB_XCNT(b.x)], 1u);
  return b;
}
DI void xcd_barrier_complete(unsigned* bar, unsigned x, unsigned& nloc, unsigned& nx) {
  const unsigned G = gridDim.x * gridDim.y * gridDim.z;
  unsigned sum, cnt, mine, sp = 0u;
  for (;;) {
    sum = 0u; cnt = 0u; mine = 0u;
#pragma unroll
    for (unsigned j = 0; j < 16; ++j) { const unsigned c = xb_ld(&bar[XB_XCNT(j)]); sum += c; cnt += (c > 0u) ? 1u : 0u; mine = (j == x) ? c : mine; }
    if (sum == G) break;
    __builtin_amdgcn_s_sleep(1);
    if ((++sp & 255u) == 0u) { if (xb_ld(&bar[XB_TMO])) break; if (sp > XB_SPIN_CAP) { atomicAdd(&bar[XB_TMO], 1u); break; } }
  }
  nloc = mine > 0u ? mine : 1u; nx = cnt > 0u ? cnt : 1u;
}
DI void xcd_barrier(const XcdBarrier& b) {
  asm volatile("s_waitcnt vmcnt(0)" ::: "memory");
  __syncthreads();
  if (threadIdx.x == 0) {
    unsigned* bar = b.bar;
    __builtin_amdgcn_s_waitcnt(0);
    unsigned nloc = b.st[0], nx = b.st[1];
    if (nloc == 0u) { xcd_barrier_complete(bar, b.x, nloc, nx); b.st[0] = nloc; b.st[1] = nx; }
    const unsigned old = xb_add(&bar[XB_XSUB(b.x)], 1u);
    const unsigned gen = old / nloc;
    if (old + 1u == (gen + 1u) * nloc) {
      __builtin_amdgcn_fence(__ATOMIC_RELEASE, "agent");
      asm volatile("s_waitcnt vmcnt(0)" ::: "memory");
      const unsigned og = xb_add(&bar[XB_TOP], 1u);
      const unsigned tg = og / nx;
      if (og + 1u == (tg + 1u) * nx) xb_add(&bar[XB_TOPGEN], 1u);
      else XB_SPIN(xb_ld(&bar[XB_TOPGEN]) == tg, bar);
      __builtin_amdgcn_fence(__ATOMIC_ACQUIRE, "agent");
      xb_add(&bar[XB_XGEN(b.x)], 1u);
      asm volatile("s_waitcnt vmcnt(0)" ::: "memory");
    } else {
      XB_SPIN(xb_ld(&bar[XB_XGEN(b.x)]) == gen, bar);
      __builtin_amdgcn_fence(__ATOMIC_ACQUIRE, "agent");
      asm volatile("s_waitcnt vmcnt(0)" ::: "memory");
    }
  }
  __syncthreads();
}

constexpr int BM = 256, BK = 64, HALF = 128, NXCD = 8, WGM = 8, HT = HALF * BK;
constexpr int GEMM_LDS = 8 * HT * 2;

DI int lds_byte(int r, int c) {
  int st = (r >> 4) * 2 + (c >> 5), rr = r & 15, cc = c & 31, ob = rr * 64 + cc * 2;
  return st * 1024 + (ob ^ (((ob >> 9) & 1) << 5));
}
DI void stage_rc(int b, int& R, int& C) {
  int st = b / 1024, sb = b % 1024, swz = sb ^ (((sb >> 9) & 1) << 5);
  R = (st >> 1) * 16 + swz / 64; C = (st & 1) * 32 + (swz % 64) / 2;
}

enum { EPI_SWIGLU = 0, EPI_RESID, EPI_F32, EPI_GLU, EPI_POOL };
struct EpiArgs {
  float* f0;
  bf16_t* b0;
  const float* c0;
  const bf16_t* cb;
  float w;
  const float* lng; const float* lnb; const float2* stats; const float* xin0; const float* xin1;
};

template <int K, int MODE, int SPLITS = 1, int RH = 128>
DI void gemm_phase(const bf16_t* __restrict__ A, const bf16_t* __restrict__ Bt, int nM, int nN, EpiArgs ea,
                   char* shmc, int bid, int nblk) {
  bf16_t* shm = (bf16_t*)shmc;
#define SA(b, h) (shm + ((b) * 2 + (h)) * HT)
#define SB(b, h) (shm + (4 + (b) * 2 + (h)) * HT)
#define STAGE(P, RS, SOFF, kt) do { const int _so = (SOFF) + (kt0 + (kt)) * (BK * 2); \
    __builtin_amdgcn_raw_ptr_buffer_load_lds(RS, (__attribute__((address_space(3))) void*)((char*)(P) + wid * 1024), 16, so0, _so, 0, 0); \
    __builtin_amdgcn_raw_ptr_buffer_load_lds(RS, (__attribute__((address_space(3))) void*)((char*)(P) + wid * 1024 + 8192), 16, so1, _so, 0, 0); } while (0)
#define LDA(dst, b, h) for (int m = 0; m < MT; ++m) for (int k = 0; k < 2; ++k) \
    dst[m][k] = *reinterpret_cast<const bf16x8*>((char*)SA(b, h) + lds_byte(wr * (RH / 2) + m * 16 + fr, k * 32 + fq * 8))
#define LDB(dst, b, h) for (int n = 0; n < 2; ++n) for (int k = 0; k < 2; ++k) \
    dst[n][k] = *reinterpret_cast<const bf16x8*>((char*)SB(b, h) + lds_byte(wc * 32 + n * 16 + fr, k * 32 + fq * 8))
#define MMA(ai, bj, At, Bt_) do { __builtin_amdgcn_s_setprio(1); \
    for (int m = 0; m < MT; ++m) for (int n = 0; n < 2; ++n) for (int k = 0; k < 2; ++k) \
      acc[ai][bj][m][n] = MFMA16(At[m][k], Bt_[n][k], acc[ai][bj][m][n]); \
    __builtin_amdgcn_s_setprio(0); } while (0)
#define WAIT_V(n) asm volatile("s_waitcnt vmcnt(" #n ")" ::: "memory")
#define WAIT_L(n) asm volatile("s_waitcnt lgkmcnt(" #n ")" ::: "memory")
#define BAR __builtin_amdgcn_s_barrier()
#define SCHED __builtin_amdgcn_sched_barrier(0)
  constexpr int MT = RH / 32;
  constexpr int TM = 2 * RH;
  const int tid = otid();
  const int wid = __builtin_amdgcn_readfirstlane(tid >> 6), lane = tid & 63, wr = wid >> 2, wc = wid & 3, fr = lane & 15, fq = lane >> 4;
  const __amdgpu_buffer_rsrc_t rsA = __builtin_amdgcn_make_buffer_rsrc((void*)A, 0, 0x7fffffff, 0x00020000);
  const __amdgpu_buffer_rsrc_t rsB = __builtin_amdgcn_make_buffer_rsrc((void*)Bt, 0, 0x7fffffff, 0x00020000);
  unsigned so0, so1;
  { int R, C; stage_rc(tid * 16, R, C); so0 = (unsigned)(R * K + C) * 2u; stage_rc(tid * 16 + 8192, R, C); so1 = (unsigned)(R * K + C) * 2u; }
  const int nwg = nM * nN;
  for (int unit = bid; unit < nwg * SPLITS; unit += nblk) {
    const int sp = SPLITS == 1 ? 0 : unit / nwg, tile = SPLITS == 1 ? unit : unit % nwg;
    const int kt0 = SPLITS == 1 ? 0 : (sp == 0 ? 0 : sp == 1 ? 12 : sp == 2 ? 24 : 34);
    const int nt = SPLITS == 1 ? K / BK : (sp < 2 ? 12 : 10);
    int wgid = tile;
    { int q = nwg / NXCD, r = nwg % NXCD, xcd = wgid % NXCD, off = wgid / NXCD;
      wgid = (xcd < r ? xcd * (q + 1) : r * (q + 1) + (xcd - r) * q) + off; }
    int nig = WGM * nN, gid = wgid / nig, fm = gid * WGM, gsz = min(nM - fm, WGM);
    int pm = fm + ((wgid % nig) % gsz), pn = (wgid % nig) / gsz, brow = pm * TM, bcol = pn * BM;
    const int A0 = brow * K * 2, A1 = A0 + RH * K * 2, B0p = bcol * K * 2, B1p = B0p + HALF * K * 2;
    f32x4 acc[2][2][MT][2] = {};
    bf16x8 At[MT][2], B0[2][2], B1[2][2];
    STAGE(SB(0, 0), rsB, B0p, 0); STAGE(SA(0, 0), rsA, A0, 0);
    STAGE(SB(0, 1), rsB, B1p, 0); STAGE(SA(0, 1), rsA, A1, 0);
    if (wr == 1) BAR;
    WAIT_V(4); BAR;
    STAGE(SB(1, 0), rsB, B0p, 1); STAGE(SA(1, 0), rsA, A0, 1); STAGE(SB(1, 1), rsB, B1p, 1);
    WAIT_V(6); BAR;
    for (int t = 0; t < nt - 2; t += 2) {
      LDB(B0, 0, 0); SCHED; LDA(At, 0, 0); STAGE(SA(1, 1), rsA, A1, t + 1);
      if (MT == 4) WAIT_L(8); else WAIT_L(6); BAR; WAIT_L(0); MMA(0, 0, At, B0); BAR; SCHED;
      LDB(B1, 0, 1); STAGE(SB(0, 0), rsB, B0p, t + 2);
      BAR; WAIT_L(0); MMA(0, 1, At, B1); BAR;
      LDA(At, 0, 1); STAGE(SA(0, 0), rsA, A0, t + 2);
      BAR; WAIT_L(0); MMA(1, 0, At, B0); BAR; SCHED;
      STAGE(SB(0, 1), rsB, B1p, t + 2);
      WAIT_V(6); BAR; MMA(1, 1, At, B1); BAR;
      LDB(B0, 1, 0); SCHED; LDA(At, 1, 0); STAGE(SA(0, 1), rsA, A1, t + 2);
      if (MT == 4) WAIT_L(8); else WAIT_L(6); BAR; WAIT_L(0); MMA(0, 0, At, B0); BAR; SCHED;
      LDB(B1, 1, 1); STAGE(SB(1, 0), rsB, B0p, t + 3);
      BAR; WAIT_L(0); MMA(0, 1, At, B1); BAR;
      LDA(At, 1, 1); STAGE(SA(1, 0), rsA, A0, t + 3);
      BAR; WAIT_L(0); MMA(1, 0, At, B0); BAR; SCHED;
      STAGE(SB(1, 1), rsB, B1p, t + 3);
      WAIT_V(6); BAR; MMA(1, 1, At, B1); BAR;
    }
    { LDB(B0, 0, 0); LDA(At, 0, 0); STAGE(SA(1, 1), rsA, A1, nt - 1);
      BAR; WAIT_L(0); MMA(0, 0, At, B0); BAR;
      LDB(B1, 0, 1); BAR; WAIT_L(0); MMA(0, 1, At, B1); BAR;
      LDA(At, 0, 1); WAIT_V(4); BAR; WAIT_L(0); MMA(1, 0, At, B0); MMA(1, 1, At, B1); BAR; }
    { LDB(B0, 1, 0); LDA(At, 1, 0); WAIT_V(2); BAR; WAIT_L(0); MMA(0, 0, At, B0); BAR;
      LDB(B1, 1, 1); WAIT_V(0); BAR; WAIT_L(0); MMA(0, 1, At, B1); BAR;
      LDA(At, 1, 1); BAR; WAIT_L(0); MMA(1, 0, At, B0); MMA(1, 1, At, B1); BAR; }
    if (wr == 0) BAR;
    const int ci = brow < NPROMPT ? 0 : 1 + (brow - NPROMPT) / 2048;
    const int ci2 = (brow + TM - 1) < NPROMPT ? 0 : 1 + (brow + TM - 1 - NPROMPT) / 2048;
    const int rsplit = ci2 == 1 ? NPROMPT : NPROMPT + 2048;
    const int te = otid(), le = te & 63, wide = te >> 6;
    const int wr = wide >> 2, wc = wide & 3, fr = le & 15, fq = le >> 4;
    const int rbase = brow + wr * (RH / 2) + fq * 4, cbase = bcol + wc * 32 + fr;
    if (MODE == EPI_SWIGLU) {
#pragma unroll
      for (int ai = 0; ai < 2; ++ai)
#pragma unroll
        for (int m = 0; m < MT; ++m)
#pragma unroll
          for (int j = 0; j < 4; ++j) {
            const int row = rbase + ai * RH + m * 16 + j;
#pragma unroll
            for (int n = 0; n < 2; ++n) {
              float g = acc[ai][0][m][n][j], u = acc[ai][1][m][n][j];
              ea.b0[(size_t)row * DFF + pn * 128 + wc * 32 + n * 16 + fr] = f2bf(g * sigmoid_f(g) * u);
            }
          }
    } else if (MODE == EPI_RESID) {
      float gate[2][2], gate2[2][2], lg[2][2], lb[2][2];
      const bool raw = ea.lng == nullptr;
#pragma unroll
      for (int bj = 0; bj < 2; ++bj)
#pragma unroll
        for (int n = 0; n < 2; ++n) {
          const int col = cbase + bj * HALF + n * 16;
          gate[bj][n] = ea.w * ea.c0[ci * 9216 + col];
          gate2[bj][n] = ea.w * ea.c0[ci2 * 9216 + col];
          lg[bj][n] = raw ? 1.f : ea.lng[col];
          lb[bj][n] = raw ? 0.f : ea.lnb[col];
        }
#pragma unroll
      for (int ai = 0; ai < 2; ++ai)
#pragma unroll
        for (int m = 0; m < MT; ++m) {
          const int r0 = rbase + ai * RH + m * 16;
          float* xb = ea.f0 + (size_t)r0 * D + cbase;
          float xv[4][2][2];
          float2 st[4];
#pragma unroll
          for (int j = 0; j < 4; ++j) {
            const int row = r0 + j;
            const float* src = raw ? (row < NPROMPT ? ea.xin0 + (size_t)row * D : ea.xin1 + (size_t)(row - NPROMPT) * D) + cbase
                                   : xb + (size_t)j * D;
            st[j] = raw ? make_float2(0.f, 1.f) : ea.stats[row];
#pragma unroll
            for (int bj = 0; bj < 2; ++bj)
#pragma unroll
              for (int n = 0; n < 2; ++n) xv[j][bj][n] = src[bj * HALF + n * 16];
          }
#pragma unroll
          for (int j = 0; j < 4; ++j)
#pragma unroll
            for (int bj = 0; bj < 2; ++bj)
#pragma unroll
              for (int n = 0; n < 2; ++n) {
                const float x = (xv[j][bj][n] - st[j].x) * st[j].y * lg[bj][n] + lb[bj][n];
                xb[(size_t)j * D + bj * HALF + n * 16] =
                    ALPHA * x + ((r0 + j) >= rsplit ? gate2[bj][n] : gate[bj][n]) * acc[ai][bj][m][n][j];
              }
        }
    } else if (MODE == EPI_GLU) {
      float bg[2][2];
#pragma unroll
      for (int bj = 0; bj < 2; ++bj)
#pragma unroll
        for (int n = 0; n < 2; ++n) bg[bj][n] = ea.c0[cbase + bj * HALF + n * 16];
#pragma unroll
      for (int ai = 0; ai < 2; ++ai) {
        float gv[MT][4][2][2];
        const bf16_t* gb = ea.cb + (size_t)(rbase + ai * RH) * 256 + cbase;
#pragma unroll
        for (int m = 0; m < MT; ++m)
#pragma unroll
          for (int j = 0; j < 4; ++j)
#pragma unroll
            for (int bj = 0; bj < 2; ++bj)
#pragma unroll
              for (int n = 0; n < 2; ++n) gv[m][j][bj][n] = bf2f(gb[(size_t)(m * 16 + j) * 256 + bj * HALF + n * 16]);
        bf16_t* yb = ea.b0 + (size_t)(rbase + ai * RH) * D + 256 + cbase;
#pragma unroll
        for (int m = 0; m < MT; ++m)
#pragma unroll
          for (int j = 0; j < 4; ++j)
#pragma unroll
            for (int bj = 0; bj < 2; ++bj)
#pragma unroll
              for (int n = 0; n < 2; ++n)
                yb[(size_t)(m * 16 + j) * D + bj * HALF + n * 16] =
                    f2bf(gv[m][j][bj][n] * sigmoid_f(acc[ai][bj][m][n][j] + bg[bj][n]));
      }
    } else {
      float ps[2][2];
#pragma unroll
      for (int bj = 0; bj < 2; ++bj)
#pragma unroll
        for (int n = 0; n < 2; ++n) ps[bj][n] = MODE == EPI_POOL ? ea.c0[cbase + bj * HALF + n * 16] : 1.f;
#pragma unroll
      for (int ai = 0; ai < 2; ++ai)
#pragma unroll
        for (int m = 0; m < MT; ++m)
#pragma unroll
          for (int j = 0; j < 4; ++j) {
            const int row = rbase + ai * RH + m * 16 + j;
#pragma unroll
            for (int bj = 0; bj < 2; ++bj)
#pragma unroll
              for (int n = 0; n < 2; ++n) {
                const int col = cbase + bj * HALF + n * 16;
                float a = acc[ai][bj][m][n][j];
                if (MODE == EPI_F32) ea.f0[(size_t)row * DIN + col] = a;
                else ea.b0[(size_t)row * D + col] = f2bf(a * ps[bj][n]);
              }
          }
    }
  }
#undef SA
#undef SB
}

constexpr int T_W1 = 16 * 88, T_W2 = 44 * 16, T_IN = 16 * 24, T_OUT = 256, T_GLU = 16;
constexpr int PER_L = 2 * T_W1 + 2 * T_W2 + T_IN + T_OUT + T_GLU;
DI void convert_units(const Params& p, char* shmc, int unit_begin, int unit_end, int worker, int nworkers) {
  const int tid = otid();
  char* ws = PWS;
  constexpr int NTL = 4;
  __syncthreads();
  for (int u = unit_begin + worker; u < unit_end; u += nworkers) {
    const int it0 = u * NTL;
    bf16_t* dsts[NTL]; int Ks[NTL], modes[NTL], kts[NTL], ntiles[NTL];
    float4 v[NTL][2];
#pragma unroll
    for (int q = 0; q < NTL; ++q) {
      const int it = it0 + q;
      int l = it / PER_L, r = it % PER_L;
      const float* src; bf16_t* dst; int K, N, mode = 0;
      if (r < 2 * T_W1) {
        int s2 = r / T_W1; r %= T_W1;
        src = INP(I_W1) + (size_t)(l * 2 + s2) * 1024 * 5632; dst = (bf16_t*)(ws + OFF_W1T) + (size_t)(l * 2 + s2) * 5632 * 1024;
        K = 1024; N = 5632; mode = 1;
      } else if (r < 2 * T_W1 + 2 * T_W2) {
        r -= 2 * T_W1; int s2 = r / T_W2; r %= T_W2;
        src = INP(I_W2) + (size_t)(l * 2 + s2) * 2816 * 1024; dst = (bf16_t*)(ws + OFF_W2T) + (size_t)(l * 2 + s2) * 1024 * 2816;
        K = 2816; N = 1024;
      } else if (r < 2 * T_W1 + 2 * T_W2 + T_IN) {
        r -= 2 * T_W1 + 2 * T_W2;
        src = INP(I_WIN) + (size_t)l * 1024 * 1536; dst = (bf16_t*)(ws + OFF_WINT) + (size_t)l * 1536 * 1024;
        K = 1024; N = 1536;
      } else if (r < 2 * T_W1 + 2 * T_W2 + T_IN + T_OUT) {
        r -= 2 * T_W1 + 2 * T_W2 + T_IN;
        src = INP(I_WOUT) + (size_t)l * 1024 * 1024; dst = (bf16_t*)(ws + OFF_WOUTT) + (size_t)l * 1024 * 1024;
        K = 1024; N = 1024;
      } else {
        r -= 2 * T_W1 + 2 * T_W2 + T_IN + T_OUT;
        src = INP(I_WGLU) + (size_t)l * 256 * 256; dst = (bf16_t*)(ws + OFF_WGLUT) + (size_t)l * 256 * 256;
        K = 256; N = 256;
      }
      const int nkt = K / 64, kt = r % nkt, ntile = r / nkt;
      dsts[q] = dst; Ks[q] = K; modes[q] = mode; kts[q] = kt; ntiles[q] = ntile;
#pragma unroll
      for (int i = 0; i < 2; ++i) {
        int k = (tid >> 4) + 32 * i, n = (tid & 15) * 4;
        v[q][i] = *(const float4*)(src + (size_t)(kt * 64 + k) * N + ntile * 64 + n);
      }
    }
#pragma unroll
    for (int q = 0; q < NTL; ++q) {
      float* tile = (float*)shmc + q * (64 * 65);
#pragma unroll
      for (int i = 0; i < 2; ++i) {
        int k = (tid >> 4) + 32 * i, n = (tid & 15) * 4;
        tile[k * 65 + n] = v[q][i].x; tile[k * 65 + n + 1] = v[q][i].y; tile[k * 65 + n + 2] = v[q][i].z; tile[k * 65 + n + 3] = v[q][i].w;
      }
    }
    __syncthreads();
#pragma unroll
    for (int q = 0; q < NTL; ++q) {
      const float* tile = (const float*)shmc + q * (64 * 65);
      int n = tid >> 3, kk = (tid & 7) * 8;
      int nsrc = ntiles[q] * 64 + n, nrow = nsrc;
      if (modes[q] == 1) {
        if (nsrc < 2816) nrow = (nsrc >> 7) * 256 + (nsrc & 127);
        else { int mm = nsrc - 2816; nrow = (mm >> 7) * 256 + 128 + (mm & 127); }
      }
      bf16x8 o = pack8(tile[(kk + 0) * 65 + n], tile[(kk + 1) * 65 + n], tile[(kk + 2) * 65 + n], tile[(kk + 3) * 65 + n],
                       tile[(kk + 4) * 65 + n], tile[(kk + 5) * 65 + n], tile[(kk + 6) * 65 + n], tile[(kk + 7) * 65 + n]);
      *(bf16x8*)(dsts[q] + (size_t)nrow * Ks[q] + kts[q] * 64 + kk) = o;
    }
    __syncthreads();
  }
}

DI void prep_phase(const Params& p, char* shmc, int bid, int nblk) {
  const int tid = otid(), wid = tid >> 6, lane = tid & 63;
  char* ws = PWS;
  convert_units(p, shmc, 0, T_W1 / 4, bid, nblk);
  const int gtid = bid * 512 + tid, gn = nblk * 512;
  for (int i = gtid; i < 2 * 65536; i += gn) {
    int l = i >> 16, n = (i >> 8) & 255, k = i & 255;
    int gi = n >> 6, d = n & 63, gj = k >> 6, c = k & 63;
    float v = (gi == gj) ? INP(I_POOLW)[((size_t)(l * 4 + gi) * 64 + c) * 64 + d] : 0.f;
    ((bf16_t*)(ws + OFF_WPOOLT))[i] = f2bf(v);
  }
  {
    float* sc = (float*)shmc + 4 * 64 * 65;
    float* red = sc + 3 * 1024;
    for (int i = tid; i < 3 * 1024; i += 512) {
      int ci = i >> 10, k = i & 1023;
      float v = ci == 0 ? INP(I_CCTX)[k] : INP(I_C)[(ci - 1) * 1024 + k];
      sc[i] = v * sigmoid_f(v);
    }
    __syncthreads();
    for (int it = bid; it < 288; it += nblk) {
      int l = it / 144, cb = it % 144, col = cb * 64 + lane;
      const float* wp = INP(I_WMOD) + (size_t)l * 1024 * 9216 + col;
      float a0 = 0.f, a1 = 0.f, a2 = 0.f;
#pragma unroll 8
      for (int k = wid * 128; k < wid * 128 + 128; ++k) {
        float w = wp[(size_t)k * 9216];
        a0 += sc[k] * w; a1 += sc[1024 + k] * w; a2 += sc[2048 + k] * w;
      }
      red[(wid * 3 + 0) * 64 + lane] = a0; red[(wid * 3 + 1) * 64 + lane] = a1; red[(wid * 3 + 2) * 64 + lane] = a2;
      __syncthreads();
      if (tid < 192) {
        int ci = tid >> 6;
        float s = 0.f;
        for (int w = 0; w < 8; ++w) s += red[(w * 3 + ci) * 64 + lane];
        ((float*)(ws + OFF_MOD))[(size_t)(l * 3 + ci) * 9216 + col] = s + INP(I_BMOD)[l * 9216 + col];
      }
      __syncthreads();
    }
  }
  for (int i = gtid; i < 2 * 2 * 512 * 128; i += gn) {
    int c = i & 127, t = (i >> 7) & 511, b = (i >> 16) & 1, l = i >> 17;
    size_t si = ((size_t)(b * 2 + l) * 512 + t) * 128 + c;
    const size_t sb_ = (size_t)((l * 2 + b) * 2 + (c >> 6)) * 163840;
    ((bf16_t*)(ws + OFF_KS))[sb_ + kfrag_off(t, c & 63)] = f2bf(INP(I_CK)[si]);
    ((bf16_t*)(ws + OFF_VST))[sb_ + vfrag_off(t, c & 63)] = f2bf(INP(I_CV)[si]);
  }
  for (int i = gtid; i < 4096; i += gn) {
    float lre = INP(I_LRE)[i], lim = INP(I_LIM)[i];
    float dt = expf(INP(I_LSTEP)[i >> 6]);
    float e = expf(lre * dt), ang = lim * dt;
    float br = e * cosf(ang), bi = e * sinf(ang);
    float ar = br - 1.f, ai = bi, den = lre * lre + lim * lim;
    float cr = (ar * lre + ai * lim) / den, cim = (ai * lre - ar * lim) / den;
    ((float2*)(ws + OFF_LAMB))[i] = make_float2(br, bi);
    float pr = br, pi = bi;
    for (int s = 0; s < 6; ++s) { float nr = pr * pr - pi * pi, ni = 2.f * pr * pi; pr = nr; pi = ni; }
    ((float2*)(ws + OFF_LAMT))[i] = make_float2(pr, pi);
  }
  for (int i = gtid; i < 64 * 8 * 64; i += gn) {
    const int gidx = i >> 9, nt = (i >> 6) & 7, ln = i & 63, fr = ln & 15, fq = ln >> 4;
    bf16x8 o = (bf16x8){0, 0, 0, 0, 0, 0, 0, 0};
    if (fq < 2) {
      const int n = nt * 8 + (fr >> 1), idx = gidx * 64 + n;
      float lre = INP(I_LRE)[idx], lim = INP(I_LIM)[idx];
      float dt = expf(INP(I_LSTEP)[gidx]);
      float e = expf(lre * dt), ang = lim * dt;
      float br = e * cosf(ang), bi = e * sinf(ang);
      float ar = br - 1.f, ai = bi, den = lre * lre + lim * lim;
      float cr = (ar * lre + ai * lim) / den, cim = (ai * lre - ar * lim) / den;
      float v[8];
#pragma unroll
      for (int j = 0; j < 8; ++j) {
        float xr = INP(I_BRE)[(size_t)idx * 16 + fq * 8 + j], xi = INP(I_BIM)[(size_t)idx * 16 + fq * 8 + j];
        v[j] = (fr & 1) ? cr * xi + cim * xr : cr * xr - cim * xi;
      }
      o = pack8(v[0], v[1], v[2], v[3], v[4], v[5], v[6], v[7]);
    }
    ((bf16x8*)(ws + OFF_BF))[i] = o;
  }
  for (int i = gtid; i < 64 * 4 * 64; i += gn) {
    const int gidx = i >> 8, ks = (i >> 6) & 3, ln = i & 63, fr = ln & 15, fq = ln >> 4;
    const size_t co = ((size_t)gidx * 16 + fr) * 64 + ks * 16 + fq * 4;
    float4 cr = *(const float4*)(INP(I_CRE) + co), cim = *(const float4*)(INP(I_CIM) + co);
    ((bf16x8*)(ws + OFF_CF))[i] = pack8(cr.x, -cim.x, cr.y, -cim.y, cr.z, -cim.z, cr.w, -cim.w);
  }
}

DI void lnmod_phase(const Params& p, int l_ln, int ln_idx, int l_mod, int mod_idx, int bid, int nblk) {
  const int tid = otid(), wid = tid >> 6, lane = tid & 63;
  float* xy = (float*)(PWS + OFF_XY);
  bf16_t* h = (bf16_t*)(PWS + OFF_H);
  const float* modv = (const float*)(PWS + OFF_MOD);
  const int stride = nblk * 8;
  float4 gg[4], bb[4];
  if (l_ln >= 0) {
    const float* g = INP(I_LNG) + (l_ln * 3 + ln_idx) * 1024;
    const float* b = INP(I_LNB) + (l_ln * 3 + ln_idx) * 1024;
#pragma unroll
    for (int i = 0; i < 4; ++i) { gg[i] = *(const float4*)(g + lane * 4 + i * 256); bb[i] = *(const float4*)(b + lane * 4 + i * 256); }
  }
#define LN_SRC(R) (l_ln < 0 ? ((R) < NPROMPT ? INP(I_XP) + (size_t)(R) * D : INP(I_XS) + (size_t)((R) - NPROMPT) * D) : xy + (size_t)(R) * D)
  int row = bid * 8 + wid;
  float4 nv[4];
  if (row < NTOK) {
    const float* src = LN_SRC(row);
#pragma unroll
    for (int i = 0; i < 4; ++i) nv[i] = *(const float4*)(src + lane * 4 + i * 256);
  }
  for (; row < NTOK; row += stride) {
    float4 v[4];
#pragma unroll
    for (int i = 0; i < 4; ++i) v[i] = nv[i];
    if (row + stride < NTOK) {
      const float* src = LN_SRC(row + stride);
#pragma unroll
      for (int i = 0; i < 4; ++i) nv[i] = *(const float4*)(src + lane * 4 + i * 256);
    }
    float4 ma[4], mc[4];
    if (l_mod >= 0) {
      int ci = row < NPROMPT ? 0 : 1 + (row - NPROMPT) / 2048;
      const float* sh = modv + (size_t)(l_mod * 3 + ci) * 9216 + mod_idx * 1024;
#pragma unroll
      for (int i = 0; i < 4; ++i) { ma[i] = *(const float4*)(sh + lane * 4 + i * 256); mc[i] = *(const float4*)(sh + 1024 + lane * 4 + i * 256); }
    }
    if (l_ln >= 0) {
      float s = 0.f;
#pragma unroll
      for (int i = 0; i < 4; ++i) s += v[i].x + v[i].y + v[i].z + v[i].w;
      float mean = wave_sum(s, lane) * (1.f / 1024.f);
      float q = 0.f;
#pragma unroll
      for (int i = 0; i < 4; ++i) {
        v[i].x -= mean; v[i].y -= mean; v[i].z -= mean; v[i].w -= mean;
        q += v[i].x * v[i].x + v[i].y * v[i].y + v[i].z * v[i].z + v[i].w * v[i].w;
      }
      float rstd = rsqrtf(wave_sum(q, lane) * (1.f / 1024.f) + LN_EPS);
      if (lane == 0) ((float2*)(PWS + OFF_STATS))[row] = make_float2(mean, rstd);
#pragma unroll
      for (int i = 0; i < 4; ++i) {
        v[i].x = v[i].x * rstd * gg[i].x + bb[i].x; v[i].y = v[i].y * rstd * gg[i].y + bb[i].y;
        v[i].z = v[i].z * rstd * gg[i].z + bb[i].z; v[i].w = v[i].w * rstd * gg[i].w + bb[i].w;
      }
    }
    if (l_mod < 0) {
      float* dx = p.out + (size_t)row * D;
#pragma unroll
      for (int i = 0; i < 4; ++i) *(float4*)(dx + lane * 4 + i * 256) = v[i];
    }
    if (l_mod >= 0) {
#pragma unroll
      for (int i = 0; i < 4; ++i) {
        u32x2 o = {pk2(v[i].x * (1.f + mc[i].x) + ma[i].x, v[i].y * (1.f + mc[i].y) + ma[i].y),
                   pk2(v[i].z * (1.f + mc[i].z) + ma[i].z, v[i].w * (1.f + mc[i].w) + ma[i].w)};
        *(u32x2*)(h + (size_t)row * D + lane * 4 + i * 256) = o;
      }
    }
  }
#undef LN_SRC
}

struct PostTok { float xq[4], xk[2], xv2[2], xz[4], pc[4], t0[2], t1[4], t2[8], t3[16]; };
DI void post_load(const float* proj, int row, int lane, PostTok& k) {
  const float* pr = proj + (size_t)row * DIN;
  int t, L;
  if (row >= NPROMPT) { t = (row - NPROMPT) & 2047; L = 2048; } else { t = row & 255; L = 256; }
#pragma unroll
  for (int i = 0; i < 4; ++i) { k.xq[i] = pr[512 + i * 64 + lane]; k.xz[i] = pr[1280 + i * 64 + lane]; k.pc[i] = pr[i * 64 + lane]; }
#pragma unroll
  for (int i = 0; i < 2; ++i) { k.xk[i] = pr[768 + i * 64 + lane]; k.xv2[i] = pr[896 + i * 64 + lane]; }
#define PT_TAP(ARR, GI, HW) _Pragma("unroll") for (int d = -(HW); d < (HW); ++d) { \
    const int tt = t + d; const bool ok = tt >= 0 && tt < L; \
    k.ARR[d + (HW)] = pr[(ptrdiff_t)(ok ? d : 0) * DIN + (GI) * 64 + lane]; }
  PT_TAP(t0, 0, 1) PT_TAP(t1, 1, 2) PT_TAP(t2, 2, 4) PT_TAP(t3, 3, 8)
#undef PT_TAP
}

DI void post_phase(const Params& p, int l, char* shmc, int bid, int nblk) {
  const int tid = otid(), wid = tid >> 6, lane = tid & 63;
  char* ws = PWS;
  const float* proj = (const float*)(ws + OFF_R);
  bf16_t* qb = (bf16_t*)(ws + OFF_QB);
  const float qn = INP(I_QN)[l * 64 + lane], kn = INP(I_KN)[l * 64 + lane];
  const int fi = lane & 15;
  const float inv = exp2f(-(float)fi * (13.287712379549449f / 16.f));
  const int stride = nblk * 8;
  int row = bid * 8 + wid;
  PostTok nx;
  if (row < NTOK) post_load(proj, row, lane, nx);
  for (; row < NTOK; row += stride) {
    const PostTok c = nx;
    if (row + stride < NTOK) post_load(proj, row + stride, lane, nx);
    const bool samp = row >= NPROMPT;
    int b, t, L;
    if (samp) { b = (row - NPROMPT) >> 11; t = (row - NPROMPT) & 2047; L = 2048; }
    else { b = row >> 8; t = row & 255; L = 256; }
    float cs = 1.f, sn = 0.f;
    if (samp) {
      float pos = (float)((lane & 31) < 16 ? (t >> 6) : (t & 63));
      float ang = pos * inv;
      cs = cosf(ang); sn = sinf(ang);
    }
    float xq[4], xk[2], xv2[2], xz[4];
#pragma unroll
    for (int i = 0; i < 4; ++i) { xq[i] = c.xq[i]; xz[i] = c.xz[i]; }
#pragma unroll
    for (int i = 0; i < 2; ++i) { xk[i] = c.xk[i]; xv2[i] = c.xv2[i]; }
    {
      bf16_t* df = (bf16_t*)(ws + OFF_DIFF) + (size_t)row * 256;
#define PT_SUM(ARR, GI, HW) { int lo = max(t - (HW), 0), hi = min(t + (HW), L); float s_ = 0.f; \
        _Pragma("unroll") for (int d = -(HW); d < (HW); ++d) { const int tt = t + d; s_ += (tt >= 0 && tt < L) ? c.ARR[d + (HW)] : 0.f; } \
        df[(GI) * 64 + lane] = f2bf(s_ / (float)(hi - lo) - c.pc[GI]); }
      PT_SUM(t0, 0, 1) PT_SUM(t1, 1, 2) PT_SUM(t2, 2, 4) PT_SUM(t3, 3, 8)
#undef PT_SUM
    }
#pragma unroll
    for (int hd = 0; hd < 4; ++hd) {
      float x = xq[hd];
      float ss = wave_sum(x * x, lane) * (1.f / 64.f);
      float xn = x * rsqrtf(ss + RMS_EPS) * qn;
      if (samp) {
        float o = shfl_x(xn, 32, lane);
        xn = lane < 32 ? xn * cs - o * sn : o * sn + xn * cs;
      }
      qb[(size_t)row * 256 + hd * 64 + lane] = f2bf(xn);
    }
#pragma unroll
    for (int hd = 0; hd < 2; ++hd) {
      float x = xk[hd];
      float ss = wave_sum(x * x, lane) * (1.f / 64.f);
      float xn = x * rsqrtf(ss + RMS_EPS) * kn;
      float vv = xv2[hd];
      if (samp) {
        float o = shfl_x(xn, 32, lane);
        xn = lane < 32 ? xn * cs - o * sn : o * sn + xn * cs;
        const size_t sb_ = (size_t)((l * 2 + b) * 2 + hd) * 163840;
        ((bf16_t*)(ws + OFF_KS))[sb_ + kfrag_off(512 + t, lane)] = f2bf(xn);
        ((bf16_t*)(ws + OFF_VST))[sb_ + vfrag_off(512 + t, lane)] = f2bf(vv);
      } else {
        size_t oo = ((size_t)(b * 2 + l) * 256 + t) * 128 + hd * 64 + lane;
        p.out[OUT_K + oo] = xn;
        p.out[OUT_V + oo] = vv;
        const size_t sb_ = (size_t)(b * 2 + hd) * 16384;
        ((bf16_t*)(ws + OFF_KP))[sb_ + kfrag_off(t, lane)] = f2bf(xn);
        ((bf16_t*)(ws + OFF_VPT))[sb_ + vfrag_off(t, lane)] = f2bf(vv);
      }
    }
    {
      float z[4]; float s = 0.f;
#pragma unroll
      for (int i = 0; i < 4; ++i) { z[i] = gelu_t(xz[i]); s += z[i]; }
      float mean = wave_sum(s, lane) * (1.f / 256.f);
      float q = 0.f;
#pragma unroll
      for (int i = 0; i < 4; ++i) { z[i] -= mean; q += z[i] * z[i]; }
      float rstd = rsqrtf(wave_sum(q, lane) * (1.f / 256.f) + LN_EPS);
      bf16_t* vct = (bf16_t*)(ws + OFF_VCT) + (size_t)(row >> 7) * 256 * 128 + (row & 127);
#pragma unroll
      for (int i = 0; i < 4; ++i) {
        int c = i * 64 + lane;
        float vn = z[i] * rstd * INP(I_CLG)[l * 256 + c] + INP(I_CLB)[l * 256 + c];
        vct[(size_t)c * 128] = f2bf(vn);
      }
    }
  }
}

struct AttnState { f32x16 o0, o1; float m, l; };
#define ATT_LOADKV(KF, VF, K0) do { const int kt_ = (K0) >> 5; \
    _Pragma("unroll") for (int s_ = 0; s_ < 4; ++s_) KF[s_] = *(const bf16x8*)(Kb + ((size_t)(kt_ * 4 + s_) * 64 + lane) * 8); \
    _Pragma("unroll") for (int s_ = 0; s_ < 2; ++s_) { \
      VF[s_][0] = *(const bf16x8*)(Vt + ((size_t)((kt_ * 2 + s_) * 2 + 0) * 64 + lane) * 8); \
      VF[s_][1] = *(const bf16x8*)(Vt + ((size_t)((kt_ * 2 + s_) * 2 + 1) * 64 + lane) * 8); } } while (0)

DI void attn_core(const bf16_t* __restrict__ Q, int qrow0, int head, const bf16_t* __restrict__ Kb,
                  const bf16_t* __restrict__ Vt, int kbeg, int kend, int lane, AttnState& st) {
  const int r = lane & 31, hh = lane >> 5;
  bf16x8 qf[4];
  const bf16_t* qp = Q + (size_t)(qrow0 + r) * 256 + head * 64 + 8 * hh;
#pragma unroll
  for (int s = 0; s < 4; ++s) qf[s] = *(const bf16x8*)(qp + 16 * s);
  f32x16 o0, o1;
#pragma unroll
  for (int i = 0; i < 16; ++i) { o0[i] = 0.f; o1[i] = 0.f; }
  float m = -INFINITY, lsum = 0.f;
  const float c = 0.125f * 1.4426950408889634f;
  bf16x8 kf[4], vf[2][2];
  ATT_LOADKV(kf, vf, kbeg);
  for (int k0 = kbeg; k0 < kend; k0 += 32) {
    const int kn = min(k0 + 32, kend - 32);
    bf16x8 kfn[4], vfn[2][2];
    ATT_LOADKV(kfn, vfn, kn);
    f32x16 sa;
#pragma unroll
    for (int i = 0; i < 16; ++i) sa[i] = 0.f;
#pragma unroll
    for (int s = 0; s < 4; ++s) sa = MFMA32(kf[s], qf[s], sa);
    float mx = sa[0];
#pragma unroll
    for (int i = 1; i < 16; ++i) mx = fmaxf(mx, sa[i]);
    mx = fmaxf(mx, shfl_x(mx, 32, lane));
    float mn = fmaxf(m, mx);
    float alpha = __builtin_amdgcn_exp2f((m - mn) * c);
    m = mn;
    float pv[16]; float ps = 0.f;
#pragma unroll
    for (int i = 0; i < 16; ++i) { pv[i] = __builtin_amdgcn_exp2f((sa[i] - mn) * c); ps += pv[i]; }
    lsum = lsum * alpha + ps;
#pragma unroll
    for (int i = 0; i < 16; ++i) { o0[i] *= alpha; o1[i] *= alpha; }
#pragma unroll
    for (int s = 0; s < 2; ++s) {
      bf16x8 pf = pack8(pv[8 * s], pv[8 * s + 1], pv[8 * s + 2], pv[8 * s + 3], pv[8 * s + 4], pv[8 * s + 5], pv[8 * s + 6], pv[8 * s + 7]);
      o0 = MFMA32(vf[s][0], pf, o0);
      o1 = MFMA32(vf[s][1], pf, o1);
    }
#pragma unroll
    for (int s = 0; s < 4; ++s) kf[s] = kfn[s];
#pragma unroll
    for (int s = 0; s < 2; ++s) { vf[s][0] = vfn[s][0]; vf[s][1] = vfn[s][1]; }
  }
  lsum += shfl_x(lsum, 32, lane);
  st.o0 = o0; st.o1 = o1; st.m = m; st.l = lsum;
}

DI void attn_prompt_item(const bf16_t* Q, int qrow0, int head, const bf16_t* Kb, const bf16_t* Vt, bf16_t* Y, int lane) {
  AttnState st;
  attn_core(Q, qrow0, head, Kb, Vt, 0, 256, lane, st);
  const int r = lane & 31, hh = lane >> 5;
  const float il = 1.f / st.l;
  bf16_t* yp = Y + (size_t)(qrow0 + r) * D + 512 + head * 64 + 4 * hh;
#pragma unroll
  for (int g4 = 0; g4 < 4; ++g4) {
    u32x2 a = {pk2(st.o0[4 * g4] * il, st.o0[4 * g4 + 1] * il), pk2(st.o0[4 * g4 + 2] * il, st.o0[4 * g4 + 3] * il)};
    u32x2 b = {pk2(st.o1[4 * g4] * il, st.o1[4 * g4 + 1] * il), pk2(st.o1[4 * g4 + 2] * il, st.o1[4 * g4 + 3] * il)};
    *(u32x2*)(yp + 8 * g4) = a;
    *(u32x2*)(yp + 32 + 8 * g4) = b;
  }
}

DI void attn_sample_item(const Params& p, int l, int it, char* shmc, int wid, int lane) {
  char* ws = PWS;
  float* Osh = (float*)shmc;
  float* Msh = Osh + 8 * 32 * 64;
  float* Lsh = Msh + 8 * 64;
  const int b = it >> 7, head = (it >> 5) & 3, qpair = it & 31;
  const int qsub = wid & 1, ksplit = wid >> 1;
  const int qrow0 = NPROMPT + b * 2048 + (qpair * 2 + qsub) * 32;
  AttnState st;
  attn_core((const bf16_t*)(ws + OFF_QB), qrow0, head, (const bf16_t*)(ws + OFF_KS) + (size_t)((l * 2 + b) * 2 + (head >> 1)) * 163840,
            (const bf16_t*)(ws + OFF_VST) + (size_t)((l * 2 + b) * 2 + (head >> 1)) * 163840, ksplit * 640, ksplit * 640 + 640, lane, st);
  Msh[wid * 64 + lane] = st.m; Lsh[wid * 64 + lane] = st.l;
#pragma unroll
  for (int i = 0; i < 16; ++i) { Osh[(wid * 32 + i) * 64 + lane] = st.o0[i]; Osh[(wid * 32 + 16 + i) * 64 + lane] = st.o1[i]; }
  __syncthreads();
  {
    const float c = 0.125f * 1.4426950408889634f;
    float mm[4], M = -INFINITY;
#pragma unroll
    for (int k = 0; k < 4; ++k) { mm[k] = Msh[(2 * k + qsub) * 64 + lane]; M = fmaxf(M, mm[k]); }
    float sc[4], Lt = 0.f;
#pragma unroll
    for (int k = 0; k < 4; ++k) { sc[k] = __builtin_amdgcn_exp2f((mm[k] - M) * c); Lt += Lsh[(2 * k + qsub) * 64 + lane] * sc[k]; }
    const float il = 1.f / Lt;
    float ov[8];
#pragma unroll
    for (int e = 0; e < 8; ++e) {
      float a = 0.f;
#pragma unroll
      for (int k = 0; k < 4; ++k) a += Osh[((2 * k + qsub) * 32 + ksplit * 8 + e) * 64 + lane] * sc[k];
      ov[e] = a * il;
    }
    const int r = lane & 31, hh = lane >> 5;
    const int dblk = ksplit >> 1, g4 = (ksplit & 1) * 2;
    bf16_t* yp = (bf16_t*)(ws + OFF_YMIX) + (size_t)(qrow0 + r) * D + 512 + head * 64 + dblk * 32 + 8 * g4 + 4 * hh;
    u32x2 a = {pk2(ov[0], ov[1]), pk2(ov[2], ov[3])};
    u32x2 bq = {pk2(ov[4], ov[5]), pk2(ov[6], ov[7])};
    *(u32x2*)yp = a;
    *(u32x2*)(yp + 8) = bq;
  }
  __syncthreads();
}

DI void chunk_item(const Params& p, int l, int ch, int hd, int sp, int lane) {
  const int fr = lane & 15, fq = lane >> 4;
  char* ws = PWS;
  const float* wsrc = INP(I_CWS) + ((size_t)(l * 4 + hd) * 128 + sp * 16 + fr) * 128 + fq * 8;
  const bf16_t* vb = (const bf16_t*)(ws + OFF_VCT) + ((size_t)ch * 256 + hd * 64 + fr) * 128 + fq * 8;
  f32x4 acc[4];
#pragma unroll
  for (int i = 0; i < 4; ++i) acc[i] = (f32x4){0.f, 0.f, 0.f, 0.f};
#pragma unroll
  for (int ks = 0; ks < 4; ++ks) {
    float4 a0 = *(const float4*)(wsrc + ks * 32), a1 = *(const float4*)(wsrc + ks * 32 + 4);
    bf16x8 af = pack8(a0.x, a0.y, a0.z, a0.w, a1.x, a1.y, a1.z, a1.w);
#pragma unroll
    for (int nt = 0; nt < 4; ++nt) {
      bf16x8 bfr = *(const bf16x8*)(vb + (size_t)nt * 16 * 128 + ks * 32);
      acc[nt] = MFMA16(af, bfr, acc[nt]);
    }
  }
  const float* proj = (const float*)(ws + OFF_R);
  bf16_t* ymix = (bf16_t*)(ws + OFF_YMIX);
  float uu[4][4];
#pragma unroll
  for (int j = 0; j < 4; ++j)
#pragma unroll
    for (int nt = 0; nt < 4; ++nt)
      uu[j][nt] = proj[(size_t)(ch * 128 + sp * 16 + fq * 4 + j) * DIN + 1024 + hd * 64 + nt * 16 + fr];
#pragma unroll
  for (int j = 0; j < 4; ++j) {
    int pp = sp * 16 + fq * 4 + j, tok = ch * 128 + pp;
    float bs = INP(I_CBS)[(l * 4 + hd) * 128 + pp];
#pragma unroll
    for (int nt = 0; nt < 4; ++nt) {
      int c = hd * 64 + nt * 16 + fr;
      ymix[(size_t)tok * D + 768 + c] = f2bf(gelu_t(uu[j][nt]) * (acc[nt][j] + bs));
    }
  }
}

constexpr int SSM_BU_LD = 132, SSM_H_LD = 136;
constexpr int SSM_WAVE_LDS = 16 * SSM_BU_LD * 4 + 16 * SSM_H_LD * 2;
#define LDS_FENCE() do { asm volatile("s_waitcnt lgkmcnt(0)" ::: "memory"); __builtin_amdgcn_wave_barrier(); } while (0)

DI void ssm_load_u(const Params& p, int ck, int g, int lane, bf16x8 (&af)[4]) {
  const int fr = lane & 15, fq = lane >> 4;
  const float* ub = (const float*)(PWS + OFF_R) + (size_t)ck * 64 * DIN + 256 + g * 16;
#pragma unroll
  for (int tile = 0; tile < 4; ++tile) {
    if (fq < 2) {
      const float* up = ub + (size_t)(tile * 16 + fr) * DIN + fq * 8;
      float4 a0 = *(const float4*)up, a1 = *(const float4*)(up + 4);
      af[tile] = pack8(a0.x, a0.y, a0.z, a0.w, a1.x, a1.y, a1.z, a1.w);
    } else {
      af[tile] = (bf16x8){0, 0, 0, 0, 0, 0, 0, 0};
    }
  }
}

template <int MODE, int DIR>
DI void ssm_dir(const Params& p, int l, int ck, int g, int lane, const bf16x8 (&af)[4], f32x4 (&yacc)[4], char* wlds) {
  constexpr bool CHAIN = MODE == 1;
  const int fr = lane & 15, fq = lane >> 4;
  char* ws = PWS;
  float* BU = (float*)wlds;
  bf16_t* Hs = (bf16_t*)(wlds + 16 * SSM_BU_LD * 4);
  const int gidx = (l * 2 + DIR) * 16 + g, idx = gidx * 64 + lane;
  bf16x8 bfr[8], cf[4];
#pragma unroll
  for (int nt = 0; nt < 8; ++nt) bfr[nt] = ((const bf16x8*)(ws + OFF_BF))[(gidx * 8 + nt) * 64 + lane];
#pragma unroll
  for (int ks = 0; ks < 4; ++ks) cf[ks] = ((const bf16x8*)(ws + OFF_CF))[(gidx * 4 + ks) * 64 + lane];
  const float2 lam = ((const float2*)(ws + OFF_LAMB))[idx];
  float hr = 0.f, hi = 0.f;
  const bool samp = ck >= 128;
  const int CPS = samp ? 32 : 4;
  const int cs = samp ? ((ck - 128) & 31) : (ck & 3);
  const int b = samp ? ((ck - 128) >> 5) : (ck >> 2);
  if (CHAIN) {
    const float2 lamT = ((const float2*)(ws + OFF_LAMT))[idx];
    const float2* Eb = (const float2*)(ws + OFF_E);
    const int cbase = ck - cs;
    if (samp) {
      size_t si = ((size_t)((b * 2 + l) * 2 + DIR) * 16 + g) * 64 + lane;
      hr = INP(I_SRE)[si]; hi = INP(I_SIM)[si];
    }
    const int nstep = DIR == 0 ? cs : CPS - 1 - cs;
    for (int base = 0; base < nstep; base += 8) {
      float2 ev[8];
#pragma unroll
      for (int k = 0; k < 8; ++k) {
        const int st = min(base + k, nstep - 1);
        const int c2 = DIR == 0 ? st : CPS - 1 - st;
        ev[k] = Eb[((size_t)((cbase + c2) * 16 + g) * 2 + DIR) * 64 + lane];
      }
#pragma unroll
      for (int k = 0; k < 8; ++k)
        if (base + k < nstep) {
          float nr = lamT.x * hr - lamT.y * hi + ev[k].x, ni = lamT.x * hi + lamT.y * hr + ev[k].y; hr = nr; hi = ni;
        }
    }
  }
#pragma unroll
  for (int sb = 0; sb < 4; ++sb) {
    const int tile = DIR ? 3 - sb : sb;
#pragma unroll
    for (int nt = 0; nt < 8; ++nt) {
      f32x4 cz = MFMA16(af[tile], bfr[nt], ((f32x4){0.f, 0.f, 0.f, 0.f}));
#pragma unroll
      for (int j = 0; j < 4; ++j) BU[(fq * 4 + j) * SSM_BU_LD + nt * 16 + fr] = cz[j];
    }
    LDS_FENCE();
#pragma unroll
    for (int q = 0; q < 16; ++q) {
      const int tt = DIR ? 15 - q : q;
      const float2 bu = *(const float2*)(BU + tt * SSM_BU_LD + 2 * lane);
      float nr = lam.x * hr - lam.y * hi + bu.x, ni = lam.x * hi + lam.y * hr + bu.y; hr = nr; hi = ni;
      *(unsigned*)(Hs + tt * SSM_H_LD + 2 * lane) = pk2(hr, hi);
    }
    LDS_FENCE();
#pragma unroll
    for (int ks = 0; ks < 4; ++ks) {
      bf16x8 ah = *(const bf16x8*)(Hs + fr * SSM_H_LD + ks * 32 + fq * 8);
      yacc[tile] = MFMA16(ah, cf[ks], yacc[tile]);
    }
    LDS_FENCE();
  }
  if (!CHAIN) {
    ((float2*)(ws + OFF_E))[((size_t)(ck * 16 + g) * 2 + DIR) * 64 + lane] = make_float2(hr, hi);
  } else if (!samp && ((DIR == 0 && cs == 3) || (DIR == 1 && cs == 0))) {
    size_t so = ((size_t)((b * 2 + l) * 2 + DIR) * 16 + g) * 64 + lane;
    p.out[OUT_SRE + so] = hr; p.out[OUT_SIM + so] = hi;
  }
}

#define SSM1_MODE 2
DI void ssm1_item(const Params& p, int l, int ck, int g, int dir, int lane, char* wlds) {
  bf16x8 af[4]; f32x4 yacc[4];
#pragma unroll
  for (int i = 0; i < 4; ++i) yacc[i] = (f32x4){0.f, 0.f, 0.f, 0.f};
  ssm_load_u(p, ck, g, lane, af);
  if (dir) ssm_dir<SSM1_MODE, 1>(p, l, ck, g, lane, af, yacc, wlds);
  else ssm_dir<SSM1_MODE, 0>(p, l, ck, g, lane, af, yacc, wlds);
}

DI void ssm2_item(const Params& p, int l, int ck, int g, int lane, char* wlds) {
  const int fr = lane & 15, fq = lane >> 4;
  bf16x8 af[4]; f32x4 yacc[4];
#pragma unroll
  for (int i = 0; i < 4; ++i) yacc[i] = (f32x4){0.f, 0.f, 0.f, 0.f};
  ssm_load_u(p, ck, g, lane, af);
  ssm_dir<1, 0>(p, l, ck, g, lane, af, yacc, wlds);
  ssm_dir<1, 1>(p, l, ck, g, lane, af, yacc, wlds);
  char* ws = PWS;
  const float* ub = (const float*)(ws + OFF_R) + (size_t)ck * 64 * DIN + 256 + g * 16;
  bf16_t* sg = (bf16_t*)(ws + OFF_SG);
  const int c = g * 16 + fr;
  const float dd = INP(I_SSMD)[l * 256 + c];
  float uv[4][4];
#pragma unroll
  for (int t4 = 0; t4 < 4; ++t4)
#pragma unroll
    for (int j = 0; j < 4; ++j) uv[t4][j] = ub[(size_t)(t4 * 16 + fq * 4 + j) * DIN + fr];
#pragma unroll
  for (int t4 = 0; t4 < 4; ++t4)
#pragma unroll
    for (int j = 0; j < 4; ++j) {
      size_t row = (size_t)ck * 64 + t4 * 16 + fq * 4 + j;
      sg[row * 256 + c] = f2bf(gelu_t(yacc[t4][j] + dd * uv[t4][j]));
    }
}

DI void ssm1_phase(const Params& p, int l, char* shmc, int bid, int nblk) {
  const int tid = otid(), wid = __builtin_amdgcn_readfirstlane(tid >> 6), lane = tid & 63;
  char* wlds = shmc + wid * SSM_WAVE_LDS;
  for (int it = wid * nblk + bid; it < 6144; it += nblk * 8) ssm1_item(p, l, it >> 5, (it >> 1) & 15, it & 1, lane, wlds);
}

DI void mix_phase(const Params& p, int l, char* shmc, int bid, int nblk) {
  const int tid = otid(), wid = __builtin_amdgcn_readfirstlane(tid >> 6), lane = tid & 63;
  char* ws = PWS;
  for (int it = bid; it < 256; it += nblk) attn_sample_item(p, l, it, shmc, wid, lane);
  for (int it = bid * 8 + wid; it < 1024; it += nblk * 8) {
    int b = it >> 5, head = (it >> 3) & 3, qt = it & 7;
    attn_prompt_item((const bf16_t*)(ws + OFF_QB), b * 256 + qt * 32, head, (const bf16_t*)(ws + OFF_KP) + (size_t)(b * 2 + (head >> 1)) * 16384,
                     (const bf16_t*)(ws + OFF_VPT) + (size_t)(b * 2 + (head >> 1)) * 16384, (bf16_t*)(ws + OFF_YMIX), lane);
  }
  __syncthreads();
  char* wlds = shmc + wid * SSM_WAVE_LDS;
  const int slot = wid * nblk + bid, nslot = nblk * 8;
  for (int it = slot; it < 6144; it += nslot) {
    if (it < 3072) ssm2_item(p, l, it >> 4, it & 15, lane, wlds);
    else { int j = it - 3072; chunk_item(p, l, j >> 5, (j >> 3) & 3, j & 7, lane); }
  }
}

constexpr int N_PHASE = 26;
DI void run_phase(const Params& p, int ph, char* shm, int bid, int nblk) {
  char* ws = PWS;
  if (ph == 0) { prep_phase(p, shm, bid, nblk); return; }
  if (ph == 25) { lnmod_phase(p, 1, 2, -1, 0, bid, nblk); return; }
  const int l = (ph - 1) / 12, s = (ph - 1) % 12;
  const bf16_t* hA = (const bf16_t*)(ws + OFF_H);
  bf16_t* hid = (bf16_t*)(ws + OFF_R);
  float* xy = (float*)(ws + OFF_XY);
  const float* modl = (const float*)(ws + OFF_MOD) + (size_t)l * 3 * 9216;
  EpiArgs ea; ea.f0 = nullptr; ea.b0 = nullptr; ea.c0 = nullptr; ea.cb = nullptr; ea.w = 0.f;
  ea.lng = nullptr; ea.lnb = nullptr; ea.stats = (const float2*)(ws + OFF_STATS); ea.xin0 = nullptr; ea.xin1 = nullptr;
  switch (s) {
    case 0: if (l == 0) lnmod_phase(p, -1, 0, 0, 0, bid, nblk); else lnmod_phase(p, l - 1, 2, l, 0, bid, nblk); break;
    case 1: case 10: {
      int sI = s == 1 ? 0 : 1;
      ea.b0 = hid;
      gemm_phase<1024, EPI_SWIGLU>(hA, (const bf16_t*)(ws + OFF_W1T) + (size_t)(l * 2 + sI) * 5632 * 1024, 48, 22, ea, shm, bid, nblk);
      if (l == 0 && nblk == 256 && bid >= 32) {
        if (sI == 0) convert_units(p, shm, T_W1 / 4, PER_L / 4, bid - 32, 224);
        else convert_units(p, shm, PER_L / 4, 2 * PER_L / 4, bid - 32, 224);
      } else if (l == 0 && nblk != 256 && sI == 0) {
        convert_units(p, shm, T_W1 / 4, 2 * PER_L / 4, bid, nblk);
      }
    } break;
    case 2: case 11: {
      int sI = s == 2 ? 0 : 1;
      ea.f0 = xy; ea.c0 = modl + (s == 2 ? 2 : 8) * 1024; ea.w = 0.5f;
      if (s == 2) {
        if (l == 0) { ea.xin0 = INP(I_XP); ea.xin1 = INP(I_XS); }
        else { ea.lng = INP(I_LNG) + ((l - 1) * 3 + 2) * 1024; ea.lnb = INP(I_LNB) + ((l - 1) * 3 + 2) * 1024; }
      } else { ea.lng = INP(I_LNG) + (l * 3 + 1) * 1024; ea.lnb = INP(I_LNB) + (l * 3 + 1) * 1024; }
      gemm_phase<2816, EPI_RESID, 1, 96>(hid, (const bf16_t*)(ws + OFF_W2T) + (size_t)(l * 2 + sI) * 1024 * 2816, 64, 4, ea, shm, bid, nblk);
    } break;
    case 3: lnmod_phase(p, l, 0, l, 3, bid, nblk); break;
    case 4: {
      ea.f0 = (float*)(ws + OFF_R);
      gemm_phase<1024, EPI_F32, 1, 96>(hA, (const bf16_t*)(ws + OFF_WINT) + (size_t)l * 1536 * 1024, 64, 6, ea, shm, bid, nblk);
    } break;
    case 5: post_phase(p, l, shm, bid, nblk); ssm1_phase(p, l, shm, bid, nblk); break;
    case 6: mix_phase(p, l, shm, bid, nblk); break;
    case 7: {
      ea.b0 = (bf16_t*)(ws + OFF_YMIX); ea.cb = (const bf16_t*)(ws + OFF_SG); ea.c0 = INP(I_BGLU) + l * 256;
      gemm_phase<256, EPI_GLU>((const bf16_t*)(ws + OFF_SG), (const bf16_t*)(ws + OFF_WGLUT) + (size_t)l * 65536, 48, 1, ea, shm, bid, nblk);
      ea.c0 = INP(I_POOLS) + l * 256;
      int bid2 = (bid + nblk - (nblk >> 1)) % nblk;
      gemm_phase<256, EPI_POOL>((const bf16_t*)(ws + OFF_DIFF), (const bf16_t*)(ws + OFF_WPOOLT) + (size_t)l * 65536, 48, 1, ea, shm, bid2, nblk);
    } break;
    case 8: {
      ea.f0 = xy; ea.c0 = modl + 5 * 1024; ea.w = 1.0f;
      ea.lng = INP(I_LNG) + (l * 3 + 0) * 1024; ea.lnb = INP(I_LNB) + (l * 3 + 0) * 1024;
      gemm_phase<1024, EPI_RESID, 1, 96>((const bf16_t*)(ws + OFF_YMIX), (const bf16_t*)(ws + OFF_WOUTT) + (size_t)l * 1024 * 1024, 64, 4, ea, shm, bid, nblk);
    } break;
    case 9: lnmod_phase(p, l, 1, l, 6, bid, nblk); break;
  }
}

__global__ __launch_bounds__(512, 2) void mega(Params p, int ph_lo, int ph_hi) {
  extern __shared__ __attribute__((aligned(16))) char shm[];
  __shared__ uint4 xb_words;
  const int bid = blockIdx.x, nblk = gridDim.x;
  if (threadIdx.x == 0) xb_words = make_uint4(0u, 0u, 0u, 0u);
  __syncthreads();
  const XcdBarrier xb = xcd_barrier_post((unsigned*)(p.ws + OFF_BAR), (volatile LAS unsigned*)&xb_words);
  for (int ph = ph_lo; ph < ph_hi; ++ph) {
    if (ph > ph_lo) {
      if (ph_hi < 0) cg::this_grid().sync();
      xcd_barrier(xb);
    }
    run_phase(p, ph, shm, bid, nblk);
  }
}

extern "C" void kernel_launch(void* const* d_in, const int* in_sizes, int n_in, void* d_out, int out_size, void* d_ws,
                              size_t ws_size, hipStream_t stream) {
  static int grid_blocks = 0;
  if (!grid_blocks) {
    hipFuncSetAttribute((const void*)mega, hipFuncAttributeMaxDynamicSharedMemorySize, GEMM_LDS);
    int dev = 0, cus = 0, per_cu = 0;
    hipGetDevice(&dev);
    hipDeviceGetAttribute(&cus, hipDeviceAttributeMultiprocessorCount, dev);
    hipOccupancyMaxActiveBlocksPerMultiprocessor(&per_cu, mega, 512, GEMM_LDS);
    if (per_cu < 1) per_cu = 1;
    if (per_cu > 1) per_cu = 1;
    grid_blocks = cus * per_cu;
  }
  Params p{};
  for (int i = 0; i < N_IN; ++i) p.in[i] = (const float*)d_in[i];
  p.out = (float*)d_out;
  p.ws = (char*)d_ws;
  hipMemsetAsync((char*)d_ws + OFF_BAR, 0, 16384, stream);
#if ONE_LAUNCH
  int lo = 0, hi = N_PHASE;
  void* args[] = {&p, &lo, &hi};
  hipError_t e = hipLaunchCooperativeKernel((const void*)mega, dim3(grid_blocks), dim3(512), args, GEMM_LDS, stream);
  if (e != hipSuccess) fprintf(stderr, "cooperative launch failed: %s (grid %d)\n", hipGetErrorString(e), grid_blocks);
#else
  for (int ph = 0; ph < N_PHASE; ++ph) mega<<<grid_blocks, 512, GEMM_LDS, stream>>>(p, ph, ph + 1);
#endif
}
```

```cpp
#include <hip/hip_runtime.h>
#include <hip/hip_cooperative_groups.h>
#include <cstdio>
namespace cg = cooperative_groups;

#define DI __device__ __forceinline__
typedef unsigned short bf16_t;
typedef __attribute__((ext_vector_type(8))) short bf16x8;
typedef __attribute__((ext_vector_type(4))) short s16x4;
typedef __attribute__((ext_vector_type(4))) float f32x4;
typedef __attribute__((ext_vector_type(16))) float f32x16;
typedef __attribute__((ext_vector_type(2))) float f32x2;
typedef __attribute__((ext_vector_type(2))) __bf16 bf16x2v;
typedef __attribute__((ext_vector_type(4))) unsigned u32x4;
typedef __attribute__((ext_vector_type(2))) unsigned u32x2;

#ifndef ONE_LAUNCH
#define ONE_LAUNCH 1
#endif

constexpr int D = 1024, NTOK = 12288, NPROMPT = 8192, DFF = 2816, DIN = 1536;
constexpr float ALPHA = 1.4142135623730951f;
constexpr float LN_EPS = 1e-5f, RMS_EPS = 1e-6f;
enum { I_XP = 0, I_XS, I_CK, I_CV, I_SRE, I_SIM, I_C, I_CCTX, I_WMOD, I_BMOD, I_LNG, I_LNB, I_W1, I_W2, I_WIN, I_WOUT,
       I_POOLW, I_POOLS, I_LRE, I_LIM, I_LSTEP, I_BRE, I_BIM, I_CRE, I_CIM, I_SSMD, I_WGLU, I_BGLU, I_QN, I_KN,
       I_CLG, I_CLB, I_CWS, I_CBS, N_IN };
constexpr size_t OUT_K = 12582912, OUT_V = 14680064, OUT_SRE = 16777216, OUT_SIM = 16908288;

constexpr size_t OFF_W1T = 0;
constexpr size_t OFF_W2T = OFF_W1T + 46137344;
constexpr size_t OFF_WINT = OFF_W2T + 23068672;
constexpr size_t OFF_WOUTT = OFF_WINT + 6291456;
constexpr size_t OFF_WGLUT = OFF_WOUTT + 4194304;
constexpr size_t OFF_WPOOLT = OFF_WGLUT + 262144;
constexpr size_t OFF_MOD = OFF_WPOOLT + 262144;
constexpr size_t OFF_XY = OFF_MOD + 221184;
constexpr size_t OFF_H = OFF_XY + 50331648;
constexpr size_t OFF_YMIX = OFF_H + 25165824;
constexpr size_t OFF_R = OFF_YMIX + 25165824;
constexpr size_t OFF_QB = OFF_R + 75497472;
constexpr size_t OFF_KP = OFF_QB + 6291456;
constexpr size_t OFF_KS = OFF_KP + 2097152;
constexpr size_t OFF_VPT = OFF_KS + 2621440;
constexpr size_t OFF_VST = OFF_VPT + 2097152;
constexpr size_t OFF_VCT = OFF_VST + 2621440;
constexpr size_t OFF_DIFF = OFF_VCT + 6291456;
constexpr size_t OFF_SG = OFF_DIFF + 6291456;
constexpr size_t OFF_E = OFF_SG + 6291456;
constexpr size_t OFF_LAMB = OFF_E + 3145728;
constexpr size_t OFF_LAMT = OFF_LAMB + 32768;
constexpr size_t OFF_BBAR = OFF_LAMT + 32768;
constexpr size_t OFF_BAR = OFF_BBAR + 524288;
constexpr size_t OFF_BF = OFF_BAR + 16384;
constexpr size_t OFF_CF = OFF_BF + 524288;
constexpr size_t OFF_STATS = OFF_CF + 262144;
constexpr size_t WS_TOTAL = OFF_STATS + 98304;

struct Params { const float* in[N_IN]; float* out; char* ws; };

DI int otid() {
  int z = 0; asm volatile("" : "+s"(z));
  int lane = __builtin_amdgcn_mbcnt_hi(-1, __builtin_amdgcn_mbcnt_lo(-1, z));
  int w = __builtin_amdgcn_readfirstlane(threadIdx.x >> 6);
  return w * 64 + lane;
}
DI int osgpr(int i) { asm volatile("" : "+s"(i)); return i; }
#define INP(i) (p.in[osgpr(i)])
DI char* ows(char* w) { asm volatile("" : "+s"(w)); return w; }
#define PWS ows(p.ws)
DI unsigned pk2(float a, float b) { f32x2 v = {a, b}; bf16x2v r = __builtin_convertvector(v, bf16x2v); return __builtin_bit_cast(unsigned, r); }
DI bf16_t f2bf(float a) { return (bf16_t)(pk2(a, 0.f) & 0xffffu); }
DI float bf2f(bf16_t v) { return __uint_as_float(((unsigned)v) << 16); }
DI bf16x8 pack8(float a0, float a1, float a2, float a3, float a4, float a5, float a6, float a7) {
  u32x4 u = {pk2(a0, a1), pk2(a2, a3), pk2(a4, a5), pk2(a6, a7)};
  return __builtin_bit_cast(bf16x8, u);
}
DI float gelu_t(float x) {
  float z = 0.7978845608028654f * (x + 0.044715f * x * x * x);
  float e = __expf(2.f * z);
  float th = 1.f - 2.f / (e + 1.f);
  return 0.5f * x * (1.f + th);
}
DI float sigmoid_f(float x) { return 1.f / (1.f + __expf(-x)); }
DI float shfl_x(float v, int mask, int lane) {
  return __int_as_float(__builtin_amdgcn_ds_bpermute((lane ^ mask) << 2, __float_as_int(v)));
}
template <int CTRL> DI float dpp_f(float v) {
  return __int_as_float(__builtin_amdgcn_update_dpp(0, __float_as_int(v), CTRL, 0xf, 0xf, true));
}
DI float wave_sum(float v, int lane) {
  (void)lane;
  v += dpp_f<0xB1>(v);
  v += dpp_f<0x4E>(v);
  v += dpp_f<0x141>(v);
  v += dpp_f<0x140>(v);
  const int iv = __float_as_int(v);
  float r0 = __int_as_float(__builtin_amdgcn_readlane(iv, 0)), r1 = __int_as_float(__builtin_amdgcn_readlane(iv, 16));
  float r2 = __int_as_float(__builtin_amdgcn_readlane(iv, 32)), r3 = __int_as_float(__builtin_amdgcn_readlane(iv, 48));
  return (r0 + r1) + (r2 + r3);
}
DI size_t kfrag_off(int key, int d) {
  return ((size_t)((key >> 5) * 4 + (d >> 4)) * 64 + ((d >> 3) & 1) * 32 + (key & 31)) * 8 + (d & 7);
}
DI size_t vfrag_off(int key, int d) {
  const int kk = key & 31, w = kk & 15;
  return ((size_t)(((key >> 5) * 2 + (kk >> 4)) * 2 + (d >> 5)) * 64 + ((w >> 2) & 1) * 32 + (d & 31)) * 8 + (((w >> 3) << 2) | (w & 3));
}

#define MFMA16(a, b, c) __builtin_amdgcn_mfma_f32_16x16x32_bf16((a), (b), (c), 0, 0, 0)
#define MFMA32(a, b, c) __builtin_amdgcn_mfma_f32_32x32x16_bf16((a), (b), (c), 0, 0, 0)


#define XB_TMO      128
#define XB_XCNT(j)  (256  + 64 * (j))
#define XB_XSUB(j)  (1280 + 64 * (j))
#define XB_XGEN(j)  (2304 + 64 * (j))
#define XB_TOP      3328
#define XB_TOPGEN   3392
#define XCD_BAR_WORDS 3456
#define XB_SPIN_CAP (1u << 18)
#define LAS __attribute__((address_space(3)))
DI unsigned xb_ld(unsigned* p) { return __hip_atomic_load(p, __ATOMIC_RELAXED, __HIP_MEMORY_SCOPE_AGENT); }
DI unsigned xb_add(unsigned* p, unsigned v) { return __hip_atomic_fetch_add(p, v, __ATOMIC_RELAXED, __HIP_MEMORY_SCOPE_AGENT); }
DI unsigned xb_xcc_id() { return (unsigned)__builtin_amdgcn_s_getreg((3 << 11) | 20) & 0xFu; }
#define XB_SPIN(cond, bar) do { unsigned _sp = 0; while (cond) { __builtin_amdgcn_s_sleep(1); \
    if ((++_sp & 255u) == 0u) { if (xb_ld(&(bar)[XB_TMO])) break; if (_sp > XB_SPIN_CAP) { atomicAdd(&(bar)[XB_TMO], 1u); break; } } } } while (0)
struct XcdBarrier { unsigned* bar; unsigned x; volatile LAS unsigned* st; };
DI XcdBarrier xcd_barrier_post(unsigned* bar, volatile LAS unsigned* st) {
  XcdBarrier b; b.bar = bar; b.x = xb_xcc_id(); b.st = st;
  if (threadIdx.x == 0) (void)xb_add(&bar[XB_XCNT(b.x)], 1u);
  return b;
}
DI void xcd_barrier_complete(unsigned* bar, unsigned x, unsigned& nloc, unsigned& nx) {
  const unsigned G = gridDim.x * gridDim.y * gridDim.z;
  unsigned sum, cnt, mine, sp = 0u;
  for (;;) {
    sum = 0u; cnt = 0u; mine = 0u;
#pragma unroll
    for (unsigned j = 0; j < 16; ++j) { const unsigned c = xb_ld(&bar[XB_XCNT(j)]); sum += c; cnt += (c > 0u) ? 1u : 0u; mine = (j == x) ? c : mine; }
    if (sum == G) break;
    __builtin_amdgcn_s_sleep(1);
    if ((++sp & 255u) == 0u) { if (xb_ld(&bar[XB_TMO])) break; if (sp > XB_SPIN_CAP) { atomicAdd(&bar[XB_TMO], 1u); break; } }
  }
  nloc = mine > 0u ? mine : 1u; nx = cnt > 0u ? cnt : 1u;
}
DI void xcd_barrier(const XcdBarrier& b) {
  asm volatile("s_waitcnt vmcnt(0)" ::: "memory");
  __syncthreads();
  if (threadIdx.x == 0) {
    unsigned* bar = b.bar;
    __builtin_amdgcn_s_waitcnt(0);
    unsigned nloc = b.st[0], nx = b.st[1];
    if (nloc == 0u) { xcd_barrier_complete(bar, b.x, nloc, nx); b.st[0] = nloc; b.st[1] = nx; }
    const unsigned old = xb_add(&bar[XB_XSUB(b.x)], 1u);
    const unsigned gen = old / nloc;
    if (old + 1u == (gen + 1u) * nloc) {
      __builtin_amdgcn_fence(__ATOMIC_RELEASE, "agent");
      asm volatile("s_waitcnt vmcnt(0)" ::: "memory");
      const unsigned og = xb_add(&bar[XB_TOP], 1u);
      const unsigned tg = og / nx;
      if (og + 1u == (tg + 1u) * nx) xb_add(&bar[XB_TOPGEN], 1u);
      else XB_SPIN(xb_ld(&bar[XB_TOPGEN]) == tg, bar);
      __builtin_amdgcn_fence(__ATOMIC_ACQUIRE, "agent");
      xb_add(&bar[XB_XGEN(b.x)], 1u);
      asm volatile("s_waitcnt vmcnt(0)" ::: "memory");
    } else {
      XB_SPIN(xb_ld(&bar[XB_XGEN(b.x)]) == gen, bar);
      __builtin_amdgcn_fence(__ATOMIC_ACQUIRE, "agent");
      asm volatile("s_waitcnt vmcnt(0)" ::: "memory");
    }
  }
  __syncthreads();
}

constexpr int BM = 256, BK = 64, HALF = 128, NXCD = 8, WGM = 8, HT = HALF * BK;
constexpr int GEMM_LDS = 8 * HT * 2;

DI int lds_byte(int r, int c) {
  int st = (r >> 4) * 2 + (c >> 5), rr = r & 15, cc = c & 31, ob = rr * 64 + cc * 2;
  return st * 1024 + (ob ^ (((ob >> 9) & 1) << 5));
}
DI void stage_rc(int b, int& R, int& C) {
  int st = b / 1024, sb = b % 1024, swz = sb ^ (((sb >> 9) & 1) << 5);
  R = (st >> 1) * 16 + swz / 64; C = (st & 1) * 32 + (swz % 64) / 2;
}

enum { EPI_SWIGLU = 0, EPI_RESID, EPI_F32, EPI_GLU, EPI_POOL };
struct EpiArgs {
  float* f0;
  bf16_t* b0;
  const float* c0;
  const bf16_t* cb;
  float w;
  const float* lng; const float* lnb; const float2* stats; const float* xin0; const float* xin1;
};

template <int K, int MODE, int SPLITS = 1, int RH = 128>
DI void gemm_phase(const bf16_t* __restrict__ A, const bf16_t* __restrict__ Bt, int nM, int nN, EpiArgs ea,
                   char* shmc, int bid, int nblk, int mrow0 = 0) {
  bf16_t* shm = (bf16_t*)shmc;
#define SA(b, h) (shm + ((b) * 2 + (h)) * HT)
#define SB(b, h) (shm + (4 + (b) * 2 + (h)) * HT)
#define STAGE(P, RS, SOFF, kt) do { const int _so = (SOFF) + (kt0 + (kt)) * (BK * 2); \
    __builtin_amdgcn_raw_ptr_buffer_load_lds(RS, (__attribute__((address_space(3))) void*)((char*)(P) + wid * 1024), 16, so0, _so, 0, 0); \
    __builtin_amdgcn_raw_ptr_buffer_load_lds(RS, (__attribute__((address_space(3))) void*)((char*)(P) + wid * 1024 + 8192), 16, so1, _so, 0, 0); } while (0)
#define LDA(dst, b, h) for (int m = 0; m < MT; ++m) for (int k = 0; k < 2; ++k) \
    dst[m][k] = *reinterpret_cast<const bf16x8*>((char*)SA(b, h) + lds_byte(wr * (RH / 2) + m * 16 + fr, k * 32 + fq * 8))
#define LDB(dst, b, h) for (int n = 0; n < 2; ++n) for (int k = 0; k < 2; ++k) \
    dst[n][k] = *reinterpret_cast<const bf16x8*>((char*)SB(b, h) + lds_byte(wc * 32 + n * 16 + fr, k * 32 + fq * 8))
#define MMA(ai, bj, At, Bt_) do { __builtin_amdgcn_s_setprio(1); \
    for (int m = 0; m < MT; ++m) for (int n = 0; n < 2; ++n) for (int k = 0; k < 2; ++k) \
      acc[ai][bj][m][n] = MFMA16(At[m][k], Bt_[n][k], acc[ai][bj][m][n]); \
    __builtin_amdgcn_s_setprio(0); } while (0)
#define WAIT_V(n) asm volatile("s_waitcnt vmcnt(" #n ")" ::: "memory")
#define WAIT_L(n) asm volatile("s_waitcnt lgkmcnt(" #n ")" ::: "memory")
#define BAR __builtin_amdgcn_s_barrier()
#define SCHED __builtin_amdgcn_sched_barrier(0)
  constexpr int MT = RH / 32;
  constexpr int TM = 2 * RH;
  const int tid = otid();
  const int wid = __builtin_amdgcn_readfirstlane(tid >> 6), lane = tid & 63, wr = wid >> 2, wc = wid & 3, fr = lane & 15, fq = lane >> 4;
  const __amdgpu_buffer_rsrc_t rsA = __builtin_amdgcn_make_buffer_rsrc((void*)A, 0, 0x7fffffff, 0x00020000);
  const __amdgpu_buffer_rsrc_t rsB = __builtin_amdgcn_make_buffer_rsrc((void*)Bt, 0, 0x7fffffff, 0x00020000);
  unsigned so0, so1;
  { int R, C; stage_rc(tid * 16, R, C); so0 = (unsigned)(R * K + C) * 2u; stage_rc(tid * 16 + 8192, R, C); so1 = (unsigned)(R * K + C) * 2u; }
  const int nwg = nM * nN;
  for (int unit = bid; unit < nwg * SPLITS; unit += nblk) {
    const int sp = SPLITS == 1 ? 0 : unit / nwg, tile = SPLITS == 1 ? unit : unit % nwg;
    const int kt0 = SPLITS == 1 ? 0 : (sp == 0 ? 0 : sp == 1 ? 12 : sp == 2 ? 24 : 34);
    const int nt = SPLITS == 1 ? K / BK : (sp < 2 ? 12 : 10);
    int wgid = tile;
    { int q = nwg / NXCD, r = nwg % NXCD, xcd = wgid % NXCD, off = wgid / NXCD;
      wgid = (xcd < r ? xcd * (q + 1) : r * (q + 1) + (xcd - r) * q) + off; }
    int nig = WGM * nN, gid = wgid / nig, fm = gid * WGM, gsz = min(nM - fm, WGM);
    int pm = fm + ((wgid % nig) % gsz), pn = (wgid % nig) / gsz, brow = mrow0 + pm * TM, bcol = pn * BM;
    const int A0 = brow * K * 2, A1 = A0 + RH * K * 2, B0p = bcol * K * 2, B1p = B0p + HALF * K * 2;
    f32x4 acc[2][2][MT][2] = {};
    bf16x8 At[MT][2], B0[2][2], B1[2][2];
    STAGE(SB(0, 0), rsB, B0p, 0); STAGE(SA(0, 0), rsA, A0, 0);
    STAGE(SB(0, 1), rsB, B1p, 0); STAGE(SA(0, 1), rsA, A1, 0);
    if (wr == 1) BAR;
    WAIT_V(4); BAR;
    STAGE(SB(1, 0), rsB, B0p, 1); STAGE(SA(1, 0), rsA, A0, 1); STAGE(SB(1, 1), rsB, B1p, 1);
    WAIT_V(6); BAR;
    for (int t = 0; t < nt - 2; t += 2) {
      LDB(B0, 0, 0); SCHED; LDA(At, 0, 0); STAGE(SA(1, 1), rsA, A1, t + 1);
      if (MT == 4) WAIT_L(8); else if (MT == 3) WAIT_L(6); else WAIT_L(4); BAR; WAIT_L(0); MMA(0, 0, At, B0); BAR; SCHED;
      LDB(B1, 0, 1); STAGE(SB(0, 0), rsB, B0p, t + 2);
      BAR; WAIT_L(0); MMA(0, 1, At, B1); BAR;
      LDA(At, 0, 1); STAGE(SA(0, 0), rsA, A0, t + 2);
      BAR; WAIT_L(0); MMA(1, 0, At, B0); BAR; SCHED;
      STAGE(SB(0, 1), rsB, B1p, t + 2);
      WAIT_V(6); BAR; MMA(1, 1, At, B1); BAR;
      LDB(B0, 1, 0); SCHED; LDA(At, 1, 0); STAGE(SA(0, 1), rsA, A1, t + 2);
      if (MT == 4) WAIT_L(8); else if (MT == 3) WAIT_L(6); else WAIT_L(4); BAR; WAIT_L(0); MMA(0, 0, At, B0); BAR; SCHED;
      LDB(B1, 1, 1); STAGE(SB(1, 0), rsB, B0p, t + 3);
      BAR; WAIT_L(0); MMA(0, 1, At, B1); BAR;
      LDA(At, 1, 1); STAGE(SA(1, 0), rsA, A0, t + 3);
      BAR; WAIT_L(0); MMA(1, 0, At, B0); BAR; SCHED;
      STAGE(SB(1, 1), rsB, B1p, t + 3);
      WAIT_V(6); BAR; MMA(1, 1, At, B1); BAR;
    }
    { LDB(B0, 0, 0); LDA(At, 0, 0); STAGE(SA(1, 1), rsA, A1, nt - 1);
      BAR; WAIT_L(0); MMA(0, 0, At, B0); BAR;
      LDB(B1, 0, 1); BAR; WAIT_L(0); MMA(0, 1, At, B1); BAR;
      LDA(At, 0, 1); WAIT_V(4); BAR; WAIT_L(0); MMA(1, 0, At, B0); MMA(1, 1, At, B1); BAR; }
    { LDB(B0, 1, 0); LDA(At, 1, 0); WAIT_V(2); BAR; WAIT_L(0); MMA(0, 0, At, B0); BAR;
      LDB(B1, 1, 1); WAIT_V(0); BAR; WAIT_L(0); MMA(0, 1, At, B1); BAR;
      LDA(At, 1, 1); BAR; WAIT_L(0); MMA(1, 0, At, B0); MMA(1, 1, At, B1); BAR; }
    if (wr == 0) BAR;
    const int ci = brow < NPROMPT ? 0 : 1 + (brow - NPROMPT) / 2048;
    const int ci2 = (brow + TM - 1) < NPROMPT ? 0 : 1 + (brow + TM - 1 - NPROMPT) / 2048;
    const int rsplit = ci2 == 1 ? NPROMPT : NPROMPT + 2048;
    const int te = otid(), le = te & 63, wide = te >> 6;
    const int wr = wide >> 2, wc = wide & 3, fr = le & 15, fq = le >> 4;
    const int rbase = brow + wr * (RH / 2) + fq * 4, cbase = bcol + wc * 32 + fr;
    if (MODE == EPI_SWIGLU) {
#pragma unroll
      for (int ai = 0; ai < 2; ++ai)
#pragma unroll
        for (int m = 0; m < MT; ++m)
#pragma unroll
          for (int j = 0; j < 4; ++j) {
            const int row = rbase + ai * RH + m * 16 + j;
#pragma unroll
            for (int n = 0; n < 2; ++n) {
              float g = acc[ai][0][m][n][j], u = acc[ai][1][m][n][j];
              ea.b0[(size_t)row * DFF + pn * 128 + wc * 32 + n * 16 + fr] = f2bf(g * sigmoid_f(g) * u);
            }
          }
    } else if (MODE == EPI_RESID) {
      float gate[2][2], gate2[2][2], lg[2][2], lb[2][2];
      const bool raw = ea.lng == nullptr;
#pragma unroll
      for (int bj = 0; bj < 2; ++bj)
#pragma unroll
        for (int n = 0; n < 2; ++n) {
          const int col = cbase + bj * HALF + n * 16;
          gate[bj][n] = ea.w * ea.c0[ci * 9216 + col];
          gate2[bj][n] = ea.w * ea.c0[ci2 * 9216 + col];
          lg[bj][n] = raw ? 1.f : ea.lng[col];
          lb[bj][n] = raw ? 0.f : ea.lnb[col];
        }
#pragma unroll
      for (int ai = 0; ai < 2; ++ai)
#pragma unroll
        for (int m = 0; m < MT; ++m) {
          const int r0 = rbase + ai * RH + m * 16;
          float* xb = ea.f0 + (size_t)r0 * D + cbase;
          float xv[4][2][2];
          float2 st[4];
#pragma unroll
          for (int j = 0; j < 4; ++j) {
            const int row = r0 + j;
            const float* src = raw ? (row < NPROMPT ? ea.xin0 + (size_t)row * D : ea.xin1 + (size_t)(row - NPROMPT) * D) + cbase
                                   : xb + (size_t)j * D;
            st[j] = raw ? make_float2(0.f, 1.f) : ea.stats[row];
#pragma unroll
            for (int bj = 0; bj < 2; ++bj)
#pragma unroll
              for (int n = 0; n < 2; ++n) xv[j][bj][n] = src[bj * HALF + n * 16];
          }
#pragma unroll
          for (int j = 0; j < 4; ++j)
#pragma unroll
            for (int bj = 0; bj < 2; ++bj)
#pragma unroll
              for (int n = 0; n < 2; ++n) {
                const float x = (xv[j][bj][n] - st[j].x) * st[j].y * lg[bj][n] + lb[bj][n];
                xb[(size_t)j * D + bj * HALF + n * 16] =
                    ALPHA * x + ((r0 + j) >= rsplit ? gate2[bj][n] : gate[bj][n]) * acc[ai][bj][m][n][j];
              }
        }
    } else if (MODE == EPI_GLU) {
      float bg[2][2];
#pragma unroll
      for (int bj = 0; bj < 2; ++bj)
#pragma unroll
        for (int n = 0; n < 2; ++n) bg[bj][n] = ea.c0[cbase + bj * HALF + n * 16];
#pragma unroll
      for (int ai = 0; ai < 2; ++ai) {
        float gv[MT][4][2][2];
        const bf16_t* gb = ea.cb + (size_t)(rbase + ai * RH) * 256 + cbase;
#pragma unroll
        for (int m = 0; m < MT; ++m)
#pragma unroll
          for (int j = 0; j < 4; ++j)
#pragma unroll
            for (int bj = 0; bj < 2; ++bj)
#pragma unroll
              for (int n = 0; n < 2; ++n) gv[m][j][bj][n] = bf2f(gb[(size_t)(m * 16 + j) * 256 + bj * HALF + n * 16]);
        bf16_t* yb = ea.b0 + (size_t)(rbase + ai * RH) * D + 256 + cbase;
#pragma unroll
        for (int m = 0; m < MT; ++m)
#pragma unroll
          for (int j = 0; j < 4; ++j)
#pragma unroll
            for (int bj = 0; bj < 2; ++bj)
#pragma unroll
              for (int n = 0; n < 2; ++n)
                yb[(size_t)(m * 16 + j) * D + bj * HALF + n * 16] =
                    f2bf(gv[m][j][bj][n] * sigmoid_f(acc[ai][bj][m][n][j] + bg[bj][n]));
      }
    } else {
      float ps[2][2];
#pragma unroll
      for (int bj = 0; bj < 2; ++bj)
#pragma unroll
        for (int n = 0; n < 2; ++n) ps[bj][n] = MODE == EPI_POOL ? ea.c0[cbase + bj * HALF + n * 16] : 1.f;
#pragma unroll
      for (int ai = 0; ai < 2; ++ai)
#pragma unroll
        for (int m = 0; m < MT; ++m)
#pragma unroll
          for (int j = 0; j < 4; ++j) {
            const int row = rbase + ai * RH + m * 16 + j;
#pragma unroll
            for (int bj = 0; bj < 2; ++bj)
#pragma unroll
              for (int n = 0; n < 2; ++n) {
                const int col = cbase + bj * HALF + n * 16;
                float a = acc[ai][bj][m][n][j];
                if (MODE == EPI_F32) ea.f0[(size_t)row * DIN + col] = a;
                else ea.b0[(size_t)row * D + col] = f2bf(a * ps[bj][n]);
              }
          }
    }
  }
#undef SA
#undef SB
}

constexpr int T_W1 = 16 * 88, T_W2 = 44 * 16, T_IN = 16 * 24, T_OUT = 256, T_GLU = 16;
constexpr int PER_L = 2 * T_W1 + 2 * T_W2 + T_IN + T_OUT + T_GLU;
DI void convert_units(const Params& p, char* shmc, int unit_begin, int unit_end, int worker, int nworkers) {
  const int tid = otid();
  char* ws = PWS;
  constexpr int NTL = 4;
  __syncthreads();
  for (int u = unit_begin + worker; u < unit_end; u += nworkers) {
    const int it0 = u * NTL;
    bf16_t* dsts[NTL]; int Ks[NTL], modes[NTL], kts[NTL], ntiles[NTL];
    float4 v[NTL][2];
#pragma unroll
    for (int q = 0; q < NTL; ++q) {
      const int it = it0 + q;
      int l = it / PER_L, r = it % PER_L;
      const float* src; bf16_t* dst; int K, N, mode = 0;
      if (r < 2 * T_W1) {
        int s2 = r / T_W1; r %= T_W1;
        src = INP(I_W1) + (size_t)(l * 2 + s2) * 1024 * 5632; dst = (bf16_t*)(ws + OFF_W1T) + (size_t)(l * 2 + s2) * 5632 * 1024;
        K = 1024; N = 5632; mode = 1;
      } else if (r < 2 * T_W1 + 2 * T_W2) {
        r -= 2 * T_W1; int s2 = r / T_W2; r %= T_W2;
        src = INP(I_W2) + (size_t)(l * 2 + s2) * 2816 * 1024; dst = (bf16_t*)(ws + OFF_W2T) + (size_t)(l * 2 + s2) * 1024 * 2816;
        K = 2816; N = 1024;
      } else if (r < 2 * T_W1 + 2 * T_W2 + T_IN) {
        r -= 2 * T_W1 + 2 * T_W2;
        src = INP(I_WIN) + (size_t)l * 1024 * 1536; dst = (bf16_t*)(ws + OFF_WINT) + (size_t)l * 1536 * 1024;
        K = 1024; N = 1536;
      } else if (r < 2 * T_W1 + 2 * T_W2 + T_IN + T_OUT) {
        r -= 2 * T_W1 + 2 * T_W2 + T_IN;
        src = INP(I_WOUT) + (size_t)l * 1024 * 1024; dst = (bf16_t*)(ws + OFF_WOUTT) + (size_t)l * 1024 * 1024;
        K = 1024; N = 1024;
      } else {
        r -= 2 * T_W1 + 2 * T_W2 + T_IN + T_OUT;
        src = INP(I_WGLU) + (size_t)l * 256 * 256; dst = (bf16_t*)(ws + OFF_WGLUT) + (size_t)l * 256 * 256;
        K = 256; N = 256;
      }
      const int nkt = K / 64, kt = r % nkt, ntile = r / nkt;
      dsts[q] = dst; Ks[q] = K; modes[q] = mode; kts[q] = kt; ntiles[q] = ntile;
#pragma unroll
      for (int i = 0; i < 2; ++i) {
        int k = (tid >> 4) + 32 * i, n = (tid & 15) * 4;
        v[q][i] = *(const float4*)(src + (size_t)(kt * 64 + k) * N + ntile * 64 + n);
      }
    }
#pragma unroll
    for (int q = 0; q < NTL; ++q) {
      float* tile = (float*)shmc + q * (64 * 65);
#pragma unroll
      for (int i = 0; i < 2; ++i) {
        int k = (tid >> 4) + 32 * i, n = (tid & 15) * 4;
        tile[k * 65 + n] = v[q][i].x; tile[k * 65 + n + 1] = v[q][i].y; tile[k * 65 + n + 2] = v[q][i].z; tile[k * 65 + n + 3] = v[q][i].w;
      }
    }
    __syncthreads();
#pragma unroll
    for (int q = 0; q < NTL; ++q) {
      const float* tile = (const float*)shmc + q * (64 * 65);
      int n = tid >> 3, kk = (tid & 7) * 8;
      int nsrc = ntiles[q] * 64 + n, nrow = nsrc;
      if (modes[q] == 1) {
        if (nsrc < 2816) nrow = (nsrc >> 7) * 256 + (nsrc & 127);
        else { int mm = nsrc - 2816; nrow = (mm >> 7) * 256 + 128 + (mm & 127); }
      }
      bf16x8 o = pack8(tile[(kk + 0) * 65 + n], tile[(kk + 1) * 65 + n], tile[(kk + 2) * 65 + n], tile[(kk + 3) * 65 + n],
                       tile[(kk + 4) * 65 + n], tile[(kk + 5) * 65 + n], tile[(kk + 6) * 65 + n], tile[(kk + 7) * 65 + n]);
      *(bf16x8*)(dsts[q] + (size_t)nrow * Ks[q] + kts[q] * 64 + kk) = o;
    }
    __syncthreads();
  }
}

DI void prep_phase(const Params& p, char* shmc, int bid, int nblk) {
  const int tid = otid(), wid = tid >> 6, lane = tid & 63;
  char* ws = PWS;
  convert_units(p, shmc, 0, T_W1 / 4, bid, nblk);
  const int gtid = bid * 512 + tid, gn = nblk * 512;
  for (int i = gtid; i < 2 * 65536; i += gn) {
    int l = i >> 16, n = (i >> 8) & 255, k = i & 255;
    int gi = n >> 6, d = n & 63, gj = k >> 6, c = k & 63;
    float v = (gi == gj) ? INP(I_POOLW)[((size_t)(l * 4 + gi) * 64 + c) * 64 + d] : 0.f;
    ((bf16_t*)(ws + OFF_WPOOLT))[i] = f2bf(v);
  }
  {
    float* sc = (float*)shmc + 4 * 64 * 65;
    float* red = sc + 3 * 1024;
    for (int i = tid; i < 3 * 1024; i += 512) {
      int ci = i >> 10, k = i & 1023;
      float v = ci == 0 ? INP(I_CCTX)[k] : INP(I_C)[(ci - 1) * 1024 + k];
      sc[i] = v * sigmoid_f(v);
    }
    __syncthreads();
    for (int it = bid; it < 288; it += nblk) {
      int l = it / 144, cb = it % 144, col = cb * 64 + lane;
      const float* wp = INP(I_WMOD) + (size_t)l * 1024 * 9216 + col;
      float a0 = 0.f, a1 = 0.f, a2 = 0.f;
#pragma unroll 8
      for (int k = wid * 128; k < wid * 128 + 128; ++k) {
        float w = wp[(size_t)k * 9216];
        a0 += sc[k] * w; a1 += sc[1024 + k] * w; a2 += sc[2048 + k] * w;
      }
      red[(wid * 3 + 0) * 64 + lane] = a0; red[(wid * 3 + 1) * 64 + lane] = a1; red[(wid * 3 + 2) * 64 + lane] = a2;
      __syncthreads();
      if (tid < 192) {
        int ci = tid >> 6;
        float s = 0.f;
        for (int w = 0; w < 8; ++w) s += red[(w * 3 + ci) * 64 + lane];
        ((float*)(ws + OFF_MOD))[(size_t)(l * 3 + ci) * 9216 + col] = s + INP(I_BMOD)[l * 9216 + col];
      }
      __syncthreads();
    }
  }
  for (int i = gtid; i < 2 * 2 * 512 * 128; i += gn) {
    int c = i & 127, t = (i >> 7) & 511, b = (i >> 16) & 1, l = i >> 17;
    size_t si = ((size_t)(b * 2 + l) * 512 + t) * 128 + c;
    const size_t sb_ = (size_t)((l * 2 + b) * 2 + (c >> 6)) * 163840;
    ((bf16_t*)(ws + OFF_KS))[sb_ + kfrag_off(t, c & 63)] = f2bf(INP(I_CK)[si]);
    ((bf16_t*)(ws + OFF_VST))[sb_ + vfrag_off(t, c & 63)] = f2bf(INP(I_CV)[si]);
  }
  for (int i = gtid; i < 4096; i += gn) {
    float lre = INP(I_LRE)[i], lim = INP(I_LIM)[i];
    float dt = expf(INP(I_LSTEP)[i >> 6]);
    float e = expf(lre * dt), ang = lim * dt;
    float br = e * cosf(ang), bi = e * sinf(ang);
    float ar = br - 1.f, ai = bi, den = lre * lre + lim * lim;
    float cr = (ar * lre + ai * lim) / den, cim = (ai * lre - ar * lim) / den;
    ((float2*)(ws + OFF_LAMB))[i] = make_float2(br, bi);
    float pr = br, pi = bi;
    for (int s = 0; s < 6; ++s) { float nr = pr * pr - pi * pi, ni = 2.f * pr * pi; pr = nr; pi = ni; }
    ((float2*)(ws + OFF_LAMT))[i] = make_float2(pr, pi);
  }
  for (int i = gtid; i < 64 * 8 * 64; i += gn) {
    const int gidx = i >> 9, nt = (i >> 6) & 7, ln = i & 63, fr = ln & 15, fq = ln >> 4;
    bf16x8 o = (bf16x8){0, 0, 0, 0, 0, 0, 0, 0};
    if (fq < 2) {
      const int n = nt * 8 + (fr >> 1), idx = gidx * 64 + n;
      float lre = INP(I_LRE)[idx], lim = INP(I_LIM)[idx];
      float dt = expf(INP(I_LSTEP)[gidx]);
      float e = expf(lre * dt), ang = lim * dt;
      float br = e * cosf(ang), bi = e * sinf(ang);
      float ar = br - 1.f, ai = bi, den = lre * lre + lim * lim;
      float cr = (ar * lre + ai * lim) / den, cim = (ai * lre - ar * lim) / den;
      float v[8];
#pragma unroll
      for (int j = 0; j < 8; ++j) {
        float xr = INP(I_BRE)[(size_t)idx * 16 + fq * 8 + j], xi = INP(I_BIM)[(size_t)idx * 16 + fq * 8 + j];
        v[j] = (fr & 1) ? cr * xi + cim * xr : cr * xr - cim * xi;
      }
      o = pack8(v[0], v[1], v[2], v[3], v[4], v[5], v[6], v[7]);
    }
    ((bf16x8*)(ws + OFF_BF))[i] = o;
  }
  for (int i = gtid; i < 64 * 4 * 64; i += gn) {
    const int gidx = i >> 8, ks = (i >> 6) & 3, ln = i & 63, fr = ln & 15, fq = ln >> 4;
    const size_t co = ((size_t)gidx * 16 + fr) * 64 + ks * 16 + fq * 4;
    float4 cr = *(const float4*)(INP(I_CRE) + co), cim = *(const float4*)(INP(I_CIM) + co);
    ((bf16x8*)(ws + OFF_CF))[i] = pack8(cr.x, -cim.x, cr.y, -cim.y, cr.z, -cim.z, cr.w, -cim.w);
  }
}

DI void lnmod_phase(const Params& p, int l_ln, int ln_idx, int l_mod, int mod_idx, int bid, int nblk) {
  const int tid = otid(), wid = tid >> 6, lane = tid & 63;
  float* xy = (float*)(PWS + OFF_XY);
  bf16_t* h = (bf16_t*)(PWS + OFF_H);
  const float* modv = (const float*)(PWS + OFF_MOD);
  const int stride = nblk * 8;
  float4 gg[4], bb[4];
  if (l_ln >= 0) {
    const float* g = INP(I_LNG) + (l_ln * 3 + ln_idx) * 1024;
    const float* b = INP(I_LNB) + (l_ln * 3 + ln_idx) * 1024;
#pragma unroll
    for (int i = 0; i < 4; ++i) { gg[i] = *(const float4*)(g + lane * 4 + i * 256); bb[i] = *(const float4*)(b + lane * 4 + i * 256); }
  }
#define LN_SRC(R) (l_ln < 0 ? ((R) < NPROMPT ? INP(I_XP) + (size_t)(R) * D : INP(I_XS) + (size_t)((R) - NPROMPT) * D) : xy + (size_t)(R) * D)
  int row = bid * 8 + wid;
  float4 nv[4];
  if (row < NTOK) {
    const float* src = LN_SRC(row);
#pragma unroll
    for (int i = 0; i < 4; ++i) nv[i] = *(const float4*)(src + lane * 4 + i * 256);
  }
  for (; row < NTOK; row += stride) {
    float4 v[4];
#pragma unroll
    for (int i = 0; i < 4; ++i) v[i] = nv[i];
    if (row + stride < NTOK) {
      const float* src = LN_SRC(row + stride);
#pragma unroll
      for (int i = 0; i < 4; ++i) nv[i] = *(const float4*)(src + lane * 4 + i * 256);
    }
    float4 ma[4], mc[4];
    if (l_mod >= 0) {
      int ci = row < NPROMPT ? 0 : 1 + (row - NPROMPT) / 2048;
      const float* sh = modv + (size_t)(l_mod * 3 + ci) * 9216 + mod_idx * 1024;
#pragma unroll
      for (int i = 0; i < 4; ++i) { ma[i] = *(const float4*)(sh + lane * 4 + i * 256); mc[i] = *(const float4*)(sh + 1024 + lane * 4 + i * 256); }
    }
    if (l_ln >= 0) {
      float s = 0.f;
#pragma unroll
      for (int i = 0; i < 4; ++i) s += v[i].x + v[i].y + v[i].z + v[i].w;
      float mean = wave_sum(s, lane) * (1.f / 1024.f);
      float q = 0.f;
#pragma unroll
      for (int i = 0; i < 4; ++i) {
        v[i].x -= mean; v[i].y -= mean; v[i].z -= mean; v[i].w -= mean;
        q += v[i].x * v[i].x + v[i].y * v[i].y + v[i].z * v[i].z + v[i].w * v[i].w;
      }
      float rstd = rsqrtf(wave_sum(q, lane) * (1.f / 1024.f) + LN_EPS);
      if (lane == 0) ((float2*)(PWS + OFF_STATS))[row] = make_float2(mean, rstd);
#pragma unroll
      for (int i = 0; i < 4; ++i) {
        v[i].x = v[i].x * rstd * gg[i].x + bb[i].x; v[i].y = v[i].y * rstd * gg[i].y + bb[i].y;
        v[i].z = v[i].z * rstd * gg[i].z + bb[i].z; v[i].w = v[i].w * rstd * gg[i].w + bb[i].w;
      }
    }
    if (l_mod < 0) {
      float* dx = p.out + (size_t)row * D;
#pragma unroll
      for (int i = 0; i < 4; ++i) *(float4*)(dx + lane * 4 + i * 256) = v[i];
    }
    if (l_mod >= 0) {
#pragma unroll
      for (int i = 0; i < 4; ++i) {
        u32x2 o = {pk2(v[i].x * (1.f + mc[i].x) + ma[i].x, v[i].y * (1.f + mc[i].y) + ma[i].y),
                   pk2(v[i].z * (1.f + mc[i].z) + ma[i].z, v[i].w * (1.f + mc[i].w) + ma[i].w)};
        *(u32x2*)(h + (size_t)row * D + lane * 4 + i * 256) = o;
      }
    }
  }
#undef LN_SRC
}

struct PostTok { float xq[4], xk[2], xv2[2], xz[4], pc[4], t0[2], t1[4], t2[8], t3[16]; };
DI void post_load(const float* proj, int row, int lane, PostTok& k) {
  const float* pr = proj + (size_t)row * DIN;
  int t, L;
  if (row >= NPROMPT) { t = (row - NPROMPT) & 2047; L = 2048; } else { t = row & 255; L = 256; }
#pragma unroll
  for (int i = 0; i < 4; ++i) { k.xq[i] = pr[512 + i * 64 + lane]; k.xz[i] = pr[1280 + i * 64 + lane]; k.pc[i] = pr[i * 64 + lane]; }
#pragma unroll
  for (int i = 0; i < 2; ++i) { k.xk[i] = pr[768 + i * 64 + lane]; k.xv2[i] = pr[896 + i * 64 + lane]; }
#define PT_TAP(ARR, GI, HW) _Pragma("unroll") for (int d = -(HW); d < (HW); ++d) { \
    const int tt = t + d; const bool ok = tt >= 0 && tt < L; \
    k.ARR[d + (HW)] = pr[(ptrdiff_t)(ok ? d : 0) * DIN + (GI) * 64 + lane]; }
  PT_TAP(t0, 0, 1) PT_TAP(t1, 1, 2) PT_TAP(t2, 2, 4) PT_TAP(t3, 3, 8)
#undef PT_TAP
}

DI void post_phase(const Params& p, int l, char* shmc, int bid, int nblk) {
  const int tid = otid(), wid = tid >> 6, lane = tid & 63;
  char* ws = PWS;
  const float* proj = (const float*)(ws + OFF_R);
  bf16_t* qb = (bf16_t*)(ws + OFF_QB);
  const float qn = INP(I_QN)[l * 64 + lane], kn = INP(I_KN)[l * 64 + lane];
  const int fi = lane & 15;
  const float inv = exp2f(-(float)fi * (13.287712379549449f / 16.f));
  const int stride = nblk * 8;
  int row = bid * 8 + wid;
  PostTok nx;
  if (row < NTOK) post_load(proj, row, lane, nx);
  for (; row < NTOK; row += stride) {
    const PostTok c = nx;
    if (row + stride < NTOK) post_load(proj, row + stride, lane, nx);
    const bool samp = row >= NPROMPT;
    int b, t, L;
    if (samp) { b = (row - NPROMPT) >> 11; t = (row - NPROMPT) & 2047; L = 2048; }
    else { b = row >> 8; t = row & 255; L = 256; }
    float cs = 1.f, sn = 0.f;
    if (samp) {
      float pos = (float)((lane & 31) < 16 ? (t >> 6) : (t & 63));
      float ang = pos * inv;
      cs = cosf(ang); sn = sinf(ang);
    }
    float xq[4], xk[2], xv2[2], xz[4];
#pragma unroll
    for (int i = 0; i < 4; ++i) { xq[i] = c.xq[i]; xz[i] = c.xz[i]; }
#pragma unroll
    for (int i = 0; i < 2; ++i) { xk[i] = c.xk[i]; xv2[i] = c.xv2[i]; }
    {
      bf16_t* df = (bf16_t*)(ws + OFF_DIFF) + (size_t)row * 256;
#define PT_SUM(ARR, GI, HW) { int lo = max(t - (HW), 0), hi = min(t + (HW), L); float s_ = 0.f; \
        _Pragma("unroll") for (int d = -(HW); d < (HW); ++d) { const int tt = t + d; s_ += (tt >= 0 && tt < L) ? c.ARR[d + (HW)] : 0.f; } \
        df[(GI) * 64 + lane] = f2bf(s_ / (float)(hi - lo) - c.pc[GI]); }
      PT_SUM(t0, 0, 1) PT_SUM(t1, 1, 2) PT_SUM(t2, 2, 4) PT_SUM(t3, 3, 8)
#undef PT_SUM
    }
#pragma unroll
    for (int hd = 0; hd < 4; ++hd) {
      float x = xq[hd];
      float ss = wave_sum(x * x, lane) * (1.f / 64.f);
      float xn = x * rsqrtf(ss + RMS_EPS) * qn;
      if (samp) {
        float o = shfl_x(xn, 32, lane);
        xn = lane < 32 ? xn * cs - o * sn : o * sn + xn * cs;
      }
      qb[(size_t)row * 256 + hd * 64 + lane] = f2bf(xn);
    }
#pragma unroll
    for (int hd = 0; hd < 2; ++hd) {
      float x = xk[hd];
      float ss = wave_sum(x * x, lane) * (1.f / 64.f);
      float xn = x * rsqrtf(ss + RMS_EPS) * kn;
      float vv = xv2[hd];
      if (samp) {
        float o = shfl_x(xn, 32, lane);
        xn = lane < 32 ? xn * cs - o * sn : o * sn + xn * cs;
        const size_t sb_ = (size_t)((l * 2 + b) * 2 + hd) * 163840;
        ((bf16_t*)(ws + OFF_KS))[sb_ + kfrag_off(512 + t, lane)] = f2bf(xn);
        ((bf16_t*)(ws + OFF_VST))[sb_ + vfrag_off(512 + t, lane)] = f2bf(vv);
      } else {
        size_t oo = ((size_t)(b * 2 + l) * 256 + t) * 128 + hd * 64 + lane;
        p.out[OUT_K + oo] = xn;
        p.out[OUT_V + oo] = vv;
        const size_t sb_ = (size_t)(b * 2 + hd) * 16384;
        ((bf16_t*)(ws + OFF_KP))[sb_ + kfrag_off(t, lane)] = f2bf(xn);
        ((bf16_t*)(ws + OFF_VPT))[sb_ + vfrag_off(t, lane)] = f2bf(vv);
      }
    }
    {
      float z[4]; float s = 0.f;
#pragma unroll
      for (int i = 0; i < 4; ++i) { z[i] = gelu_t(xz[i]); s += z[i]; }
      float mean = wave_sum(s, lane) * (1.f / 256.f);
      float q = 0.f;
#pragma unroll
      for (int i = 0; i < 4; ++i) { z[i] -= mean; q += z[i] * z[i]; }
      float rstd = rsqrtf(wave_sum(q, lane) * (1.f / 256.f) + LN_EPS);
      bf16_t* vct = (bf16_t*)(ws + OFF_VCT) + (size_t)(row >> 7) * 256 * 128 + (row & 127);
#pragma unroll
      for (int i = 0; i < 4; ++i) {
        int c = i * 64 + lane;
        float vn = z[i] * rstd * INP(I_CLG)[l * 256 + c] + INP(I_CLB)[l * 256 + c];
        vct[(size_t)c * 128] = f2bf(vn);
      }
    }
  }
}

struct AttnState { f32x16 o0, o1; float m, l; };
#define ATT_LOADKV(KF, VF, K0) do { const int kt_ = (K0) >> 5; \
    _Pragma("unroll") for (int s_ = 0; s_ < 4; ++s_) KF[s_] = *(const bf16x8*)(Kb + ((size_t)(kt_ * 4 + s_) * 64 + lane) * 8); \
    _Pragma("unroll") for (int s_ = 0; s_ < 2; ++s_) { \
      VF[s_][0] = *(const bf16x8*)(Vt + ((size_t)((kt_ * 2 + s_) * 2 + 0) * 64 + lane) * 8); \
      VF[s_][1] = *(const bf16x8*)(Vt + ((size_t)((kt_ * 2 + s_) * 2 + 1) * 64 + lane) * 8); } } while (0)

DI void attn_core(const bf16_t* __restrict__ Q, int qrow0, int head, const bf16_t* __restrict__ Kb,
                  const bf16_t* __restrict__ Vt, int kbeg, int kend, int lane, AttnState& st) {
  const int r = lane & 31, hh = lane >> 5;
  bf16x8 qf[4];
  const bf16_t* qp = Q + (size_t)(qrow0 + r) * 256 + head * 64 + 8 * hh;
#pragma unroll
  for (int s = 0; s < 4; ++s) qf[s] = *(const bf16x8*)(qp + 16 * s);
  f32x16 o0, o1;
#pragma unroll
  for (int i = 0; i < 16; ++i) { o0[i] = 0.f; o1[i] = 0.f; }
  float m = -INFINITY, lsum = 0.f;
  const float c = 0.125f * 1.4426950408889634f;
  bf16x8 kf[4], vf[2][2];
  ATT_LOADKV(kf, vf, kbeg);
  for (int k0 = kbeg; k0 < kend; k0 += 32) {
    const int kn = min(k0 + 32, kend - 32);
    bf16x8 kfn[4], vfn[2][2];
    ATT_LOADKV(kfn, vfn, kn);
    f32x16 sa;
#pragma unroll
    for (int i = 0; i < 16; ++i) sa[i] = 0.f;
#pragma unroll
    for (int s = 0; s < 4; ++s) sa = MFMA32(kf[s], qf[s], sa);
    float mx = sa[0];
#pragma unroll
    for (int i = 1; i < 16; ++i) mx = fmaxf(mx, sa[i]);
    mx = fmaxf(mx, shfl_x(mx, 32, lane));
    float mn = fmaxf(m, mx);
    float alpha = __builtin_amdgcn_exp2f((m - mn) * c);
    m = mn;
    float pv[16]; float ps = 0.f;
#pragma unroll
    for (int i = 0; i < 16; ++i) { pv[i] = __builtin_amdgcn_exp2f((sa[i] - mn) * c); ps += pv[i]; }
    lsum = lsum * alpha + ps;
#pragma unroll
    for (int i = 0; i < 16; ++i) { o0[i] *= alpha; o1[i] *= alpha; }
#pragma unroll
    for (int s = 0; s < 2; ++s) {
      bf16x8 pf = pack8(pv[8 * s], pv[8 * s + 1], pv[8 * s + 2], pv[8 * s + 3], pv[8 * s + 4], pv[8 * s + 5], pv[8 * s + 6], pv[8 * s + 7]);
      o0 = MFMA32(vf[s][0], pf, o0);
      o1 = MFMA32(vf[s][1], pf, o1);
    }
#pragma unroll
    for (int s = 0; s < 4; ++s) kf[s] = kfn[s];
#pragma unroll
    for (int s = 0; s < 2; ++s) { vf[s][0] = vfn[s][0]; vf[s][1] = vfn[s][1]; }
  }
  lsum += shfl_x(lsum, 32, lane);
  st.o0 = o0; st.o1 = o1; st.m = m; st.l = lsum;
}

DI void attn_prompt_item(const bf16_t* Q, int qrow0, int head, const bf16_t* Kb, const bf16_t* Vt, bf16_t* Y, int lane) {
  AttnState st;
  attn_core(Q, qrow0, head, Kb, Vt, 0, 256, lane, st);
  const int r = lane & 31, hh = lane >> 5;
  const float il = 1.f / st.l;
  bf16_t* yp = Y + (size_t)(qrow0 + r) * D + 512 + head * 64 + 4 * hh;
#pragma unroll
  for (int g4 = 0; g4 < 4; ++g4) {
    u32x2 a = {pk2(st.o0[4 * g4] * il, st.o0[4 * g4 + 1] * il), pk2(st.o0[4 * g4 + 2] * il, st.o0[4 * g4 + 3] * il)};
    u32x2 b = {pk2(st.o1[4 * g4] * il, st.o1[4 * g4 + 1] * il), pk2(st.o1[4 * g4 + 2] * il, st.o1[4 * g4 + 3] * il)};
    *(u32x2*)(yp + 8 * g4) = a;
    *(u32x2*)(yp + 32 + 8 * g4) = b;
  }
}

DI void attn_sample_item(const Params& p, int l, int it, char* shmc, int wid, int lane) {
  char* ws = PWS;
  float* Osh = (float*)shmc;
  float* Msh = Osh + 8 * 32 * 64;
  float* Lsh = Msh + 8 * 64;
  const int b = it >> 7, head = (it >> 5) & 3, qpair = it & 31;
  const int qsub = wid & 1, ksplit = wid >> 1;
  const int qrow0 = NPROMPT + b * 2048 + (qpair * 2 + qsub) * 32;
  AttnState st;
  attn_core((const bf16_t*)(ws + OFF_QB), qrow0, head, (const bf16_t*)(ws + OFF_KS) + (size_t)((l * 2 + b) * 2 + (head >> 1)) * 163840,
            (const bf16_t*)(ws + OFF_VST) + (size_t)((l * 2 + b) * 2 + (head >> 1)) * 163840, ksplit * 640, ksplit * 640 + 640, lane, st);
  Msh[wid * 64 + lane] = st.m; Lsh[wid * 64 + lane] = st.l;
#pragma unroll
  for (int i = 0; i < 16; ++i) { Osh[(wid * 32 + i) * 64 + lane] = st.o0[i]; Osh[(wid * 32 + 16 + i) * 64 + lane] = st.o1[i]; }
  __syncthreads();
  {
    const float c = 0.125f * 1.4426950408889634f;
    float mm[4], M = -INFINITY;
#pragma unroll
    for (int k = 0; k < 4; ++k) { mm[k] = Msh[(2 * k + qsub) * 64 + lane]; M = fmaxf(M, mm[k]); }
    float sc[4], Lt = 0.f;
#pragma unroll
    for (int k = 0; k < 4; ++k) { sc[k] = __builtin_amdgcn_exp2f((mm[k] - M) * c); Lt += Lsh[(2 * k + qsub) * 64 + lane] * sc[k]; }
    const float il = 1.f / Lt;
    float ov[8];
#pragma unroll
    for (int e = 0; e < 8; ++e) {
      float a = 0.f;
#pragma unroll
      for (int k = 0; k < 4; ++k) a += Osh[((2 * k + qsub) * 32 + ksplit * 8 + e) * 64 + lane] * sc[k];
      ov[e] = a * il;
    }
    const int r = lane & 31, hh = lane >> 5;
    const int dblk = ksplit >> 1, g4 = (ksplit & 1) * 2;
    bf16_t* yp = (bf16_t*)(ws + OFF_YMIX) + (size_t)(qrow0 + r) * D + 512 + head * 64 + dblk * 32 + 8 * g4 + 4 * hh;
    u32x2 a = {pk2(ov[0], ov[1]), pk2(ov[2], ov[3])};
    u32x2 bq = {pk2(ov[4], ov[5]), pk2(ov[6], ov[7])};
    *(u32x2*)yp = a;
    *(u32x2*)(yp + 8) = bq;
  }
  __syncthreads();
}

DI void chunk_item(const Params& p, int l, int ch, int hd, int sp, int lane) {
  const int fr = lane & 15, fq = lane >> 4;
  char* ws = PWS;
  const float* wsrc = INP(I_CWS) + ((size_t)(l * 4 + hd) * 128 + sp * 16 + fr) * 128 + fq * 8;
  const bf16_t* vb = (const bf16_t*)(ws + OFF_VCT) + ((size_t)ch * 256 + hd * 64 + fr) * 128 + fq * 8;
  f32x4 acc[4];
#pragma unroll
  for (int i = 0; i < 4; ++i) acc[i] = (f32x4){0.f, 0.f, 0.f, 0.f};
#pragma unroll
  for (int ks = 0; ks < 4; ++ks) {
    float4 a0 = *(const float4*)(wsrc + ks * 32), a1 = *(const float4*)(wsrc + ks * 32 + 4);
    bf16x8 af = pack8(a0.x, a0.y, a0.z, a0.w, a1.x, a1.y, a1.z, a1.w);
#pragma unroll
    for (int nt = 0; nt < 4; ++nt) {
      bf16x8 bfr = *(const bf16x8*)(vb + (size_t)nt * 16 * 128 + ks * 32);
      acc[nt] = MFMA16(af, bfr, acc[nt]);
    }
  }
  const float* proj = (const float*)(ws + OFF_R);
  bf16_t* ymix = (bf16_t*)(ws + OFF_YMIX);
  float uu[4][4];
#pragma unroll
  for (int j = 0; j < 4; ++j)
#pragma unroll
    for (int nt = 0; nt < 4; ++nt)
      uu[j][nt] = proj[(size_t)(ch * 128 + sp * 16 + fq * 4 + j) * DIN + 1024 + hd * 64 + nt * 16 + fr];
#pragma unroll
  for (int j = 0; j < 4; ++j) {
    int pp = sp * 16 + fq * 4 + j, tok = ch * 128 + pp;
    float bs = INP(I_CBS)[(l * 4 + hd) * 128 + pp];
#pragma unroll
    for (int nt = 0; nt < 4; ++nt) {
      int c = hd * 64 + nt * 16 + fr;
      ymix[(size_t)tok * D + 768 + c] = f2bf(gelu_t(uu[j][nt]) * (acc[nt][j] + bs));
    }
  }
}

constexpr int SSM_BU_LD = 132, SSM_H_LD = 136;
constexpr int SSM_WAVE_LDS = 16 * SSM_BU_LD * 4 + 16 * SSM_H_LD * 2;
#define LDS_FENCE() do { asm volatile("s_waitcnt lgkmcnt(0)" ::: "memory"); __builtin_amdgcn_wave_barrier(); } while (0)

DI void ssm_load_u(const Params& p, int ck, int g, int lane, bf16x8 (&af)[4]) {
  const int fr = lane & 15, fq = lane >> 4;
  const float* ub = (const float*)(PWS + OFF_R) + (size_t)ck * 64 * DIN + 256 + g * 16;
#pragma unroll
  for (int tile = 0; tile < 4; ++tile) {
    if (fq < 2) {
      const float* up = ub + (size_t)(tile * 16 + fr) * DIN + fq * 8;
      float4 a0 = *(const float4*)up, a1 = *(const float4*)(up + 4);
      af[tile] = pack8(a0.x, a0.y, a0.z, a0.w, a1.x, a1.y, a1.z, a1.w);
    } else {
      af[tile] = (bf16x8){0, 0, 0, 0, 0, 0, 0, 0};
    }
  }
}

template <int MODE, int DIR>
DI void ssm_dir(const Params& p, int l, int ck, int g, int lane, const bf16x8 (&af)[4], f32x4 (&yacc)[4], char* wlds) {
  constexpr bool CHAIN = MODE == 1;
  const int fr = lane & 15, fq = lane >> 4;
  char* ws = PWS;
  float* BU = (float*)wlds;
  bf16_t* Hs = (bf16_t*)(wlds + 16 * SSM_BU_LD * 4);
  const int gidx = (l * 2 + DIR) * 16 + g, idx = gidx * 64 + lane;
  bf16x8 bfr[8], cf[4];
#pragma unroll
  for (int nt = 0; nt < 8; ++nt) bfr[nt] = ((const bf16x8*)(ws + OFF_BF))[(gidx * 8 + nt) * 64 + lane];
#pragma unroll
  for (int ks = 0; ks < 4; ++ks) cf[ks] = ((const bf16x8*)(ws + OFF_CF))[(gidx * 4 + ks) * 64 + lane];
  const float2 lam = ((const float2*)(ws + OFF_LAMB))[idx];
  float hr = 0.f, hi = 0.f;
  const bool samp = ck >= 128;
  const int CPS = samp ? 32 : 4;
  const int cs = samp ? ((ck - 128) & 31) : (ck & 3);
  const int b = samp ? ((ck - 128) >> 5) : (ck >> 2);
  if (CHAIN) {
    const float2 lamT = ((const float2*)(ws + OFF_LAMT))[idx];
    const float2* Eb = (const float2*)(ws + OFF_E);
    const int cbase = ck - cs;
    if (samp) {
      size_t si = ((size_t)((b * 2 + l) * 2 + DIR) * 16 + g) * 64 + lane;
      hr = INP(I_SRE)[si]; hi = INP(I_SIM)[si];
    }
    const int nstep = DIR == 0 ? cs : CPS - 1 - cs;
    for (int base = 0; base < nstep; base += 8) {
      float2 ev[8];
#pragma unroll
      for (int k = 0; k < 8; ++k) {
        const int st = min(base + k, nstep - 1);
        const int c2 = DIR == 0 ? st : CPS - 1 - st;
        ev[k] = Eb[((size_t)((cbase + c2) * 16 + g) * 2 + DIR) * 64 + lane];
      }
#pragma unroll
      for (int k = 0; k < 8; ++k)
        if (base + k < nstep) {
          float nr = lamT.x * hr - lamT.y * hi + ev[k].x, ni = lamT.x * hi + lamT.y * hr + ev[k].y; hr = nr; hi = ni;
        }
    }
  }
#pragma unroll
  for (int sb = 0; sb < 4; ++sb) {
    const int tile = DIR ? 3 - sb : sb;
#pragma unroll
    for (int nt = 0; nt < 8; ++nt) {
      f32x4 cz = MFMA16(af[tile], bfr[nt], ((f32x4){0.f, 0.f, 0.f, 0.f}));
#pragma unroll
      for (int j = 0; j < 4; ++j) BU[(fq * 4 + j) * SSM_BU_LD + nt * 16 + fr] = cz[j];
    }
    LDS_FENCE();
#pragma unroll
    for (int q = 0; q < 16; ++q) {
      const int tt = DIR ? 15 - q : q;
      const float2 bu = *(const float2*)(BU + tt * SSM_BU_LD + 2 * lane);
      float nr = lam.x * hr - lam.y * hi + bu.x, ni = lam.x * hi + lam.y * hr + bu.y; hr = nr; hi = ni;
      *(unsigned*)(Hs + tt * SSM_H_LD + 2 * lane) = pk2(hr, hi);
    }
    LDS_FENCE();
#pragma unroll
    for (int ks = 0; ks < 4; ++ks) {
      bf16x8 ah = *(const bf16x8*)(Hs + fr * SSM_H_LD + ks * 32 + fq * 8);
      yacc[tile] = MFMA16(ah, cf[ks], yacc[tile]);
    }
    LDS_FENCE();
  }
  if (!CHAIN) {
    ((float2*)(ws + OFF_E))[((size_t)(ck * 16 + g) * 2 + DIR) * 64 + lane] = make_float2(hr, hi);
  } else if (!samp && ((DIR == 0 && cs == 3) || (DIR == 1 && cs == 0))) {
    size_t so = ((size_t)((b * 2 + l) * 2 + DIR) * 16 + g) * 64 + lane;
    p.out[OUT_SRE + so] = hr; p.out[OUT_SIM + so] = hi;
  }
}

#define SSM1_MODE 2
DI void ssm1_item(const Params& p, int l, int ck, int g, int dir, int lane, char* wlds) {
  bf16x8 af[4]; f32x4 yacc[4];
#pragma unroll
  for (int i = 0; i < 4; ++i) yacc[i] = (f32x4){0.f, 0.f, 0.f, 0.f};
  ssm_load_u(p, ck, g, lane, af);
  if (dir) ssm_dir<SSM1_MODE, 1>(p, l, ck, g, lane, af, yacc, wlds);
  else ssm_dir<SSM1_MODE, 0>(p, l, ck, g, lane, af, yacc, wlds);
}

DI void ssm2_item(const Params& p, int l, int ck, int g, int lane, char* wlds) {
  const int fr = lane & 15, fq = lane >> 4;
  bf16x8 af[4]; f32x4 yacc[4];
#pragma unroll
  for (int i = 0; i < 4; ++i) yacc[i] = (f32x4){0.f, 0.f, 0.f, 0.f};
  ssm_load_u(p, ck, g, lane, af);
  ssm_dir<1, 0>(p, l, ck, g, lane, af, yacc, wlds);
  ssm_dir<1, 1>(p, l, ck, g, lane, af, yacc, wlds);
  char* ws = PWS;
  const float* ub = (const float*)(ws + OFF_R) + (size_t)ck * 64 * DIN + 256 + g * 16;
  bf16_t* sg = (bf16_t*)(ws + OFF_SG);
  const int c = g * 16 + fr;
  const float dd = INP(I_SSMD)[l * 256 + c];
  float uv[4][4];
#pragma unroll
  for (int t4 = 0; t4 < 4; ++t4)
#pragma unroll
    for (int j = 0; j < 4; ++j) uv[t4][j] = ub[(size_t)(t4 * 16 + fq * 4 + j) * DIN + fr];
#pragma unroll
  for (int t4 = 0; t4 < 4; ++t4)
#pragma unroll
    for (int j = 0; j < 4; ++j) {
      size_t row = (size_t)ck * 64 + t4 * 16 + fq * 4 + j;
      sg[row * 256 + c] = f2bf(gelu_t(yacc[t4][j] + dd * uv[t4][j]));
    }
}

DI void ssm1_phase(const Params& p, int l, char* shmc, int bid, int nblk) {
  const int tid = otid(), wid = __builtin_amdgcn_readfirstlane(tid >> 6), lane = tid & 63;
  char* wlds = shmc + wid * SSM_WAVE_LDS;
  for (int it = wid * nblk + bid; it < 6144; it += nblk * 8) ssm1_item(p, l, it >> 5, (it >> 1) & 15, it & 1, lane, wlds);
}

DI void mix_phase(const Params& p, int l, char* shmc, int bid, int nblk) {
  const int tid = otid(), wid = __builtin_amdgcn_readfirstlane(tid >> 6), lane = tid & 63;
  char* ws = PWS;
  for (int it = bid; it < 256; it += nblk) attn_sample_item(p, l, it, shmc, wid, lane);
  for (int it = bid * 8 + wid; it < 1024; it += nblk * 8) {
    int b = it >> 5, head = (it >> 3) & 3, qt = it & 7;
    attn_prompt_item((const bf16_t*)(ws + OFF_QB), b * 256 + qt * 32, head, (const bf16_t*)(ws + OFF_KP) + (size_t)(b * 2 + (head >> 1)) * 16384,
                     (const bf16_t*)(ws + OFF_VPT) + (size_t)(b * 2 + (head >> 1)) * 16384, (bf16_t*)(ws + OFF_YMIX), lane);
  }
  __syncthreads();
  char* wlds = shmc + wid * SSM_WAVE_LDS;
  const int slot = wid * nblk + bid, nslot = nblk * 8;
  for (int it = slot; it < 6144; it += nslot) {
    if (it < 3072) ssm2_item(p, l, it >> 4, it & 15, lane, wlds);
    else { int j = it - 3072; chunk_item(p, l, j >> 5, (j >> 3) & 3, j & 7, lane); }
  }
}

constexpr int N_PHASE = 26;
DI void run_phase(const Params& p, int ph, char* shm, int bid, int nblk) {
  char* ws = PWS;
  if (ph == 0) { prep_phase(p, shm, bid, nblk); return; }
  if (ph == 25) { lnmod_phase(p, 1, 2, -1, 0, bid, nblk); return; }
  const int l = (ph - 1) / 12, s = (ph - 1) % 12;
  const bf16_t* hA = (const bf16_t*)(ws + OFF_H);
  bf16_t* hid = (bf16_t*)(ws + OFF_R);
  float* xy = (float*)(ws + OFF_XY);
  const float* modl = (const float*)(ws + OFF_MOD) + (size_t)l * 3 * 9216;
  EpiArgs ea; ea.f0 = nullptr; ea.b0 = nullptr; ea.c0 = nullptr; ea.cb = nullptr; ea.w = 0.f;
  ea.lng = nullptr; ea.lnb = nullptr; ea.stats = (const float2*)(ws + OFF_STATS); ea.xin0 = nullptr; ea.xin1 = nullptr;
  switch (s) {
    case 0: if (l == 0) lnmod_phase(p, -1, 0, 0, 0, bid, nblk); else lnmod_phase(p, l - 1, 2, l, 0, bid, nblk); break;
    case 1: case 10: {
      int sI = s == 1 ? 0 : 1;
      ea.b0 = hid;
      const bf16_t* w1 = (const bf16_t*)(ws + OFF_W1T) + (size_t)(l * 2 + sI) * 5632 * 1024;
      if (nblk == 256) {
        gemm_phase<1024, EPI_SWIGLU>(hA, w1, 46, 22, ea, shm, bid, nblk);
        gemm_phase<1024, EPI_SWIGLU, 1, 64>(hA, w1, 4, 22, ea, shm, 255 - bid, nblk, 46 * 256);
      } else {
        gemm_phase<1024, EPI_SWIGLU>(hA, w1, 48, 22, ea, shm, bid, nblk);
      }
      if (l == 0 && nblk == 256 && bid < 168) {
        if (sI == 0) convert_units(p, shm, T_W1 / 4, PER_L / 4, bid, 168);
        else convert_units(p, shm, PER_L / 4, 2 * PER_L / 4, bid, 168);
      } else if (l == 0 && nblk != 256 && sI == 0) {
        convert_units(p, shm, T_W1 / 4, 2 * PER_L / 4, bid, nblk);
      }
    } break;
    case 2: case 11: {
      int sI = s == 2 ? 0 : 1;
      ea.f0 = xy; ea.c0 = modl + (s == 2 ? 2 : 8) * 1024; ea.w = 0.5f;
      if (s == 2) {
        if (l == 0) { ea.xin0 = INP(I_XP); ea.xin1 = INP(I_XS); }
        else { ea.lng = INP(I_LNG) + ((l - 1) * 3 + 2) * 1024; ea.lnb = INP(I_LNB) + ((l - 1) * 3 + 2) * 1024; }
      } else { ea.lng = INP(I_LNG) + (l * 3 + 1) * 1024; ea.lnb = INP(I_LNB) + (l * 3 + 1) * 1024; }
      gemm_phase<2816, EPI_RESID, 1, 96>(hid, (const bf16_t*)(ws + OFF_W2T) + (size_t)(l * 2 + sI) * 1024 * 2816, 64, 4, ea, shm, bid, nblk);
    } break;
    case 3: lnmod_phase(p, l, 0, l, 3, bid, nblk); break;
    case 4: {
      ea.f0 = (float*)(ws + OFF_R);
      gemm_phase<1024, EPI_F32, 1, 96>(hA, (const bf16_t*)(ws + OFF_WINT) + (size_t)l * 1536 * 1024, 64, 6, ea, shm, bid, nblk);
    } break;
    case 5: post_phase(p, l, shm, bid, nblk); ssm1_phase(p, l, shm, bid, nblk); break;
    case 6: mix_phase(p, l, shm, bid, nblk); break;
    case 7: {
      ea.b0 = (bf16_t*)(ws + OFF_YMIX); ea.cb = (const bf16_t*)(ws + OFF_SG); ea.c0 = INP(I_BGLU) + l * 256;
      gemm_phase<256, EPI_GLU>((const bf16_t*)(ws + OFF_SG), (const bf16_t*)(ws + OFF_WGLUT) + (size_t)l * 65536, 48, 1, ea, shm, bid, nblk);
      ea.c0 = INP(I_POOLS) + l * 256;
      int bid2 = (bid + nblk - (nblk >> 1)) % nblk;
      gemm_phase<256, EPI_POOL>((const bf16_t*)(ws + OFF_DIFF), (const bf16_t*)(ws + OFF_WPOOLT) + (size_t)l * 65536, 48, 1, ea, shm, bid2, nblk);
    } break;
    case 8: {
      ea.f0 = xy; ea.c0 = modl + 5 * 1024; ea.w = 1.0f;
      ea.lng = INP(I_LNG) + (l * 3 + 0) * 1024; ea.lnb = INP(I_LNB) + (l * 3 + 0) * 1024;
      gemm_phase<1024, EPI_RESID, 1, 96>((const bf16_t*)(ws + OFF_YMIX), (const bf16_t*)(ws + OFF_WOUTT) + (size_t)l * 1024 * 1024, 64, 4, ea, shm, bid, nblk);
    } break;
    case 9: lnmod_phase(p, l, 1, l, 6, bid, nblk); break;
  }
}

__global__ __launch_bounds__(512, 2) void mega(Params p, int ph_lo, int ph_hi) {
  extern __shared__ __attribute__((aligned(16))) char shm[];
  __shared__ uint4 xb_words;
  const int bid = blockIdx.x, nblk = gridDim.x;
  if (threadIdx.x == 0) xb_words = make_uint4(0u, 0u, 0u, 0u);
  __syncthreads();
  const XcdBarrier xb = xcd_barrier_post((unsigned*)(p.ws + OFF_BAR), (volatile LAS unsigned*)&xb_words);
  for (int ph = ph_lo; ph < ph_hi; ++ph) {
    if (ph > ph_lo) {
      if (ph_hi < 0) cg::this_grid().sync();
      xcd_barrier(xb);
    }
    run_phase(p, ph, shm, bid, nblk);
  }
}

extern "C" void kernel_launch(void* const* d_in, const int* in_sizes, int n_in, void* d_out, int out_size, void* d_ws,
                              size_t ws_size, hipStream_t stream) {
  static int grid_blocks = 0;
  if (!grid_blocks) {
    hipFuncSetAttribute((const void*)mega, hipFuncAttributeMaxDynamicSharedMemorySize, GEMM_LDS);
    int dev = 0, cus = 0, per_cu = 0;
    hipGetDevice(&dev);
    hipDeviceGetAttribute(&cus, hipDeviceAttributeMultiprocessorCount, dev);
    hipOccupancyMaxActiveBlocksPerMultiprocessor(&per_cu, mega, 512, GEMM_LDS);
    if (per_cu < 1) per_cu = 1;
    if (per_cu > 1) per_cu = 1;
    grid_blocks = cus * per_cu;
  }
  Params p{};
  for (int i = 0; i < N_IN; ++i) p.in[i] = (const float*)d_in[i];
  p.out = (float*)d_out;
  p.ws = (char*)d_ws;
  hipMemsetAsync((char*)d_ws + OFF_BAR, 0, 16384, stream);
#if ONE_LAUNCH
  int lo = 0, hi = N_PHASE;
  void* args[] = {&p, &lo, &hi};
  hipError_t e = hipLaunchCooperativeKernel((const void*)mega, dim3(grid_blocks), dim3(512), args, GEMM_LDS, stream);
  if (e != hipSuccess) fprintf(stderr, "cooperative launch failed: %s (grid %d)\n", hipGetErrorString(e), grid_blocks);
#else
  for (int ph = 0; ph < N_PHASE; ++ph) mega<<<grid_blocks, 512, GEMM_LDS, stream>>>(p, ph, ph + 1);
#endif
}
```

```cpp
#include <hip/hip_runtime.h>
#include <hip/hip_cooperative_groups.h>
#include <cstdio>
namespace cg = cooperative_groups;

#define DI __device__ __forceinline__
typedef unsigned short bf16_t;
typedef __attribute__((ext_vector_type(8))) short bf16x8;
typedef __attribute__((ext_vector_type(4))) short s16x4;
typedef __attribute__((ext_vector_type(4))) float f32x4;
typedef __attribute__((ext_vector_type(16))) float f32x16;
typedef __attribute__((ext_vector_type(2))) float f32x2;
typedef __attribute__((ext_vector_type(2))) __bf16 bf16x2v;
typedef __attribute__((ext_vector_type(4))) unsigned u32x4;
typedef __attribute__((ext_vector_type(2))) unsigned u32x2;

#ifndef ONE_LAUNCH
#define ONE_LAUNCH 1
#endif

constexpr int D = 1024, NTOK = 12288, NPROMPT = 8192, DFF = 2816, DIN = 1536;
constexpr float ALPHA = 1.4142135623730951f;
constexpr float LN_EPS = 1e-5f, RMS_EPS = 1e-6f;
enum { I_XP = 0, I_XS, I_CK, I_CV, I_SRE, I_SIM, I_C, I_CCTX, I_WMOD, I_BMOD, I_LNG, I_LNB, I_W1, I_W2, I_WIN, I_WOUT,
       I_POOLW, I_POOLS, I_LRE, I_LIM, I_LSTEP, I_BRE, I_BIM, I_CRE, I_CIM, I_SSMD, I_WGLU, I_BGLU, I_QN, I_KN,
       I_CLG, I_CLB, I_CWS, I_CBS, N_IN };
constexpr size_t OUT_K = 12582912, OUT_V = 14680064, OUT_SRE = 16777216, OUT_SIM = 16908288;

constexpr size_t OFF_W1T = 0;
constexpr size_t OFF_W2T = OFF_W1T + 46137344;
constexpr size_t OFF_WINT = OFF_W2T + 23068672;
constexpr size_t OFF_WOUTT = OFF_WINT + 6291456;
constexpr size_t OFF_WGLUT = OFF_WOUTT + 4194304;
constexpr size_t OFF_WPOOLT = OFF_WGLUT + 262144;
constexpr size_t OFF_MOD = OFF_WPOOLT + 262144;
constexpr size_t OFF_XY = OFF_MOD + 221184;
constexpr size_t OFF_H = OFF_XY + 50331648;
constexpr size_t OFF_YMIX = OFF_H + 25165824;
constexpr size_t OFF_R = OFF_YMIX + 25165824;
constexpr size_t OFF_QB = OFF_R + 75497472;
constexpr size_t OFF_KP = OFF_QB + 6291456;
constexpr size_t OFF_KS = OFF_KP + 2097152;
constexpr size_t OFF_VPT = OFF_KS + 2621440;
constexpr size_t OFF_VST = OFF_VPT + 2097152;
constexpr size_t OFF_VCT = OFF_VST + 2621440;
constexpr size_t OFF_DIFF = OFF_VCT + 6291456;
constexpr size_t OFF_SG = OFF_DIFF + 6291456;
constexpr size_t OFF_E = OFF_SG + 6291456;
constexpr size_t OFF_LAMB = OFF_E + 3145728;
constexpr size_t OFF_LAMT = OFF_LAMB + 32768;
constexpr size_t OFF_BBAR = OFF_LAMT + 32768;
constexpr size_t OFF_BAR = OFF_BBAR + 524288;
constexpr size_t OFF_BF = OFF_BAR + 16384;
constexpr size_t OFF_CF = OFF_BF + 524288;
constexpr size_t OFF_STATS = OFF_CF + 262144;
constexpr size_t WS_TOTAL = OFF_STATS + 98304;

struct Params { const float* in[N_IN]; float* out; char* ws; };

DI int otid() {
  int z = 0; asm volatile("" : "+s"(z));
  int lane = __builtin_amdgcn_mbcnt_hi(-1, __builtin_amdgcn_mbcnt_lo(-1, z));
  int w = __builtin_amdgcn_readfirstlane(threadIdx.x >> 6);
  return w * 64 + lane;
}
DI int osgpr(int i) { asm volatile("" : "+s"(i)); return i; }
#define INP(i) (p.in[osgpr(i)])
DI char* ows(char* w) { asm volatile("" : "+s"(w)); return w; }
#define PWS ows(p.ws)
DI unsigned pk2(float a, float b) { f32x2 v = {a, b}; bf16x2v r = __builtin_convertvector(v, bf16x2v); return __builtin_bit_cast(unsigned, r); }
DI bf16_t f2bf(float a) { return (bf16_t)(pk2(a, 0.f) & 0xffffu); }
DI float bf2f(bf16_t v) { return __uint_as_float(((unsigned)v) << 16); }
DI bf16x8 pack8(float a0, float a1, float a2, float a3, float a4, float a5, float a6, float a7) {
  u32x4 u = {pk2(a0, a1), pk2(a2, a3), pk2(a4, a5), pk2(a6, a7)};
  return __builtin_bit_cast(bf16x8, u);
}
DI float gelu_t(float x) {
  float z = 0.7978845608028654f * (x + 0.044715f * x * x * x);
  float e = __expf(2.f * z);
  float th = 1.f - 2.f / (e + 1.f);
  return 0.5f * x * (1.f + th);
}
DI float sigmoid_f(float x) { return 1.f / (1.f + __expf(-x)); }
DI float shfl_x(float v, int mask, int lane) {
  return __int_as_float(__builtin_amdgcn_ds_bpermute((lane ^ mask) << 2, __float_as_int(v)));
}
template <int CTRL> DI float dpp_f(float v) {
  return __int_as_float(__builtin_amdgcn_update_dpp(0, __float_as_int(v), CTRL, 0xf, 0xf, true));
}
DI float wave_sum(float v, int lane) {
  (void)lane;
  v += dpp_f<0xB1>(v);
  v += dpp_f<0x4E>(v);
  v += dpp_f<0x141>(v);
  v += dpp_f<0x140>(v);
  const int iv = __float_as_int(v);
  float r0 = __int_as_float(__builtin_amdgcn_readlane(iv, 0)), r1 = __int_as_float(__builtin_amdgcn_readlane(iv, 16));
  float r2 = __int_as_float(__builtin_amdgcn_readlane(iv, 32)), r3 = __int_as_float(__builtin_amdgcn_readlane(iv, 48));
  return (r0 + r1) + (r2 + r3);
}
DI size_t kfrag_off(int key, int d) {
  return ((size_t)((key >> 5) * 4 + (d >> 4)) * 64 + ((d >> 3) & 1) * 32 + (key & 31)) * 8 + (d & 7);
}
DI size_t vfrag_off(int key, int d) {
  const int kk = key & 31, w = kk & 15;
  return ((size_t)(((key >> 5) * 2 + (kk >> 4)) * 2 + (d >> 5)) * 64 + ((w >> 2) & 1) * 32 + (d & 31)) * 8 + (((w >> 3) << 2) | (w & 3));
}

#define MFMA16(a, b, c) __builtin_amdgcn_mfma_f32_16x16x32_bf16((a), (b), (c), 0, 0, 0)
#define MFMA32(a, b, c) __builtin_amdgcn_mfma_f32_32x32x16_bf16((a), (b), (c), 0, 0, 0)


#define XB_TMO      128
#define XB_XCNT(j)  (256  + 64 * (j))
#define XB_XSUB(j)  (1280 + 64 * (j))
#define XB_XGEN(j)  (2304 + 64 * (j))
#define XB_TOP      3328
#define XB_TOPGEN   3392
#define XCD_BAR_WORDS 3456
#define XB_SPIN_CAP (1u << 18)
#define LAS __attribute__((address_space(3)))
DI unsigned xb_ld(unsigned* p) { return __hip_atomic_load(p, __ATOMIC_RELAXED, __HIP_MEMORY_SCOPE_AGENT); }
DI unsigned xb_add(unsigned* p, unsigned v) { return __hip_atomic_fetch_add(p, v, __ATOMIC_RELAXED, __HIP_MEMORY_SCOPE_AGENT); }
DI unsigned xb_xcc_id() { return (unsigned)__builtin_amdgcn_s_getreg((3 << 11) | 20) & 0xFu; }
#define XB_SPIN(cond, bar) do { unsigned _sp = 0; while (cond) { __builtin_amdgcn_s_sleep(1); \
    if ((++_sp & 255u) == 0u) { if (xb_ld(&(bar)[XB_TMO])) break; if (_sp > XB_SPIN_CAP) { atomicAdd(&(bar)[XB_TMO], 1u); break; } } } } while (0)
struct XcdBarrier { unsigned* bar; unsigned x; volatile LAS unsigned* st; };
DI XcdBarrier xcd_barrier_post(unsigned* bar, volatile LAS unsigned* st) {
  XcdBarrier b; b.bar = bar; b.x = xb_xcc_id(); b.st = st;
  if (threadIdx.x == 0) (void)xb_add(&bar[XB_XCNT(b.x)], 1u);
  return b;
}
DI void xcd_barrier_complete(unsigned* bar, unsigned x, unsigned& nloc, unsigned& nx) {
  const unsigned G = gridDim.x * gridDim.y * gridDim.z;
  unsigned sum, cnt, mine, sp = 0u;
  for (;;) {
    sum = 0u; cnt = 0u; mine = 0u;
#pragma unroll
    for (unsigned j = 0; j < 16; ++j) { const unsigned c = xb_ld(&bar[XB_XCNT(j)]); sum += c; cnt += (c > 0u) ? 1u : 0u; mine = (j == x) ? c : mine; }
    if (sum == G) break;
    __builtin_amdgcn_s_sleep(1);
    if ((++sp & 255u) == 0u) { if (xb_ld(&bar[XB_TMO])) break; if (sp > XB_SPIN_CAP) { atomicAdd(&bar[XB_TMO], 1u); break; } }
  }
  nloc = mine > 0u ? mine : 1u; nx = cnt > 0u ? cnt : 1u;
}
DI void xcd_barrier(const XcdBarrier& b) {
  asm volatile("s_waitcnt vmcnt(0)" ::: "memory");
  __syncthreads();
  if (threadIdx.x == 0) {
    unsigned* bar = b.bar;
    __builtin_amdgcn_s_waitcnt(0);
    unsigned nloc = b.st[0], nx = b.st[1];
    if (nloc == 0u) { xcd_barrier_complete(bar, b.x, nloc, nx); b.st[0] = nloc; b.st[1] = nx; }
    const unsigned old = xb_add(&bar[XB_XSUB(b.x)], 1u);
    const unsigned gen = old / nloc;
    if (old + 1u == (gen + 1u) * nloc) {
      __builtin_amdgcn_fence(__ATOMIC_RELEASE, "agent");
      asm volatile("s_waitcnt vmcnt(0)" ::: "memory");
      const unsigned og = xb_add(&bar[XB_TOP], 1u);
      const unsigned tg = og / nx;
      if (og + 1u == (tg + 1u) * nx) xb_add(&bar[XB_TOPGEN], 1u);
      else XB_SPIN(xb_ld(&bar[XB_TOPGEN]) == tg, bar);
      __builtin_amdgcn_fence(__ATOMIC_ACQUIRE, "agent");
      xb_add(&bar[XB_XGEN(b.x)], 1u);
      asm volatile("s_waitcnt vmcnt(0)" ::: "memory");
    } else {
      XB_SPIN(xb_ld(&bar[XB_XGEN(b.x)]) == gen, bar);
      __builtin_amdgcn_fence(__ATOMIC_ACQUIRE, "agent");
      asm volatile("s_waitcnt vmcnt(0)" ::: "memory");
    }
  }
  __syncthreads();
}

constexpr int BM = 256, BK = 64, HALF = 128, NXCD = 8, WGM = 8, HT = HALF * BK;
constexpr int GEMM_LDS = 8 * HT * 2;

DI int lds_byte(int r, int c) {
  int st = (r >> 4) * 2 + (c >> 5), rr = r & 15, cc = c & 31, ob = rr * 64 + cc * 2;
  return st * 1024 + (ob ^ (((ob >> 9) & 1) << 5));
}
DI void stage_rc(int b, int& R, int& C) {
  int st = b / 1024, sb = b % 1024, swz = sb ^ (((sb >> 9) & 1) << 5);
  R = (st >> 1) * 16 + swz / 64; C = (st & 1) * 32 + (swz % 64) / 2;
}

enum { EPI_SWIGLU = 0, EPI_RESID, EPI_F32, EPI_GLU, EPI_POOL };
struct EpiArgs {
  float* f0;
  bf16_t* b0;
  const float* c0;
  const bf16_t* cb;
  float w;
  const float* lng; const float* lnb; const float2* stats; const float* xin0; const float* xin1;
};

template <int K, int MODE, int SPLITS = 1, int RH = 128>
DI void gemm_phase(const bf16_t* __restrict__ A, const bf16_t* __restrict__ Bt, int nM, int nN, EpiArgs ea,
                   char* shmc, int bid, int nblk, int mrow0 = 0) {
  bf16_t* shm = (bf16_t*)shmc;
#define SA(b, h) (shm + ((b) * 2 + (h)) * HT)
#define SB(b, h) (shm + (4 + (b) * 2 + (h)) * HT)
#define STAGE(P, RS, SOFF, kt) do { const int _so = (SOFF) + (kt0 + (kt)) * (BK * 2); \
    __builtin_amdgcn_raw_ptr_buffer_load_lds(RS, (__attribute__((address_space(3))) void*)((char*)(P) + wid * 1024), 16, so0, _so, 0, 0); \
    __builtin_amdgcn_raw_ptr_buffer_load_lds(RS, (__attribute__((address_space(3))) void*)((char*)(P) + wid * 1024 + 8192), 16, so1, _so, 0, 0); } while (0)
#define LDA(dst, b, h) for (int m = 0; m < MT; ++m) for (int k = 0; k < 2; ++k) \
    dst[m][k] = *reinterpret_cast<const bf16x8*>((char*)SA(b, h) + lds_byte(wr * (RH / 2) + m * 16 + fr, k * 32 + fq * 8))
#define LDB(dst, b, h) for (int n = 0; n < 2; ++n) for (int k = 0; k < 2; ++k) \
    dst[n][k] = *reinterpret_cast<const bf16x8*>((char*)SB(b, h) + lds_byte(wc * 32 + n * 16 + fr, k * 32 + fq * 8))
#define MMA(ai, bj, At, Bt_) do { __builtin_amdgcn_s_setprio(1); \
    for (int m = 0; m < MT; ++m) for (int n = 0; n < 2; ++n) for (int k = 0; k < 2; ++k) \
      acc[ai][bj][m][n] = MFMA16(At[m][k], Bt_[n][k], acc[ai][bj][m][n]); \
    __builtin_amdgcn_s_setprio(0); } while (0)
#define WAIT_V(n) asm volatile("s_waitcnt vmcnt(" #n ")" ::: "memory")
#define WAIT_L(n) asm volatile("s_waitcnt lgkmcnt(" #n ")" ::: "memory")
#define BAR __builtin_amdgcn_s_barrier()
#define SCHED __builtin_amdgcn_sched_barrier(0)
  constexpr int MT = RH / 32;
  constexpr int TM = 2 * RH;
  const int tid = otid();
  const int wid = __builtin_amdgcn_readfirstlane(tid >> 6), lane = tid & 63, wr = wid >> 2, wc = wid & 3, fr = lane & 15, fq = lane >> 4;
  const __amdgpu_buffer_rsrc_t rsA = __builtin_amdgcn_make_buffer_rsrc((void*)A, 0, 0x7fffffff, 0x00020000);
  const __amdgpu_buffer_rsrc_t rsB = __builtin_amdgcn_make_buffer_rsrc((void*)Bt, 0, 0x7fffffff, 0x00020000);
  unsigned so0, so1;
  { int R, C; stage_rc(tid * 16, R, C); so0 = (unsigned)(R * K + C) * 2u; stage_rc(tid * 16 + 8192, R, C); so1 = (unsigned)(R * K + C) * 2u; }
  const int nwg = nM * nN;
  for (int unit = bid; unit < nwg * SPLITS; unit += nblk) {
    const int sp = SPLITS == 1 ? 0 : unit / nwg, tile = SPLITS == 1 ? unit : unit % nwg;
    const int kt0 = SPLITS == 1 ? 0 : (sp == 0 ? 0 : sp == 1 ? 12 : sp == 2 ? 24 : 34);
    const int nt = SPLITS == 1 ? K / BK : (sp < 2 ? 12 : 10);
    int wgid = tile;
    { int q = nwg / NXCD, r = nwg % NXCD, xcd = wgid % NXCD, off = wgid / NXCD;
      wgid = (xcd < r ? xcd * (q + 1) : r * (q + 1) + (xcd - r) * q) + off; }
    int nig = WGM * nN, gid = wgid / nig, fm = gid * WGM, gsz = min(nM - fm, WGM);
    int pm = fm + ((wgid % nig) % gsz), pn = (wgid % nig) / gsz, brow = mrow0 + pm * TM, bcol = pn * BM;
    const int A0 = brow * K * 2, A1 = A0 + RH * K * 2, B0p = bcol * K * 2, B1p = B0p + HALF * K * 2;
    f32x4 acc[2][2][MT][2] = {};
    bf16x8 At[MT][2], B0[2][2], B1[2][2];
    STAGE(SB(0, 0), rsB, B0p, 0); STAGE(SA(0, 0), rsA, A0, 0);
    STAGE(SB(0, 1), rsB, B1p, 0); STAGE(SA(0, 1), rsA, A1, 0);
    if (wr == 1) BAR;
    WAIT_V(4); BAR;
    STAGE(SB(1, 0), rsB, B0p, 1); STAGE(SA(1, 0), rsA, A0, 1); STAGE(SB(1, 1), rsB, B1p, 1);
    WAIT_V(6); BAR;
    for (int t = 0; t < nt - 2; t += 2) {
      LDB(B0, 0, 0); SCHED; LDA(At, 0, 0); STAGE(SA(1, 1), rsA, A1, t + 1);
      if (MT == 4) WAIT_L(8); else if (MT == 3) WAIT_L(6); else WAIT_L(4); BAR; WAIT_L(0); MMA(0, 0, At, B0); BAR; SCHED;
      LDB(B1, 0, 1); STAGE(SB(0, 0), rsB, B0p, t + 2);
      BAR; WAIT_L(0); MMA(0, 1, At, B1); BAR;
      LDA(At, 0, 1); STAGE(SA(0, 0), rsA, A0, t + 2);
      BAR; WAIT_L(0); MMA(1, 0, At, B0); BAR; SCHED;
      STAGE(SB(0, 1), rsB, B1p, t + 2);
      WAIT_V(6); BAR; MMA(1, 1, At, B1); BAR;
      LDB(B0, 1, 0); SCHED; LDA(At, 1, 0); STAGE(SA(0, 1), rsA, A1, t + 2);
      if (MT == 4) WAIT_L(8); else if (MT == 3) WAIT_L(6); else WAIT_L(4); BAR; WAIT_L(0); MMA(0, 0, At, B0); BAR; SCHED;
      LDB(B1, 1, 1); STAGE(SB(1, 0), rsB, B0p, t + 3);
      BAR; WAIT_L(0); MMA(0, 1, At, B1); BAR;
      LDA(At, 1, 1); STAGE(SA(1, 0), rsA, A0, t + 3);
      BAR; WAIT_L(0); MMA(1, 0, At, B0); BAR; SCHED;
      STAGE(SB(1, 1), rsB, B1p, t + 3);
      WAIT_V(6); BAR; MMA(1, 1, At, B1); BAR;
    }
    { LDB(B0, 0, 0); LDA(At, 0, 0); STAGE(SA(1, 1), rsA, A1, nt - 1);
      BAR; WAIT_L(0); MMA(0, 0, At, B0); BAR;
      LDB(B1, 0, 1); BAR; WAIT_L(0); MMA(0, 1, At, B1); BAR;
      LDA(At, 0, 1); WAIT_V(4); BAR; WAIT_L(0); MMA(1, 0, At, B0); MMA(1, 1, At, B1); BAR; }
    { LDB(B0, 1, 0); LDA(At, 1, 0); WAIT_V(2); BAR; WAIT_L(0); MMA(0, 0, At, B0); BAR;
      LDB(B1, 1, 1); WAIT_V(0); BAR; WAIT_L(0); MMA(0, 1, At, B1); BAR;
      LDA(At, 1, 1); BAR; WAIT_L(0); MMA(1, 0, At, B0); MMA(1, 1, At, B1); BAR; }
    if (wr == 0) BAR;
    const int ci = brow < NPROMPT ? 0 : 1 + (brow - NPROMPT) / 2048;
    const int ci2 = (brow + TM - 1) < NPROMPT ? 0 : 1 + (brow + TM - 1 - NPROMPT) / 2048;
    const int rsplit = ci2 == 1 ? NPROMPT : NPROMPT + 2048;
    const int te = otid(), le = te & 63, wide = te >> 6;
    const int wr = wide >> 2, wc = wide & 3, fr = le & 15, fq = le >> 4;
    const int rbase = brow + wr * (RH / 2) + fq * 4, cbase = bcol + wc * 32 + fr;
    if (MODE == EPI_SWIGLU) {
#pragma unroll
      for (int ai = 0; ai < 2; ++ai)
#pragma unroll
        for (int m = 0; m < MT; ++m)
#pragma unroll
          for (int j = 0; j < 4; ++j) {
            const int row = rbase + ai * RH + m * 16 + j;
#pragma unroll
            for (int n = 0; n < 2; ++n) {
              float g = acc[ai][0][m][n][j], u = acc[ai][1][m][n][j];
              ea.b0[(size_t)row * DFF + pn * 128 + wc * 32 + n * 16 + fr] = f2bf(g * sigmoid_f(g) * u);
            }
          }
    } else if (MODE == EPI_RESID) {
      float gate[2][2], gate2[2][2], lg[2][2], lb[2][2];
      const bool raw = ea.lng == nullptr;
#pragma unroll
      for (int bj = 0; bj < 2; ++bj)
#pragma unroll
        for (int n = 0; n < 2; ++n) {
          const int col = cbase + bj * HALF + n * 16;
          gate[bj][n] = ea.w * ea.c0[ci * 9216 + col];
          gate2[bj][n] = ea.w * ea.c0[ci2 * 9216 + col];
          lg[bj][n] = raw ? 1.f : ea.lng[col];
          lb[bj][n] = raw ? 0.f : ea.lnb[col];
        }
#pragma unroll
      for (int ai = 0; ai < 2; ++ai)
#pragma unroll
        for (int m = 0; m < MT; ++m) {
          const int r0 = rbase + ai * RH + m * 16;
          float* xb = ea.f0 + (size_t)r0 * D + cbase;
          float xv[4][2][2];
          float2 st[4];
#pragma unroll
          for (int j = 0; j < 4; ++j) {
            const int row = r0 + j;
            const float* src = raw ? (row < NPROMPT ? ea.xin0 + (size_t)row * D : ea.xin1 + (size_t)(row - NPROMPT) * D) + cbase
                                   : xb + (size_t)j * D;
            st[j] = raw ? make_float2(0.f, 1.f) : ea.stats[row];
#pragma unroll
            for (int bj = 0; bj < 2; ++bj)
#pragma unroll
              for (int n = 0; n < 2; ++n) xv[j][bj][n] = src[bj * HALF + n * 16];
          }
#pragma unroll
          for (int j = 0; j < 4; ++j)
#pragma unroll
            for (int bj = 0; bj < 2; ++bj)
#pragma unroll
              for (int n = 0; n < 2; ++n) {
                const float x = (xv[j][bj][n] - st[j].x) * st[j].y * lg[bj][n] + lb[bj][n];
                xb[(size_t)j * D + bj * HALF + n * 16] =
                    ALPHA * x + ((r0 + j) >= rsplit ? gate2[bj][n] : gate[bj][n]) * acc[ai][bj][m][n][j];
              }
        }
    } else if (MODE == EPI_GLU) {
      float bg[2][2];
#pragma unroll
      for (int bj = 0; bj < 2; ++bj)
#pragma unroll
        for (int n = 0; n < 2; ++n) bg[bj][n] = ea.c0[cbase + bj * HALF + n * 16];
#pragma unroll
      for (int ai = 0; ai < 2; ++ai) {
        float gv[MT][4][2][2];
        const bf16_t* gb = ea.cb + (size_t)(rbase + ai * RH) * 256 + cbase;
#pragma unroll
        for (int m = 0; m < MT; ++m)
#pragma unroll
          for (int j = 0; j < 4; ++j)
#pragma unroll
            for (int bj = 0; bj < 2; ++bj)
#pragma unroll
              for (int n = 0; n < 2; ++n) gv[m][j][bj][n] = bf2f(gb[(size_t)(m * 16 + j) * 256 + bj * HALF + n * 16]);
        bf16_t* yb = ea.b0 + (size_t)(rbase + ai * RH) * D + 256 + cbase;
#pragma unroll
        for (int m = 0; m < MT; ++m)
#pragma unroll
          for (int j = 0; j < 4; ++j)
#pragma unroll
            for (int bj = 0; bj < 2; ++bj)
#pragma unroll
              for (int n = 0; n < 2; ++n)
                yb[(size_t)(m * 16 + j) * D + bj * HALF + n * 16] =
                    f2bf(gv[m][j][bj][n] * sigmoid_f(acc[ai][bj][m][n][j] + bg[bj][n]));
      }
    } else {
      float ps[2][2];
#pragma unroll
      for (int bj = 0; bj < 2; ++bj)
#pragma unroll
        for (int n = 0; n < 2; ++n) ps[bj][n] = MODE == EPI_POOL ? ea.c0[cbase + bj * HALF + n * 16] : 1.f;
#pragma unroll
      for (int ai = 0; ai < 2; ++ai)
#pragma unroll
        for (int m = 0; m < MT; ++m)
#pragma unroll
          for (int j = 0; j < 4; ++j) {
            const int row = rbase + ai * RH + m * 16 + j;
#pragma unroll
            for (int bj = 0; bj < 2; ++bj)
#pragma unroll
              for (int n = 0; n < 2; ++n) {
                const int col = cbase + bj * HALF + n * 16;
                float a = acc[ai][bj][m][n][j];
                if (MODE == EPI_F32) ea.f0[(size_t)row * DIN + col] = a;
                else ea.b0[(size_t)row * D + col] = f2bf(a * ps[bj][n]);
              }
          }
    }
  }
#undef SA
#undef SB
}

constexpr int T_W1 = 16 * 88, T_W2 = 44 * 16, T_IN = 16 * 24, T_OUT = 256, T_GLU = 16;
constexpr int PER_L = 2 * T_W1 + 2 * T_W2 + T_IN + T_OUT + T_GLU;
DI void convert_units(const Params& p, char* shmc, int unit_begin, int unit_end, int worker, int nworkers) {
  const int tid = otid();
  char* ws = PWS;
  constexpr int NTL = 4;
  __syncthreads();
  for (int u = unit_begin + worker; u < unit_end; u += nworkers) {
    const int it0 = u * NTL;
    bf16_t* dsts[NTL]; int Ks[NTL], modes[NTL], kts[NTL], ntiles[NTL];
    float4 v[NTL][2];
#pragma unroll
    for (int q = 0; q < NTL; ++q) {
      const int it = it0 + q;
      int l = it / PER_L, r = it % PER_L;
      const float* src; bf16_t* dst; int K, N, mode = 0;
      if (r < 2 * T_W1) {
        int s2 = r / T_W1; r %= T_W1;
        src = INP(I_W1) + (size_t)(l * 2 + s2) * 1024 * 5632; dst = (bf16_t*)(ws + OFF_W1T) + (size_t)(l * 2 + s2) * 5632 * 1024;
        K = 1024; N = 5632; mode = 1;
      } else if (r < 2 * T_W1 + 2 * T_W2) {
        r -= 2 * T_W1; int s2 = r / T_W2; r %= T_W2;
        src = INP(I_W2) + (size_t)(l * 2 + s2) * 2816 * 1024; dst = (bf16_t*)(ws + OFF_W2T) + (size_t)(l * 2 + s2) * 1024 * 2816;
        K = 2816; N = 1024;
      } else if (r < 2 * T_W1 + 2 * T_W2 + T_IN) {
        r -= 2 * T_W1 + 2 * T_W2;
        src = INP(I_WIN) + (size_t)l * 1024 * 1536; dst = (bf16_t*)(ws + OFF_WINT) + (size_t)l * 1536 * 1024;
        K = 1024; N = 1536;
      } else if (r < 2 * T_W1 + 2 * T_W2 + T_IN + T_OUT) {
        r -= 2 * T_W1 + 2 * T_W2 + T_IN;
        src = INP(I_WOUT) + (size_t)l * 1024 * 1024; dst = (bf16_t*)(ws + OFF_WOUTT) + (size_t)l * 1024 * 1024;
        K = 1024; N = 1024;
      } else {
        r -= 2 * T_W1 + 2 * T_W2 + T_IN + T_OUT;
        src = INP(I_WGLU) + (size_t)l * 256 * 256; dst = (bf16_t*)(ws + OFF_WGLUT) + (size_t)l * 256 * 256;
        K = 256; N = 256;
      }
      const int nkt = K / 64, kt = r % nkt, ntile = r / nkt;
      dsts[q] = dst; Ks[q] = K; modes[q] = mode; kts[q] = kt; ntiles[q] = ntile;
#pragma unroll
      for (int i = 0; i < 2; ++i) {
        int k = (tid >> 4) + 32 * i, n = (tid & 15) * 4;
        v[q][i] = *(const float4*)(src + (size_t)(kt * 64 + k) * N + ntile * 64 + n);
      }
    }
#pragma unroll
    for (int q = 0; q < NTL; ++q) {
      float* tile = (float*)shmc + q * (64 * 65);
#pragma unroll
      for (int i = 0; i < 2; ++i) {
        int k = (tid >> 4) + 32 * i, n = (tid & 15) * 4;
        tile[k * 65 + n] = v[q][i].x; tile[k * 65 + n + 1] = v[q][i].y; tile[k * 65 + n + 2] = v[q][i].z; tile[k * 65 + n + 3] = v[q][i].w;
      }
    }
    __syncthreads();
#pragma unroll
    for (int q = 0; q < NTL; ++q) {
      const float* tile = (const float*)shmc + q * (64 * 65);
      int n = tid >> 3, kk = (tid & 7) * 8;
      int nsrc = ntiles[q] * 64 + n, nrow = nsrc;
      if (modes[q] == 1) {
        if (nsrc < 2816) nrow = (nsrc >> 7) * 256 + (nsrc & 127);
        else { int mm = nsrc - 2816; nrow = (mm >> 7) * 256 + 128 + (mm & 127); }
      }
      bf16x8 o = pack8(tile[(kk + 0) * 65 + n], tile[(kk + 1) * 65 + n], tile[(kk + 2) * 65 + n], tile[(kk + 3) * 65 + n],
                       tile[(kk + 4) * 65 + n], tile[(kk + 5) * 65 + n], tile[(kk + 6) * 65 + n], tile[(kk + 7) * 65 + n]);
      *(bf16x8*)(dsts[q] + (size_t)nrow * Ks[q] + kts[q] * 64 + kk) = o;
    }
    __syncthreads();
  }
}

DI void prep_phase(const Params& p, char* shmc, int bid, int nblk) {
  const int tid = otid(), wid = tid >> 6, lane = tid & 63;
  char* ws = PWS;
  convert_units(p, shmc, 0, T_W1 / 4, bid, nblk);
  const int gtid = bid * 512 + tid, gn = nblk * 512;
  for (int i = gtid; i < 2 * 65536; i += gn) {
    int l = i >> 16, n = (i >> 8) & 255, k = i & 255;
    int gi = n >> 6, d = n & 63, gj = k >> 6, c = k & 63;
    float v = (gi == gj) ? INP(I_POOLW)[((size_t)(l * 4 + gi) * 64 + c) * 64 + d] : 0.f;
    ((bf16_t*)(ws + OFF_WPOOLT))[i] = f2bf(v);
  }
  {
    float* sc = (float*)shmc + 4 * 64 * 65;
    float* red = sc + 3 * 1024;
    for (int i = tid; i < 3 * 1024; i += 512) {
      int ci = i >> 10, k = i & 1023;
      float v = ci == 0 ? INP(I_CCTX)[k] : INP(I_C)[(ci - 1) * 1024 + k];
      sc[i] = v * sigmoid_f(v);
    }
    __syncthreads();
    for (int it = bid; it < 288; it += nblk) {
      int l = it / 144, cb = it % 144, col = cb * 64 + lane;
      const float* wp = INP(I_WMOD) + (size_t)l * 1024 * 9216 + col;
      float a0 = 0.f, a1 = 0.f, a2 = 0.f;
#pragma unroll 8
      for (int k = wid * 128; k < wid * 128 + 128; ++k) {
        float w = wp[(size_t)k * 9216];
        a0 += sc[k] * w; a1 += sc[1024 + k] * w; a2 += sc[2048 + k] * w;
      }
      red[(wid * 3 + 0) * 64 + lane] = a0; red[(wid * 3 + 1) * 64 + lane] = a1; red[(wid * 3 + 2) * 64 + lane] = a2;
      __syncthreads();
      if (tid < 192) {
        int ci = tid >> 6;
        float s = 0.f;
        for (int w = 0; w < 8; ++w) s += red[(w * 3 + ci) * 64 + lane];
        ((float*)(ws + OFF_MOD))[(size_t)(l * 3 + ci) * 9216 + col] = s + INP(I_BMOD)[l * 9216 + col];
      }
      __syncthreads();
    }
  }
  for (int i = gtid; i < 2 * 2 * 512 * 128; i += gn) {
    int c = i & 127, t = (i >> 7) & 511, b = (i >> 16) & 1, l = i >> 17;
    size_t si = ((size_t)(b * 2 + l) * 512 + t) * 128 + c;
    const size_t sb_ = (size_t)((l * 2 + b) * 2 + (c >> 6)) * 163840;
    ((bf16_t*)(ws + OFF_KS))[sb_ + kfrag_off(t, c & 63)] = f2bf(INP(I_CK)[si]);
    ((bf16_t*)(ws + OFF_VST))[sb_ + vfrag_off(t, c & 63)] = f2bf(INP(I_CV)[si]);
  }
  for (int i = gtid; i < 4096; i += gn) {
    float lre = INP(I_LRE)[i], lim = INP(I_LIM)[i];
    float dt = expf(INP(I_LSTEP)[i >> 6]);
    float e = expf(lre * dt), ang = lim * dt;
    float br = e * cosf(ang), bi = e * sinf(ang);
    float ar = br - 1.f, ai = bi, den = lre * lre + lim * lim;
    float cr = (ar * lre + ai * lim) / den, cim = (ai * lre - ar * lim) / den;
    ((float2*)(ws + OFF_LAMB))[i] = make_float2(br, bi);
    float pr = br, pi = bi;
    for (int s = 0; s < 6; ++s) { float nr = pr * pr - pi * pi, ni = 2.f * pr * pi; pr = nr; pi = ni; }
    ((float2*)(ws + OFF_LAMT))[i] = make_float2(pr, pi);
  }
  for (int i = gtid; i < 64 * 8 * 64; i += gn) {
    const int gidx = i >> 9, nt = (i >> 6) & 7, ln = i & 63, fr = ln & 15, fq = ln >> 4;
    bf16x8 o = (bf16x8){0, 0, 0, 0, 0, 0, 0, 0};
    if (fq < 2) {
      const int n = nt * 8 + (fr >> 1), idx = gidx * 64 + n;
      float lre = INP(I_LRE)[idx], lim = INP(I_LIM)[idx];
      float dt = expf(INP(I_LSTEP)[gidx]);
      float e = expf(lre * dt), ang = lim * dt;
      float br = e * cosf(ang), bi = e * sinf(ang);
      float ar = br - 1.f, ai = bi, den = lre * lre + lim * lim;
      float cr = (ar * lre + ai * lim) / den, cim = (ai * lre - ar * lim) / den;
      float v[8];
#pragma unroll
      for (int j = 0; j < 8; ++j) {
        float xr = INP(I_BRE)[(size_t)idx * 16 + fq * 8 + j], xi = INP(I_BIM)[(size_t)idx * 16 + fq * 8 + j];
        v[j] = (fr & 1) ? cr * xi + cim * xr : cr * xr - cim * xi;
      }
      o = pack8(v[0], v[1], v[2], v[3], v[4], v[5], v[6], v[7]);
    }
    ((bf16x8*)(ws + OFF_BF))[i] = o;
  }
  for (int i = gtid; i < 64 * 4 * 64; i += gn) {
    const int gidx = i >> 8, ks = (i >> 6) & 3, ln = i & 63, fr = ln & 15, fq = ln >> 4;
    const size_t co = ((size_t)gidx * 16 + fr) * 64 + ks * 16 + fq * 4;
    float4 cr = *(const float4*)(INP(I_CRE) + co), cim = *(const float4*)(INP(I_CIM) + co);
    ((bf16x8*)(ws + OFF_CF))[i] = pack8(cr.x, -cim.x, cr.y, -cim.y, cr.z, -cim.z, cr.w, -cim.w);
  }
}

DI void lnmod_phase(const Params& p, int l_ln, int ln_idx, int l_mod, int mod_idx, int bid, int nblk) {
  const int tid = otid(), wid = tid >> 6, lane = tid & 63;
  float* xy = (float*)(PWS + OFF_XY);
  bf16_t* h = (bf16_t*)(PWS + OFF_H);
  const float* modv = (const float*)(PWS + OFF_MOD);
  const int stride = nblk * 8;
  float4 gg[4], bb[4];
  if (l_ln >= 0) {
    const float* g = INP(I_LNG) + (l_ln * 3 + ln_idx) * 1024;
    const float* b = INP(I_LNB) + (l_ln * 3 + ln_idx) * 1024;
#pragma unroll
    for (int i = 0; i < 4; ++i) { gg[i] = *(const float4*)(g + lane * 4 + i * 256); bb[i] = *(const float4*)(b + lane * 4 + i * 256); }
  }
#define LN_SRC(R) (l_ln < 0 ? ((R) < NPROMPT ? INP(I_XP) + (size_t)(R) * D : INP(I_XS) + (size_t)((R) - NPROMPT) * D) : xy + (size_t)(R) * D)
  int row = bid * 8 + wid;
  float4 nv[4];
  if (row < NTOK) {
    const float* src = LN_SRC(row);
#pragma unroll
    for (int i = 0; i < 4; ++i) nv[i] = *(const float4*)(src + lane * 4 + i * 256);
  }
  for (; row < NTOK; row += stride) {
    float4 v[4];
#pragma unroll
    for (int i = 0; i < 4; ++i) v[i] = nv[i];
    if (row + stride < NTOK) {
      const float* src = LN_SRC(row + stride);
#pragma unroll
      for (int i = 0; i < 4; ++i) nv[i] = *(const float4*)(src + lane * 4 + i * 256);
    }
    float4 ma[4], mc[4];
    if (l_mod >= 0) {
      int ci = row < NPROMPT ? 0 : 1 + (row - NPROMPT) / 2048;
      const float* sh = modv + (size_t)(l_mod * 3 + ci) * 9216 + mod_idx * 1024;
#pragma unroll
      for (int i = 0; i < 4; ++i) { ma[i] = *(const float4*)(sh + lane * 4 + i * 256); mc[i] = *(const float4*)(sh + 1024 + lane * 4 + i * 256); }
    }
    if (l_ln >= 0) {
      float s = 0.f;
#pragma unroll
      for (int i = 0; i < 4; ++i) s += v[i].x + v[i].y + v[i].z + v[i].w;
      float mean = wave_sum(s, lane) * (1.f / 1024.f);
      float q = 0.f;
#pragma unroll
      for (int i = 0; i < 4; ++i) {
        v[i].x -= mean; v[i].y -= mean; v[i].z -= mean; v[i].w -= mean;
        q += v[i].x * v[i].x + v[i].y * v[i].y + v[i].z * v[i].z + v[i].w * v[i].w;
      }
      float rstd = rsqrtf(wave_sum(q, lane) * (1.f / 1024.f) + LN_EPS);
      if (lane == 0) ((float2*)(PWS + OFF_STATS))[row] = make_float2(mean, rstd);
#pragma unroll
      for (int i = 0; i < 4; ++i) {
        v[i].x = v[i].x * rstd * gg[i].x + bb[i].x; v[i].y = v[i].y * rstd * gg[i].y + bb[i].y;
        v[i].z = v[i].z * rstd * gg[i].z + bb[i].z; v[i].w = v[i].w * rstd * gg[i].w + bb[i].w;
      }
    }
    if (l_mod < 0) {
      float* dx = p.out + (size_t)row * D;
#pragma unroll
      for (int i = 0; i < 4; ++i) *(float4*)(dx + lane * 4 + i * 256) = v[i];
    }
    if (l_mod >= 0) {
#pragma unroll
      for (int i = 0; i < 4; ++i) {
        u32x2 o = {pk2(v[i].x * (1.f + mc[i].x) + ma[i].x, v[i].y * (1.f + mc[i].y) + ma[i].y),
                   pk2(v[i].z * (1.f + mc[i].z) + ma[i].z, v[i].w * (1.f + mc[i].w) + ma[i].w)};
        *(u32x2*)(h + (size_t)row * D + lane * 4 + i * 256) = o;
      }
    }
  }
#undef LN_SRC
}

struct PostTok { float xq[4], xk[2], xv2[2], xz[4], pc[4], t0[2], t1[4], t2[8], t3[16]; };
DI void post_load(const float* proj, int row, int lane, PostTok& k) {
  const float* pr = proj + (size_t)row * DIN;
  int t, L;
  if (row >= NPROMPT) { t = (row - NPROMPT) & 2047; L = 2048; } else { t = row & 255; L = 256; }
#pragma unroll
  for (int i = 0; i < 4; ++i) { k.xq[i] = pr[512 + i * 64 + lane]; k.xz[i] = pr[1280 + i * 64 + lane]; k.pc[i] = pr[i * 64 + lane]; }
#pragma unroll
  for (int i = 0; i < 2; ++i) { k.xk[i] = pr[768 + i * 64 + lane]; k.xv2[i] = pr[896 + i * 64 + lane]; }
#define PT_TAP(ARR, GI, HW) _Pragma("unroll") for (int d = -(HW); d < (HW); ++d) { \
    const int tt = t + d; const bool ok = tt >= 0 && tt < L; \
    k.ARR[d + (HW)] = pr[(ptrdiff_t)(ok ? d : 0) * DIN + (GI) * 64 + lane]; }
  PT_TAP(t0, 0, 1) PT_TAP(t1, 1, 2) PT_TAP(t2, 2, 4) PT_TAP(t3, 3, 8)
#undef PT_TAP
}

DI void post_phase(const Params& p, int l, char* shmc, int bid, int nblk) {
  const int tid = otid(), wid = tid >> 6, lane = tid & 63;
  char* ws = PWS;
  const float* proj = (const float*)(ws + OFF_R);
  bf16_t* qb = (bf16_t*)(ws + OFF_QB);
  const float qn = INP(I_QN)[l * 64 + lane], kn = INP(I_KN)[l * 64 + lane];
  const int fi = lane & 15;
  const float inv = exp2f(-(float)fi * (13.287712379549449f / 16.f));
  const int stride = nblk * 8;
  int row = bid * 8 + wid;
  PostTok nx;
  if (row < NTOK) post_load(proj, row, lane, nx);
  for (; row < NTOK; row += stride) {
    const PostTok c = nx;
    if (row + stride < NTOK) post_load(proj, row + stride, lane, nx);
    const bool samp = row >= NPROMPT;
    int b, t, L;
    if (samp) { b = (row - NPROMPT) >> 11; t = (row - NPROMPT) & 2047; L = 2048; }
    else { b = row >> 8; t = row & 255; L = 256; }
    float cs = 1.f, sn = 0.f;
    if (samp) {
      float pos = (float)((lane & 31) < 16 ? (t >> 6) : (t & 63));
      float ang = pos * inv;
      cs = cosf(ang); sn = sinf(ang);
    }
    float xq[4], xk[2], xv2[2], xz[4];
#pragma unroll
    for (int i = 0; i < 4; ++i) { xq[i] = c.xq[i]; xz[i] = c.xz[i]; }
#pragma unroll
    for (int i = 0; i < 2; ++i) { xk[i] = c.xk[i]; xv2[i] = c.xv2[i]; }
    {
      bf16_t* df = (bf16_t*)(ws + OFF_DIFF) + (size_t)row * 256;
#define PT_SUM(ARR, GI, HW) { int lo = max(t - (HW), 0), hi = min(t + (HW), L); float s_ = 0.f; \
        _Pragma("unroll") for (int d = -(HW); d < (HW); ++d) { const int tt = t + d; s_ += (tt >= 0 && tt < L) ? c.ARR[d + (HW)] : 0.f; } \
        df[(GI) * 64 + lane] = f2bf(s_ / (float)(hi - lo) - c.pc[GI]); }
      PT_SUM(t0, 0, 1) PT_SUM(t1, 1, 2) PT_SUM(t2, 2, 4) PT_SUM(t3, 3, 8)
#undef PT_SUM
    }
#pragma unroll
    for (int hd = 0; hd < 4; ++hd) {
      float x = xq[hd];
      float ss = wave_sum(x * x, lane) * (1.f / 64.f);
      float xn = x * rsqrtf(ss + RMS_EPS) * qn;
      if (samp) {
        float o = shfl_x(xn, 32, lane);
        xn = lane < 32 ? xn * cs - o * sn : o * sn + xn * cs;
      }
      qb[(size_t)row * 256 + hd * 64 + lane] = f2bf(xn);
    }
#pragma unroll
    for (int hd = 0; hd < 2; ++hd) {
      float x = xk[hd];
      float ss = wave_sum(x * x, lane) * (1.f / 64.f);
      float xn = x * rsqrtf(ss + RMS_EPS) * kn;
      float vv = xv2[hd];
      if (samp) {
        float o = shfl_x(xn, 32, lane);
        xn = lane < 32 ? xn * cs - o * sn : o * sn + xn * cs;
        const size_t sb_ = (size_t)((l * 2 + b) * 2 + hd) * 163840;
        ((bf16_t*)(ws + OFF_KS))[sb_ + kfrag_off(512 + t, lane)] = f2bf(xn);
        ((bf16_t*)(ws + OFF_VST))[sb_ + vfrag_off(512 + t, lane)] = f2bf(vv);
      } else {
        size_t oo = ((size_t)(b * 2 + l) * 256 + t) * 128 + hd * 64 + lane;
        p.out[OUT_K + oo] = xn;
        p.out[OUT_V + oo] = vv;
        const size_t sb_ = (size_t)(b * 2 + hd) * 16384;
        ((bf16_t*)(ws + OFF_KP))[sb_ + kfrag_off(t, lane)] = f2bf(xn);
        ((bf16_t*)(ws + OFF_VPT))[sb_ + vfrag_off(t, lane)] = f2bf(vv);
      }
    }
    {
      float z[4]; float s = 0.f;
#pragma unroll
      for (int i = 0; i < 4; ++i) { z[i] = gelu_t(xz[i]); s += z[i]; }
      float mean = wave_sum(s, lane) * (1.f / 256.f);
      float q = 0.f;
#pragma unroll
      for (int i = 0; i < 4; ++i) { z[i] -= mean; q += z[i] * z[i]; }
      float rstd = rsqrtf(wave_sum(q, lane) * (1.f / 256.f) + LN_EPS);
      bf16_t* vct = (bf16_t*)(ws + OFF_VCT) + (size_t)(row >> 7) * 256 * 128 + (row & 127);
#pragma unroll
      for (int i = 0; i < 4; ++i) {
        int c = i * 64 + lane;
        float vn = z[i] * rstd * INP(I_CLG)[l * 256 + c] + INP(I_CLB)[l * 256 + c];
        vct[(size_t)c * 128] = f2bf(vn);
      }
    }
  }
}

struct AttnState { f32x16 o0, o1; float m, l; };
#define ATT_LOADKV(KF, VF, K0) do { const int kt_ = (K0) >> 5; \
    _Pragma("unroll") for (int s_ = 0; s_ < 4; ++s_) KF[s_] = *(const bf16x8*)(Kb + ((size_t)(kt_ * 4 + s_) * 64 + lane) * 8); \
    _Pragma("unroll") for (int s_ = 0; s_ < 2; ++s_) { \
      VF[s_][0] = *(const bf16x8*)(Vt + ((size_t)((kt_ * 2 + s_) * 2 + 0) * 64 + lane) * 8); \
      VF[s_][1] = *(const bf16x8*)(Vt + ((size_t)((kt_ * 2 + s_) * 2 + 1) * 64 + lane) * 8); } } while (0)

DI void attn_core(const bf16_t* __restrict__ Q, int qrow0, int head, const bf16_t* __restrict__ Kb,
                  const bf16_t* __restrict__ Vt, int kbeg, int kend, int lane, AttnState& st) {
  const int r = lane & 31, hh = lane >> 5;
  bf16x8 qf[4];
  const bf16_t* qp = Q + (size_t)(qrow0 + r) * 256 + head * 64 + 8 * hh;
#pragma unroll
  for (int s = 0; s < 4; ++s) qf[s] = *(const bf16x8*)(qp + 16 * s);
  f32x16 o0, o1;
#pragma unroll
  for (int i = 0; i < 16; ++i) { o0[i] = 0.f; o1[i] = 0.f; }
  float m = -INFINITY, lsum = 0.f;
  const float c = 0.125f * 1.4426950408889634f;
  bf16x8 kf[4], vf[2][2];
  ATT_LOADKV(kf, vf, kbeg);
  for (int k0 = kbeg; k0 < kend; k0 += 32) {
    const int kn = min(k0 + 32, kend - 32);
    bf16x8 kfn[4], vfn[2][2];
    ATT_LOADKV(kfn, vfn, kn);
    f32x16 sa;
#pragma unroll
    for (int i = 0; i < 16; ++i) sa[i] = 0.f;
#pragma unroll
    for (int s = 0; s < 4; ++s) sa = MFMA32(kf[s], qf[s], sa);
    float mx = sa[0];
#pragma unroll
    for (int i = 1; i < 16; ++i) mx = fmaxf(mx, sa[i]);
    mx = fmaxf(mx, shfl_x(mx, 32, lane));
    float mn = fmaxf(m, mx);
    float alpha = __builtin_amdgcn_exp2f((m - mn) * c);
    m = mn;
    float pv[16]; float ps = 0.f;
#pragma unroll
    for (int i = 0; i < 16; ++i) { pv[i] = __builtin_amdgcn_exp2f((sa[i] - mn) * c); ps += pv[i]; }
    lsum = lsum * alpha + ps;
#pragma unroll
    for (int i = 0; i < 16; ++i) { o0[i] *= alpha; o1[i] *= alpha; }
#pragma unroll
    for (int s = 0; s < 2; ++s) {
      bf16x8 pf = pack8(pv[8 * s], pv[8 * s + 1], pv[8 * s + 2], pv[8 * s + 3], pv[8 * s + 4], pv[8 * s + 5], pv[8 * s + 6], pv[8 * s + 7]);
      o0 = MFMA32(vf[s][0], pf, o0);
      o1 = MFMA32(vf[s][1], pf, o1);
    }
#pragma unroll
    for (int s = 0; s < 4; ++s) kf[s] = kfn[s];
#pragma unroll
    for (int s = 0; s < 2; ++s) { vf[s][0] = vfn[s][0]; vf[s][1] = vfn[s][1]; }
  }
  lsum += shfl_x(lsum, 32, lane);
  st.o0 = o0; st.o1 = o1; st.m = m; st.l = lsum;
}

DI void attn_prompt_item(const bf16_t* Q, int qrow0, int head, const bf16_t* Kb, const bf16_t* Vt, bf16_t* Y, int lane) {
  AttnState st;
  attn_core(Q, qrow0, head, Kb, Vt, 0, 256, lane, st);
  const int r = lane & 31, hh = lane >> 5;
  const float il = 1.f / st.l;
  bf16_t* yp = Y + (size_t)(qrow0 + r) * D + 512 + head * 64 + 4 * hh;
#pragma unroll
  for (int g4 = 0; g4 < 4; ++g4) {
    u32x2 a = {pk2(st.o0[4 * g4] * il, st.o0[4 * g4 + 1] * il), pk2(st.o0[4 * g4 + 2] * il, st.o0[4 * g4 + 3] * il)};
    u32x2 b = {pk2(st.o1[4 * g4] * il, st.o1[4 * g4 + 1] * il), pk2(st.o1[4 * g4 + 2] * il, st.o1[4 * g4 + 3] * il)};
    *(u32x2*)(yp + 8 * g4) = a;
    *(u32x2*)(yp + 32 + 8 * g4) = b;
  }
}

DI void attn_sample_item(const Params& p, int l, int it, char* shmc, int wid, int lane) {
  char* ws = PWS;
  float* Osh = (float*)shmc;
  float* Msh = Osh + 8 * 32 * 64;
  float* Lsh = Msh + 8 * 64;
  const int b = it >> 7, head = (it >> 5) & 3, qpair = it & 31;
  const int qsub = wid & 1, ksplit = wid >> 1;
  const int qrow0 = NPROMPT + b * 2048 + (qpair * 2 + qsub) * 32;
  AttnState st;
  attn_core((const bf16_t*)(ws + OFF_QB), qrow0, head, (const bf16_t*)(ws + OFF_KS) + (size_t)((l * 2 + b) * 2 + (head >> 1)) * 163840,
            (const bf16_t*)(ws + OFF_VST) + (size_t)((l * 2 + b) * 2 + (head >> 1)) * 163840, ksplit * 640, ksplit * 640 + 640, lane, st);
  Msh[wid * 64 + lane] = st.m; Lsh[wid * 64 + lane] = st.l;
#pragma unroll
  for (int i = 0; i < 16; ++i) { Osh[(wid * 32 + i) * 64 + lane] = st.o0[i]; Osh[(wid * 32 + 16 + i) * 64 + lane] = st.o1[i]; }
  __syncthreads();
  {
    const float c = 0.125f * 1.4426950408889634f;
    float mm[4], M = -INFINITY;
#pragma unroll
    for (int k = 0; k < 4; ++k) { mm[k] = Msh[(2 * k + qsub) * 64 + lane]; M = fmaxf(M, mm[k]); }
    float sc[4], Lt = 0.f;
#pragma unroll
    for (int k = 0; k < 4; ++k) { sc[k] = __builtin_amdgcn_exp2f((mm[k] - M) * c); Lt += Lsh[(2 * k + qsub) * 64 + lane] * sc[k]; }
    const float il = 1.f / Lt;
    float ov[8];
#pragma unroll
    for (int e = 0; e < 8; ++e) {
      float a = 0.f;
#pragma unroll
      for (int k = 0; k < 4; ++k) a += Osh[((2 * k + qsub) * 32 + ksplit * 8 + e) * 64 + lane] * sc[k];
      ov[e] = a * il;
    }
    const int r = lane & 31, hh = lane >> 5;
    const int dblk = ksplit >> 1, g4 = (ksplit & 1) * 2;
    bf16_t* yp = (bf16_t*)(ws + OFF_YMIX) + (size_t)(qrow0 + r) * D + 512 + head * 64 + dblk * 32 + 8 * g4 + 4 * hh;
    u32x2 a = {pk2(ov[0], ov[1]), pk2(ov[2], ov[3])};
    u32x2 bq = {pk2(ov[4], ov[5]), pk2(ov[6], ov[7])};
    *(u32x2*)yp = a;
    *(u32x2*)(yp + 8) = bq;
  }
  __syncthreads();
}

DI void chunk_item(const Params& p, int l, int ch, int hd, int sp, int lane) {
  const int fr = lane & 15, fq = lane >> 4;
  char* ws = PWS;
  const float* wsrc = INP(I_CWS) + ((size_t)(l * 4 + hd) * 128 + sp * 16 + fr) * 128 + fq * 8;
  const bf16_t* vb = (const bf16_t*)(ws + OFF_VCT) + ((size_t)ch * 256 + hd * 64 + fr) * 128 + fq * 8;
  f32x4 acc[4];
#pragma unroll
  for (int i = 0; i < 4; ++i) acc[i] = (f32x4){0.f, 0.f, 0.f, 0.f};
#pragma unroll
  for (int ks = 0; ks < 4; ++ks) {
    float4 a0 = *(const float4*)(wsrc + ks * 32), a1 = *(const float4*)(wsrc + ks * 32 + 4);
    bf16x8 af = pack8(a0.x, a0.y, a0.z, a0.w, a1.x, a1.y, a1.z, a1.w);
#pragma unroll
    for (int nt = 0; nt < 4; ++nt) {
      bf16x8 bfr = *(const bf16x8*)(vb + (size_t)nt * 16 * 128 + ks * 32);
      acc[nt] = MFMA16(af, bfr, acc[nt]);
    }
  }
  const float* proj = (const float*)(ws + OFF_R);
  bf16_t* ymix = (bf16_t*)(ws + OFF_YMIX);
  float uu[4][4];
#pragma unroll
  for (int j = 0; j < 4; ++j)
#pragma unroll
    for (int nt = 0; nt < 4; ++nt)
      uu[j][nt] = proj[(size_t)(ch * 128 + sp * 16 + fq * 4 + j) * DIN + 1024 + hd * 64 + nt * 16 + fr];
#pragma unroll
  for (int j = 0; j < 4; ++j) {
    int pp = sp * 16 + fq * 4 + j, tok = ch * 128 + pp;
    float bs = INP(I_CBS)[(l * 4 + hd) * 128 + pp];
#pragma unroll
    for (int nt = 0; nt < 4; ++nt) {
      int c = hd * 64 + nt * 16 + fr;
      ymix[(size_t)tok * D + 768 + c] = f2bf(gelu_t(uu[j][nt]) * (acc[nt][j] + bs));
    }
  }
}

constexpr int SSM_BU_LD = 132, SSM_H_LD = 136;
constexpr int SSM_WAVE_LDS = 16 * SSM_BU_LD * 4 + 16 * SSM_H_LD * 2;
#define LDS_FENCE() do { asm volatile("s_waitcnt lgkmcnt(0)" ::: "memory"); __builtin_amdgcn_wave_barrier(); } while (0)

DI void ssm_load_u(const Params& p, int ck, int g, int lane, bf16x8 (&af)[4]) {
  const int fr = lane & 15, fq = lane >> 4;
  const float* ub = (const float*)(PWS + OFF_R) + (size_t)ck * 64 * DIN + 256 + g * 16;
#pragma unroll
  for (int tile = 0; tile < 4; ++tile) {
    if (fq < 2) {
      const float* up = ub + (size_t)(tile * 16 + fr) * DIN + fq * 8;
      float4 a0 = *(const float4*)up, a1 = *(const float4*)(up + 4);
      af[tile] = pack8(a0.x, a0.y, a0.z, a0.w, a1.x, a1.y, a1.z, a1.w);
    } else {
      af[tile] = (bf16x8){0, 0, 0, 0, 0, 0, 0, 0};
    }
  }
}

template <int MODE, int DIR>
DI void ssm_dir(const Params& p, int l, int ck, int g, int lane, const bf16x8 (&af)[4], f32x4 (&yacc)[4], char* wlds) {
  constexpr bool CHAIN = MODE == 1;
  const int fr = lane & 15, fq = lane >> 4;
  char* ws = PWS;
  float* BU = (float*)wlds;
  bf16_t* Hs = (bf16_t*)(wlds + 16 * SSM_BU_LD * 4);
  const int gidx = (l * 2 + DIR) * 16 + g, idx = gidx * 64 + lane;
  bf16x8 bfr[8], cf[4];
#pragma unroll
  for (int nt = 0; nt < 8; ++nt) bfr[nt] = ((const bf16x8*)(ws + OFF_BF))[(gidx * 8 + nt) * 64 + lane];
#pragma unroll
  for (int ks = 0; ks < 4; ++ks) cf[ks] = ((const bf16x8*)(ws + OFF_CF))[(gidx * 4 + ks) * 64 + lane];
  const float2 lam = ((const float2*)(ws + OFF_LAMB))[idx];
  float hr = 0.f, hi = 0.f;
  const bool samp = ck >= 128;
  const int CPS = samp ? 32 : 4;
  const int cs = samp ? ((ck - 128) & 31) : (ck & 3);
  const int b = samp ? ((ck - 128) >> 5) : (ck >> 2);
  if (CHAIN) {
    const float2 lamT = ((const float2*)(ws + OFF_LAMT))[idx];
    const float2* Eb = (const float2*)(ws + OFF_E);
    const int cbase = ck - cs;
    if (samp) {
      size_t si = ((size_t)((b * 2 + l) * 2 + DIR) * 16 + g) * 64 + lane;
      hr = INP(I_SRE)[si]; hi = INP(I_SIM)[si];
    }
    const int nstep = DIR == 0 ? cs : CPS - 1 - cs;
    for (int base = 0; base < nstep; base += 8) {
      float2 ev[8];
#pragma unroll
      for (int k = 0; k < 8; ++k) {
        const int st = min(base + k, nstep - 1);
        const int c2 = DIR == 0 ? st : CPS - 1 - st;
        ev[k] = Eb[((size_t)((cbase + c2) * 16 + g) * 2 + DIR) * 64 + lane];
      }
#pragma unroll
      for (int k = 0; k < 8; ++k)
        if (base + k < nstep) {
          float nr = lamT.x * hr - lamT.y * hi + ev[k].x, ni = lamT.x * hi + lamT.y * hr + ev[k].y; hr = nr; hi = ni;
        }
    }
  }
#pragma unroll
  for (int sb = 0; sb < 4; ++sb) {
    const int tile = DIR ? 3 - sb : sb;
#pragma unroll
    for (int nt = 0; nt < 8; ++nt) {
      f32x4 cz = MFMA16(af[tile], bfr[nt], ((f32x4){0.f, 0.f, 0.f, 0.f}));
#pragma unroll
      for (int j = 0; j < 4; ++j) BU[(fq * 4 + j) * SSM_BU_LD + nt * 16 + fr] = cz[j];
    }
    LDS_FENCE();
#pragma unroll
    for (int q = 0; q < 16; ++q) {
      const int tt = DIR ? 15 - q : q;
      const float2 bu = *(const float2*)(BU + tt * SSM_BU_LD + 2 * lane);
      float nr = lam.x * hr - lam.y * hi + bu.x, ni = lam.x * hi + lam.y * hr + bu.y; hr = nr; hi = ni;
      *(unsigned*)(Hs + tt * SSM_H_LD + 2 * lane) = pk2(hr, hi);
    }
    LDS_FENCE();
#pragma unroll
    for (int ks = 0; ks < 4; ++ks) {
      bf16x8 ah = *(const bf16x8*)(Hs + fr * SSM_H_LD + ks * 32 + fq * 8);
      yacc[tile] = MFMA16(ah, cf[ks], yacc[tile]);
    }
    LDS_FENCE();
  }
  if (!CHAIN) {
    ((float2*)(ws + OFF_E))[((size_t)(ck * 16 + g) * 2 + DIR) * 64 + lane] = make_float2(hr, hi);
  } else if (!samp && ((DIR == 0 && cs == 3) || (DIR == 1 && cs == 0))) {
    size_t so = ((size_t)((b * 2 + l) * 2 + DIR) * 16 + g) * 64 + lane;
    p.out[OUT_SRE + so] = hr; p.out[OUT_SIM + so] = hi;
  }
}

#define SSM1_MODE 2
DI void ssm1_item(const Params& p, int l, int ck, int g, int dir, int lane, char* wlds) {
  bf16x8 af[4]; f32x4 yacc[4];
#pragma unroll
  for (int i = 0; i < 4; ++i) yacc[i] = (f32x4){0.f, 0.f, 0.f, 0.f};
  ssm_load_u(p, ck, g, lane, af);
  if (dir) ssm_dir<SSM1_MODE, 1>(p, l, ck, g, lane, af, yacc, wlds);
  else ssm_dir<SSM1_MODE, 0>(p, l, ck, g, lane, af, yacc, wlds);
}

DI void ssm2_item(const Params& p, int l, int ck, int g, int lane, char* wlds) {
  const int fr = lane & 15, fq = lane >> 4;
  bf16x8 af[4]; f32x4 yacc[4];
#pragma unroll
  for (int i = 0; i < 4; ++i) yacc[i] = (f32x4){0.f, 0.f, 0.f, 0.f};
  ssm_load_u(p, ck, g, lane, af);
  ssm_dir<1, 0>(p, l, ck, g, lane, af, yacc, wlds);
  ssm_dir<1, 1>(p, l, ck, g, lane, af, yacc, wlds);
  char* ws = PWS;
  const float* ub = (const float*)(ws + OFF_R) + (size_t)ck * 64 * DIN + 256 + g * 16;
  bf16_t* sg = (bf16_t*)(ws + OFF_SG);
  const int c = g * 16 + fr;
  const float dd = INP(I_SSMD)[l * 256 + c];
  float uv[4][4];
#pragma unroll
  for (int t4 = 0; t4 < 4; ++t4)
#pragma unroll
    for (int j = 0; j < 4; ++j) uv[t4][j] = ub[(size_t)(t4 * 16 + fq * 4 + j) * DIN + fr];
#pragma unroll
  for (int t4 = 0; t4 < 4; ++t4)
#pragma unroll
    for (int j = 0; j < 4; ++j) {
      size_t row = (size_t)ck * 64 + t4 * 16 + fq * 4 + j;
      sg[row * 256 + c] = f2bf(gelu_t(yacc[t4][j] + dd * uv[t4][j]));
    }
}

DI void ssm1_phase(const Params& p, int l, char* shmc, int bid, int nblk) {
  const int tid = otid(), wid = __builtin_amdgcn_readfirstlane(tid >> 6), lane = tid & 63;
  char* wlds = shmc + wid * SSM_WAVE_LDS;
  for (int it = wid * nblk + bid; it < 6144; it += nblk * 8) ssm1_item(p, l, it >> 5, (it >> 1) & 15, it & 1, lane, wlds);
}

DI void mix_phase(const Params& p, int l, char* shmc, int bid, int nblk) {
  const int tid = otid(), wid = __builtin_amdgcn_readfirstlane(tid >> 6), lane = tid & 63;
  char* ws = PWS;
  for (int it = bid; it < 256; it += nblk) attn_sample_item(p, l, it, shmc, wid, lane);
  for (int it = bid * 8 + wid; it < 1024; it += nblk * 8) {
    int b = it >> 5, head = (it >> 3) & 3, qt = it & 7;
    attn_prompt_item((const bf16_t*)(ws + OFF_QB), b * 256 + qt * 32, head, (const bf16_t*)(ws + OFF_KP) + (size_t)(b * 2 + (head >> 1)) * 16384,
                     (const bf16_t*)(ws + OFF_VPT) + (size_t)(b * 2 + (head >> 1)) * 16384, (bf16_t*)(ws + OFF_YMIX), lane);
  }
  __syncthreads();
  char* wlds = shmc + wid * SSM_WAVE_LDS;
  const int slot = wid * nblk + bid, nslot = nblk * 8;
  for (int it = slot; it < 6144; it += nslot) {
    if (it < 3072) ssm2_item(p, l, it >> 4, it & 15, lane, wlds);
    else { int j = it - 3072; chunk_item(p, l, j >> 5, (j >> 3) & 3, j & 7, lane); }
  }
}

constexpr int N_PHASE = 26;
DI void run_phase(const Params& p, int ph, char* shm, int bid, int nblk) {
  char* ws = PWS;
  if (ph == 0) { prep_phase(p, shm, bid, nblk); return; }
  if (ph == 25) { lnmod_phase(p, 1, 2, -1, 0, bid, nblk); return; }
  const int l = (ph - 1) / 12, s = (ph - 1) % 12;
  const bf16_t* hA = (const bf16_t*)(ws + OFF_H);
  bf16_t* hid = (bf16_t*)(ws + OFF_R);
  float* xy = (float*)(ws + OFF_XY);
  const float* modl = (const float*)(ws + OFF_MOD) + (size_t)l * 3 * 9216;
  EpiArgs ea; ea.f0 = nullptr; ea.b0 = nullptr; ea.c0 = nullptr; ea.cb = nullptr; ea.w = 0.f;
  ea.lng = nullptr; ea.lnb = nullptr; ea.stats = (const float2*)(ws + OFF_STATS); ea.xin0 = nullptr; ea.xin1 = nullptr;
  switch (s) {
    case 0: if (l == 0) lnmod_phase(p, -1, 0, 0, 0, bid, nblk); else lnmod_phase(p, l - 1, 2, l, 0, bid, nblk); break;
    case 1: case 10: {
      int sI = s == 1 ? 0 : 1;
      ea.b0 = hid;
      const bf16_t* w1 = (const bf16_t*)(ws + OFF_W1T) + (size_t)(l * 2 + sI) * 5632 * 1024;
      if (nblk == 256) {
        gemm_phase<1024, EPI_SWIGLU>(hA, w1, 46, 22, ea, shm, bid, nblk);
        gemm_phase<1024, EPI_SWIGLU, 1, 64>(hA, w1, 4, 22, ea, shm, 255 - bid, nblk, 46 * 256);
      } else {
        gemm_phase<1024, EPI_SWIGLU>(hA, w1, 48, 22, ea, shm, bid, nblk);
      }
      if (l == 0 && nblk == 256 && bid < 168) {
        if (sI == 0) convert_units(p, shm, T_W1 / 4, PER_L / 4, bid, 168);
        else convert_units(p, shm, PER_L / 4, 2 * PER_L / 4, bid, 168);
      } else if (l == 0 && nblk != 256 && sI == 0) {
        convert_units(p, shm, T_W1 / 4, 2 * PER_L / 4, bid, nblk);
      }
    } break;
    case 2: case 11: {
      int sI = s == 2 ? 0 : 1;
      ea.f0 = xy; ea.c0 = modl + (s == 2 ? 2 : 8) * 1024; ea.w = 0.5f;
      if (s == 2) {
        if (l == 0) { ea.xin0 = INP(I_XP); ea.xin1 = INP(I_XS); }
        else { ea.lng = INP(I_LNG) + ((l - 1) * 3 + 2) * 1024; ea.lnb = INP(I_LNB) + ((l - 1) * 3 + 2) * 1024; }
      } else { ea.lng = INP(I_LNG) + (l * 3 + 1) * 1024; ea.lnb = INP(I_LNB) + (l * 3 + 1) * 1024; }
      gemm_phase<2816, EPI_RESID, 1, 96>(hid, (const bf16_t*)(ws + OFF_W2T) + (size_t)(l * 2 + sI) * 1024 * 2816, 64, 4, ea, shm, bid, nblk);
    } break;
    case 3: lnmod_phase(p, l, 0, l, 3, bid, nblk); break;
    case 4: {
      ea.f0 = (float*)(ws + OFF_R);
      gemm_phase<1024, EPI_F32, 1, 96>(hA, (const bf16_t*)(ws + OFF_WINT) + (size_t)l * 1536 * 1024, 64, 6, ea, shm, bid, nblk);
    } break;
    case 5: post_phase(p, l, shm, bid, nblk); ssm1_phase(p, l, shm, bid, nblk); break;
    case 6: mix_phase(p, l, shm, bid, nblk); break;
    case 7: {
      ea.b0 = (bf16_t*)(ws + OFF_YMIX); ea.cb = (const bf16_t*)(ws + OFF_SG); ea.c0 = INP(I_BGLU) + l * 256;
      gemm_phase<256, EPI_GLU, 1, 64>((const bf16_t*)(ws + OFF_SG), (const bf16_t*)(ws + OFF_WGLUT) + (size_t)l * 65536, 96, 1, ea, shm, bid, nblk);
      ea.c0 = INP(I_POOLS) + l * 256;
      int bid2 = (bid + nblk - (nblk >> 1)) % nblk;
      gemm_phase<256, EPI_POOL, 1, 64>((const bf16_t*)(ws + OFF_DIFF), (const bf16_t*)(ws + OFF_WPOOLT) + (size_t)l * 65536, 96, 1, ea, shm, bid2, nblk);
    } break;
    case 8: {
      ea.f0 = xy; ea.c0 = modl + 5 * 1024; ea.w = 1.0f;
      ea.lng = INP(I_LNG) + (l * 3 + 0) * 1024; ea.lnb = INP(I_LNB) + (l * 3 + 0) * 1024;
      gemm_phase<1024, EPI_RESID, 1, 96>((const bf16_t*)(ws + OFF_YMIX), (const bf16_t*)(ws + OFF_WOUTT) + (size_t)l * 1024 * 1024, 64, 4, ea, shm, bid, nblk);
    } break;
    case 9: lnmod_phase(p, l, 1, l, 6, bid, nblk); break;
  }
}

__global__ __launch_bounds__(512, 2) void mega(Params p, int ph_lo, int ph_hi) {
  extern __shared__ __attribute__((aligned(16))) char shm[];
  __shared__ uint4 xb_words;
  const int bid = blockIdx.x, nblk = gridDim.x;
  if (threadIdx.x == 0) xb_words = make_uint4(0u, 0u, 0u, 0u);
  __syncthreads();
  const XcdBarrier xb = xcd_barrier_post((unsigned*)(p.ws + OFF_BAR), (volatile LAS unsigned*)&xb_words);
  for (int ph = ph_lo; ph < ph_hi; ++ph) {
    if (ph > ph_lo) {
      if (ph_hi < 0) cg::this_grid().sync();
      xcd_barrier(xb);
    }
    run_phase(p, ph, shm, bid, nblk);
  }
}

extern "C" void kernel_launch(void* const* d_in, const int* in_sizes, int n_in, void* d_out, int out_size, void* d_ws,
                              size_t ws_size, hipStream_t stream) {
  static int grid_blocks = 0;
  if (!grid_blocks) {
    hipFuncSetAttribute((const void*)mega, hipFuncAttributeMaxDynamicSharedMemorySize, GEMM_LDS);
    int dev = 0, cus = 0, per_cu = 0;
    hipGetDevice(&dev);
    hipDeviceGetAttribute(&cus, hipDeviceAttributeMultiprocessorCount, dev);
    hipOccupancyMaxActiveBlocksPerMultiprocessor(&per_cu, mega, 512, GEMM_LDS);
    if (per_cu < 1) per_cu = 1;
    if (per_cu > 1) per_cu = 1;
    grid_blocks = cus * per_cu;
  }
  Params p{};
  for (int i = 0; i < N_IN; ++i) p.in[i] = (const float*)d_in[i];
  p.out = (float*)d_out;
  p.ws = (char*)d_ws;
  hipMemsetAsync((char*)d_ws + OFF_BAR, 0, 16384, stream);
#if ONE_LAUNCH
  int lo = 0, hi = N_PHASE;
  void* args[] = {&p, &lo, &hi};
  hipError_t e = hipLaunchCooperativeKernel((const void*)mega, dim3(grid_blocks), dim3(512), args, GEMM_LDS, stream);
  if (e != hipSuccess) fprintf(stderr, "cooperative launch failed: %s (grid %d)\n", hipGetErrorString(e), grid_blocks);
#else
  for (int ph = 0; ph < N_PHASE; ++ph) mega<<<grid_blocks, 512, GEMM_LDS, stream>>>(p, ph, ph + 1);
#endif
}
```

```cpp
#include <hip/hip_runtime.h>
#include <hip/hip_cooperative_groups.h>
#include <cstdio>
namespace cg = cooperative_groups;

#define DI __device__ __forceinline__
typedef unsigned short bf16_t;
typedef __attribute__((ext_vector_type(8))) short bf16x8;
typedef __attribute__((ext_vector_type(4))) short s16x4;
typedef __attribute__((ext_vector_type(4))) float f32x4;
typedef __attribute__((ext_vector_type(16))) float f32x16;
typedef __attribute__((ext_vector_type(2))) float f32x2;
typedef __attribute__((ext_vector_type(2))) __bf16 bf16x2v;
typedef __attribute__((ext_vector_type(4))) unsigned u32x4;
typedef __attribute__((ext_vector_type(2))) unsigned u32x2;

#ifndef ONE_LAUNCH
#define ONE_LAUNCH 1
#endif

constexpr int D = 1024, NTOK = 12288, NPROMPT = 8192, DFF = 2816, DIN = 1536;
constexpr float ALPHA = 1.4142135623730951f;
constexpr float LN_EPS = 1e-5f, RMS_EPS = 1e-6f;
enum { I_XP = 0, I_XS, I_CK, I_CV, I_SRE, I_SIM, I_C, I_CCTX, I_WMOD, I_BMOD, I_LNG, I_LNB, I_W1, I_W2, I_WIN, I_WOUT,
       I_POOLW, I_POOLS, I_LRE, I_LIM, I_LSTEP, I_BRE, I_BIM, I_CRE, I_CIM, I_SSMD, I_WGLU, I_BGLU, I_QN, I_KN,
       I_CLG, I_CLB, I_CWS, I_CBS, N_IN };
constexpr size_t OUT_K = 12582912, OUT_V = 14680064, OUT_SRE = 16777216, OUT_SIM = 16908288;

constexpr size_t OFF_W1T = 0;
constexpr size_t OFF_W2T = OFF_W1T + 46137344;
constexpr size_t OFF_WINT = OFF_W2T + 23068672;
constexpr size_t OFF_WOUTT = OFF_WINT + 6291456;
constexpr size_t OFF_WGLUT = OFF_WOUTT + 4194304;
constexpr size_t OFF_WPOOLT = OFF_WGLUT + 262144;
constexpr size_t OFF_MOD = OFF_WPOOLT + 262144;
constexpr size_t OFF_XY = OFF_MOD + 221184;
constexpr size_t OFF_H = OFF_XY + 50331648;
constexpr size_t OFF_YMIX = OFF_H + 25165824;
constexpr size_t OFF_R = OFF_YMIX + 25165824;
constexpr size_t OFF_QB = OFF_R + 75497472;
constexpr size_t OFF_KP = OFF_QB + 6291456;
constexpr size_t OFF_KS = OFF_KP + 2097152;
constexpr size_t OFF_VPT = OFF_KS + 2621440;
constexpr size_t OFF_VST = OFF_VPT + 2097152;
constexpr size_t OFF_VCT = OFF_VST + 2621440;
constexpr size_t OFF_DIFF = OFF_VCT + 6291456;
constexpr size_t OFF_SG = OFF_DIFF + 6291456;
constexpr size_t OFF_E = OFF_SG + 6291456;
constexpr size_t OFF_LAMB = OFF_E + 3145728;
constexpr size_t OFF_LAMT = OFF_LAMB + 32768;
constexpr size_t OFF_BBAR = OFF_LAMT + 32768;
constexpr size_t OFF_BAR = OFF_BBAR + 524288;
constexpr size_t OFF_BF = OFF_BAR + 16384;
constexpr size_t OFF_CF = OFF_BF + 524288;
constexpr size_t OFF_STATS = OFF_CF + 262144;
constexpr size_t WS_TOTAL = OFF_STATS + 98304;

struct Params { const float* in[N_IN]; float* out; char* ws; };

DI int otid() {
  int z = 0; asm volatile("" : "+s"(z));
  int lane = __builtin_amdgcn_mbcnt_hi(-1, __builtin_amdgcn_mbcnt_lo(-1, z));
  int w = __builtin_amdgcn_readfirstlane(threadIdx.x >> 6);
  return w * 64 + lane;
}
DI int osgpr(int i) { asm volatile("" : "+s"(i)); return i; }
#define INP(i) (p.in[osgpr(i)])
DI char* ows(char* w) { asm volatile("" : "+s"(w)); return w; }
#define PWS ows(p.ws)
DI unsigned pk2(float a, float b) { f32x2 v = {a, b}; bf16x2v r = __builtin_convertvector(v, bf16x2v); return __builtin_bit_cast(unsigned, r); }
DI bf16_t f2bf(float a) { return (bf16_t)(pk2(a, 0.f) & 0xffffu); }
DI float bf2f(bf16_t v) { return __uint_as_float(((unsigned)v) << 16); }
DI bf16x8 pack8(float a0, float a1, float a2, float a3, float a4, float a5, float a6, float a7) {
  u32x4 u = {pk2(a0, a1), pk2(a2, a3), pk2(a4, a5), pk2(a6, a7)};
  return __builtin_bit_cast(bf16x8, u);
}
DI float gelu_t(float x) {
  float z = 0.7978845608028654f * (x + 0.044715f * x * x * x);
  float e = __expf(2.f * z);
  float th = 1.f - 2.f / (e + 1.f);
  return 0.5f * x * (1.f + th);
}
DI float sigmoid_f(float x) { return 1.f / (1.f + __expf(-x)); }
DI float shfl_x(float v, int mask, int lane) {
  return __int_as_float(__builtin_amdgcn_ds_bpermute((lane ^ mask) << 2, __float_as_int(v)));
}
template <int CTRL> DI float dpp_f(float v) {
  return __int_as_float(__builtin_amdgcn_update_dpp(0, __float_as_int(v), CTRL, 0xf, 0xf, true));
}
DI float wave_sum(float v, int lane) {
  (void)lane;
  v += dpp_f<0xB1>(v);
  v += dpp_f<0x4E>(v);
  v += dpp_f<0x141>(v);
  v += dpp_f<0x140>(v);
  const int iv = __float_as_int(v);
  float r0 = __int_as_float(__builtin_amdgcn_readlane(iv, 0)), r1 = __int_as_float(__builtin_amdgcn_readlane(iv, 16));
  float r2 = __int_as_float(__builtin_amdgcn_readlane(iv, 32)), r3 = __int_as_float(__builtin_amdgcn_readlane(iv, 48));
  return (r0 + r1) + (r2 + r3);
}
DI size_t kfrag_off(int key, int d) {
  return ((size_t)((key >> 5) * 4 + (d >> 4)) * 64 + ((d >> 3) & 1) * 32 + (key & 31)) * 8 + (d & 7);
}
DI size_t vfrag_off(int key, int d) {
  const int kk = key & 31, w = kk & 15;
  return ((size_t)(((key >> 5) * 2 + (kk >> 4)) * 2 + (d >> 5)) * 64 + ((w >> 2) & 1) * 32 + (d & 31)) * 8 + (((w >> 3) << 2) | (w & 3));
}

#define MFMA16(a, b, c) __builtin_amdgcn_mfma_f32_16x16x32_bf16((a), (b), (c), 0, 0, 0)
#define MFMA32(a, b, c) __builtin_amdgcn_mfma_f32_32x32x16_bf16((a), (b), (c), 0, 0, 0)


#define XB_TMO      128
#define XB_XCNT(j)  (256  + 64 * (j))
#define XB_XSUB(j)  (1280 + 64 * (j))
#define XB_XGEN(j)  (2304 + 64 * (j))
#define XB_TOP      3328
#define XB_TOPGEN   3392
#define XCD_BAR_WORDS 3456
#define XB_SPIN_CAP (1u << 18)
#define LAS __attribute__((address_space(3)))
DI unsigned xb_ld(unsigned* p) { return __hip_atomic_load(p, __ATOMIC_RELAXED, __HIP_MEMORY_SCOPE_AGENT); }
DI unsigned xb_add(unsigned* p, unsigned v) { return __hip_atomic_fetch_add(p, v, __ATOMIC_RELAXED, __HIP_MEMORY_SCOPE_AGENT); }
DI unsigned xb_xcc_id() { return (unsigned)__builtin_amdgcn_s_getreg((3 << 11) | 20) & 0xFu; }
#define XB_SPIN(cond, bar) do { unsigned _sp = 0; while (cond) { __builtin_amdgcn_s_sleep(1); \
    if ((++_sp & 255u) == 0u) { if (xb_ld(&(bar)[XB_TMO])) break; if (_sp > XB_SPIN_CAP) { atomicAdd(&(bar)[XB_TMO], 1u); break; } } } } while (0)
struct XcdBarrier { unsigned* bar; unsigned x; volatile LAS unsigned* st; };
DI XcdBarrier xcd_barrier_post(unsigned* bar, volatile LAS unsigned* st) {
  XcdBarrier b; b.bar = bar; b.x = xb_xcc_id(); b.st = st;
  if (threadIdx.x == 0) (void)xb_add(&bar[XB_XCNT(b.x)], 1u);
  return b;
}
DI void xcd_barrier_complete(unsigned* bar, unsigned x, unsigned& nloc, unsigned& nx) {
  const unsigned G = gridDim.x * gridDim.y * gridDim.z;
  unsigned sum, cnt, mine, sp = 0u;
  for (;;) {
    sum = 0u; cnt = 0u; mine = 0u;
#pragma unroll
    for (unsigned j = 0; j < 16; ++j) { const unsigned c = xb_ld(&bar[XB_XCNT(j)]); sum += c; cnt += (c > 0u) ? 1u : 0u; mine = (j == x) ? c : mine; }
    if (sum == G) break;
    __builtin_amdgcn_s_sleep(1);
    if ((++sp & 255u) == 0u) { if (xb_ld(&bar[XB_TMO])) break; if (sp > XB_SPIN_CAP) { atomicAdd(&bar[XB_TMO], 1u); break; } }
  }
  nloc = mine > 0u ? mine : 1u; nx = cnt > 0u ? cnt : 1u;
}
DI void xcd_barrier(const XcdBarrier& b) {
  asm volatile("s_waitcnt vmcnt(0)" ::: "memory");
  __syncthreads();
  if (threadIdx.x == 0) {
    unsigned* bar = b.bar;
    __builtin_amdgcn_s_waitcnt(0);
    unsigned nloc = b.st[0], nx = b.st[1];
    if (nloc == 0u) { xcd_barrier_complete(bar, b.x, nloc, nx); b.st[0] = nloc; b.st[1] = nx; }
    const unsigned old = xb_add(&bar[XB_XSUB(b.x)], 1u);
    const unsigned gen = old / nloc;
    if (old + 1u == (gen + 1u) * nloc) {
      __builtin_amdgcn_fence(__ATOMIC_RELEASE, "agent");
      asm volatile("s_waitcnt vmcnt(0)" ::: "memory");
      const unsigned og = xb_add(&bar[XB_TOP], 1u);
      const unsigned tg = og / nx;
      if (og + 1u == (tg + 1u) * nx) xb_add(&bar[XB_TOPGEN], 1u);
      else XB_SPIN(xb_ld(&bar[XB_TOPGEN]) == tg, bar);
      __builtin_amdgcn_fence(__ATOMIC_ACQUIRE, "agent");
      xb_add(&bar[XB_XGEN(b.x)], 1u);
      asm volatile("s_waitcnt vmcnt(0)" ::: "memory");
    } else {
      XB_SPIN(xb_ld(&bar[XB_XGEN(b.x)]) == gen, bar);
      __builtin_amdgcn_fence(__ATOMIC_ACQUIRE, "agent");
      asm volatile("s_waitcnt vmcnt(0)" ::: "memory");
    }
  }
  __syncthreads();
}

constexpr int BM = 256, BK = 64, HALF = 128, NXCD = 8, WGM = 8, HT = HALF * BK;
constexpr int GEMM_LDS = 8 * HT * 2;

DI int lds_byte(int r, int c) {
  int st = (r >> 4) * 2 + (c >> 5), rr = r & 15, cc = c & 31, ob = rr * 64 + cc * 2;
  return st * 1024 + (ob ^ (((ob >> 9) & 1) << 5));
}
DI void stage_rc(int b, int& R, int& C) {
  int st = b / 1024, sb = b % 1024, swz = sb ^ (((sb >> 9) & 1) << 5);
  R = (st >> 1) * 16 + swz / 64; C = (st & 1) * 32 + (swz % 64) / 2;
}

enum { EPI_SWIGLU = 0, EPI_RESID, EPI_F32, EPI_GLU, EPI_POOL };
struct EpiArgs {
  float* f0;
  bf16_t* b0;
  const float* c0;
  const bf16_t* cb;
  float w;
  const float* lng; const float* lnb; const float2* stats; const float* xin0; const float* xin1;
};

template <int K, int MODE, int SPLITS = 1, int RH = 128>
DI void gemm_phase(const bf16_t* __restrict__ A, const bf16_t* __restrict__ Bt, int nM, int nN, EpiArgs ea,
                   char* shmc, int bid, int nblk, int mrow0 = 0) {
  bf16_t* shm = (bf16_t*)shmc;
#define SA(b, h) (shm + ((b) * 2 + (h)) * HT)
#define SB(b, h) (shm + (4 + (b) * 2 + (h)) * HT)
#define STAGE(P, RS, SOFF, kt) do { const int _so = (SOFF) + (kt0 + (kt)) * (BK * 2); \
    __builtin_amdgcn_raw_ptr_buffer_load_lds(RS, (__attribute__((address_space(3))) void*)((char*)(P) + wid * 1024), 16, so0, _so, 0, 0); \
    __builtin_amdgcn_raw_ptr_buffer_load_lds(RS, (__attribute__((address_space(3))) void*)((char*)(P) + wid * 1024 + 8192), 16, so1, _so, 0, 0); } while (0)
#define LDA(dst, b, h) for (int m = 0; m < MT; ++m) for (int k = 0; k < 2; ++k) \
    dst[m][k] = *reinterpret_cast<const bf16x8*>((char*)SA(b, h) + lds_byte(wr * (RH / 2) + m * 16 + fr, k * 32 + fq * 8))
#define LDB(dst, b, h) for (int n = 0; n < 2; ++n) for (int k = 0; k < 2; ++k) \
    dst[n][k] = *reinterpret_cast<const bf16x8*>((char*)SB(b, h) + lds_byte(wc * 32 + n * 16 + fr, k * 32 + fq * 8))
#define MMA(ai, bj, At, Bt_) do { __builtin_amdgcn_s_setprio(1); \
    for (int m = 0; m < MT; ++m) for (int n = 0; n < 2; ++n) for (int k = 0; k < 2; ++k) \
      acc[ai][bj][m][n] = MFMA16(At[m][k], Bt_[n][k], acc[ai][bj][m][n]); \
    __builtin_amdgcn_s_setprio(0); } while (0)
#define WAIT_V(n) asm volatile("s_waitcnt vmcnt(" #n ")" ::: "memory")
#define WAIT_L(n) asm volatile("s_waitcnt lgkmcnt(" #n ")" ::: "memory")
#define BAR __builtin_amdgcn_s_barrier()
#define SCHED __builtin_amdgcn_sched_barrier(0)
  constexpr int MT = RH / 32;
  constexpr int TM = 2 * RH;
  const int tid = otid();
  const int wid = __builtin_amdgcn_readfirstlane(tid >> 6), lane = tid & 63, wr = wid >> 2, wc = wid & 3, fr = lane & 15, fq = lane >> 4;
  const __amdgpu_buffer_rsrc_t rsA = __builtin_amdgcn_make_buffer_rsrc((void*)A, 0, 0x7fffffff, 0x00020000);
  const __amdgpu_buffer_rsrc_t rsB = __builtin_amdgcn_make_buffer_rsrc((void*)Bt, 0, 0x7fffffff, 0x00020000);
  unsigned so0, so1;
  { int R, C; stage_rc(tid * 16, R, C); so0 = (unsigned)(R * K + C) * 2u; stage_rc(tid * 16 + 8192, R, C); so1 = (unsigned)(R * K + C) * 2u; }
  const int nwg = nM * nN;
#define UNIT_SETUP(U) do { const int u_ = (U); \
    const int sp_ = SPLITS == 1 ? 0 : u_ / nwg; int wgid = SPLITS == 1 ? u_ : u_ % nwg; \
    n_kt0 = SPLITS == 1 ? 0 : (sp_ == 0 ? 0 : sp_ == 1 ? 12 : sp_ == 2 ? 24 : 34); \
    n_nt = SPLITS == 1 ? K / BK : (sp_ < 2 ? 12 : 10); \
    { int q = nwg / NXCD, r = nwg % NXCD, xcd = wgid % NXCD, off = wgid / NXCD; \
      wgid = (xcd < r ? xcd * (q + 1) : r * (q + 1) + (xcd - r) * q) + off; } \
    int nig = WGM * nN, gid = wgid / nig, fm = gid * WGM, gsz = min(nM - fm, WGM); \
    int pm = fm + ((wgid % nig) % gsz); n_pn = (wgid % nig) / gsz; n_brow = mrow0 + pm * TM; n_bcol = n_pn * BM; } while (0)
#define UNIT_PRESTAGE() do { const int kt0 = n_kt0; \
    const int a0_ = n_brow * K * 2, b0_ = n_bcol * K * 2; \
    STAGE(SB(0, 0), rsB, b0_, 0); STAGE(SA(0, 0), rsA, a0_, 0); \
    STAGE(SB(0, 1), rsB, b0_ + HALF * K * 2, 0); STAGE(SA(0, 1), rsA, a0_ + RH * K * 2, 0); } while (0)
  int n_kt0 = 0, n_nt = 0, n_pn = 0, n_brow = 0, n_bcol = 0;
  if (bid < nwg * SPLITS) { UNIT_SETUP(bid); UNIT_PRESTAGE(); }
  for (int unit = bid; unit < nwg * SPLITS; unit += nblk) {
    const int kt0 = n_kt0, nt = n_nt, pn = n_pn, brow = n_brow, bcol = n_bcol;
    const bool has_next = unit + nblk < nwg * SPLITS;
    if (has_next) UNIT_SETUP(unit + nblk);
    const int A0 = brow * K * 2, A1 = A0 + RH * K * 2, B0p = bcol * K * 2, B1p = B0p + HALF * K * 2;
    f32x4 acc[2][2][MT][2] = {};
    bf16x8 At[MT][2], B0[2][2], B1[2][2];
    if (wr == 1) BAR;
    WAIT_V(4); BAR;
    STAGE(SB(1, 0), rsB, B0p, 1); STAGE(SA(1, 0), rsA, A0, 1); STAGE(SB(1, 1), rsB, B1p, 1);
    WAIT_V(6); BAR;
    for (int t = 0; t < nt - 2; t += 2) {
      LDB(B0, 0, 0); SCHED; LDA(At, 0, 0); STAGE(SA(1, 1), rsA, A1, t + 1);
      if (MT == 4) WAIT_L(8); else if (MT == 3) WAIT_L(6); else WAIT_L(4); BAR; WAIT_L(0); MMA(0, 0, At, B0); BAR; SCHED;
      LDB(B1, 0, 1); STAGE(SB(0, 0), rsB, B0p, t + 2);
      BAR; WAIT_L(0); MMA(0, 1, At, B1); BAR;
      LDA(At, 0, 1); STAGE(SA(0, 0), rsA, A0, t + 2);
      BAR; WAIT_L(0); MMA(1, 0, At, B0); BAR; SCHED;
      STAGE(SB(0, 1), rsB, B1p, t + 2);
      WAIT_V(6); BAR; MMA(1, 1, At, B1); BAR;
      LDB(B0, 1, 0); SCHED; LDA(At, 1, 0); STAGE(SA(0, 1), rsA, A1, t + 2);
      if (MT == 4) WAIT_L(8); else if (MT == 3) WAIT_L(6); else WAIT_L(4); BAR; WAIT_L(0); MMA(0, 0, At, B0); BAR; SCHED;
      LDB(B1, 1, 1); STAGE(SB(1, 0), rsB, B0p, t + 3);
      BAR; WAIT_L(0); MMA(0, 1, At, B1); BAR;
      LDA(At, 1, 1); STAGE(SA(1, 0), rsA, A0, t + 3);
      BAR; WAIT_L(0); MMA(1, 0, At, B0); BAR; SCHED;
      STAGE(SB(1, 1), rsB, B1p, t + 3);
      WAIT_V(6); BAR; MMA(1, 1, At, B1); BAR;
    }
    { LDB(B0, 0, 0); LDA(At, 0, 0); STAGE(SA(1, 1), rsA, A1, nt - 1);
      BAR; WAIT_L(0); MMA(0, 0, At, B0); BAR;
      LDB(B1, 0, 1); BAR; WAIT_L(0); MMA(0, 1, At, B1); BAR;
      LDA(At, 0, 1); WAIT_V(4); BAR; WAIT_L(0); MMA(1, 0, At, B0); MMA(1, 1, At, B1); BAR; }
    {
      LDB(B0, 1, 0); LDA(At, 1, 0); WAIT_V(2); BAR;
      if (has_next) UNIT_PRESTAGE();
      WAIT_L(0); MMA(0, 0, At, B0); BAR;
      LDB(B1, 1, 1); if (has_next) WAIT_V(8); else WAIT_V(0); BAR; WAIT_L(0); MMA(0, 1, At, B1); BAR;
      LDA(At, 1, 1); BAR; WAIT_L(0); MMA(1, 0, At, B0); MMA(1, 1, At, B1); BAR; }
    if (wr == 0) BAR;
    const int ci = brow < NPROMPT ? 0 : 1 + (brow - NPROMPT) / 2048;
    const int ci2 = (brow + TM - 1) < NPROMPT ? 0 : 1 + (brow + TM - 1 - NPROMPT) / 2048;
    const int rsplit = ci2 == 1 ? NPROMPT : NPROMPT + 2048;
    const int te = otid(), le = te & 63, wide = te >> 6;
    const int wr = wide >> 2, wc = wide & 3, fr = le & 15, fq = le >> 4;
    const int rbase = brow + wr * (RH / 2) + fq * 4, cbase = bcol + wc * 32 + fr;
    if (MODE == EPI_SWIGLU) {
#pragma unroll
      for (int ai = 0; ai < 2; ++ai)
#pragma unroll
        for (int m = 0; m < MT; ++m)
#pragma unroll
          for (int j = 0; j < 4; ++j) {
            const int row = rbase + ai * RH + m * 16 + j;
#pragma unroll
            for (int n = 0; n < 2; ++n) {
              float g = acc[ai][0][m][n][j], u = acc[ai][1][m][n][j];
              ea.b0[(size_t)row * DFF + pn * 128 + wc * 32 + n * 16 + fr] = f2bf(g * sigmoid_f(g) * u);
            }
          }
    } else if (MODE == EPI_RESID) {
      float gate[2][2], gate2[2][2], lg[2][2], lb[2][2];
      const bool raw = ea.lng == nullptr;
#pragma unroll
      for (int bj = 0; bj < 2; ++bj)
#pragma unroll
        for (int n = 0; n < 2; ++n) {
          const int col = cbase + bj * HALF + n * 16;
          gate[bj][n] = ea.w * ea.c0[ci * 9216 + col];
          gate2[bj][n] = ea.w * ea.c0[ci2 * 9216 + col];
          lg[bj][n] = raw ? 1.f : ea.lng[col];
          lb[bj][n] = raw ? 0.f : ea.lnb[col];
        }
#pragma unroll
      for (int ai = 0; ai < 2; ++ai)
#pragma unroll
        for (int m = 0; m < MT; ++m) {
          const int r0 = rbase + ai * RH + m * 16;
          float* xb = ea.f0 + (size_t)r0 * D + cbase;
          float xv[4][2][2];
          float2 st[4];
#pragma unroll
          for (int j = 0; j < 4; ++j) {
            const int row = r0 + j;
            const float* src = raw ? (row < NPROMPT ? ea.xin0 + (size_t)row * D : ea.xin1 + (size_t)(row - NPROMPT) * D) + cbase
                                   : xb + (size_t)j * D;
            st[j] = raw ? make_float2(0.f, 1.f) : ea.stats[row];
#pragma unroll
            for (int bj = 0; bj < 2; ++bj)
#pragma unroll
              for (int n = 0; n < 2; ++n) xv[j][bj][n] = src[bj * HALF + n * 16];
          }
#pragma unroll
          for (int j = 0; j < 4; ++j)
#pragma unroll
            for (int bj = 0; bj < 2; ++bj)
#pragma unroll
              for (int n = 0; n < 2; ++n) {
                const float x = (xv[j][bj][n] - st[j].x) * st[j].y * lg[bj][n] + lb[bj][n];
                xb[(size_t)j * D + bj * HALF + n * 16] =
                    ALPHA * x + ((r0 + j) >= rsplit ? gate2[bj][n] : gate[bj][n]) * acc[ai][bj][m][n][j];
              }
        }
    } else if (MODE == EPI_GLU) {
      float bg[2][2];
#pragma unroll
      for (int bj = 0; bj < 2; ++bj)
#pragma unroll
        for (int n = 0; n < 2; ++n) bg[bj][n] = ea.c0[cbase + bj * HALF + n * 16];
#pragma unroll
      for (int ai = 0; ai < 2; ++ai) {
        float gv[MT][4][2][2];
        const bf16_t* gb = ea.cb + (size_t)(rbase + ai * RH) * 256 + cbase;
#pragma unroll
        for (int m = 0; m < MT; ++m)
#pragma unroll
          for (int j = 0; j < 4; ++j)
#pragma unroll
            for (int bj = 0; bj < 2; ++bj)
#pragma unroll
              for (int n = 0; n < 2; ++n) gv[m][j][bj][n] = bf2f(gb[(size_t)(m * 16 + j) * 256 + bj * HALF + n * 16]);
        bf16_t* yb = ea.b0 + (size_t)(rbase + ai * RH) * D + 256 + cbase;
#pragma unroll
        for (int m = 0; m < MT; ++m)
#pragma unroll
          for (int j = 0; j < 4; ++j)
#pragma unroll
            for (int bj = 0; bj < 2; ++bj)
#pragma unroll
              for (int n = 0; n < 2; ++n)
                yb[(size_t)(m * 16 + j) * D + bj * HALF + n * 16] =
                    f2bf(gv[m][j][bj][n] * sigmoid_f(acc[ai][bj][m][n][j] + bg[bj][n]));
      }
    } else {
      float ps[2][2];
#pragma unroll
      for (int bj = 0; bj < 2; ++bj)
#pragma unroll
        for (int n = 0; n < 2; ++n) ps[bj][n] = MODE == EPI_POOL ? ea.c0[cbase + bj * HALF + n * 16] : 1.f;
#pragma unroll
      for (int ai = 0; ai < 2; ++ai)
#pragma unroll
        for (int m = 0; m < MT; ++m)
#pragma unroll
          for (int j = 0; j < 4; ++j) {
            const int row = rbase + ai * RH + m * 16 + j;
#pragma unroll
            for (int bj = 0; bj < 2; ++bj)
#pragma unroll
              for (int n = 0; n < 2; ++n) {
                const int col = cbase + bj * HALF + n * 16;
                float a = acc[ai][bj][m][n][j];
                if (MODE == EPI_F32) ea.f0[(size_t)row * DIN + col] = a;
                else ea.b0[(size_t)row * D + col] = f2bf(a * ps[bj][n]);
              }
          }
    }
  }
#undef UNIT_SETUP
#undef UNIT_PRESTAGE
#undef SA
#undef SB
}

constexpr int T_W1 = 16 * 88, T_W2 = 44 * 16, T_IN = 16 * 24, T_OUT = 256, T_GLU = 16;
constexpr int PER_L = 2 * T_W1 + 2 * T_W2 + T_IN + T_OUT + T_GLU;
DI void convert_units(const Params& p, char* shmc, int unit_begin, int unit_end, int worker, int nworkers) {
  const int tid = otid();
  char* ws = PWS;
  constexpr int NTL = 4;
  __syncthreads();
  for (int u = unit_begin + worker; u < unit_end; u += nworkers) {
    const int it0 = u * NTL;
    bf16_t* dsts[NTL]; int Ks[NTL], modes[NTL], kts[NTL], ntiles[NTL];
    float4 v[NTL][2];
#pragma unroll
    for (int q = 0; q < NTL; ++q) {
      const int it = it0 + q;
      int l = it / PER_L, r = it % PER_L;
      const float* src; bf16_t* dst; int K, N, mode = 0;
      if (r < 2 * T_W1) {
        int s2 = r / T_W1; r %= T_W1;
        src = INP(I_W1) + (size_t)(l * 2 + s2) * 1024 * 5632; dst = (bf16_t*)(ws + OFF_W1T) + (size_t)(l * 2 + s2) * 5632 * 1024;
        K = 1024; N = 5632; mode = 1;
      } else if (r < 2 * T_W1 + 2 * T_W2) {
        r -= 2 * T_W1; int s2 = r / T_W2; r %= T_W2;
        src = INP(I_W2) + (size_t)(l * 2 + s2) * 2816 * 1024; dst = (bf16_t*)(ws + OFF_W2T) + (size_t)(l * 2 + s2) * 1024 * 2816;
        K = 2816; N = 1024;
      } else if (r < 2 * T_W1 + 2 * T_W2 + T_IN) {
        r -= 2 * T_W1 + 2 * T_W2;
        src = INP(I_WIN) + (size_t)l * 1024 * 1536; dst = (bf16_t*)(ws + OFF_WINT) + (size_t)l * 1536 * 1024;
        K = 1024; N = 1536;
      } else if (r < 2 * T_W1 + 2 * T_W2 + T_IN + T_OUT) {
        r -= 2 * T_W1 + 2 * T_W2 + T_IN;
        src = INP(I_WOUT) + (size_t)l * 1024 * 1024; dst = (bf16_t*)(ws + OFF_WOUTT) + (size_t)l * 1024 * 1024;
        K = 1024; N = 1024;
      } else {
        r -= 2 * T_W1 + 2 * T_W2 + T_IN + T_OUT;
        src = INP(I_WGLU) + (size_t)l * 256 * 256; dst = (bf16_t*)(ws + OFF_WGLUT) + (size_t)l * 256 * 256;
        K = 256; N = 256;
      }
      const int nkt = K / 64, kt = r % nkt, ntile = r / nkt;
      dsts[q] = dst; Ks[q] = K; modes[q] = mode; kts[q] = kt; ntiles[q] = ntile;
#pragma unroll
      for (int i = 0; i < 2; ++i) {
        int k = (tid >> 4) + 32 * i, n = (tid & 15) * 4;
        v[q][i] = *(const float4*)(src + (size_t)(kt * 64 + k) * N + ntile * 64 + n);
      }
    }
#pragma unroll
    for (int q = 0; q < NTL; ++q) {
      float* tile = (float*)shmc + q * (64 * 65);
#pragma unroll
      for (int i = 0; i < 2; ++i) {
        int k = (tid >> 4) + 32 * i, n = (tid & 15) * 4;
        tile[k * 65 + n] = v[q][i].x; tile[k * 65 + n + 1] = v[q][i].y; tile[k * 65 + n + 2] = v[q][i].z; tile[k * 65 + n + 3] = v[q][i].w;
      }
    }
    __syncthreads();
#pragma unroll
    for (int q = 0; q < NTL; ++q) {
      const float* tile = (const float*)shmc + q * (64 * 65);
      int n = tid >> 3, kk = (tid & 7) * 8;
      int nsrc = ntiles[q] * 64 + n, nrow = nsrc;
      if (modes[q] == 1) {
        if (nsrc < 2816) nrow = (nsrc >> 7) * 256 + (nsrc & 127);
        else { int mm = nsrc - 2816; nrow = (mm >> 7) * 256 + 128 + (mm & 127); }
      }
      bf16x8 o = pack8(tile[(kk + 0) * 65 + n], tile[(kk + 1) * 65 + n], tile[(kk + 2) * 65 + n], tile[(kk + 3) * 65 + n],
                       tile[(kk + 4) * 65 + n], tile[(kk + 5) * 65 + n], tile[(kk + 6) * 65 + n], tile[(kk + 7) * 65 + n]);
      *(bf16x8*)(dsts[q] + (size_t)nrow * Ks[q] + kts[q] * 64 + kk) = o;
    }
    __syncthreads();
  }
}

DI void prep_phase(const Params& p, char* shmc, int bid, int nblk) {
  const int tid = otid(), wid = tid >> 6, lane = tid & 63;
  char* ws = PWS;
  convert_units(p, shmc, 0, T_W1 / 4, bid, nblk);
  const int gtid = bid * 512 + tid, gn = nblk * 512;
  for (int i = gtid; i < 2 * 65536; i += gn) {
    int l = i >> 16, n = (i >> 8) & 255, k = i & 255;
    int gi = n >> 6, d = n & 63, gj = k >> 6, c = k & 63;
    float v = (gi == gj) ? INP(I_POOLW)[((size_t)(l * 4 + gi) * 64 + c) * 64 + d] : 0.f;
    ((bf16_t*)(ws + OFF_WPOOLT))[i] = f2bf(v);
  }
  {
    float* sc = (float*)shmc + 4 * 64 * 65;
    float* red = sc + 3 * 1024;
    for (int i = tid; i < 3 * 1024; i += 512) {
      int ci = i >> 10, k = i & 1023;
      float v = ci == 0 ? INP(I_CCTX)[k] : INP(I_C)[(ci - 1) * 1024 + k];
      sc[i] = v * sigmoid_f(v);
    }
    __syncthreads();
    for (int it = bid; it < 288; it += nblk) {
      int l = it / 144, cb = it % 144, col = cb * 64 + lane;
      const float* wp = INP(I_WMOD) + (size_t)l * 1024 * 9216 + col;
      float a0 = 0.f, a1 = 0.f, a2 = 0.f;
#pragma unroll 8
      for (int k = wid * 128; k < wid * 128 + 128; ++k) {
        float w = wp[(size_t)k * 9216];
        a0 += sc[k] * w; a1 += sc[1024 + k] * w; a2 += sc[2048 + k] * w;
      }
      red[(wid * 3 + 0) * 64 + lane] = a0; red[(wid * 3 + 1) * 64 + lane] = a1; red[(wid * 3 + 2) * 64 + lane] = a2;
      __syncthreads();
      if (tid < 192) {
        int ci = tid >> 6;
        float s = 0.f;
        for (int w = 0; w < 8; ++w) s += red[(w * 3 + ci) * 64 + lane];
        ((float*)(ws + OFF_MOD))[(size_t)(l * 3 + ci) * 9216 + col] = s + INP(I_BMOD)[l * 9216 + col];
      }
      __syncthreads();
    }
  }
  for (int i = gtid; i < 2 * 2 * 512 * 128; i += gn) {
    int c = i & 127, t = (i >> 7) & 511, b = (i >> 16) & 1, l = i >> 17;
    size_t si = ((size_t)(b * 2 + l) * 512 + t) * 128 + c;
    const size_t sb_ = (size_t)((l * 2 + b) * 2 + (c >> 6)) * 163840;
    ((bf16_t*)(ws + OFF_KS))[sb_ + kfrag_off(t, c & 63)] = f2bf(INP(I_CK)[si]);
    ((bf16_t*)(ws + OFF_VST))[sb_ + vfrag_off(t, c & 63)] = f2bf(INP(I_CV)[si]);
  }
  for (int i = gtid; i < 4096; i += gn) {
    float lre = INP(I_LRE)[i], lim = INP(I_LIM)[i];
    float dt = expf(INP(I_LSTEP)[i >> 6]);
    float e = expf(lre * dt), ang = lim * dt;
    float br = e * cosf(ang), bi = e * sinf(ang);
    float ar = br - 1.f, ai = bi, den = lre * lre + lim * lim;
    float cr = (ar * lre + ai * lim) / den, cim = (ai * lre - ar * lim) / den;
    ((float2*)(ws + OFF_LAMB))[i] = make_float2(br, bi);
    float pr = br, pi = bi;
    for (int s = 0; s < 6; ++s) { float nr = pr * pr - pi * pi, ni = 2.f * pr * pi; pr = nr; pi = ni; }
    ((float2*)(ws + OFF_LAMT))[i] = make_float2(pr, pi);
  }
  for (int i = gtid; i < 64 * 8 * 64; i += gn) {
    const int gidx = i >> 9, nt = (i >> 6) & 7, ln = i & 63, fr = ln & 15, fq = ln >> 4;
    bf16x8 o = (bf16x8){0, 0, 0, 0, 0, 0, 0, 0};
    if (fq < 2) {
      const int n = nt * 8 + (fr >> 1), idx = gidx * 64 + n;
      float lre = INP(I_LRE)[idx], lim = INP(I_LIM)[idx];
      float dt = expf(INP(I_LSTEP)[gidx]);
      float e = expf(lre * dt), ang = lim * dt;
      float br = e * cosf(ang), bi = e * sinf(ang);
      float ar = br - 1.f, ai = bi, den = lre * lre + lim * lim;
      float cr = (ar * lre + ai * lim) / den, cim = (ai * lre - ar * lim) / den;
      float v[8];
#pragma unroll
      for (int j = 0; j < 8; ++j) {
        float xr = INP(I_BRE)[(size_t)idx * 16 + fq * 8 + j], xi = INP(I_BIM)[(size_t)idx * 16 + fq * 8 + j];
        v[j] = (fr & 1) ? cr * xi + cim * xr : cr * xr - cim * xi;
      }
      o = pack8(v[0], v[1], v[2], v[3], v[4], v[5], v[6], v[7]);
    }
    ((bf16x8*)(ws + OFF_BF))[i] = o;
  }
  for (int i = gtid; i < 64 * 4 * 64; i += gn) {
    const int gidx = i >> 8, ks = (i >> 6) & 3, ln = i & 63, fr = ln & 15, fq = ln >> 4;
    const size_t co = ((size_t)gidx * 16 + fr) * 64 + ks * 16 + fq * 4;
    float4 cr = *(const float4*)(INP(I_CRE) + co), cim = *(const float4*)(INP(I_CIM) + co);
    ((bf16x8*)(ws + OFF_CF))[i] = pack8(cr.x, -cim.x, cr.y, -cim.y, cr.z, -cim.z, cr.w, -cim.w);
  }
}

DI void lnmod_phase(const Params& p, int l_ln, int ln_idx, int l_mod, int mod_idx, int bid, int nblk) {
  const int tid = otid(), wid = tid >> 6, lane = tid & 63;
  float* xy = (float*)(PWS + OFF_XY);
  bf16_t* h = (bf16_t*)(PWS + OFF_H);
  const float* modv = (const float*)(PWS + OFF_MOD);
  const int stride = nblk * 8;
  float4 gg[4], bb[4];
  if (l_ln >= 0) {
    const float* g = INP(I_LNG) + (l_ln * 3 + ln_idx) * 1024;
    const float* b = INP(I_LNB) + (l_ln * 3 + ln_idx) * 1024;
#pragma unroll
    for (int i = 0; i < 4; ++i) { gg[i] = *(const float4*)(g + lane * 4 + i * 256); bb[i] = *(const float4*)(b + lane * 4 + i * 256); }
  }
#define LN_SRC(R) (l_ln < 0 ? ((R) < NPROMPT ? INP(I_XP) + (size_t)(R) * D : INP(I_XS) + (size_t)((R) - NPROMPT) * D) : xy + (size_t)(R) * D)
  int row = bid * 8 + wid;
  float4 nv[4];
  if (row < NTOK) {
    const float* src = LN_SRC(row);
#pragma unroll
    for (int i = 0; i < 4; ++i) nv[i] = *(const float4*)(src + lane * 4 + i * 256);
  }
  for (; row < NTOK; row += stride) {
    float4 v[4];
#pragma unroll
    for (int i = 0; i < 4; ++i) v[i] = nv[i];
    if (row + stride < NTOK) {
      const float* src = LN_SRC(row + stride);
#pragma unroll
      for (int i = 0; i < 4; ++i) nv[i] = *(const float4*)(src + lane * 4 + i * 256);
    }
    float4 ma[4], mc[4];
    if (l_mod >= 0) {
      int ci = row < NPROMPT ? 0 : 1 + (row - NPROMPT) / 2048;
      const float* sh = modv + (size_t)(l_mod * 3 + ci) * 9216 + mod_idx * 1024;
#pragma unroll
      for (int i = 0; i < 4; ++i) { ma[i] = *(const float4*)(sh + lane * 4 + i * 256); mc[i] = *(const float4*)(sh + 1024 + lane * 4 + i * 256); }
    }
    if (l_ln >= 0) {
      float s = 0.f;
#pragma unroll
      for (int i = 0; i < 4; ++i) s += v[i].x + v[i].y + v[i].z + v[i].w;
      float mean = wave_sum(s, lane) * (1.f / 1024.f);
      float q = 0.f;
#pragma unroll
      for (int i = 0; i < 4; ++i) {
        v[i].x -= mean; v[i].y -= mean; v[i].z -= mean; v[i].w -= mean;
        q += v[i].x * v[i].x + v[i].y * v[i].y + v[i].z * v[i].z + v[i].w * v[i].w;
      }
      float rstd = rsqrtf(wave_sum(q, lane) * (1.f / 1024.f) + LN_EPS);
      if (lane == 0) ((float2*)(PWS + OFF_STATS))[row] = make_float2(mean, rstd);
#pragma unroll
      for (int i = 0; i < 4; ++i) {
        v[i].x = v[i].x * rstd * gg[i].x + bb[i].x; v[i].y = v[i].y * rstd * gg[i].y + bb[i].y;
        v[i].z = v[i].z * rstd * gg[i].z + bb[i].z; v[i].w = v[i].w * rstd * gg[i].w + bb[i].w;
      }
    }
    if (l_mod < 0) {
      float* dx = p.out + (size_t)row * D;
#pragma unroll
      for (int i = 0; i < 4; ++i) *(float4*)(dx + lane * 4 + i * 256) = v[i];
    }
    if (l_mod >= 0) {
#pragma unroll
      for (int i = 0; i < 4; ++i) {
        u32x2 o = {pk2(v[i].x * (1.f + mc[i].x) + ma[i].x, v[i].y * (1.f + mc[i].y) + ma[i].y),
                   pk2(v[i].z * (1.f + mc[i].z) + ma[i].z, v[i].w * (1.f + mc[i].w) + ma[i].w)};
        *(u32x2*)(h + (size_t)row * D + lane * 4 + i * 256) = o;
      }
    }
  }
#undef LN_SRC
}

struct PostTok { float xq[4], xk[2], xv2[2], xz[4], pc[4], t0[2], t1[4], t2[8], t3[16]; };
DI void post_load(const float* proj, int row, int lane, PostTok& k) {
  const float* pr = proj + (size_t)row * DIN;
  int t, L;
  if (row >= NPROMPT) { t = (row - NPROMPT) & 2047; L = 2048; } else { t = row & 255; L = 256; }
#pragma unroll
  for (int i = 0; i < 4; ++i) { k.xq[i] = pr[512 + i * 64 + lane]; k.xz[i] = pr[1280 + i * 64 + lane]; k.pc[i] = pr[i * 64 + lane]; }
#pragma unroll
  for (int i = 0; i < 2; ++i) { k.xk[i] = pr[768 + i * 64 + lane]; k.xv2[i] = pr[896 + i * 64 + lane]; }
#define PT_TAP(ARR, GI, HW) _Pragma("unroll") for (int d = -(HW); d < (HW); ++d) { \
    const int tt = t + d; const bool ok = tt >= 0 && tt < L; \
    k.ARR[d + (HW)] = pr[(ptrdiff_t)(ok ? d : 0) * DIN + (GI) * 64 + lane]; }
  PT_TAP(t0, 0, 1) PT_TAP(t1, 1, 2) PT_TAP(t2, 2, 4) PT_TAP(t3, 3, 8)
#undef PT_TAP
}

DI void post_phase(const Params& p, int l, char* shmc, int bid, int nblk) {
  const int tid = otid(), wid = tid >> 6, lane = tid & 63;
  char* ws = PWS;
  const float* proj = (const float*)(ws + OFF_R);
  bf16_t* qb = (bf16_t*)(ws + OFF_QB);
  const float qn = INP(I_QN)[l * 64 + lane], kn = INP(I_KN)[l * 64 + lane];
  const int fi = lane & 15;
  const float inv = exp2f(-(float)fi * (13.287712379549449f / 16.f));
  const int stride = nblk * 8;
  int row = bid * 8 + wid;
  PostTok nx;
  if (row < NTOK) post_load(proj, row, lane, nx);
  for (; row < NTOK; row += stride) {
    const PostTok c = nx;
    if (row + stride < NTOK) post_load(proj, row + stride, lane, nx);
    const bool samp = row >= NPROMPT;
    int b, t, L;
    if (samp) { b = (row - NPROMPT) >> 11; t = (row - NPROMPT) & 2047; L = 2048; }
    else { b = row >> 8; t = row & 255; L = 256; }
    float cs = 1.f, sn = 0.f;
    if (samp) {
      float pos = (float)((lane & 31) < 16 ? (t >> 6) : (t & 63));
      float ang = pos * inv;
      cs = cosf(ang); sn = sinf(ang);
    }
    float xq[4], xk[2], xv2[2], xz[4];
#pragma unroll
    for (int i = 0; i < 4; ++i) { xq[i] = c.xq[i]; xz[i] = c.xz[i]; }
#pragma unroll
    for (int i = 0; i < 2; ++i) { xk[i] = c.xk[i]; xv2[i] = c.xv2[i]; }
    {
      bf16_t* df = (bf16_t*)(ws + OFF_DIFF) + (size_t)row * 256;
#define PT_SUM(ARR, GI, HW) { int lo = max(t - (HW), 0), hi = min(t + (HW), L); float s_ = 0.f; \
        _Pragma("unroll") for (int d = -(HW); d < (HW); ++d) { const int tt = t + d; s_ += (tt >= 0 && tt < L) ? c.ARR[d + (HW)] : 0.f; } \
        df[(GI) * 64 + lane] = f2bf(s_ / (float)(hi - lo) - c.pc[GI]); }
      PT_SUM(t0, 0, 1) PT_SUM(t1, 1, 2) PT_SUM(t2, 2, 4) PT_SUM(t3, 3, 8)
#undef PT_SUM
    }
#pragma unroll
    for (int hd = 0; hd < 4; ++hd) {
      float x = xq[hd];
      float ss = wave_sum(x * x, lane) * (1.f / 64.f);
      float xn = x * rsqrtf(ss + RMS_EPS) * qn;
      if (samp) {
        float o = shfl_x(xn, 32, lane);
        xn = lane < 32 ? xn * cs - o * sn : o * sn + xn * cs;
      }
      qb[(size_t)row * 256 + hd * 64 + lane] = f2bf(xn);
    }
#pragma unroll
    for (int hd = 0; hd < 2; ++hd) {
      float x = xk[hd];
      float ss = wave_sum(x * x, lane) * (1.f / 64.f);
      float xn = x * rsqrtf(ss + RMS_EPS) * kn;
      float vv = xv2[hd];
      if (samp) {
        float o = shfl_x(xn, 32, lane);
        xn = lane < 32 ? xn * cs - o * sn : o * sn + xn * cs;
        const size_t sb_ = (size_t)((l * 2 + b) * 2 + hd) * 163840;
        ((bf16_t*)(ws + OFF_KS))[sb_ + kfrag_off(512 + t, lane)] = f2bf(xn);
        ((bf16_t*)(ws + OFF_VST))[sb_ + vfrag_off(512 + t, lane)] = f2bf(vv);
      } else {
        size_t oo = ((size_t)(b * 2 + l) * 256 + t) * 128 + hd * 64 + lane;
        p.out[OUT_K + oo] = xn;
        p.out[OUT_V + oo] = vv;
        const size_t sb_ = (size_t)(b * 2 + hd) * 16384;
        ((bf16_t*)(ws + OFF_KP))[sb_ + kfrag_off(t, lane)] = f2bf(xn);
        ((bf16_t*)(ws + OFF_VPT))[sb_ + vfrag_off(t, lane)] = f2bf(vv);
      }
    }
    {
      float z[4]; float s = 0.f;
#pragma unroll
      for (int i = 0; i < 4; ++i) { z[i] = gelu_t(xz[i]); s += z[i]; }
      float mean = wave_sum(s, lane) * (1.f / 256.f);
      float q = 0.f;
#pragma unroll
      for (int i = 0; i < 4; ++i) { z[i] -= mean; q += z[i] * z[i]; }
      float rstd = rsqrtf(wave_sum(q, lane) * (1.f / 256.f) + LN_EPS);
      bf16_t* vct = (bf16_t*)(ws + OFF_VCT) + (size_t)(row >> 7) * 256 * 128 + (row & 127);
#pragma unroll
      for (int i = 0; i < 4; ++i) {
        int c = i * 64 + lane;
        float vn = z[i] * rstd * INP(I_CLG)[l * 256 + c] + INP(I_CLB)[l * 256 + c];
        vct[(size_t)c * 128] = f2bf(vn);
      }
    }
  }
}

struct AttnState { f32x16 o0, o1; float m, l; };
#define ATT_LOADKV(KF, VF, K0) do { const int kt_ = (K0) >> 5; \
    _Pragma("unroll") for (int s_ = 0; s_ < 4; ++s_) KF[s_] = *(const bf16x8*)(Kb + ((size_t)(kt_ * 4 + s_) * 64 + lane) * 8); \
    _Pragma("unroll") for (int s_ = 0; s_ < 2; ++s_) { \
      VF[s_][0] = *(const bf16x8*)(Vt + ((size_t)((kt_ * 2 + s_) * 2 + 0) * 64 + lane) * 8); \
      VF[s_][1] = *(const bf16x8*)(Vt + ((size_t)((kt_ * 2 + s_) * 2 + 1) * 64 + lane) * 8); } } while (0)

DI void attn_core(const bf16_t* __restrict__ Q, int qrow0, int head, const bf16_t* __restrict__ Kb,
                  const bf16_t* __restrict__ Vt, int kbeg, int kend, int lane, AttnState& st) {
  const int r = lane & 31, hh = lane >> 5;
  bf16x8 qf[4];
  const bf16_t* qp = Q + (size_t)(qrow0 + r) * 256 + head * 64 + 8 * hh;
#pragma unroll
  for (int s = 0; s < 4; ++s) qf[s] = *(const bf16x8*)(qp + 16 * s);
  f32x16 o0, o1;
#pragma unroll
  for (int i = 0; i < 16; ++i) { o0[i] = 0.f; o1[i] = 0.f; }
  float m = -INFINITY, lsum = 0.f;
  const float c = 0.125f * 1.4426950408889634f;
  bf16x8 kf[4], vf[2][2];
  ATT_LOADKV(kf, vf, kbeg);
  for (int k0 = kbeg; k0 < kend; k0 += 32) {
    const int kn = min(k0 + 32, kend - 32);
    bf16x8 kfn[4], vfn[2][2];
    ATT_LOADKV(kfn, vfn, kn);
    f32x16 sa;
#pragma unroll
    for (int i = 0; i < 16; ++i) sa[i] = 0.f;
#pragma unroll
    for (int s = 0; s < 4; ++s) sa = MFMA32(kf[s], qf[s], sa);
    float mx = sa[0];
#pragma unroll
    for (int i = 1; i < 16; ++i) mx = fmaxf(mx, sa[i]);
    mx = fmaxf(mx, shfl_x(mx, 32, lane));
    float mn = fmaxf(m, mx);
    float alpha = __builtin_amdgcn_exp2f((m - mn) * c);
    m = mn;
    float pv[16]; float ps = 0.f;
#pragma unroll
    for (int i = 0; i < 16; ++i) { pv[i] = __builtin_amdgcn_exp2f((sa[i] - mn) * c); ps += pv[i]; }
    lsum = lsum * alpha + ps;
#pragma unroll
    for (int i = 0; i < 16; ++i) { o0[i] *= alpha; o1[i] *= alpha; }
#pragma unroll
    for (int s = 0; s < 2; ++s) {
      bf16x8 pf = pack8(pv[8 * s], pv[8 * s + 1], pv[8 * s + 2], pv[8 * s + 3], pv[8 * s + 4], pv[8 * s + 5], pv[8 * s + 6], pv[8 * s + 7]);
      o0 = MFMA32(vf[s][0], pf, o0);
      o1 = MFMA32(vf[s][1], pf, o1);
    }
#pragma unroll
    for (int s = 0; s < 4; ++s) kf[s] = kfn[s];
#pragma unroll
    for (int s = 0; s < 2; ++s) { vf[s][0] = vfn[s][0]; vf[s][1] = vfn[s][1]; }
  }
  lsum += shfl_x(lsum, 32, lane);
  st.o0 = o0; st.o1 = o1; st.m = m; st.l = lsum;
}

DI void attn_prompt_item(const bf16_t* Q, int qrow0, int head, const bf16_t* Kb, const bf16_t* Vt, bf16_t* Y, int lane) {
  AttnState st;
  attn_core(Q, qrow0, head, Kb, Vt, 0, 256, lane, st);
  const int r = lane & 31, hh = lane >> 5;
  const float il = 1.f / st.l;
  bf16_t* yp = Y + (size_t)(qrow0 + r) * D + 512 + head * 64 + 4 * hh;
#pragma unroll
  for (int g4 = 0; g4 < 4; ++g4) {
    u32x2 a = {pk2(st.o0[4 * g4] * il, st.o0[4 * g4 + 1] * il), pk2(st.o0[4 * g4 + 2] * il, st.o0[4 * g4 + 3] * il)};
    u32x2 b = {pk2(st.o1[4 * g4] * il, st.o1[4 * g4 + 1] * il), pk2(st.o1[4 * g4 + 2] * il, st.o1[4 * g4 + 3] * il)};
    *(u32x2*)(yp + 8 * g4) = a;
    *(u32x2*)(yp + 32 + 8 * g4) = b;
  }
}

DI void attn_sample_item(const Params& p, int l, int it, char* shmc, int wid, int lane) {
  char* ws = PWS;
  float* Osh = (float*)shmc;
  float* Msh = Osh + 8 * 32 * 64;
  float* Lsh = Msh + 8 * 64;
  const int b = it >> 7, head = (it >> 5) & 3, qpair = it & 31;
  const int qsub = wid & 1, ksplit = wid >> 1;
  const int qrow0 = NPROMPT + b * 2048 + (qpair * 2 + qsub) * 32;
  AttnState st;
  attn_core((const bf16_t*)(ws + OFF_QB), qrow0, head, (const bf16_t*)(ws + OFF_KS) + (size_t)((l * 2 + b) * 2 + (head >> 1)) * 163840,
            (const bf16_t*)(ws + OFF_VST) + (size_t)((l * 2 + b) * 2 + (head >> 1)) * 163840, ksplit * 640, ksplit * 640 + 640, lane, st);
  Msh[wid * 64 + lane] = st.m; Lsh[wid * 64 + lane] = st.l;
#pragma unroll
  for (int i = 0; i < 16; ++i) { Osh[(wid * 32 + i) * 64 + lane] = st.o0[i]; Osh[(wid * 32 + 16 + i) * 64 + lane] = st.o1[i]; }
  __syncthreads();
  {
    const float c = 0.125f * 1.4426950408889634f;
    float mm[4], M = -INFINITY;
#pragma unroll
    for (int k = 0; k < 4; ++k) { mm[k] = Msh[(2 * k + qsub) * 64 + lane]; M = fmaxf(M, mm[k]); }
    float sc[4], Lt = 0.f;
#pragma unroll
    for (int k = 0; k < 4; ++k) { sc[k] = __builtin_amdgcn_exp2f((mm[k] - M) * c); Lt += Lsh[(2 * k + qsub) * 64 + lane] * sc[k]; }
    const float il = 1.f / Lt;
    float ov[8];
#pragma unroll
    for (int e = 0; e < 8; ++e) {
      float a = 0.f;
#pragma unroll
      for (int k = 0; k < 4; ++k) a += Osh[((2 * k + qsub) * 32 + ksplit * 8 + e) * 64 + lane] * sc[k];
      ov[e] = a * il;
    }
    const int r = lane & 31, hh = lane >> 5;
    const int dblk = ksplit >> 1, g4 = (ksplit & 1) * 2;
    bf16_t* yp = (bf16_t*)(ws + OFF_YMIX) + (size_t)(qrow0 + r) * D + 512 + head * 64 + dblk * 32 + 8 * g4 + 4 * hh;
    u32x2 a = {pk2(ov[0], ov[1]), pk2(ov[2], ov[3])};
    u32x2 bq = {pk2(ov[4], ov[5]), pk2(ov[6], ov[7])};
    *(u32x2*)yp = a;
    *(u32x2*)(yp + 8) = bq;
  }
  __syncthreads();
}

DI void chunk_item(const Params& p, int l, int ch, int hd, int sp, int lane) {
  const int fr = lane & 15, fq = lane >> 4;
  char* ws = PWS;
  const float* wsrc = INP(I_CWS) + ((size_t)(l * 4 + hd) * 128 + sp * 16 + fr) * 128 + fq * 8;
  const bf16_t* vb = (const bf16_t*)(ws + OFF_VCT) + ((size_t)ch * 256 + hd * 64 + fr) * 128 + fq * 8;
  f32x4 acc[4];
#pragma unroll
  for (int i = 0; i < 4; ++i) acc[i] = (f32x4){0.f, 0.f, 0.f, 0.f};
#pragma unroll
  for (int ks = 0; ks < 4; ++ks) {
    float4 a0 = *(const float4*)(wsrc + ks * 32), a1 = *(const float4*)(wsrc + ks * 32 + 4);
    bf16x8 af = pack8(a0.x, a0.y, a0.z, a0.w, a1.x, a1.y, a1.z, a1.w);
#pragma unroll
    for (int nt = 0; nt < 4; ++nt) {
      bf16x8 bfr = *(const bf16x8*)(vb + (size_t)nt * 16 * 128 + ks * 32);
      acc[nt] = MFMA16(af, bfr, acc[nt]);
    }
  }
  const float* proj = (const float*)(ws + OFF_R);
  bf16_t* ymix = (bf16_t*)(ws + OFF_YMIX);
  float uu[4][4];
#pragma unroll
  for (int j = 0; j < 4; ++j)
#pragma unroll
    for (int nt = 0; nt < 4; ++nt)
      uu[j][nt] = proj[(size_t)(ch * 128 + sp * 16 + fq * 4 + j) * DIN + 1024 + hd * 64 + nt * 16 + fr];
#pragma unroll
  for (int j = 0; j < 4; ++j) {
    int pp = sp * 16 + fq * 4 + j, tok = ch * 128 + pp;
    float bs = INP(I_CBS)[(l * 4 + hd) * 128 + pp];
#pragma unroll
    for (int nt = 0; nt < 4; ++nt) {
      int c = hd * 64 + nt * 16 + fr;
      ymix[(size_t)tok * D + 768 + c] = f2bf(gelu_t(uu[j][nt]) * (acc[nt][j] + bs));
    }
  }
}

constexpr int SSM_BU_LD = 132, SSM_H_LD = 136;
constexpr int SSM_WAVE_LDS = 16 * SSM_BU_LD * 4 + 16 * SSM_H_LD * 2;
#define LDS_FENCE() do { asm volatile("s_waitcnt lgkmcnt(0)" ::: "memory"); __builtin_amdgcn_wave_barrier(); } while (0)

DI void ssm_load_u(const Params& p, int ck, int g, int lane, bf16x8 (&af)[4]) {
  const int fr = lane & 15, fq = lane >> 4;
  const float* ub = (const float*)(PWS + OFF_R) + (size_t)ck * 64 * DIN + 256 + g * 16;
#pragma unroll
  for (int tile = 0; tile < 4; ++tile) {
    if (fq < 2) {
      const float* up = ub + (size_t)(tile * 16 + fr) * DIN + fq * 8;
      float4 a0 = *(const float4*)up, a1 = *(const float4*)(up + 4);
      af[tile] = pack8(a0.x, a0.y, a0.z, a0.w, a1.x, a1.y, a1.z, a1.w);
    } else {
      af[tile] = (bf16x8){0, 0, 0, 0, 0, 0, 0, 0};
    }
  }
}

template <int MODE, int DIR>
DI void ssm_dir(const Params& p, int l, int ck, int g, int lane, const bf16x8 (&af)[4], f32x4 (&yacc)[4], char* wlds) {
  constexpr bool CHAIN = MODE == 1;
  const int fr = lane & 15, fq = lane >> 4;
  char* ws = PWS;
  float* BU = (float*)wlds;
  bf16_t* Hs = (bf16_t*)(wlds + 16 * SSM_BU_LD * 4);
  const int gidx = (l * 2 + DIR) * 16 + g, idx = gidx * 64 + lane;
  bf16x8 bfr[8], cf[4];
#pragma unroll
  for (int nt = 0; nt < 8; ++nt) bfr[nt] = ((const bf16x8*)(ws + OFF_BF))[(gidx * 8 + nt) * 64 + lane];
#pragma unroll
  for (int ks = 0; ks < 4; ++ks) cf[ks] = ((const bf16x8*)(ws + OFF_CF))[(gidx * 4 + ks) * 64 + lane];
  const float2 lam = ((const float2*)(ws + OFF_LAMB))[idx];
  float hr = 0.f, hi = 0.f;
  const bool samp = ck >= 128;
  const int CPS = samp ? 32 : 4;
  const int cs = samp ? ((ck - 128) & 31) : (ck & 3);
  const int b = samp ? ((ck - 128) >> 5) : (ck >> 2);
  if (CHAIN) {
    const float2 lamT = ((const float2*)(ws + OFF_LAMT))[idx];
    const float2* Eb = (const float2*)(ws + OFF_E);
    const int cbase = ck - cs;
    if (samp) {
      size_t si = ((size_t)((b * 2 + l) * 2 + DIR) * 16 + g) * 64 + lane;
      hr = INP(I_SRE)[si]; hi = INP(I_SIM)[si];
    }
    const int nstep = DIR == 0 ? cs : CPS - 1 - cs;
    for (int base = 0; base < nstep; base += 8) {
      float2 ev[8];
#pragma unroll
      for (int k = 0; k < 8; ++k) {
        const int st = min(base + k, nstep - 1);
        const int c2 = DIR == 0 ? st : CPS - 1 - st;
        ev[k] = Eb[((size_t)((cbase + c2) * 16 + g) * 2 + DIR) * 64 + lane];
      }
#pragma unroll
      for (int k = 0; k < 8; ++k)
        if (base + k < nstep) {
          float nr = lamT.x * hr - lamT.y * hi + ev[k].x, ni = lamT.x * hi + lamT.y * hr + ev[k].y; hr = nr; hi = ni;
        }
    }
  }
#pragma unroll
  for (int sb = 0; sb < 4; ++sb) {
    const int tile = DIR ? 3 - sb : sb;
#pragma unroll
    for (int nt = 0; nt < 8; ++nt) {
      f32x4 cz = MFMA16(af[tile], bfr[nt], ((f32x4){0.f, 0.f, 0.f, 0.f}));
#pragma unroll
      for (int j = 0; j < 4; ++j) BU[(fq * 4 + j) * SSM_BU_LD + nt * 16 + fr] = cz[j];
    }
    LDS_FENCE();
#pragma unroll
    for (int q = 0; q < 16; ++q) {
      const int tt = DIR ? 15 - q : q;
      const float2 bu = *(const float2*)(BU + tt * SSM_BU_LD + 2 * lane);
      float nr = lam.x * hr - lam.y * hi + bu.x, ni = lam.x * hi + lam.y * hr + bu.y; hr = nr; hi = ni;
      *(unsigned*)(Hs + tt * SSM_H_LD + 2 * lane) = pk2(hr, hi);
    }
    LDS_FENCE();
#pragma unroll
    for (int ks = 0; ks < 4; ++ks) {
      bf16x8 ah = *(const bf16x8*)(Hs + fr * SSM_H_LD + ks * 32 + fq * 8);
      yacc[tile] = MFMA16(ah, cf[ks], yacc[tile]);
    }
    LDS_FENCE();
  }
  if (!CHAIN) {
    ((float2*)(ws + OFF_E))[((size_t)(ck * 16 + g) * 2 + DIR) * 64 + lane] = make_float2(hr, hi);
  } else if (!samp && ((DIR == 0 && cs == 3) || (DIR == 1 && cs == 0))) {
    size_t so = ((size_t)((b * 2 + l) * 2 + DIR) * 16 + g) * 64 + lane;
    p.out[OUT_SRE + so] = hr; p.out[OUT_SIM + so] = hi;
  }
}

#define SSM1_MODE 2
DI void ssm1_item(const Params& p, int l, int ck, int g, int dir, int lane, char* wlds) {
  bf16x8 af[4]; f32x4 yacc[4];
#pragma unroll
  for (int i = 0; i < 4; ++i) yacc[i] = (f32x4){0.f, 0.f, 0.f, 0.f};
  ssm_load_u(p, ck, g, lane, af);
  if (dir) ssm_dir<SSM1_MODE, 1>(p, l, ck, g, lane, af, yacc, wlds);
  else ssm_dir<SSM1_MODE, 0>(p, l, ck, g, lane, af, yacc, wlds);
}

DI void ssm2_item(const Params& p, int l, int ck, int g, int lane, char* wlds) {
  const int fr = lane & 15, fq = lane >> 4;
  bf16x8 af[4]; f32x4 yacc[4];
#pragma unroll
  for (int i = 0; i < 4; ++i) yacc[i] = (f32x4){0.f, 0.f, 0.f, 0.f};
  ssm_load_u(p, ck, g, lane, af);
  ssm_dir<1, 0>(p, l, ck, g, lane, af, yacc, wlds);
  ssm_dir<1, 1>(p, l, ck, g, lane, af, yacc, wlds);
  char* ws = PWS;
  const float* ub = (const float*)(ws + OFF_R) + (size_t)ck * 64 * DIN + 256 + g * 16;
  bf16_t* sg = (bf16_t*)(ws + OFF_SG);
  const int c = g * 16 + fr;
  const float dd = INP(I_SSMD)[l * 256 + c];
  float uv[4][4];
#pragma unroll
  for (int t4 = 0; t4 < 4; ++t4)
#pragma unroll
    for (int j = 0; j < 4; ++j) uv[t4][j] = ub[(size_t)(t4 * 16 + fq * 4 + j) * DIN + fr];
#pragma unroll
  for (int t4 = 0; t4 < 4; ++t4)
#pragma unroll
    for (int j = 0; j < 4; ++j) {
      size_t row = (size_t)ck * 64 + t4 * 16 + fq * 4 + j;
      sg[row * 256 + c] = f2bf(gelu_t(yacc[t4][j] + dd * uv[t4][j]));
    }
}

DI void ssm1_phase(const Params& p, int l, char* shmc, int bid, int nblk) {
  const int tid = otid(), wid = __builtin_amdgcn_readfirstlane(tid >> 6), lane = tid & 63;
  char* wlds = shmc + wid * SSM_WAVE_LDS;
  for (int it = wid * nblk + bid; it < 6144; it += nblk * 8) ssm1_item(p, l, it >> 5, (it >> 1) & 15, it & 1, lane, wlds);
}

DI void mix_phase(const Params& p, int l, char* shmc, int bid, int nblk) {
  const int tid = otid(), wid = __builtin_amdgcn_readfirstlane(tid >> 6), lane = tid & 63;
  char* ws = PWS;
  for (int it = bid; it < 256; it += nblk) attn_sample_item(p, l, it, shmc, wid, lane);
  for (int it = bid * 8 + wid; it < 1024; it += nblk * 8) {
    int b = it >> 5, head = (it >> 3) & 3, qt = it & 7;
    attn_prompt_item((const bf16_t*)(ws + OFF_QB), b * 256 + qt * 32, head, (const bf16_t*)(ws + OFF_KP) + (size_t)(b * 2 + (head >> 1)) * 16384,
                     (const bf16_t*)(ws + OFF_VPT) + (size_t)(b * 2 + (head >> 1)) * 16384, (bf16_t*)(ws + OFF_YMIX), lane);
  }
  __syncthreads();
  char* wlds = shmc + wid * SSM_WAVE_LDS;
  const int slot = wid * nblk + bid, nslot = nblk * 8;
  for (int it = slot; it < 6144; it += nslot) {
    if (it < 3072) ssm2_item(p, l, it >> 4, it & 15, lane, wlds);
    else { int j = it - 3072; chunk_item(p, l, j >> 5, (j >> 3) & 3, j & 7, lane); }
  }
}

constexpr int N_PHASE = 26;
DI void run_phase(const Params& p, int ph, char* shm, int bid, int nblk) {
  char* ws = PWS;
  if (ph == 0) { prep_phase(p, shm, bid, nblk); return; }
  if (ph == 25) { lnmod_phase(p, 1, 2, -1, 0, bid, nblk); return; }
  const int l = (ph - 1) / 12, s = (ph - 1) % 12;
  const bf16_t* hA = (const bf16_t*)(ws + OFF_H);
  bf16_t* hid = (bf16_t*)(ws + OFF_R);
  float* xy = (float*)(ws + OFF_XY);
  const float* modl = (const float*)(ws + OFF_MOD) + (size_t)l * 3 * 9216;
  EpiArgs ea; ea.f0 = nullptr; ea.b0 = nullptr; ea.c0 = nullptr; ea.cb = nullptr; ea.w = 0.f;
  ea.lng = nullptr; ea.lnb = nullptr; ea.stats = (const float2*)(ws + OFF_STATS); ea.xin0 = nullptr; ea.xin1 = nullptr;
  switch (s) {
    case 0: if (l == 0) lnmod_phase(p, -1, 0, 0, 0, bid, nblk); else lnmod_phase(p, l - 1, 2, l, 0, bid, nblk); break;
    case 1: case 10: {
      int sI = s == 1 ? 0 : 1;
      ea.b0 = hid;
      const bf16_t* w1 = (const bf16_t*)(ws + OFF_W1T) + (size_t)(l * 2 + sI) * 5632 * 1024;
      if (nblk == 256) {
        gemm_phase<1024, EPI_SWIGLU>(hA, w1, 46, 22, ea, shm, bid, nblk);
        gemm_phase<1024, EPI_SWIGLU, 1, 64>(hA, w1, 4, 22, ea, shm, 255 - bid, nblk, 46 * 256);
      } else {
        gemm_phase<1024, EPI_SWIGLU>(hA, w1, 48, 22, ea, shm, bid, nblk);
      }
      if (l == 0 && nblk == 256 && bid < 168) {
        if (sI == 0) convert_units(p, shm, T_W1 / 4, PER_L / 4, bid, 168);
        else convert_units(p, shm, PER_L / 4, 2 * PER_L / 4, bid, 168);
      } else if (l == 0 && nblk != 256 && sI == 0) {
        convert_units(p, shm, T_W1 / 4, 2 * PER_L / 4, bid, nblk);
      }
    } break;
    case 2: case 11: {
      int sI = s == 2 ? 0 : 1;
      ea.f0 = xy; ea.c0 = modl + (s == 2 ? 2 : 8) * 1024; ea.w = 0.5f;
      if (s == 2) {
        if (l == 0) { ea.xin0 = INP(I_XP); ea.xin1 = INP(I_XS); }
        else { ea.lng = INP(I_LNG) + ((l - 1) * 3 + 2) * 1024; ea.lnb = INP(I_LNB) + ((l - 1) * 3 + 2) * 1024; }
      } else { ea.lng = INP(I_LNG) + (l * 3 + 1) * 1024; ea.lnb = INP(I_LNB) + (l * 3 + 1) * 1024; }
      gemm_phase<2816, EPI_RESID, 1, 96>(hid, (const bf16_t*)(ws + OFF_W2T) + (size_t)(l * 2 + sI) * 1024 * 2816, 64, 4, ea, shm, bid, nblk);
    } break;
    case 3: lnmod_phase(p, l, 0, l, 3, bid, nblk); break;
    case 4: {
      ea.f0 = (float*)(ws + OFF_R);
      gemm_phase<1024, EPI_F32, 1, 96>(hA, (const bf16_t*)(ws + OFF_WINT) + (size_t)l * 1536 * 1024, 64, 6, ea, shm, bid, nblk);
    } break;
    case 5: post_phase(p, l, shm, bid, nblk); ssm1_phase(p, l, shm, bid, nblk); break;
    case 6: mix_phase(p, l, shm, bid, nblk); break;
    case 7: {
      ea.b0 = (bf16_t*)(ws + OFF_YMIX); ea.cb = (const bf16_t*)(ws + OFF_SG); ea.c0 = INP(I_BGLU) + l * 256;
      gemm_phase<256, EPI_GLU, 1, 64>((const bf16_t*)(ws + OFF_SG), (const bf16_t*)(ws + OFF_WGLUT) + (size_t)l * 65536, 96, 1, ea, shm, bid, nblk);
      ea.c0 = INP(I_POOLS) + l * 256;
      int bid2 = (bid + nblk - (nblk >> 1)) % nblk;
      gemm_phase<256, EPI_POOL, 1, 64>((const bf16_t*)(ws + OFF_DIFF), (const bf16_t*)(ws + OFF_WPOOLT) + (size_t)l * 65536, 96, 1, ea, shm, bid2, nblk);
    } break;
    case 8: {
      ea.f0 = xy; ea.c0 = modl + 5 * 1024; ea.w = 1.0f;
      ea.lng = INP(I_LNG) + (l * 3 + 0) * 1024; ea.lnb = INP(I_LNB) + (l * 3 + 0) * 1024;
      gemm_phase<1024, EPI_RESID, 1, 96>((const bf16_t*)(ws + OFF_YMIX), (const bf16_t*)(ws + OFF_WOUTT) + (size_t)l * 1024 * 1024, 64, 4, ea, shm, bid, nblk);
    } break;
    case 9: lnmod_phase(p, l, 1, l, 6, bid, nblk); break;
  }
}

__global__ __launch_bounds__(512, 2) void mega(Params p, int ph_lo, int ph_hi) {
  extern __shared__ __attribute__((aligned(16))) char shm[];
  __shared__ uint4 xb_words;
  const int bid = blockIdx.x, nblk = gridDim.x;
  if (threadIdx.x == 0) xb_words = make_uint4(0u, 0u, 0u, 0u);
  __syncthreads();
  const XcdBarrier xb = xcd_barrier_post((unsigned*)(p.ws + OFF_BAR), (volatile LAS unsigned*)&xb_words);
  for (int ph = ph_lo; ph < ph_hi; ++ph) {
    if (ph > ph_lo) {
      if (ph_hi < 0) cg::this_grid().sync();
      xcd_barrier(xb);
    }
    run_phase(p, ph, shm, bid, nblk);
  }
}

extern "C" void kernel_launch(void* const* d_in, const int* in_sizes, int n_in, void* d_out, int out_size, void* d_ws,
                              size_t ws_size, hipStream_t stream) {
  static int grid_blocks = 0;
  if (!grid_blocks) {
    hipFuncSetAttribute((const void*)mega, hipFuncAttributeMaxDynamicSharedMemorySize, GEMM_LDS);
    int dev = 0, cus = 0, per_cu = 0;
    hipGetDevice(&dev);
    hipDeviceGetAttribute(&cus, hipDeviceAttributeMultiprocessorCount, dev);
    hipOccupancyMaxActiveBlocksPerMultiprocessor(&per_cu, mega, 512, GEMM_LDS);
    if (per_cu < 1) per_cu = 1;
    if (per_cu > 1) per_cu = 1;
    grid_blocks = cus * per_cu;
  }
  Params p{};
  for (int i = 0; i < N_IN; ++i) p.in[i] = (const float*)d_in[i];
  p.out = (float*)d_out;
  p.ws = (char*)d_ws;
  hipMemsetAsync((char*)d_ws + OFF_BAR, 0, 16384, stream);
#if ONE_LAUNCH
  int lo = 0, hi = N_PHASE;
  void* args[] = {&p, &lo, &hi};
  hipError_t e = hipLaunchCooperativeKernel((const void*)mega, dim3(grid_blocks), dim3(512), args, GEMM_LDS, stream);
  if (e != hipSuccess) fprintf(stderr, "cooperative launch failed: %s (grid %d)\n", hipGetErrorString(e), grid_blocks);
#else
  for (int ph = 0; ph < N_PHASE; ++ph) mega<<<grid_blocks, 512, GEMM_LDS, stream>>>(p, ph, ph + 1);
#endif
}
```
